# Optimizing an MI355X kernel written in HIP

```python
import math
import jax, jax.numpy as jnp
from jax import lax
import numpy as np

D_MODEL = 1024
BATCH = 32
SEQ = 2048
DEPTH = 2

N_META = 16
CHUNK = 128
Q_BLOCK = 128
CONV_W = 256
CONV_K = 3
RET_HEADS = 4
RET_DK = 64
RET_DV = 64
MLA_HEADS = 8
MLA_NOPE = 64
MLA_ROPE = 32
MLA_V = 64
MLA_QK = MLA_NOPE + MLA_ROPE
Q_LORA = 256
KV_LORA = 128
MIX_OUT = CONV_W + RET_HEADS * RET_DV + MLA_HEADS * MLA_V
D_FF = 4 * D_MODEL
ROPE_BASE = 10000.0
NORM_EPS = 1e-6
IN_SIZES = (CONV_W, CONV_W, CONV_W,
            RET_HEADS * RET_DK, RET_HEADS * RET_DK, RET_HEADS * RET_DV, RET_HEADS * RET_DV,
            Q_LORA, KV_LORA, MLA_ROPE)
D_IN = sum(IN_SIZES)

kernel_name = "hymba_conv_retention_mla_hybrid"


def rms_norm(x, g):
    xf = x.astype(jnp.float32)
    y = xf * lax.rsqrt(jnp.mean(jnp.square(xf), axis=-1, keepdims=True) + NORM_EPS)
    return (y * g.astype(jnp.float32)).astype(x.dtype)


def rope_tables(n_pos, dim, dtype):
    inv = 1.0 / (ROPE_BASE ** (jnp.arange(0, dim, 2, dtype=jnp.float32) / dim))
    ang = jnp.arange(n_pos, dtype=jnp.float32)[:, None] * inv[None, :]
    return jnp.cos(ang).astype(dtype), jnp.sin(ang).astype(dtype)


def apply_rope(x, cos, sin):
    x1, x2 = jnp.split(x, 2, axis=-1)
    c = cos[None, :, None, :]
    s = sin[None, :, None, :]
    return jnp.concatenate([x1 * c - x2 * s, x2 * c + x1 * s], axis=-1)


def causal_dwconv(u, w):
    return lax.conv_general_dilated(
        u, w[:, None, :].astype(u.dtype), window_strides=(1,), padding=[(CONV_K - 1, 0)],
        dimension_numbers=('NWC', 'WIO', 'NWC'), feature_group_count=u.shape[-1])


def chunkwise_retention(q, k, v):
    B, T, H, dk = q.shape
    dv = v.shape[-1]
    pad = CHUNK - N_META
    f32 = jnp.float32
    padw = ((0, 0), (pad, 0), (0, 0), (0, 0))
    qp = jnp.pad(q.astype(f32), padw)
    kp = jnp.pad(k.astype(f32), padw)
    vp = jnp.pad(v.astype(f32), padw)
    n = (T + pad) // CHUNK

    def to_chunks(a):
        return a.reshape(B, n, CHUNK, H, a.shape[-1]).transpose(1, 0, 3, 2, 4)

    log_g = jnp.log1p(-jnp.exp2(-5.0 - jnp.arange(H, dtype=f32)))
    idx = jnp.arange(CHUNK, dtype=f32)
    diff = idx[:, None] - idx[None, :]
    decay = jnp.where(diff >= 0, jnp.exp(jnp.maximum(diff, 0.0)[None] * log_g[:, None, None]), 0.0)
    xi = jnp.exp((idx[None, :] + 1.0) * log_g[:, None])[..., None]
    zeta = jnp.exp((CHUNK - 1.0 - idx[None, :]) * log_g[:, None])[..., None]
    chunk_decay = jnp.exp(CHUNK * log_g)[:, None, None]

    def step(state, xs):
        qc, kc, vc = xs
        scores = jnp.einsum('bhid,bhjd->bhij', qc, kc) * decay
        inner = jnp.einsum('bhij,bhje->bhie', scores, vc)
        cross = jnp.einsum('bhid,bhde->bhie', qc, state) * xi
        new_state = chunk_decay * state + jnp.einsum('bhjd,bhje->bhde', kc * zeta, vc)
        return new_state, inner + cross

    state0 = jnp.zeros((B, H, dk, dv), f32)
    _, out = lax.scan(step, state0, (to_chunks(qp), to_chunks(kp), to_chunks(vp)))
    out = out.transpose(1, 0, 3, 2, 4).reshape(B, n * CHUNK, H, dv)[:, pad:]
    return out.astype(q.dtype)


def block_causal_attention(q, k, v):
    T = q.shape[1]
    scale = 1.0 / math.sqrt(q.shape[-1])
    bounds = [(0, N_META)] + [(s, min(s + Q_BLOCK, T)) for s in range(N_META, T, Q_BLOCK)]
    outs = []
    for s, e in bounds:
        qb, kb, vb = q[:, s:e], k[:, :e], v[:, :e]
        logits = jnp.einsum('bqhd,bkhd->bhqk', qb, kb).astype(jnp.float32) * scale
        mask = jnp.arange(e)[None, :] <= jnp.arange(s, e)[:, None]
        p = jax.nn.softmax(jnp.where(mask, logits, -jnp.inf), axis=-1).astype(vb.dtype)
        outs.append(jnp.einsum('bhqk,bkhd->bqhd', p, vb))
    return jnp.concatenate(outs, axis=1)


def hybrid_layer(x, cos_r, sin_r, cos_m, sin_m, attn_norm_g, w_in, conv_w, ret_gn_g,
                 q_norm_g, w_uq, kv_norm_g, w_ukv, q_head_norm_g, k_head_norm_g, w_out,
                 mlp_norm_g, w_mlp_in, w_mlp_out):
    B, T, _ = x.shape
    h = rms_norm(x, attn_norm_g)
    proj = h @ w_in
    offs = []
    acc = 0
    for sz in IN_SIZES[:-1]:
        acc += sz
        offs.append(acc)
    cb, cc, ch, rq, rk, rv, rg, cq, ckv, kr = jnp.split(proj, offs, axis=-1)

    y_conv = cb * causal_dwconv(cc * ch, conv_w)

    q_r = apply_rope(rq.reshape(B, T, RET_HEADS, RET_DK), cos_r, sin_r)
    k_r = apply_rope(rk.reshape(B, T, RET_HEADS, RET_DK), cos_r, sin_r) * (RET_DK ** -0.5)
    v_r = rv.reshape(B, T, RET_HEADS, RET_DV)
    o_r = rms_norm(chunkwise_retention(q_r, k_r, v_r), ret_gn_g)
    y_ret = jax.nn.silu(rg) * o_r.reshape(B, T, RET_HEADS * RET_DV)

    q_m = (rms_norm(cq, q_norm_g) @ w_uq).reshape(B, T, MLA_HEADS, MLA_QK)
    kv = (rms_norm(ckv, kv_norm_g) @ w_ukv).reshape(B, T, MLA_HEADS, MLA_NOPE + MLA_V)
    k_nope, v_m = kv[..., :MLA_NOPE], kv[..., MLA_NOPE:]
    k_rope = jnp.broadcast_to(kr[:, :, None, :], (B, T, MLA_HEADS, MLA_ROPE))
    k_m = jnp.concatenate([k_nope, k_rope], axis=-1)
    q_m = rms_norm(q_m, q_head_norm_g)
    k_m = rms_norm(k_m, k_head_norm_g)
    q_m = jnp.concatenate([q_m[..., :MLA_NOPE], apply_rope(q_m[..., MLA_NOPE:], cos_m, sin_m)], axis=-1)
    k_m = jnp.concatenate([k_m[..., :MLA_NOPE], apply_rope(k_m[..., MLA_NOPE:], cos_m, sin_m)], axis=-1)
    y_mla = block_causal_attention(q_m, k_m, v_m).reshape(B, T, MLA_HEADS * MLA_V)

    x = x + jnp.concatenate([y_conv, y_ret, y_mla], axis=-1) @ w_out

    u = rms_norm(x, mlp_norm_g) @ w_mlp_in
    return x + jnp.square(jax.nn.relu(u)) @ w_mlp_out


def setup_inputs(seed: int = 0) -> dict:
    key = jax.random.key(seed)
    ks = jax.random.split(key, 16)
    nrm = jax.random.normal

    def gain(k, shape):
        return 1.0 + 0.02 * nrm(k, shape, jnp.float32)

    return {
        "x": nrm(ks[0], (BATCH, SEQ, D_MODEL), jnp.float32),
        "meta_tokens": nrm(ks[1], (N_META, D_MODEL), jnp.float32),
        "attn_norm_g": gain(ks[2], (DEPTH, D_MODEL)),
        "w_in": nrm(ks[3], (DEPTH, D_MODEL, D_IN), jnp.float32) * D_MODEL ** -0.5,
        "conv_w": nrm(ks[4], (DEPTH, CONV_K, CONV_W), jnp.float32) * CONV_K ** -0.5,
        "ret_gn_g": gain(ks[5], (DEPTH, RET_HEADS, RET_DV)),
        "q_norm_g": gain(ks[6], (DEPTH, Q_LORA)),
        "w_uq": nrm(ks[7], (DEPTH, Q_LORA, MLA_HEADS * MLA_QK), jnp.float32) * Q_LORA ** -0.5,
        "kv_norm_g": gain(ks[8], (DEPTH, KV_LORA)),
        "w_ukv": nrm(ks[9], (DEPTH, KV_LORA, MLA_HEADS * (MLA_NOPE + MLA_V)), jnp.float32) * KV_LORA ** -0.5,
        "q_head_norm_g": gain(ks[10], (DEPTH, MLA_QK)),
        "k_head_norm_g": gain(ks[11], (DEPTH, MLA_QK)),
        "w_out": nrm(ks[12], (DEPTH, MIX_OUT, D_MODEL), jnp.float32) * MIX_OUT ** -0.5,
        "mlp_norm_g": gain(ks[13], (DEPTH, D_MODEL)),
        "w_mlp_in": nrm(ks[14], (DEPTH, D_MODEL, D_FF), jnp.float32) * D_MODEL ** -0.5,
        "w_mlp_out": nrm(ks[15], (DEPTH, D_FF, D_MODEL), jnp.float32) * D_FF ** -0.5,
    }


def reference(x, meta_tokens, attn_norm_g, w_in, conv_w, ret_gn_g, q_norm_g, w_uq, kv_norm_g,
              w_ukv, q_head_norm_g, k_head_norm_g, w_out, mlp_norm_g, w_mlp_in, w_mlp_out):
    B = x.shape[0]
    meta = jnp.broadcast_to(meta_tokens.astype(x.dtype)[None], (B, N_META, D_MODEL))
    h = jnp.concatenate([meta, x], axis=1)
    T = h.shape[1]
    cos_r, sin_r = rope_tables(T, RET_DK, h.dtype)
    cos_m, sin_m = rope_tables(T, MLA_ROPE, h.dtype)
    for l in range(DEPTH):
        h = hybrid_layer(h, cos_r, sin_r, cos_m, sin_m, attn_norm_g[l], w_in[l], conv_w[l],
                         ret_gn_g[l], q_norm_g[l], w_uq[l], kv_norm_g[l], w_ukv[l],
                         q_head_norm_g[l], k_head_norm_g[l], w_out[l], mlp_norm_g[l],
                         w_mlp_in[l], w_mlp_out[l])
    return h[:, N_META:]
```

```cpp
#include <hip/hip_runtime.h>
#include <hip/hip_cooperative_groups.h>
#include <cstdio>
#include <cstdint>
#include <cmath>
namespace cg = cooperative_groups;
#ifndef MK_MULTI
#define MK_MULTI 0
#endif
namespace pg8 {
#define PG8_LAS __attribute__((address_space(3)))
typedef unsigned short bf16_t;
typedef short bf16x8 __attribute__((ext_vector_type(8)));
typedef float f32x4 __attribute__((ext_vector_type(4)));
typedef unsigned u32x4 __attribute__((ext_vector_type(4)));
constexpr int BM = 256, BK = 64, HALF = 128, HTB = HALF * BK * 2  , STAGE_BYTES = 8 * HTB, NXCD = 8, WGM = 8;

__host__ __device__ __forceinline__ int lds_byte(int r, int c) { const int st = (r >> 4) * 2 + (c >> 5), rr = r & 15, cc = c & 31, ob = rr * 64 + cc * 2; return st * 1024 + (ob ^ (((ob >> 9) & 1) << 5)); }
__host__ __device__ __forceinline__ void stage_rc(int b, int& R, int& C) { const int st = b / 1024, sb = b % 1024, swz = sb ^ (((sb >> 9) & 1) << 5); R = (st >> 1) * 16 + swz / 64; C = (st & 1) * 32 + (swz % 64) / 2; }
__host__ __device__ __forceinline__ int perm32(int rho) { const int n = rho >> 4, i = rho & 15; return 8 * (i >> 2) + 4 * n + (i & 3); }

__device__ __forceinline__ int opaque_tid() { int t = threadIdx.x; asm volatile("" : "+v"(t)); return t; }
struct Unit { int pm, pn; };
struct Gemm { const bf16_t* A; const bf16_t* Bt; int M, N, K, lda; };

struct StaticOrder {
    int nM, nN, nwg, G, c;
    __host__ __device__ void init(int M, int N, int G_, int c_) { nM = M / BM; nN = N / BM; nwg = nM * nN; G = G_; c = c_; }
    __host__ __device__ bool next(int i, Unit& u) const {
        const long L = (long)i * G + c; if (L >= nwg) return false;
        int wgid = (int)L; { const int q = nwg / NXCD, r = nwg % NXCD, xcd = wgid % NXCD, off = wgid / NXCD; wgid = (xcd < r ? xcd * (q + 1) : r * (q + 1) + (xcd - r) * q) + off; }
        const int nig = WGM * nN, gid = wgid / nig, fm = gid * WGM, gsz = (nM - fm) < WGM ? (nM - fm) : WGM;
        u.pm = fm + ((wgid % nig) % gsz); u.pn = (wgid % nig) / gsz; return true;
    }
    __device__ __forceinline__ void a_ready(const Unit&) const {}
    __device__ __forceinline__ void done(const Unit&) const {}
};

__device__ __forceinline__ unsigned cvt_pk_bf16(float lo, float hi) { unsigned r; asm volatile("v_cvt_pk_bf16_f32 %0, %1, %2" : "=v"(r) : "v"(lo), "v"(hi)); return r; }
struct EpiAny {
    static constexpr bool AFTER_DRAIN = false;
    int mode, perm; bf16_t* O; int ldc; float* X; float* out;
    __device__ __forceinline__ void operator()(const f32x4 (&acc)[2][2][4][2], const Unit& u, int wr, int wc, int fr, int fq) const {
        if (mode < 2) {
            const int row0 = u.pm * BM + wr * 64 + fr; const int col0 = u.pn * BM + wc * 32 + 8 * fq; const bool sq = mode == 1;
#pragma unroll
            for (int ai = 0; ai < 2; ++ai)
#pragma unroll
                for (int m = 0; m < 4; ++m) { bf16_t* rowp = O + (size_t)(row0 + ai * HALF + m * 16) * ldc + col0;
#pragma unroll
                    for (int bj = 0; bj < 2; ++bj) { f32x4 v0 = acc[ai][bj][m][0], v1 = acc[ai][bj][m][1];
                        if (sq) {
#pragma unroll
                            for (int e = 0; e < 4; ++e) { const float a = fmaxf(v0[e], 0.f), b = fmaxf(v1[e], 0.f); v0[e] = a * a; v1[e] = b * b; } }
                        u32x4 w; w.x = cvt_pk_bf16(v0[0], v0[1]); w.y = cvt_pk_bf16(v0[2], v0[3]); w.z = cvt_pk_bf16(v1[0], v1[1]); w.w = cvt_pk_bf16(v1[2], v1[3]);
                        *(u32x4*)(rowp + bj * HALF) = w; } }
        } else {
            const int col0 = u.pn * BM + wc * 32 + 4 * fq; const bool toout = mode == 3;
#pragma unroll
            for (int ai = 0; ai < 2; ++ai)
#pragma unroll
                for (int m = 0; m < 4; ++m) { const int r = u.pm * BM + ai * HALF + wr * 64 + m * 16 + fr; float* xp = X + (size_t)r * 1024 + col0;
                    const int b = r / 2064, t = r - b * 2064; float* op = toout ? out + ((size_t)b * 2048 + (t - 16)) * 1024 + col0 : xp; const bool wr_ok = !toout || (t >= 16);
#pragma unroll
                    for (int bj = 0; bj < 2; ++bj)
#pragma unroll
                        for (int n = 0; n < 2; ++n) { const f32x4 v = *(const f32x4*)(xp + bj * HALF + n * 16) + acc[ai][bj][m][n]; if (wr_ok) *(f32x4*)(op + bj * HALF + n * 16) = v; }
                    asm volatile("" ::: "memory"); }
        }
    }
};

template <class Epi, class Sched, bool ALIGN_EPI = false, bool SP2 = false>
__device__ __forceinline__ void gemm_phase(PG8_LAS unsigned char* lds, const Gemm g, const Sched& S, const Epi& E) {
    const int tid = opaque_tid(), wid = __builtin_amdgcn_readfirstlane(tid >> 6), lane = tid & 63, wr = wid >> 2, wc = wid & 3, fr = lane & 15, fq = lane >> 4;
    const int K = g.K, nt = K / BK;
    unsigned voffA[2], voffB[2];
#pragma unroll
    for (int i = 0; i < 2; ++i) { int R, C; stage_rc(tid * 16 + i * 8192, R, C); const int Rb = E.perm ? ((R & ~31) + perm32(R & 31)) : R;
        voffA[i] = (unsigned)(R * g.lda + C) * 2u; voffB[i] = (unsigned)(Rb * K + C) * 2u; }
    const size_t kstep = (size_t)(BK * 2);
    const size_t hstepA = (size_t)HALF * g.lda * 2, hstepB = (size_t)HALF * K * 2;
    const size_t tstepA = 2 * hstepA, tstepB = 2 * hstepB;
    const unsigned ldsw = (unsigned)wid * 1024u;
    const int aoff = lds_byte(wr * 64 + fr, fq * 8), boff = lds_byte(wc * 32 + fr, fq * 8);
#define PG8_SA(b, h) (((b) * 2 + (h)) * HTB)
#define PG8_SB(b, h) ((4 + (b) * 2 + (h)) * HTB)
#define PG8_STAGE(bufoff, gbase, voff) do { _Pragma("unroll") for (int _i = 0; _i < 2; ++_i) \
        __builtin_amdgcn_global_load_lds((const unsigned*)((const char*)(gbase) + (voff)[_i]), (PG8_LAS unsigned*)(lds + (bufoff) + ldsw + _i * 8192), 16, 0, 0); } while (0)
#define PG8_LDA(dst, b, h) do { _Pragma("unroll") for (int m = 0; m < 4; ++m) _Pragma("unroll") for (int k = 0; k < 2; ++k) dst[m][k] = *(const PG8_LAS bf16x8*)(lds + PG8_SA(b, h) + aoff + m * 2048 + k * 1024); } while (0)
#define PG8_LDB(dst, b, h) do { _Pragma("unroll") for (int n = 0; n < 2; ++n) _Pragma("unroll") for (int k = 0; k < 2; ++k) dst[n][k] = *(const PG8_LAS bf16x8*)(lds + PG8_SB(b, h) + boff + n * 2048 + k * 1024); } while (0)
#define PG8_MMA(ai, bj, At, Bt) do { __builtin_amdgcn_s_setprio(1); _Pragma("unroll") for (int m = 0; m < 4; ++m) _Pragma("unroll") for (int n = 0; n < 2; ++n) _Pragma("unroll") for (int k = 0; k < 2; ++k) \
        acc[ai][bj][m][n] = __builtin_amdgcn_mfma_f32_16x16x32_bf16(Bt[n][k], At[m][k], acc[ai][bj][m][n], 0, 0, 0); __builtin_amdgcn_s_setprio(0); } while (0)
#define PG8_WAIT_V(n) asm volatile("s_waitcnt vmcnt(" #n ")" ::: "memory")
#define PG8_WAIT_L(n) asm volatile("s_waitcnt lgkmcnt(" #n ")" ::: "memory")
#define PG8_BAR __builtin_amdgcn_s_barrier()
#define PG8_SCHED __builtin_amdgcn_sched_barrier(0)
    Unit cur, nxt; int ui = 0;
    if (!S.next(0, cur)) return;
    f32x4 acc[2][2][4][2];
#pragma unroll
    for (int a = 0; a < 2; ++a)
#pragma unroll
        for (int b = 0; b < 2; ++b)
#pragma unroll
            for (int m = 0; m < 4; ++m)
#pragma unroll
                for (int n = 0; n < 2; ++n) acc[a][b][m][n] = (f32x4){0.f, 0.f, 0.f, 0.f};
    bf16x8 At[4][2], B0[2][2], B1[2][2];
    const char* cA = (const char*)g.A + (size_t)cur.pm * tstepA; const char* cB = (const char*)g.Bt + (size_t)cur.pn * tstepB;
    S.a_ready(cur);
    if constexpr (SP2) {
        PG8_STAGE(PG8_SB(0, 0), cB, voffB); PG8_STAGE(PG8_SB(0, 1), cB + hstepB, voffB); PG8_STAGE(PG8_SA(0, 0), cA, voffA); PG8_STAGE(PG8_SA(0, 1), cA + hstepA, voffA);
        if (wr == 1) PG8_BAR;
        PG8_WAIT_V(2); PG8_BAR;
        PG8_STAGE(PG8_SB(1, 0), cB + kstep, voffB); PG8_STAGE(PG8_SA(1, 0), cA + kstep, voffA); PG8_STAGE(PG8_SB(1, 1), cB + hstepB + kstep, voffB);
        PG8_WAIT_V(6); PG8_BAR;
    } else {
        PG8_STAGE(PG8_SB(0, 0), cB, voffB); PG8_STAGE(PG8_SA(0, 0), cA, voffA); PG8_STAGE(PG8_SB(0, 1), cB + hstepB, voffB); PG8_STAGE(PG8_SA(0, 1), cA + hstepA, voffA);
        if (wr == 1) PG8_BAR;
        PG8_WAIT_V(4); PG8_BAR;
        PG8_STAGE(PG8_SB(1, 0), cB + kstep, voffB); PG8_STAGE(PG8_SA(1, 0), cA + kstep, voffA); PG8_STAGE(PG8_SB(1, 1), cB + hstepB + kstep, voffB);
        PG8_WAIT_V(6); PG8_BAR;
    }
    for (;;) {
        const bool has_next = S.next(ui + 1, nxt);
        const char* nA = has_next ? (const char*)g.A + (size_t)nxt.pm * tstepA : cA; const char* nB = has_next ? (const char*)g.Bt + (size_t)nxt.pn * tstepB : cB;
        for (int t = 0; t < nt; t += 2) {
            const bool last = (t == nt - 2);
            const char* a1 = cA + (size_t)(t + 1) * kstep;
            const char* a2 = last ? nA : cA + (size_t)(t + 2) * kstep; const char* b2 = last ? nB : cB + (size_t)(t + 2) * kstep;
            const char* a3 = a2 + kstep; const char* b3 = b2 + kstep;
            if (last && has_next) S.a_ready(nxt);
            if constexpr (SP2) {
            PG8_LDB(B0, 0, 0); PG8_LDB(B1, 0, 1); PG8_SCHED; PG8_LDA(At, 0, 0); PG8_STAGE(PG8_SA(1, 1), a1 + hstepA, voffA);
            PG8_WAIT_V(8); PG8_WAIT_L(0); PG8_BAR; PG8_MMA(0, 0, At, B0); PG8_MMA(0, 1, At, B1); PG8_BAR; PG8_SCHED;
            PG8_LDA(At, 0, 1); PG8_STAGE(PG8_SB(0, 0), b2, voffB); PG8_STAGE(PG8_SB(0, 1), b2 + hstepB, voffB); PG8_STAGE(PG8_SA(0, 0), a2, voffA);
            PG8_WAIT_V(8); PG8_WAIT_L(0); PG8_BAR; PG8_MMA(1, 0, At, B0); PG8_MMA(1, 1, At, B1); PG8_BAR; PG8_SCHED;
            PG8_LDB(B0, 1, 0); PG8_LDB(B1, 1, 1); PG8_SCHED; PG8_LDA(At, 1, 0); PG8_STAGE(PG8_SA(0, 1), a2 + hstepA, voffA);
            PG8_WAIT_V(8); PG8_WAIT_L(0); PG8_BAR; PG8_MMA(0, 0, At, B0); PG8_MMA(0, 1, At, B1); PG8_BAR; PG8_SCHED;
            PG8_LDA(At, 1, 1); PG8_STAGE(PG8_SB(1, 0), b3, voffB); PG8_STAGE(PG8_SB(1, 1), b3 + hstepB, voffB); PG8_STAGE(PG8_SA(1, 0), a3, voffA);
            PG8_WAIT_V(8); PG8_WAIT_L(0); PG8_BAR; PG8_MMA(1, 0, At, B0); PG8_MMA(1, 1, At, B1); PG8_BAR; PG8_SCHED;
            } else {
            PG8_LDB(B0, 0, 0); PG8_SCHED; PG8_LDA(At, 0, 0); PG8_STAGE(PG8_SA(1, 1), a1 + hstepA, voffA);
            PG8_WAIT_L(8); PG8_BAR; PG8_WAIT_L(0); PG8_MMA(0, 0, At, B0); PG8_BAR; PG8_SCHED;
            PG8_LDB(B1, 0, 1); PG8_STAGE(PG8_SB(0, 0), b2, voffB);
            PG8_BAR; PG8_WAIT_L(0); PG8_MMA(0, 1, At, B1); PG8_BAR;
            PG8_LDA(At, 0, 1); PG8_STAGE(PG8_SA(0, 0), a2, voffA);
            PG8_BAR; PG8_WAIT_L(0); PG8_MMA(1, 0, At, B0); PG8_BAR; PG8_SCHED;
            PG8_STAGE(PG8_SB(0, 1), b2 + hstepB, voffB);
            PG8_WAIT_V(6); PG8_BAR; PG8_MMA(1, 1, At, B1); PG8_BAR;
            PG8_LDB(B0, 1, 0); PG8_SCHED; PG8_LDA(At, 1, 0); PG8_STAGE(PG8_SA(0, 1), a2 + hstepA, voffA);
            PG8_WAIT_L(8); PG8_BAR; PG8_WAIT_L(0); PG8_MMA(0, 0, At, B0); PG8_BAR; PG8_SCHED;
            PG8_LDB(B1, 1, 1); PG8_STAGE(PG8_SB(1, 0), b3, voffB);
            PG8_BAR; PG8_WAIT_L(0); PG8_MMA(0, 1, At, B1); PG8_BAR;
            PG8_LDA(At, 1, 1); PG8_STAGE(PG8_SA(1, 0), a3, voffA);
            PG8_BAR; PG8_WAIT_L(0); PG8_MMA(1, 0, At, B0); PG8_BAR; PG8_SCHED;
            PG8_STAGE(PG8_SB(1, 1), b3 + hstepB, voffB);
            PG8_WAIT_V(6); PG8_BAR; PG8_MMA(1, 1, At, B1); PG8_BAR;
            }
        }
        if constexpr (ALIGN_EPI) { if (wr == 0) PG8_BAR; }
        if constexpr (!Epi::AFTER_DRAIN) { E(acc, cur, wr, wc, fr, fq); S.done(cur); }
        if (!has_next) break;
#pragma unroll
        for (int a = 0; a < 2; ++a)
#pragma unroll
            for (int b = 0; b < 2; ++b)
#pragma unroll
                for (int m = 0; m < 4; ++m)
#pragma unroll
                    for (int n = 0; n < 2; ++n) acc[a][b][m][n] = (f32x4){0.f, 0.f, 0.f, 0.f};
        cur = nxt; cA = nA; cB = nB; ++ui;
        if constexpr (ALIGN_EPI) { if (wr == 1) PG8_BAR; }
    }
    PG8_WAIT_V(0);
    if constexpr (!ALIGN_EPI) { if (wr == 0) PG8_BAR; }
    PG8_BAR;
    if constexpr (Epi::AFTER_DRAIN) { E.fused(acc, cur, wr, wc, fr, fq, lds, wid, lane); S.done(cur); }
#undef PG8_SA
#undef PG8_SB
#undef PG8_STAGE
#undef PG8_LDA
#undef PG8_LDB
#undef PG8_MMA
#undef PG8_WAIT_V
#undef PG8_WAIT_L
#undef PG8_BAR
#undef PG8_SCHED
}
}

#define GAS __attribute__((address_space(1)))
#define LAS __attribute__((address_space(3)))
typedef unsigned short bf16;
typedef unsigned u32x4 __attribute__((ext_vector_type(4)));
typedef unsigned u32x2 __attribute__((ext_vector_type(2)));
typedef float f32x4 __attribute__((ext_vector_type(4)));
typedef float f32x2 __attribute__((ext_vector_type(2)));
typedef short bf16x8 __attribute__((ext_vector_type(8)));
typedef float f32x16 __attribute__((ext_vector_type(16)));
constexpr int DM = 1024, BATCH = 32, SEQ = 2048, NMETA = 16, TT = SEQ + NMETA, M = BATCH * TT, DIN = 2208, DINP = 2304, DFF = 4096, DEPTH = 2;
static_assert(M % 256 == 0, "row tiles");
constexpr int C_CB = 0, C_CC = 256, C_CH = 512, C_RQ = 768, C_RK = 1024, C_RV = 1280, C_RG = 1536, C_CQ = 1792, C_CKV = 2048, C_KR = 2176;
constexpr float EPS = 1e-6f;
constexpr float QSCALE = 0.10206207261596575f * 1.4426950408889634f;
constexpr size_t MiB = 1u << 20;
constexpr size_t WS_RT = 1 * MiB, WS_MT = 1 * MiB + 768 * 1024;
constexpr size_t WS_WIN = 4 * MiB, WS_WUQ = 13 * MiB, WS_WUKV = 14 * MiB, WS_WOUT = 15 * MiB, WS_W1 = 19 * MiB, WS_W2 = 35 * MiB;
constexpr size_t WS_X = 52 * MiB, WS_XN = 310 * MiB, WS_PROJ = 440 * MiB, WS_QRAW = 731 * MiB, WS_KV = 828 * MiB, WS_H = 440 * MiB, WS_END = 957 * MiB;
static_assert(WS_X + (size_t)M * DM * 4 <= WS_XN && WS_XN + (size_t)M * DM * 2 <= WS_PROJ && WS_PROJ + (size_t)M * DINP * 2 <= WS_QRAW && WS_QRAW + (size_t)M * 768 * 2 <= WS_KV &&
              WS_KV + (size_t)M * 1024 * 2 <= WS_END && WS_H + (size_t)M * DFF * 2 <= WS_END, "d_ws map");
constexpr int NWAVES = 8, LDS_BYTES = 147456;

__device__ __forceinline__ unsigned f2bf(float f) { unsigned u = __builtin_bit_cast(unsigned, f); return (u + 0x7fffu + ((u >> 16) & 1u)) >> 16; }
__device__ __forceinline__ unsigned pk2(float lo, float hi) { return f2bf(lo) | (f2bf(hi) << 16); }
__device__ __forceinline__ float bflo(unsigned w) { return __uint_as_float(w << 16); }
__device__ __forceinline__ float bfhi(unsigned w) { return __uint_as_float(w & 0xffff0000u); }
__device__ __forceinline__ float bf1(bf16 h) { return __uint_as_float((unsigned)h << 16); }
__device__ __forceinline__ float wave_sum(float v) {
#pragma unroll
    for (int o = 1; o < 64; o <<= 1) v += __shfl_xor(v, o);
    return v;
}
__device__ __forceinline__ float half_sum(float v) {
#pragma unroll
    for (int o = 1; o < 32; o <<= 1) v += __shfl_xor(v, o);
    return v;
}

namespace att {
typedef float f32x2_t __attribute__((ext_vector_type(2))); typedef __bf16 bf16x2_t __attribute__((ext_vector_type(2)));
__device__ __forceinline__ unsigned cvtpk(float lo, float hi) { f32x2_t v = {lo, hi}; bf16x2_t b = __builtin_convertvector(v, bf16x2_t); return __builtin_bit_cast(unsigned, b); }
constexpr int VP = 144;
template <int DQK, bool SM>
__device__ __forceinline__ void unit(LAS unsigned char* lds, const bf16* Q, int ldq, const bf16* K, int ldk, const bf16* V, int ldv, bf16* O, int ldo,
                                     const bf16* G, int ldg, const float* gain, float lg2, int q0, int qend) {
    constexpr int KP = DQK * 2 + 16, CH = DQK / 8, ND = DQK / 16, KB = 64 * KP, VB = 64 * VP;
    const int tid = pg8::opaque_tid(), lane = tid & 63, wid = __builtin_amdgcn_readfirstlane(tid >> 6), r32 = lane & 31, hi = lane >> 5;
    LAS unsigned char* Kb = lds; LAS unsigned char* Vb = lds + 2 * KB;
    const int q0w = q0 + 32 * wid, tq = q0w + r32;
    const bool wact = q0w < qend;
    bf16x8 qr[ND];
    { const int qrow = tq < TT ? tq : TT - 1; const bf16* qp = Q + (size_t)qrow * ldq + 8 * hi;
#pragma unroll
      for (int d0 = 0; d0 < ND; ++d0) qr[d0] = *(const bf16x8*)(qp + 16 * d0); }
    const int ntiles = (qend - 1) / 64 + 1;
    const int kkey0 = tid / CH, kch0 = tid % CH, kkey1 = (tid + 512) / CH, kch1 = (tid + 512) % CH;
    const bool has2 = (64 * CH > 512) && (tid + 512 < 64 * CH);
    const int vkey = tid & 63, vch = tid >> 6;
    const int pr32 = (r32 & 0x13) | ((r32 & 4) << 1) | ((r32 & 8) >> 1);
    u32x4 kreg0, kreg1 = {0u, 0u, 0u, 0u}, vreg;
#define ATT_LOAD(j) do { int r0_ = 64 * (j) + kkey0; r0_ = r0_ < TT ? r0_ : TT - 1; kreg0 = *(const u32x4*)(K + (size_t)r0_ * ldk + 8 * kch0); \
        if (has2) { int r1_ = 64 * (j) + kkey1; r1_ = r1_ < TT ? r1_ : TT - 1; kreg1 = *(const u32x4*)(K + (size_t)r1_ * ldk + 8 * kch1); } \
        int rv_ = 64 * (j) + vkey; rv_ = rv_ < TT ? rv_ : TT - 1; vreg = *(const u32x4*)(V + (size_t)rv_ * ldv + 8 * vch); } while (0)
#define ATT_STORE(buf) do { *(LAS u32x4*)(Kb + (buf) * KB + kkey0 * KP + 16 * kch0) = kreg0; if (has2) *(LAS u32x4*)(Kb + (buf) * KB + kkey1 * KP + 16 * kch1) = kreg1; \
        LAS unsigned char* vd_ = Vb + (buf) * VB + (8 * vch) * VP + 2 * vkey; \
        _Pragma("unroll") for (int i_ = 0; i_ < 8; ++i_) { const unsigned w_ = vreg[i_ >> 1]; *(LAS unsigned short*)(vd_ + i_ * VP) = (unsigned short)((i_ & 1) ? (w_ >> 16) : (w_ & 0xffffu)); } } while (0)
    f32x16 o0, o1;
#pragma unroll
    for (int r = 0; r < 16; ++r) { o0[r] = 0.f; o1[r] = 0.f; }
    float m_run = -INFINITY, l_run = 0.f;
    ATT_LOAD(0); ATT_STORE(0); __syncthreads();
    for (int j = 0; j < ntiles; ++j) {
        const int buf = j & 1;
        if (j + 1 < ntiles) ATT_LOAD(j + 1);
        if (wact && 64 * j <= q0w + 31) {
            const LAS unsigned char* kb = Kb + buf * KB + pr32 * KP + 16 * hi;
            f32x16 s0, s1;
#pragma unroll
            for (int r = 0; r < 16; ++r) { s0[r] = 0.f; s1[r] = 0.f; }
#pragma unroll
            for (int d0 = 0; d0 < ND; ++d0) {
                const bf16x8 k0 = *(const LAS bf16x8*)(kb + 32 * d0), k1 = *(const LAS bf16x8*)(kb + 32 * KP + 32 * d0);
                s0 = __builtin_amdgcn_mfma_f32_32x32x16_bf16(k0, qr[d0], s0, 0, 0, 0);
                s1 = __builtin_amdgcn_mfma_f32_32x32x16_bf16(k1, qr[d0], s1, 0, 0, 0);
            }
            const int kbase = 64 * j + 8 * hi;
            if (SM) {
                if (64 * j + 63 > q0w) {
#pragma unroll
                    for (int r = 0; r < 16; ++r) { const int kk = kbase + 16 * (r >> 3) + (r & 7); if (kk > tq) s0[r] = -INFINITY; if (kk + 32 > tq) s1[r] = -INFINITY; }
                }
                float mx = fmaxf(s0[0], s1[0]);
#pragma unroll
                for (int r = 1; r < 16; ++r) mx = fmaxf(mx, fmaxf(s0[r], s1[r]));
                mx = fmaxf(mx, __shfl_xor(mx, 32));
                const float mn = fmaxf(m_run, mx), alpha = __builtin_amdgcn_exp2f(m_run - mn); m_run = mn;
                float ps = 0.f;
#pragma unroll
                for (int r = 0; r < 16; ++r) { s0[r] = __builtin_amdgcn_exp2f(s0[r] - mn); s1[r] = __builtin_amdgcn_exp2f(s1[r] - mn); ps += s0[r] + s1[r]; }
                l_run = l_run * alpha + ps;
#pragma unroll
                for (int r = 0; r < 16; ++r) { o0[r] *= alpha; o1[r] *= alpha; }
            } else {
                const int dk0 = tq - kbase;
#pragma unroll
                for (int r = 0; r < 16; ++r) { const int dk = dk0 - (16 * (r >> 3) + (r & 7));
                    const float w0 = dk >= 0 ? __builtin_amdgcn_exp2f(lg2 * (float)dk) : 0.f, w1 = dk >= 32 ? __builtin_amdgcn_exp2f(lg2 * (float)(dk - 32)) : 0.f;
                    s0[r] *= w0; s1[r] *= w1; }
            }
            u32x4 pw[4];
#pragma unroll
            for (int ks = 0; ks < 2; ++ks) {
                pw[ks] = (u32x4){cvtpk(s0[8 * ks], s0[8 * ks + 1]), cvtpk(s0[8 * ks + 2], s0[8 * ks + 3]), cvtpk(s0[8 * ks + 4], s0[8 * ks + 5]), cvtpk(s0[8 * ks + 6], s0[8 * ks + 7])};
                pw[2 + ks] = (u32x4){cvtpk(s1[8 * ks], s1[8 * ks + 1]), cvtpk(s1[8 * ks + 2], s1[8 * ks + 3]), cvtpk(s1[8 * ks + 4], s1[8 * ks + 5]), cvtpk(s1[8 * ks + 6], s1[8 * ks + 7])};
            }
            const LAS unsigned char* vb = Vb + buf * VB + r32 * VP + 16 * hi;
#pragma unroll
            for (int ks = 0; ks < 4; ++ks) {
                const bf16x8 v0 = *(const LAS bf16x8*)(vb + 32 * ks), v1 = *(const LAS bf16x8*)(vb + 32 * VP + 32 * ks);
                const bf16x8 pf = __builtin_bit_cast(bf16x8, pw[ks]);
                o0 = __builtin_amdgcn_mfma_f32_32x32x16_bf16(v0, pf, o0, 0, 0, 0);
                o1 = __builtin_amdgcn_mfma_f32_32x32x16_bf16(v1, pf, o1, 0, 0, 0);
            }
        }
        if (j + 1 < ntiles) ATT_STORE(buf ^ 1);
        __syncthreads();
    }
#undef ATT_LOAD
#undef ATT_STORE
    if (wact) {
        if (SM) {
            const float l = l_run + __shfl_xor(l_run, 32), inv = 1.f / l;
            if (tq < qend) { bf16* op = O + (size_t)tq * ldo + 4 * hi;
#pragma unroll
                for (int g = 0; g < 4; ++g) {
                    u32x2 a, b; a.x = cvtpk(o0[4 * g] * inv, o0[4 * g + 1] * inv); a.y = cvtpk(o0[4 * g + 2] * inv, o0[4 * g + 3] * inv);
                    b.x = cvtpk(o1[4 * g] * inv, o1[4 * g + 1] * inv); b.y = cvtpk(o1[4 * g + 2] * inv, o1[4 * g + 3] * inv);
                    *(u32x2*)(op + 8 * g) = a; *(u32x2*)(op + 32 + 8 * g) = b; } }
        } else {
            float ss = 0.f;
#pragma unroll
            for (int r = 0; r < 16; ++r) ss += o0[r] * o0[r] + o1[r] * o1[r];
            ss += __shfl_xor(ss, 32);
            const float rs = 1.0f / sqrtf(ss * (1.f / 64.f) + EPS);
            if (tq < qend) { bf16* op = O + (size_t)tq * ldo + 4 * hi; const bf16* gp = G + (size_t)tq * ldg + 4 * hi; const float* gn = gain + 4 * hi;
#pragma unroll
                for (int g = 0; g < 4; ++g) {
#pragma unroll
                    for (int db = 0; db < 2; ++db) {
                        const u32x2 gw = *(const u32x2*)(gp + 32 * db + 8 * g); const f32x4 ga = *(const f32x4*)(gn + 32 * db + 8 * g);
                        float gv[4] = {bflo(gw.x), bfhi(gw.x), bflo(gw.y), bfhi(gw.y)}; float y[4];
#pragma unroll
                        for (int e = 0; e < 4; ++e) { const float ov = db ? o1[4 * g + e] : o0[4 * g + e]; const float sg = gv[e] / (1.f + __expf(-gv[e])); y[e] = ov * rs * ga[e] * sg; }
                        u32x2 w; w.x = cvtpk(y[0], y[1]); w.y = cvtpk(y[2], y[3]); *(u32x2*)(op + 32 * db + 8 * g) = w; } } }
        }
    }
}
}

struct Args { const float* in[16]; float* out; unsigned char* ws; int ph_lo, ph_hi; };
typedef const __attribute__((address_space(4))) Args* KArgsP;
#define RT   ((f32x2*)(ws + WS_RT))
#define MT   ((f32x2*)(ws + WS_MT))
#define WIN  ((bf16*)(ws + WS_WIN))
#define WUQ  ((bf16*)(ws + WS_WUQ))
#define WUKV ((bf16*)(ws + WS_WUKV))
#define WOUT ((bf16*)(ws + WS_WOUT))
#define W1   ((bf16*)(ws + WS_W1))
#define W2   ((bf16*)(ws + WS_W2))
#define XF   ((float*)(ws + WS_X))
#define XN   ((bf16*)(ws + WS_XN))
#define MIX  ((bf16*)(ws + WS_XN))
#define PROJ ((bf16*)(ws + WS_PROJ))
#define QRAW ((bf16*)(ws + WS_QRAW))
#define KVR  ((bf16*)(ws + WS_KV))
#define HB   ((bf16*)(ws + WS_H))
enum { I_X = 0, I_META, I_ANG, I_WIN, I_CONVW, I_RETG, I_QNG, I_WUQ, I_KVNG, I_WUKV, I_QHG, I_KHG, I_WOUT, I_MLPG, I_W1, I_W2 };
constexpr int NPHASE = 10 * DEPTH;

__device__ __forceinline__ void p0_transpose_item(const float* W, const float* gk, int K, int N, bf16* WT, LAS float* scr, int item, int lane) {
    const int nblk = N / 32, kb = item / nblk, nb = item % nblk, k0 = 64 * kb, n0 = 32 * nb;
#pragma unroll 8
    for (int i = 0; i < 32; ++i) { const int kk = 2 * i + (lane >> 5); const float gv = gk ? gk[k0 + kk] : 1.f; scr[kk * 33 + (lane & 31)] = W[(size_t)(k0 + kk) * N + n0 + (lane & 31)] * gv; }
    asm volatile("s_waitcnt lgkmcnt(0)" ::: "memory");
    const int c = lane & 7;
#pragma unroll
    for (int j = 0; j < 4; ++j) { const int n = (lane >> 3) + 8 * j; const LAS float* s = scr + (8 * c) * 33 + n;
        u32x4 o; o.x = pk2(s[0 * 33], s[1 * 33]); o.y = pk2(s[2 * 33], s[3 * 33]); o.z = pk2(s[4 * 33], s[5 * 33]); o.w = pk2(s[6 * 33], s[7 * 33]);
        *(u32x4*)(WT + (size_t)(n0 + n) * K + k0 + 8 * c) = o; }
    asm volatile("s_waitcnt lgkmcnt(0)" ::: "memory");
}
__device__ __forceinline__ void rms_row(const float* xrow, float* xcopy, bf16* orow, int lane) {
    const f32x4* xr = (const f32x4*)xrow + lane;
    f32x4 v[4]; float s = 0.f;
#pragma unroll
    for (int j = 0; j < 4; ++j) { v[j] = xr[64 * j]; s += (v[j].x * v[j].x + v[j].y * v[j].y) + (v[j].z * v[j].z + v[j].w * v[j].w); }
    if (xcopy) { f32x4* xc = (f32x4*)xcopy + lane;
#pragma unroll
        for (int j = 0; j < 4; ++j) xc[64 * j] = v[j]; }
    const float rs = 1.0f / sqrtf(wave_sum(s) * (1.f / DM) + EPS);
    unsigned long long* o8 = (unsigned long long*)orow + lane;
#pragma unroll
    for (int j = 0; j < 4; ++j) o8[64 * j] = (unsigned long long)pk2(v[j].x * rs, v[j].y * rs) | ((unsigned long long)pk2(v[j].z * rs, v[j].w * rs) << 32);
}
__device__ __forceinline__ f32x2 cossin(float ang) {
    const float n = rintf(ang * 0.15915494309189535f);
    float r = fmaf(-n, 6.28125f, ang); r = fmaf(-n, 0.0019353071795864769f, r);
    const float rev = r * 0.15915494309189535f;
    f32x2 o; o.x = __builtin_amdgcn_cosf(rev); o.y = __builtin_amdgcn_sinf(rev); return o;
}

__global__ void __launch_bounds__(NWAVES * 64, 2) hybrid_fwd(Args args) {
    extern __shared__ __attribute__((aligned(16))) unsigned char lds_raw[];
    LAS unsigned char* lds = (LAS unsigned char*)lds_raw;
    cg::grid_group grid = cg::this_grid();
    const int G = gridDim.x, NGW = G * NWAVES;
    const int lo = args.ph_lo, hi = args.ph_hi;
    for (int ph = lo; ph < hi; ++ph) {
        KArgsP ap = (KArgsP)__builtin_amdgcn_kernarg_segment_ptr(); asm volatile("" : "+s"(ap));
        unsigned char* const ws = ap->ws;
        const int tid = pg8::opaque_tid(), lane = tid & 63, wave = __builtin_amdgcn_readfirstlane(tid >> 6), gw = blockIdx.x * NWAVES + wave;
        const int l = ph == 0 ? 0 : (ph - 1) / 10, k = ph == 0 ? -1 : (ph - 1) % 10;
        if (k == -1) {
            LAS float* scr = (LAS float*)(lds + wave * 16384);
            constexpr int I_IN = 16 * 69, I_UQ = 4 * 24, I_UKV = 2 * 32, I_O = 16 * 32, I_1 = 16 * 128, I_2 = 64 * 32, I_L = I_IN + I_UQ + I_UKV + I_O + I_1 + I_2;
            for (int it = gw; it < DEPTH * I_L; it += NGW) {
                const int ll = it / I_L; int r = it - ll * I_L;
                if (r < I_IN) { p0_transpose_item(ap->in[I_WIN] + (size_t)ll * DM * DIN, ap->in[I_ANG] + ll * DM, DM, DIN, WIN + (size_t)ll * DINP * DM, scr, r, lane); continue; } r -= I_IN;
                if (r < I_UQ) { p0_transpose_item(ap->in[I_WUQ] + (size_t)ll * 256 * 768, ap->in[I_QNG] + ll * 256, 256, 768, WUQ + (size_t)ll * 768 * 256, scr, r, lane); continue; } r -= I_UQ;
                if (r < I_UKV) { p0_transpose_item(ap->in[I_WUKV] + (size_t)ll * 128 * 1024, ap->in[I_KVNG] + ll * 128, 128, 1024, WUKV + (size_t)ll * 1024 * 128, scr, r, lane); continue; } r -= I_UKV;
                if (r < I_O) { p0_transpose_item(ap->in[I_WOUT] + (size_t)ll * DM * DM, nullptr, DM, DM, WOUT + (size_t)ll * DM * DM, scr, r, lane); continue; } r -= I_O;
                if (r < I_1) { p0_transpose_item(ap->in[I_W1] + (size_t)ll * DM * DFF, ap->in[I_MLPG] + ll * DM, DM, DFF, W1 + (size_t)ll * DFF * DM, scr, r, lane); continue; } r -= I_1;
                p0_transpose_item(ap->in[I_W2] + (size_t)ll * DFF * DM, nullptr, DFF, DM, W2 + (size_t)ll * DM * DFF, scr, r, lane);
            }
            for (int it = gw; it < DEPTH * (DINP - DIN); it += NGW) {
                const int ll = it / (DINP - DIN), r = DIN + it % (DINP - DIN); u32x4* p = (u32x4*)(WIN + ((size_t)ll * DINP + r) * DM) + lane;
                p[0] = (u32x4){0u, 0u, 0u, 0u}; p[64] = (u32x4){0u, 0u, 0u, 0u};
            }
            for (int e = blockIdx.x * 512 + tid; e < TT * 32; e += G * 512) { const int t = e >> 5, i = e & 31; const float inv = exp2f(-13.287712379549449f * (float)(2 * i) * (1.f / 64.f)); RT[e] = cossin((float)t * inv); }
            for (int e = blockIdx.x * 512 + tid; e < TT * 16; e += G * 512) { const int t = e >> 4, i = e & 15; const float inv = exp2f(-13.287712379549449f * (float)(2 * i) * (1.f / 32.f)); MT[e] = cossin((float)t * inv); }
            for (int m = gw; m < M; m += NGW) { const int b = m / TT, t = m - b * TT;
                const float* src = t < NMETA ? ap->in[I_META] + (size_t)t * DM : ap->in[I_X] + ((size_t)b * SEQ + (t - NMETA)) * DM;
                rms_row(src, XF + (size_t)m * DM, XN + (size_t)m * DM, lane); }
        } else if (k == 0 || k == 2 || k == 5 || k == 7 || k == 8) {
            const int ng = k == 2 ? 2 : 1;
            for (int gi = 0; gi < ng; ++gi) {
                pg8::Gemm g; pg8::EpiAny E; E.X = XF; E.out = ap->out; E.O = nullptr; E.ldc = 0;
                if (k == 0)      { g = pg8::Gemm{XN, WIN + (size_t)l * DINP * DM, M, DINP, DM, DM}; E.mode = 0; E.perm = 1; E.O = PROJ; E.ldc = DINP; }
                else if (k == 2 && gi == 0) { g = pg8::Gemm{PROJ + C_CQ, WUQ + (size_t)l * 768 * 256, M, 768, 256, DINP}; E.mode = 0; E.perm = 1; E.O = QRAW; E.ldc = 768; }
                else if (k == 2) { g = pg8::Gemm{PROJ + C_CKV, WUKV + (size_t)l * 1024 * 128, M, 1024, 128, DINP}; E.mode = 0; E.perm = 1; E.O = KVR; E.ldc = 1024; }
                else if (k == 5) { g = pg8::Gemm{MIX, WOUT + (size_t)l * DM * DM, M, DM, DM, DM}; E.mode = 2; E.perm = 0; }
                else if (k == 7) { g = pg8::Gemm{XN, W1 + (size_t)l * DFF * DM, M, DFF, DM, DM}; E.mode = 1; E.perm = 1; E.O = HB; E.ldc = DFF; }
                else             { g = pg8::Gemm{HB, W2 + (size_t)l * DM * DFF, M, DM, DFF, DFF}; E.mode = (l == DEPTH - 1) ? 3 : 2; E.perm = 0; }
                pg8::StaticOrder S; S.init(M, g.N, G, (int)blockIdx.x);
                pg8::gemm_phase<pg8::EpiAny, pg8::StaticOrder, true, true>(lds, g, S, E);
            }
        } else if (k == 1) {
            const float* cw = ap->in[I_CONVW] + l * 3 * 256;
            for (int m = gw; m < M; m += NGW) {
                const int b = m / TT, t = m - b * TT; bf16* pr = PROJ + (size_t)m * DINP;
                { const int c = 4 * lane; const u32x2 cbv = *(const u32x2*)(pr + C_CB + c); float a0 = 0.f, a1 = 0.f, a2 = 0.f, a3 = 0.f;
#pragma unroll
                  for (int j = 0; j < 3; ++j) { if (t - 2 + j >= 0) { const bf16* p2 = pr - (2 - j) * DINP; const u32x2 ccv = *(const u32x2*)(p2 + C_CC + c), chv = *(const u32x2*)(p2 + C_CH + c); const f32x4 w = *(const f32x4*)(cw + j * 256 + c);
                        a0 += w.x * (bflo(ccv.x) * bflo(chv.x)); a1 += w.y * (bfhi(ccv.x) * bfhi(chv.x)); a2 += w.z * (bflo(ccv.y) * bflo(chv.y)); a3 += w.w * (bfhi(ccv.y) * bfhi(chv.y)); } }
                  u32x2 o; o.x = pk2(bflo(cbv.x) * a0, bfhi(cbv.x) * a1); o.y = pk2(bflo(cbv.y) * a2, bfhi(cbv.y) * a3); *(u32x2*)(MIX + (size_t)m * DM + c) = o; }
                { const int h = lane >> 4, i = (2 * lane) & 31; const f32x4 cs = *(const f32x4*)(RT + t * 32 + i);
#pragma unroll
                  for (int w = 0; w < 2; ++w) { bf16* p = pr + (w ? C_RK : C_RQ) + 64 * h + i; const float sc = w ? 0.125f : 1.f; const unsigned x1 = *(const unsigned*)p, x2 = *(const unsigned*)(p + 32);
                      const float a0 = bflo(x1), a1 = bfhi(x1), b0 = bflo(x2), b1 = bfhi(x2);
                      *(unsigned*)p = pk2((a0 * cs.x - b0 * cs.y) * sc, (a1 * cs.z - b1 * cs.w) * sc); *(unsigned*)(p + 32) = pk2((b0 * cs.x + a0 * cs.y) * sc, (b1 * cs.z + a1 * cs.w) * sc); } }
                { bf16* p = pr + C_CQ + 4 * lane; const u32x2 v = *(const u32x2*)p; const float a0 = bflo(v.x), a1 = bfhi(v.x), a2 = bflo(v.y), a3 = bfhi(v.y);
                  const float rs = 1.0f / sqrtf(wave_sum(a0 * a0 + a1 * a1 + a2 * a2 + a3 * a3) * (1.f / 256.f) + EPS); u32x2 o; o.x = pk2(a0 * rs, a1 * rs); o.y = pk2(a2 * rs, a3 * rs); *(u32x2*)p = o; }
                { bf16* p = pr + C_CKV + 2 * lane; const unsigned v = *(const unsigned*)p; const float a0 = bflo(v), a1 = bfhi(v);
                  const float rs = 1.0f / sqrtf(wave_sum(a0 * a0 + a1 * a1) * (1.f / 128.f) + EPS); *(unsigned*)p = pk2(a0 * rs, a1 * rs); }
            }
        } else if (k == 3) {
            const float* qg = ap->in[I_QHG] + l * 96; const float* kg = ap->in[I_KHG] + l * 96;
            const int hf = lane >> 5, l5 = lane & 31;
            const float g0q = qg[2 * l5], g1q = qg[2 * l5 + 1], g2q = qg[64 + (l5 & 15)], g3q = qg[80 + (l5 & 15)];
            const float g0k = kg[2 * l5], g1k = kg[2 * l5 + 1], g2k = kg[64 + (l5 & 15)], g3k = kg[80 + (l5 & 15)];
            for (int m = gw; m < M; m += NGW) {
                const int b = m / TT, t = m - b * TT; bf16* pr = PROJ + (size_t)m * DINP;
                const f32x2 cs = MT[t * 16 + (l5 & 15)];
                float kr0 = 0.f, kr1 = 0.f; if (l5 < 16) { kr0 = bf1(pr[C_KR + l5]); kr1 = bf1(pr[C_KR + 16 + l5]); }
#pragma unroll
                for (int it = 0; it < 4; ++it) { const int h = 2 * it + hf;
                    { bf16* q = QRAW + (size_t)m * 768 + 96 * h; const unsigned nv = *(const unsigned*)(q + 2 * l5); float n0 = bflo(nv), n1 = bfhi(nv), r0 = 0.f, r1 = 0.f;
                      if (l5 < 16) { r0 = bf1(q[64 + l5]); r1 = bf1(q[80 + l5]); }
                      const float rs = 1.0f / sqrtf(half_sum(n0 * n0 + n1 * n1 + r0 * r0 + r1 * r1) * (1.f / 96.f) + EPS);
                      n0 *= rs * g0q; n1 *= rs * g1q; r0 *= rs * g2q; r1 *= rs * g3q;
                      *(unsigned*)(q + 2 * l5) = pk2(n0 * QSCALE, n1 * QSCALE);
                      if (l5 < 16) { q[64 + l5] = (bf16)f2bf((r0 * cs.x - r1 * cs.y) * QSCALE); q[80 + l5] = (bf16)f2bf((r1 * cs.x + r0 * cs.y) * QSCALE); } }
                    { const bf16* kn = KVR + (size_t)m * 1024 + 128 * h; bf16* ko = pr + 96 * h; const unsigned nv = *(const unsigned*)(kn + 2 * l5); float n0 = bflo(nv), n1 = bfhi(nv), r0 = kr0, r1 = kr1;
                      const float rs = 1.0f / sqrtf(half_sum(n0 * n0 + n1 * n1 + r0 * r0 + r1 * r1) * (1.f / 96.f) + EPS);
                      n0 *= rs * g0k; n1 *= rs * g1k; r0 *= rs * g2k; r1 *= rs * g3k;
                      *(unsigned*)(ko + 2 * l5) = pk2(n0, n1);
                      if (l5 < 16) { ko[64 + l5] = (bf16)f2bf(r0 * cs.x - r1 * cs.y); ko[80 + l5] = (bf16)f2bf(r1 * cs.x + r0 * cs.y); } }
                }
            }
        } else if (k == 4) {
            for (int item = blockIdx.x; item < 512; item += G) {
                if (item < 256) { const int b = item >> 3, h = item & 7; const size_t rb = (size_t)b * TT;
                    const bf16* Qp = QRAW + rb * 768 + 96 * h; const bf16* Kp = PROJ + rb * DINP + 96 * h; const bf16* Vp = KVR + rb * 1024 + 128 * h + 64; bf16* Op = MIX + rb * DM + 512 + 64 * h;
                    for (int blk = 8; blk >= 0; --blk) { const int q0 = blk ? 16 + 256 * (blk - 1) : 0, qend = blk ? q0 + 256 : 16;
                        att::unit<96, true>(lds, Qp, 768, Kp, DINP, Vp, 1024, Op, DM, nullptr, 0, nullptr, 0.f, q0, qend); }
                } else { const int it = item - 256, bh = it >> 1, hf = it & 1, b = bh >> 2, h = bh & 3; const size_t rb = (size_t)b * TT;
                    const bf16* Pp = PROJ + rb * DINP + 64 * h; bf16* Op = MIX + rb * DM + 256 + 64 * h;
                    const float lg2 = log2f(1.0f - exp2f(-5.0f - (float)h)); const unsigned bm = hf ? 0x0CCu : 0x133u;
                    for (int blk = 8; blk >= 0; --blk) { if (!((bm >> blk) & 1u)) continue; const int q0 = blk ? 16 + 256 * (blk - 1) : 0, qend = blk ? q0 + 256 : 16;
                        att::unit<64, false>(lds, Pp + C_RQ, DINP, Pp + C_RK, DINP, Pp + C_RV, DINP, Op, DM, Pp + C_RG, DINP, ap->in[I_RETG] + l * 256 + 64 * h, lg2, q0, qend); }
                }
            }
        } else {
            for (int m = gw; m < M; m += NGW) rms_row(XF + (size_t)m * DM, nullptr, XN + (size_t)m * DM, lane);
        }
        if (ph + 1 < hi) grid.sync();
    }
}

extern "C" void kernel_launch(void* const* d_in, const int* in_sizes, int n_in, void* d_out, int out_size, void* d_ws, size_t ws_size, hipStream_t stream) {
    static int grid = 0;
    if (grid == 0) {
        if (n_in != 16 || out_size != BATCH * SEQ * DM || ws_size < WS_END) { fprintf(stderr, "kernel_launch: unexpected shapes (n_in %d, out %d, ws %zu)\n", n_in, out_size, ws_size); grid = -1; return; }
        int dev = 0, cus = 0, per_cu = 0;
        if (hipGetDevice(&dev) != hipSuccess || hipDeviceGetAttribute(&cus, hipDeviceAttributeMultiprocessorCount, dev) != hipSuccess) { grid = -1; return; }
        if (hipFuncSetAttribute((const void*)hybrid_fwd, hipFuncAttributeMaxDynamicSharedMemorySize, LDS_BYTES) != hipSuccess) { fprintf(stderr, "kernel_launch: hipFuncSetAttribute failed\n"); grid = -1; return; }
        if (hipOccupancyMaxActiveBlocksPerMultiprocessor(&per_cu, (const void*)hybrid_fwd, NWAVES * 64, LDS_BYTES) != hipSuccess || per_cu < 1) { fprintf(stderr, "kernel_launch: occupancy query says %d\n", per_cu); per_cu = 1; }
        (void)hipGetLastError();
        grid = cus;
    }
    if (grid < 0) return;
    Args a{};
    for (int i = 0; i < 16; ++i) a.in[i] = (const float*)d_in[i];
    a.out = (float*)d_out; a.ws = (unsigned char*)d_ws;
#if MK_MULTI
    for (int ph = 0; ph < NPHASE; ++ph) { a.ph_lo = ph; a.ph_hi = ph + 1; hipLaunchKernelGGL(hybrid_fwd, dim3(grid), dim3(NWAVES * 64), LDS_BYTES, stream, a); }
#else
    a.ph_lo = 0; a.ph_hi = NPHASE;
    void* kargs[] = {&a};
    const hipError_t e = hipLaunchCooperativeKernel((const void*)hybrid_fwd, dim3(grid), dim3(NWAVES * 64), kargs, LDS_BYTES, stream);
    if (e != hipSuccess) fprintf(stderr, "kernel_launch: cooperative launch failed: %s (grid %d)\n", hipGetErrorString(e), grid);
#endif
}
```

```cpp
#include <hip/hip_runtime.h>
#include <hip/hip_cooperative_groups.h>
#include <cstdio>
#include <cstdint>
#include <cmath>
namespace cg = cooperative_groups;
#ifndef MK_MULTI
#define MK_MULTI 0
#endif
namespace pg8 {
#define PG8_LAS __attribute__((address_space(3)))
typedef unsigned short bf16_t;
typedef short bf16x8 __attribute__((ext_vector_type(8)));
typedef float f32x4 __attribute__((ext_vector_type(4)));
typedef unsigned u32x4 __attribute__((ext_vector_type(4)));
typedef unsigned u32x2 __attribute__((ext_vector_type(2)));
constexpr int BM = 256, BK = 64, HALF = 128, HTB = HALF * BK * 2  , STAGE_BYTES = 8 * HTB, NXCD = 8, WGM = 8;

__host__ __device__ __forceinline__ int lds_byte(int r, int c) { const int st = (r >> 4) * 2 + (c >> 5), rr = r & 15, cc = c & 31, ob = rr * 64 + cc * 2; return st * 1024 + (ob ^ (((ob >> 9) & 1) << 5)); }
__host__ __device__ __forceinline__ void stage_rc(int b, int& R, int& C) { const int st = b / 1024, sb = b % 1024, swz = sb ^ (((sb >> 9) & 1) << 5); R = (st >> 1) * 16 + swz / 64; C = (st & 1) * 32 + (swz % 64) / 2; }
__host__ __device__ __forceinline__ int perm32(int rho) { const int n = rho >> 4, i = rho & 15; return 8 * (i >> 2) + 4 * n + (i & 3); }

__device__ __forceinline__ int opaque_tid() { int t = threadIdx.x; asm volatile("" : "+v"(t)); return t; }
struct Unit { int pm, pn; };
struct Gemm { const bf16_t* A; const bf16_t* Bt; int M, N, K, lda; };

struct StaticOrder {
    int nM, nN, nwg, G, c;
    __host__ __device__ void init(int M, int N, int G_, int c_) { nM = M / BM; nN = N / BM; nwg = nM * nN; G = G_; c = c_; }
    __host__ __device__ bool next(int i, Unit& u) const {
        const long L = (long)i * G + c; if (L >= nwg) return false;
        int wgid = (int)L; { const int q = nwg / NXCD, r = nwg % NXCD, xcd = wgid % NXCD, off = wgid / NXCD; wgid = (xcd < r ? xcd * (q + 1) : r * (q + 1) + (xcd - r) * q) + off; }
        const int nig = WGM * nN, gid = wgid / nig, fm = gid * WGM, gsz = (nM - fm) < WGM ? (nM - fm) : WGM;
        u.pm = fm + ((wgid % nig) % gsz); u.pn = (wgid % nig) / gsz; return true;
    }
    __device__ __forceinline__ void a_ready(const Unit&) const {}
    __device__ __forceinline__ void done(const Unit&) const {}
};

__device__ __forceinline__ unsigned cvt_pk_bf16(float lo, float hi) { unsigned r; asm volatile("v_cvt_pk_bf16_f32 %0, %1, %2" : "=v"(r) : "v"(lo), "v"(hi)); return r; }
struct EpiAny {
    static constexpr bool AFTER_DRAIN = false;
    int mode, perm; bf16_t* O; int ldc; const float* xin; float* X; float* out; bf16_t* xb; float* ssx; const float* rs_src; float* ssq; float* sskv;
    __device__ __forceinline__ void operator()(const f32x4 (&acc)[2][2][4][2], const Unit& u, int wr, int wc, int fr, int fq) const {
        if (mode < 2) {
            const int row0 = u.pm * BM + wr * 64 + fr; const int col0 = u.pn * BM + wc * 32 + 8 * fq; const bool sq = mode == 1;
            const int sstile = ssq ? (u.pn == 7 ? 1 : (u.pn == 8 ? 2 : 0)) : 0;
#pragma unroll
            for (int ai = 0; ai < 2; ++ai)
#pragma unroll
                for (int m = 0; m < 4; ++m) { const int row = row0 + ai * HALF + m * 16; bf16_t* rowp = O + (size_t)row * ldc + col0;
                    float rs = 1.f;
                    if (rs_src) { const f32x4* p = (const f32x4*)(rs_src + (size_t)row * 16); const f32x4 a = (p[0] + p[1]) + (p[2] + p[3]); rs = 1.0f / sqrtf(((a[0] + a[1]) + (a[2] + a[3])) * (1.f / 1024.f) + 1e-6f); }
                    float part = 0.f;
#pragma unroll
                    for (int bj = 0; bj < 2; ++bj) { f32x4 v0 = acc[ai][bj][m][0] * rs, v1 = acc[ai][bj][m][1] * rs;
                        if (sq) {
#pragma unroll
                            for (int e = 0; e < 4; ++e) { const float a = fmaxf(v0[e], 0.f), b = fmaxf(v1[e], 0.f); v0[e] = a * a; v1[e] = b * b; } }
                        if (sstile == 1 || (sstile == 2 && bj == 0)) part += ((v0[0] * v0[0] + v0[1] * v0[1]) + (v0[2] * v0[2] + v0[3] * v0[3])) + ((v1[0] * v1[0] + v1[1] * v1[1]) + (v1[2] * v1[2] + v1[3] * v1[3]));
                        u32x4 w; w.x = cvt_pk_bf16(v0[0], v0[1]); w.y = cvt_pk_bf16(v0[2], v0[3]); w.z = cvt_pk_bf16(v1[0], v1[1]); w.w = cvt_pk_bf16(v1[2], v1[3]);
                        *(u32x4*)(rowp + bj * HALF) = w; }
                    if (sstile) { part += __shfl_xor(part, 16); part += __shfl_xor(part, 32); if (fq == 0) (sstile == 1 ? ssq : sskv)[(size_t)row * 4 + wc] = part; }
                }
        } else {
            const int col0 = u.pn * BM + wc * 32 + 4 * fq; const bool toout = mode == 3;
#pragma unroll
            for (int ai = 0; ai < 2; ++ai)
#pragma unroll
                for (int m = 0; m < 4; ++m) { const int r = u.pm * BM + ai * HALF + wr * 64 + m * 16 + fr; const float* xp = xin + (size_t)r * 1024 + col0;
                    float* op = (toout ? out : X) + (size_t)r * 1024 + col0; const bool wr_ok = true;
                    bf16_t* bp = xb + (size_t)r * 1024 + col0; float part = 0.f;
#pragma unroll
                    for (int bj = 0; bj < 2; ++bj)
#pragma unroll
                        for (int n = 0; n < 2; ++n) { const f32x4 v = *(const f32x4*)(xp + bj * HALF + n * 16) + acc[ai][bj][m][n]; if (wr_ok) *(f32x4*)(op + bj * HALF + n * 16) = v;
                            if (!toout) { part += (v[0] * v[0] + v[1] * v[1]) + (v[2] * v[2] + v[3] * v[3]); u32x2 w; w.x = cvt_pk_bf16(v[0], v[1]); w.y = cvt_pk_bf16(v[2], v[3]); *(u32x2*)(bp + bj * HALF + n * 16) = w; } }
                    if (!toout) { part += __shfl_xor(part, 16); part += __shfl_xor(part, 32); if (fq == 0) ssx[(size_t)r * 16 + u.pn * 4 + wc] = part; }
                    asm volatile("" ::: "memory"); }
        }
    }
};

template <class Epi, class Sched, bool ALIGN_EPI = false, bool SP2 = false>
__device__ __forceinline__ void gemm_phase(PG8_LAS unsigned char* lds, const Gemm g, const Sched& S, const Epi& E) {
    const int tid = opaque_tid(), wid = __builtin_amdgcn_readfirstlane(tid >> 6), lane = tid & 63, wr = wid >> 2, wc = wid & 3, fr = lane & 15, fq = lane >> 4;
    const int K = g.K, nt = K / BK;
    unsigned voffA[2], voffB[2];
#pragma unroll
    for (int i = 0; i < 2; ++i) { int R, C; stage_rc(tid * 16 + i * 8192, R, C); const int Rb = E.perm ? ((R & ~31) + perm32(R & 31)) : R;
        voffA[i] = (unsigned)(R * g.lda + C) * 2u; voffB[i] = (unsigned)(Rb * K + C) * 2u; }
    const size_t kstep = (size_t)(BK * 2);
    const size_t hstepA = (size_t)HALF * g.lda * 2, hstepB = (size_t)HALF * K * 2;
    const size_t tstepA = 2 * hstepA, tstepB = 2 * hstepB;
    const unsigned ldsw = (unsigned)wid * 1024u;
    const int aoff = lds_byte(wr * 64 + fr, fq * 8), boff = lds_byte(wc * 32 + fr, fq * 8);
#define PG8_SA(b, h) (((b) * 2 + (h)) * HTB)
#define PG8_SB(b, h) ((4 + (b) * 2 + (h)) * HTB)
#define PG8_STAGE(bufoff, gbase, voff) do { _Pragma("unroll") for (int _i = 0; _i < 2; ++_i) \
        __builtin_amdgcn_global_load_lds((const unsigned*)((const char*)(gbase) + (voff)[_i]), (PG8_LAS unsigned*)(lds + (bufoff) + ldsw + _i * 8192), 16, 0, 0); } while (0)
#define PG8_LDA(dst, b, h) do { _Pragma("unroll") for (int m = 0; m < 4; ++m) _Pragma("unroll") for (int k = 0; k < 2; ++k) dst[m][k] = *(const PG8_LAS bf16x8*)(lds + PG8_SA(b, h) + aoff + m * 2048 + k * 1024); } while (0)
#define PG8_LDB(dst, b, h) do { _Pragma("unroll") for (int n = 0; n < 2; ++n) _Pragma("unroll") for (int k = 0; k < 2; ++k) dst[n][k] = *(const PG8_LAS bf16x8*)(lds + PG8_SB(b, h) + boff + n * 2048 + k * 1024); } while (0)
#define PG8_MMA(ai, bj, At, Bt) do { __builtin_amdgcn_s_setprio(1); _Pragma("unroll") for (int m = 0; m < 4; ++m) _Pragma("unroll") for (int n = 0; n < 2; ++n) _Pragma("unroll") for (int k = 0; k < 2; ++k) \
        acc[ai][bj][m][n] = __builtin_amdgcn_mfma_f32_16x16x32_bf16(Bt[n][k], At[m][k], acc[ai][bj][m][n], 0, 0, 0); __builtin_amdgcn_s_setprio(0); } while (0)
#define PG8_WAIT_V(n) asm volatile("s_waitcnt vmcnt(" #n ")" ::: "memory")
#define PG8_WAIT_L(n) asm volatile("s_waitcnt lgkmcnt(" #n ")" ::: "memory")
#define PG8_BAR __builtin_amdgcn_s_barrier()
#define PG8_SCHED __builtin_amdgcn_sched_barrier(0)
    Unit cur, nxt; int ui = 0;
    if (!S.next(0, cur)) return;
    f32x4 acc[2][2][4][2];
#pragma unroll
    for (int a = 0; a < 2; ++a)
#pragma unroll
        for (int b = 0; b < 2; ++b)
#pragma unroll
            for (int m = 0; m < 4; ++m)
#pragma unroll
                for (int n = 0; n < 2; ++n) acc[a][b][m][n] = (f32x4){0.f, 0.f, 0.f, 0.f};
    bf16x8 At[4][2], B0[2][2], B1[2][2];
    const char* cA = (const char*)g.A + (size_t)cur.pm * tstepA; const char* cB = (const char*)g.Bt + (size_t)cur.pn * tstepB;
    S.a_ready(cur);
    if constexpr (SP2) {
        PG8_STAGE(PG8_SB(0, 0), cB, voffB); PG8_STAGE(PG8_SB(0, 1), cB + hstepB, voffB); PG8_STAGE(PG8_SA(0, 0), cA, voffA); PG8_STAGE(PG8_SA(0, 1), cA + hstepA, voffA);
        if (wr == 1) PG8_BAR;
        PG8_WAIT_V(2); PG8_BAR;
        PG8_STAGE(PG8_SB(1, 0), cB + kstep, voffB); PG8_STAGE(PG8_SA(1, 0), cA + kstep, voffA); PG8_STAGE(PG8_SB(1, 1), cB + hstepB + kstep, voffB);
        PG8_WAIT_V(6); PG8_BAR;
    } else {
        PG8_STAGE(PG8_SB(0, 0), cB, voffB); PG8_STAGE(PG8_SA(0, 0), cA, voffA); PG8_STAGE(PG8_SB(0, 1), cB + hstepB, voffB); PG8_STAGE(PG8_SA(0, 1), cA + hstepA, voffA);
        if (wr == 1) PG8_BAR;
        PG8_WAIT_V(4); PG8_BAR;
        PG8_STAGE(PG8_SB(1, 0), cB + kstep, voffB); PG8_STAGE(PG8_SA(1, 0), cA + kstep, voffA); PG8_STAGE(PG8_SB(1, 1), cB + hstepB + kstep, voffB);
        PG8_WAIT_V(6); PG8_BAR;
    }
    for (;;) {
        const bool has_next = S.next(ui + 1, nxt);
        const char* nA = has_next ? (const char*)g.A + (size_t)nxt.pm * tstepA : cA; const char* nB = has_next ? (const char*)g.Bt + (size_t)nxt.pn * tstepB : cB;
        for (int t = 0; t < nt; t += 2) {
            const bool last = (t == nt - 2);
            const char* a1 = cA + (size_t)(t + 1) * kstep;
            const char* a2 = last ? nA : cA + (size_t)(t + 2) * kstep; const char* b2 = last ? nB : cB + (size_t)(t + 2) * kstep;
            const char* a3 = a2 + kstep; const char* b3 = b2 + kstep;
            if (last && has_next) S.a_ready(nxt);
            if constexpr (SP2) {
            PG8_LDB(B0, 0, 0); PG8_LDB(B1, 0, 1); PG8_SCHED; PG8_LDA(At, 0, 0); PG8_STAGE(PG8_SA(1, 1), a1 + hstepA, voffA);
            PG8_WAIT_V(8); PG8_WAIT_L(0); PG8_BAR; PG8_MMA(0, 0, At, B0); PG8_MMA(0, 1, At, B1); PG8_BAR; PG8_SCHED;
            PG8_LDA(At, 0, 1); PG8_STAGE(PG8_SB(0, 0), b2, voffB); PG8_STAGE(PG8_SB(0, 1), b2 + hstepB, voffB); PG8_STAGE(PG8_SA(0, 0), a2, voffA);
            PG8_WAIT_V(8); PG8_WAIT_L(0); PG8_BAR; PG8_MMA(1, 0, At, B0); PG8_MMA(1, 1, At, B1); PG8_BAR; PG8_SCHED;
            PG8_LDB(B0, 1, 0); PG8_LDB(B1, 1, 1); PG8_SCHED; PG8_LDA(At, 1, 0); PG8_STAGE(PG8_SA(0, 1), a2 + hstepA, voffA);
            PG8_WAIT_V(8); PG8_WAIT_L(0); PG8_BAR; PG8_MMA(0, 0, At, B0); PG8_MMA(0, 1, At, B1); PG8_BAR; PG8_SCHED;
            PG8_LDA(At, 1, 1); PG8_STAGE(PG8_SB(1, 0), b3, voffB); PG8_STAGE(PG8_SB(1, 1), b3 + hstepB, voffB); PG8_STAGE(PG8_SA(1, 0), a3, voffA);
            PG8_WAIT_V(8); PG8_WAIT_L(0); PG8_BAR; PG8_MMA(1, 0, At, B0); PG8_MMA(1, 1, At, B1); PG8_BAR; PG8_SCHED;
            } else {
            PG8_LDB(B0, 0, 0); PG8_SCHED; PG8_LDA(At, 0, 0); PG8_STAGE(PG8_SA(1, 1), a1 + hstepA, voffA);
            PG8_WAIT_L(8); PG8_BAR; PG8_WAIT_L(0); PG8_MMA(0, 0, At, B0); PG8_BAR; PG8_SCHED;
            PG8_LDB(B1, 0, 1); PG8_STAGE(PG8_SB(0, 0), b2, voffB);
            PG8_BAR; PG8_WAIT_L(0); PG8_MMA(0, 1, At, B1); PG8_BAR;
            PG8_LDA(At, 0, 1); PG8_STAGE(PG8_SA(0, 0), a2, voffA);
            PG8_BAR; PG8_WAIT_L(0); PG8_MMA(1, 0, At, B0); PG8_BAR; PG8_SCHED;
            PG8_STAGE(PG8_SB(0, 1), b2 + hstepB, voffB);
            PG8_WAIT_V(6); PG8_BAR; PG8_MMA(1, 1, At, B1); PG8_BAR;
            PG8_LDB(B0, 1, 0); PG8_SCHED; PG8_LDA(At, 1, 0); PG8_STAGE(PG8_SA(0, 1), a2 + hstepA, voffA);
            PG8_WAIT_L(8); PG8_BAR; PG8_WAIT_L(0); PG8_MMA(0, 0, At, B0); PG8_BAR; PG8_SCHED;
            PG8_LDB(B1, 1, 1); PG8_STAGE(PG8_SB(1, 0), b3, voffB);
            PG8_BAR; PG8_WAIT_L(0); PG8_MMA(0, 1, At, B1); PG8_BAR;
            PG8_LDA(At, 1, 1); PG8_STAGE(PG8_SA(1, 0), a3, voffA);
            PG8_BAR; PG8_WAIT_L(0); PG8_MMA(1, 0, At, B0); PG8_BAR; PG8_SCHED;
            PG8_STAGE(PG8_SB(1, 1), b3 + hstepB, voffB);
            PG8_WAIT_V(6); PG8_BAR; PG8_MMA(1, 1, At, B1); PG8_BAR;
            }
        }
        if constexpr (ALIGN_EPI) { if (wr == 0) PG8_BAR; }
        if constexpr (!Epi::AFTER_DRAIN) { E(acc, cur, wr, wc, fr, fq); S.done(cur); }
        if (!has_next) break;
#pragma unroll
        for (int a = 0; a < 2; ++a)
#pragma unroll
            for (int b = 0; b < 2; ++b)
#pragma unroll
                for (int m = 0; m < 4; ++m)
#pragma unroll
                    for (int n = 0; n < 2; ++n) acc[a][b][m][n] = (f32x4){0.f, 0.f, 0.f, 0.f};
        cur = nxt; cA = nA; cB = nB; ++ui;
        if constexpr (ALIGN_EPI) { if (wr == 1) PG8_BAR; }
    }
    PG8_WAIT_V(0);
    if constexpr (!ALIGN_EPI) { if (wr == 0) PG8_BAR; }
    PG8_BAR;
    if constexpr (Epi::AFTER_DRAIN) { E.fused(acc, cur, wr, wc, fr, fq, lds, wid, lane); S.done(cur); }
#undef PG8_SA
#undef PG8_SB
#undef PG8_STAGE
#undef PG8_LDA
#undef PG8_LDB
#undef PG8_MMA
#undef PG8_WAIT_V
#undef PG8_WAIT_L
#undef PG8_BAR
#undef PG8_SCHED
}
}

#define GAS __attribute__((address_space(1)))
#define LAS __attribute__((address_space(3)))
typedef unsigned short bf16;
typedef unsigned u32x4 __attribute__((ext_vector_type(4)));
typedef unsigned u32x2 __attribute__((ext_vector_type(2)));
typedef float f32x4 __attribute__((ext_vector_type(4)));
typedef float f32x2 __attribute__((ext_vector_type(2)));
typedef short bf16x8 __attribute__((ext_vector_type(8)));
typedef float f32x16 __attribute__((ext_vector_type(16)));
constexpr int DM = 1024, BATCH = 32, SEQ = 2048, NMETA = 16, TT = SEQ + NMETA, DIN = 2208, DINP = 2304, DFF = 4096, DEPTH = 2;
constexpr int MREAL = BATCH * SEQ, MR0 = MREAL, MV = MREAL + NMETA, M = MREAL + 256;
static_assert(MREAL % 256 == 0, "row tiles");
__device__ __forceinline__ int rowof(int b, int t) { return t < NMETA ? MR0 + t : b * SEQ + (t - NMETA); }
constexpr int C_CB = 0, C_CC = 256, C_CH = 512, C_RQ = 768, C_RK = 1024, C_RV = 1280, C_RG = 1536, C_CQ = 1792, C_CKV = 2048, C_KR = 2176;
constexpr float EPS = 1e-6f;
constexpr float QSCALE = 0.10206207261596575f * 1.4426950408889634f;
constexpr size_t MiB = 1u << 20;
constexpr size_t WS_RT = 1 * MiB, WS_MT = 1 * MiB + 768 * 1024;
constexpr size_t WS_WIN = 4 * MiB, WS_WUQ = 13 * MiB, WS_WUKV = 14 * MiB, WS_WOUT = 15 * MiB, WS_W1 = 19 * MiB, WS_W2 = 35 * MiB;
constexpr size_t WS_X = 52 * MiB, WS_XN = 310 * MiB, WS_PROJ = 440 * MiB, WS_QRAW = 731 * MiB, WS_KV = 828 * MiB, WS_H = 440 * MiB, WS_SSX = 958 * MiB, WS_SSQ = 964 * MiB, WS_SSKV = 966 * MiB, WS_END = 968 * MiB;
static_assert(WS_X + (size_t)M * DM * 4 <= WS_XN && WS_XN + (size_t)M * DM * 2 <= WS_PROJ && WS_PROJ + (size_t)M * DINP * 2 <= WS_QRAW && WS_QRAW + (size_t)M * 768 * 2 <= WS_KV &&
              WS_KV + (size_t)M * 1024 * 2 <= WS_SSX && WS_H + (size_t)M * DFF * 2 <= WS_SSX && WS_SSX + (size_t)M * 64 <= WS_SSQ && WS_SSQ + (size_t)M * 16 <= WS_SSKV && WS_SSKV + (size_t)M * 16 <= WS_END, "d_ws map");
constexpr int NWAVES = 8, LDS_BYTES = 147456;

__device__ __forceinline__ unsigned f2bf(float f) { unsigned u = __builtin_bit_cast(unsigned, f); return (u + 0x7fffu + ((u >> 16) & 1u)) >> 16; }
__device__ __forceinline__ unsigned pk2(float lo, float hi) { return f2bf(lo) | (f2bf(hi) << 16); }
__device__ __forceinline__ float bflo(unsigned w) { return __uint_as_float(w << 16); }
__device__ __forceinline__ float bfhi(unsigned w) { return __uint_as_float(w & 0xffff0000u); }
__device__ __forceinline__ float bf1(bf16 h) { return __uint_as_float((unsigned)h << 16); }
__device__ __forceinline__ float wave_sum(float v) {
#pragma unroll
    for (int o = 1; o < 64; o <<= 1) v += __shfl_xor(v, o);
    return v;
}
__device__ __forceinline__ float half_sum(float v) {
#pragma unroll
    for (int o = 1; o < 32; o <<= 1) v += __shfl_xor(v, o);
    return v;
}

namespace att {
typedef float f32x2_t __attribute__((ext_vector_type(2))); typedef __bf16 bf16x2_t __attribute__((ext_vector_type(2)));
__device__ __forceinline__ unsigned cvtpk(float lo, float hi) { f32x2_t v = {lo, hi}; bf16x2_t b = __builtin_convertvector(v, bf16x2_t); return __builtin_bit_cast(unsigned, b); }
constexpr int VP = 144;
template <int DQK, bool SM>
__device__ __forceinline__ void unit(LAS unsigned char* lds, const bf16* Q, int ldq, const bf16* K, int ldk, const bf16* V, int ldv, bf16* O, int ldo,
                                     const bf16* G, int ldg, const float* gain, float lg2, int b, int q0, int qend) {
    constexpr int KP = DQK * 2 + 16, CH = DQK / 8, ND = DQK / 16, KB = 64 * KP, VB = 64 * VP;
    const int tid = pg8::opaque_tid(), lane = tid & 63, wid = __builtin_amdgcn_readfirstlane(tid >> 6), r32 = lane & 31, hi = lane >> 5;
    LAS unsigned char* Kb = lds; LAS unsigned char* Vb = lds + 2 * KB;
    const int q0w = q0 + 32 * wid, tq = q0w + r32;
    const bool wact = q0w < qend;
    bf16x8 qr[ND];
    const int qrow = rowof(b, tq < TT ? tq : TT - 1);
    { const bf16* qp = Q + (size_t)qrow * ldq + 8 * hi;
#pragma unroll
      for (int d0 = 0; d0 < ND; ++d0) qr[d0] = *(const bf16x8*)(qp + 16 * d0); }
    const int ntiles = (qend - 1) / 64 + 1;
    const int kkey0 = tid / CH, kch0 = tid % CH, kkey1 = (tid + 512) / CH, kch1 = (tid + 512) % CH;
    const bool has2 = (64 * CH > 512) && (tid + 512 < 64 * CH);
    const int vkey = tid & 63, vch = tid >> 6;
    const int pr32 = (r32 & 0x13) | ((r32 & 4) << 1) | ((r32 & 8) >> 1);
    u32x4 kreg0, kreg1 = {0u, 0u, 0u, 0u}, vreg;
#define ATT_LOAD(j) do { int r0_ = 64 * (j) + kkey0; r0_ = r0_ < TT ? r0_ : TT - 1; kreg0 = *(const u32x4*)(K + (size_t)rowof(b, r0_) * ldk + 8 * kch0); \
        if (has2) { int r1_ = 64 * (j) + kkey1; r1_ = r1_ < TT ? r1_ : TT - 1; kreg1 = *(const u32x4*)(K + (size_t)rowof(b, r1_) * ldk + 8 * kch1); } \
        int rv_ = 64 * (j) + vkey; rv_ = rv_ < TT ? rv_ : TT - 1; vreg = *(const u32x4*)(V + (size_t)rowof(b, rv_) * ldv + 8 * vch); } while (0)
#define ATT_STORE(buf) do { *(LAS u32x4*)(Kb + (buf) * KB + kkey0 * KP + 16 * kch0) = kreg0; if (has2) *(LAS u32x4*)(Kb + (buf) * KB + kkey1 * KP + 16 * kch1) = kreg1; \
        LAS unsigned char* vd_ = Vb + (buf) * VB + (8 * vch) * VP + 2 * vkey; \
        _Pragma("unroll") for (int i_ = 0; i_ < 8; ++i_) { const unsigned w_ = vreg[i_ >> 1]; *(LAS unsigned short*)(vd_ + i_ * VP) = (unsigned short)((i_ & 1) ? (w_ >> 16) : (w_ & 0xffffu)); } } while (0)
    f32x16 o0, o1;
#pragma unroll
    for (int r = 0; r < 16; ++r) { o0[r] = 0.f; o1[r] = 0.f; }
    float m_run = -INFINITY, l_run = 0.f;
    ATT_LOAD(0); ATT_STORE(0); __syncthreads();
    for (int j = 0; j < ntiles; ++j) {
        const int buf = j & 1;
        if (j + 1 < ntiles) ATT_LOAD(j + 1);
        if (wact && 64 * j <= q0w + 31) {
            const LAS unsigned char* kb = Kb + buf * KB + pr32 * KP + 16 * hi;
            f32x16 s0, s1;
#pragma unroll
            for (int r = 0; r < 16; ++r) { s0[r] = 0.f; s1[r] = 0.f; }
#pragma unroll
            for (int d0 = 0; d0 < ND; ++d0) {
                const bf16x8 k0 = *(const LAS bf16x8*)(kb + 32 * d0), k1 = *(const LAS bf16x8*)(kb + 32 * KP + 32 * d0);
                s0 = __builtin_amdgcn_mfma_f32_32x32x16_bf16(k0, qr[d0], s0, 0, 0, 0);
                s1 = __builtin_amdgcn_mfma_f32_32x32x16_bf16(k1, qr[d0], s1, 0, 0, 0);
            }
            const int kbase = 64 * j + 8 * hi;
            if (SM) {
                if (64 * j + 63 > q0w) {
#pragma unroll
                    for (int r = 0; r < 16; ++r) { const int kk = kbase + 16 * (r >> 3) + (r & 7); if (kk > tq) s0[r] = -INFINITY; if (kk + 32 > tq) s1[r] = -INFINITY; }
                }
                float mx = fmaxf(s0[0], s1[0]);
#pragma unroll
                for (int r = 1; r < 16; ++r) mx = fmaxf(mx, fmaxf(s0[r], s1[r]));
                mx = fmaxf(mx, __shfl_xor(mx, 32));
                const float mn = fmaxf(m_run, mx), alpha = __builtin_amdgcn_exp2f(m_run - mn); m_run = mn;
                float ps = 0.f;
#pragma unroll
                for (int r = 0; r < 16; ++r) { s0[r] = __builtin_amdgcn_exp2f(s0[r] - mn); s1[r] = __builtin_amdgcn_exp2f(s1[r] - mn); ps += s0[r] + s1[r]; }
                l_run = l_run * alpha + ps;
#pragma unroll
                for (int r = 0; r < 16; ++r) { o0[r] *= alpha; o1[r] *= alpha; }
            } else {
                const int dk0 = tq - kbase;
#pragma unroll
                for (int r = 0; r < 16; ++r) { const int dk = dk0 - (16 * (r >> 3) + (r & 7));
                    const float w0 = dk >= 0 ? __builtin_amdgcn_exp2f(lg2 * (float)dk) : 0.f, w1 = dk >= 32 ? __builtin_amdgcn_exp2f(lg2 * (float)(dk - 32)) : 0.f;
                    s0[r] *= w0; s1[r] *= w1; }
            }
            u32x4 pw[4];
#pragma unroll
            for (int ks = 0; ks < 2; ++ks) {
                pw[ks] = (u32x4){cvtpk(s0[8 * ks], s0[8 * ks + 1]), cvtpk(s0[8 * ks + 2], s0[8 * ks + 3]), cvtpk(s0[8 * ks + 4], s0[8 * ks + 5]), cvtpk(s0[8 * ks + 6], s0[8 * ks + 7])};
                pw[2 + ks] = (u32x4){cvtpk(s1[8 * ks], s1[8 * ks + 1]), cvtpk(s1[8 * ks + 2], s1[8 * ks + 3]), cvtpk(s1[8 * ks + 4], s1[8 * ks + 5]), cvtpk(s1[8 * ks + 6], s1[8 * ks + 7])};
            }
            const LAS unsigned char* vb = Vb + buf * VB + r32 * VP + 16 * hi;
#pragma unroll
            for (int ks = 0; ks < 4; ++ks) {
                const bf16x8 v0 = *(const LAS bf16x8*)(vb + 32 * ks), v1 = *(const LAS bf16x8*)(vb + 32 * VP + 32 * ks);
                const bf16x8 pf = __builtin_bit_cast(bf16x8, pw[ks]);
                o0 = __builtin_amdgcn_mfma_f32_32x32x16_bf16(v0, pf, o0, 0, 0, 0);
                o1 = __builtin_amdgcn_mfma_f32_32x32x16_bf16(v1, pf, o1, 0, 0, 0);
            }
        }
        if (j + 1 < ntiles) ATT_STORE(buf ^ 1);
        __syncthreads();
    }
#undef ATT_LOAD
#undef ATT_STORE
    if (wact) {
        if (SM) {
            const float l = l_run + __shfl_xor(l_run, 32), inv = 1.f / l;
            if (tq < qend) { bf16* op = O + (size_t)qrow * ldo + 4 * hi;
#pragma unroll
                for (int g = 0; g < 4; ++g) {
                    u32x2 a, b; a.x = cvtpk(o0[4 * g] * inv, o0[4 * g + 1] * inv); a.y = cvtpk(o0[4 * g + 2] * inv, o0[4 * g + 3] * inv);
                    b.x = cvtpk(o1[4 * g] * inv, o1[4 * g + 1] * inv); b.y = cvtpk(o1[4 * g + 2] * inv, o1[4 * g + 3] * inv);
                    *(u32x2*)(op + 8 * g) = a; *(u32x2*)(op + 32 + 8 * g) = b; } }
        } else {
            float ss = 0.f;
#pragma unroll
            for (int r = 0; r < 16; ++r) ss += o0[r] * o0[r] + o1[r] * o1[r];
            ss += __shfl_xor(ss, 32);
            const float rs = 1.0f / sqrtf(ss * (1.f / 64.f) + EPS);
            if (tq < qend) { bf16* op = O + (size_t)qrow * ldo + 4 * hi; const bf16* gp = G + (size_t)qrow * ldg + 4 * hi; const float* gn = gain + 4 * hi;
#pragma unroll
                for (int g = 0; g < 4; ++g) {
#pragma unroll
                    for (int db = 0; db < 2; ++db) {
                        const u32x2 gw = *(const u32x2*)(gp + 32 * db + 8 * g); const f32x4 ga = *(const f32x4*)(gn + 32 * db + 8 * g);
                        float gv[4] = {bflo(gw.x), bfhi(gw.x), bflo(gw.y), bfhi(gw.y)}; float y[4];
#pragma unroll
                        for (int e = 0; e < 4; ++e) { const float ov = db ? o1[4 * g + e] : o0[4 * g + e]; const float sg = gv[e] / (1.f + __expf(-gv[e])); y[e] = ov * rs * ga[e] * sg; }
                        u32x2 w; w.x = cvtpk(y[0], y[1]); w.y = cvtpk(y[2], y[3]); *(u32x2*)(op + 32 * db + 8 * g) = w; } } }
        }
    }
}
}

struct Args { const float* in[16]; float* out; unsigned char* ws; int ph_lo, ph_hi; };
typedef const __attribute__((address_space(4))) Args* KArgsP;
#define RT   ((f32x2*)(ws + WS_RT))
#define MT   ((f32x2*)(ws + WS_MT))
#define WIN  ((bf16*)(ws + WS_WIN))
#define WUQ  ((bf16*)(ws + WS_WUQ))
#define WUKV ((bf16*)(ws + WS_WUKV))
#define WOUT ((bf16*)(ws + WS_WOUT))
#define W1   ((bf16*)(ws + WS_W1))
#define W2   ((bf16*)(ws + WS_W2))
#define XF   ((float*)(ws + WS_X))
#define XN   ((bf16*)(ws + WS_XN))
#define MIX  ((bf16*)(ws + WS_XN))
#define PROJ ((bf16*)(ws + WS_PROJ))
#define QRAW ((bf16*)(ws + WS_QRAW))
#define KVR  ((bf16*)(ws + WS_KV))
#define HB   ((bf16*)(ws + WS_H))
#define SSX  ((float*)(ws + WS_SSX))
#define SSQ  ((float*)(ws + WS_SSQ))
#define SSKV ((float*)(ws + WS_SSKV))
#define XB2  ((bf16*)(ap->out))
enum { I_X = 0, I_META, I_ANG, I_WIN, I_CONVW, I_RETG, I_QNG, I_WUQ, I_KVNG, I_WUKV, I_QHG, I_KHG, I_WOUT, I_MLPG, I_W1, I_W2 };
constexpr int NPP = 7, NPHASE = 1 + NPP * DEPTH;

__device__ __forceinline__ void p0_transpose_item(const float* W, const float* gk, int K, int N, bf16* WT, LAS float* scr, int item, int lane) {
    const int nblk = N / 32, kb = item / nblk, nb = item % nblk, k0 = 64 * kb, n0 = 32 * nb;
#pragma unroll 8
    for (int i = 0; i < 32; ++i) { const int kk = 2 * i + (lane >> 5); const float gv = gk ? gk[k0 + kk] : 1.f; scr[kk * 33 + (lane & 31)] = W[(size_t)(k0 + kk) * N + n0 + (lane & 31)] * gv; }
    asm volatile("s_waitcnt lgkmcnt(0)" ::: "memory");
    const int c = lane & 7;
#pragma unroll
    for (int j = 0; j < 4; ++j) { const int n = (lane >> 3) + 8 * j; const LAS float* s = scr + (8 * c) * 33 + n;
        u32x4 o; o.x = pk2(s[0 * 33], s[1 * 33]); o.y = pk2(s[2 * 33], s[3 * 33]); o.z = pk2(s[4 * 33], s[5 * 33]); o.w = pk2(s[6 * 33], s[7 * 33]);
        *(u32x4*)(WT + (size_t)(n0 + n) * K + k0 + 8 * c) = o; }
    asm volatile("s_waitcnt lgkmcnt(0)" ::: "memory");
}
__device__ __forceinline__ void row_prep(const float* xrow, float* xcopy, bf16* orow, float* ss16, int lane) {
    const f32x4* xr = (const f32x4*)xrow + lane;
    f32x4 v[4]; float s = 0.f;
#pragma unroll
    for (int j = 0; j < 4; ++j) { v[j] = xr[64 * j]; s += (v[j].x * v[j].x + v[j].y * v[j].y) + (v[j].z * v[j].z + v[j].w * v[j].w); }
    if (xcopy) { f32x4* xc = (f32x4*)xcopy + lane;
#pragma unroll
        for (int j = 0; j < 4; ++j) xc[64 * j] = v[j]; }
    const float tot = wave_sum(s);
    if (lane < 16) ss16[lane] = lane == 0 ? tot : 0.f;
    unsigned long long* o8 = (unsigned long long*)orow + lane;
#pragma unroll
    for (int j = 0; j < 4; ++j) o8[64 * j] = (unsigned long long)att::cvtpk(v[j].x, v[j].y) | ((unsigned long long)att::cvtpk(v[j].z, v[j].w) << 32);
}
__device__ __forceinline__ f32x2 cossin(float ang) {
    const float n = rintf(ang * 0.15915494309189535f);
    float r = fmaf(-n, 6.28125f, ang); r = fmaf(-n, 0.0019353071795864769f, r);
    const float rev = r * 0.15915494309189535f;
    f32x2 o; o.x = __builtin_amdgcn_cosf(rev); o.y = __builtin_amdgcn_sinf(rev); return o;
}

struct EpiMeta { int mode, need_rs; bf16* O; int ldc; const float* xin; float* X; bf16* xb; };
__device__ __forceinline__ void meta_gemm(const bf16* A, int lda, const bf16* Bt, int N, int K, const EpiMeta& E, int gw, int NGW, int lane) {
    for (int n = gw; n < N; n += NGW) {
        float acc[16], ssa[16];
#pragma unroll
        for (int r = 0; r < 16; ++r) { acc[r] = 0.f; ssa[r] = 0.f; }
        for (int c = lane; c < K / 8; c += 64) {
            const u32x4 w = *(const u32x4*)(Bt + (size_t)n * K + 8 * c);
            float wf[8];
#pragma unroll
            for (int e = 0; e < 4; ++e) { wf[2 * e] = bflo(w[e]); wf[2 * e + 1] = bfhi(w[e]); }
#pragma unroll
            for (int r = 0; r < 16; ++r) { const u32x4 a = *(const u32x4*)(A + (size_t)r * lda + 8 * c);
#pragma unroll
                for (int e = 0; e < 4; ++e) { const float a0 = bflo(a[e]), a1 = bfhi(a[e]); acc[r] += a0 * wf[2 * e] + a1 * wf[2 * e + 1]; ssa[r] += a0 * a0 + a1 * a1; } }
        }
        float mine = 0.f, myss = 0.f;
#pragma unroll
        for (int r = 0; r < 16; ++r) { const float s = wave_sum(acc[r]), q = E.need_rs ? wave_sum(ssa[r]) : 0.f; if (lane == r) { mine = s; myss = q; } }
        if (lane < 16) { const int r = lane;
            if (E.mode < 2) { float v = mine * (E.need_rs ? 1.0f / sqrtf(myss * (1.f / 1024.f) + EPS) : 1.f); if (E.mode == 1) { v = fmaxf(v, 0.f); v = v * v; } E.O[(size_t)(MR0 + r) * E.ldc + n] = (bf16)f2bf(v); }
            else { const float x = E.xin[(size_t)r * DM + n] + mine; E.X[(size_t)(MR0 + r) * DM + n] = x; E.xb[(size_t)(MR0 + r) * DM + n] = (bf16)f2bf(x); } }
    }
}

__global__ void __launch_bounds__(NWAVES * 64, 2) hybrid_fwd(Args args) {
    extern __shared__ __attribute__((aligned(16))) unsigned char lds_raw[];
    LAS unsigned char* lds = (LAS unsigned char*)lds_raw;
    cg::grid_group grid = cg::this_grid();
    const int G = gridDim.x, NGW = G * NWAVES;
    const int lo = args.ph_lo, hi = args.ph_hi;
    for (int ph = lo; ph < hi; ++ph) {
        KArgsP ap = (KArgsP)__builtin_amdgcn_kernarg_segment_ptr(); asm volatile("" : "+s"(ap));
        unsigned char* const ws = ap->ws;
        const int tid = pg8::opaque_tid(), lane = tid & 63, wave = __builtin_amdgcn_readfirstlane(tid >> 6), gw = blockIdx.x * NWAVES + wave;
        const int l = ph == 0 ? 0 : (ph - 1) / NPP, k = ph == 0 ? -1 : (ph - 1) % NPP;
        if (k == -1) {
            LAS float* scr = (LAS float*)(lds + wave * 16384);
            constexpr int I_IN = 16 * 69, I_UQ = 4 * 24, I_UKV = 2 * 32, I_O = 16 * 32, I_1 = 16 * 128, I_2 = 64 * 32, I_L = I_IN + I_UQ + I_UKV + I_O + I_1 + I_2;
            for (int it = gw; it < DEPTH * I_L; it += NGW) {
                const int ll = it / I_L; int r = it - ll * I_L;
                if (r < I_IN) { p0_transpose_item(ap->in[I_WIN] + (size_t)ll * DM * DIN, ap->in[I_ANG] + ll * DM, DM, DIN, WIN + (size_t)ll * DINP * DM, scr, r, lane); continue; } r -= I_IN;
                if (r < I_UQ) { p0_transpose_item(ap->in[I_WUQ] + (size_t)ll * 256 * 768, ap->in[I_QNG] + ll * 256, 256, 768, WUQ + (size_t)ll * 768 * 256, scr, r, lane); continue; } r -= I_UQ;
                if (r < I_UKV) { p0_transpose_item(ap->in[I_WUKV] + (size_t)ll * 128 * 1024, ap->in[I_KVNG] + ll * 128, 128, 1024, WUKV + (size_t)ll * 1024 * 128, scr, r, lane); continue; } r -= I_UKV;
                if (r < I_O) { p0_transpose_item(ap->in[I_WOUT] + (size_t)ll * DM * DM, nullptr, DM, DM, WOUT + (size_t)ll * DM * DM, scr, r, lane); continue; } r -= I_O;
                if (r < I_1) { p0_transpose_item(ap->in[I_W1] + (size_t)ll * DM * DFF, ap->in[I_MLPG] + ll * DM, DM, DFF, W1 + (size_t)ll * DFF * DM, scr, r, lane); continue; } r -= I_1;
                p0_transpose_item(ap->in[I_W2] + (size_t)ll * DFF * DM, nullptr, DFF, DM, W2 + (size_t)ll * DM * DFF, scr, r, lane);
            }
            for (int it = gw; it < DEPTH * (DINP - DIN); it += NGW) {
                const int ll = it / (DINP - DIN), r = DIN + it % (DINP - DIN); u32x4* p = (u32x4*)(WIN + ((size_t)ll * DINP + r) * DM) + lane;
                p[0] = (u32x4){0u, 0u, 0u, 0u}; p[64] = (u32x4){0u, 0u, 0u, 0u};
            }
            for (int e = blockIdx.x * 512 + tid; e < TT * 32; e += G * 512) { const int t = e >> 5, i = e & 31; const float inv = exp2f(-13.287712379549449f * (float)(2 * i) * (1.f / 64.f)); RT[e] = cossin((float)t * inv); }
            for (int e = blockIdx.x * 512 + tid; e < TT * 16; e += G * 512) { const int t = e >> 4, i = e & 15; const float inv = exp2f(-13.287712379549449f * (float)(2 * i) * (1.f / 32.f)); MT[e] = cossin((float)t * inv); }
            for (int m = gw; m < MV; m += NGW) {
                const float* src = m >= MR0 ? ap->in[I_META] + (size_t)(m - MR0) * DM : ap->in[I_X] + (size_t)m * DM;
                row_prep(src, m >= MR0 ? XF + (size_t)m * DM : nullptr, XN + (size_t)m * DM, SSX + (size_t)m * 16, lane); }
        } else if (k == 0 || k == 1 || k == 4 || k == 5 || k == 6) {
            const int ng = k == 1 ? 2 : 1;
            for (int gi = 0; gi < ng; ++gi) {
                pg8::Gemm g; pg8::EpiAny E; E.xin = (l == 0 && k == 4) ? ap->in[I_X] : XF; E.X = XF; E.out = ap->out; E.O = nullptr; E.ldc = 0; E.xb = nullptr; E.ssx = SSX; E.rs_src = nullptr; E.ssq = nullptr; E.sskv = nullptr;
                EpiMeta Em; Em.need_rs = 0; Em.O = nullptr; Em.ldc = 0; Em.xin = (l == 0 && k == 4) ? ap->in[I_META] : XF + (size_t)MR0 * DM; Em.X = XF; Em.xb = nullptr;
                if (k == 0)      { g = pg8::Gemm{XN, WIN + (size_t)l * DINP * DM, MREAL, DINP, DM, DM}; E.mode = 0; E.perm = 1; E.O = PROJ; E.ldc = DINP; E.rs_src = SSX; E.ssq = SSQ; E.sskv = SSKV; Em.need_rs = 1; }
                else if (k == 1 && gi == 0) { g = pg8::Gemm{PROJ + C_CQ, WUQ + (size_t)l * 768 * 256, MREAL, 768, 256, DINP}; E.mode = 0; E.perm = 1; E.O = QRAW; E.ldc = 768; }
                else if (k == 1) { g = pg8::Gemm{PROJ + C_CKV, WUKV + (size_t)l * 1024 * 128, MREAL, 1024, 128, DINP}; E.mode = 0; E.perm = 1; E.O = KVR; E.ldc = 1024; }
                else if (k == 4) { g = pg8::Gemm{MIX, WOUT + (size_t)l * DM * DM, MREAL, DM, DM, DM}; E.mode = 2; E.perm = 0; E.xb = XB2; }
                else if (k == 5) { g = pg8::Gemm{XB2, W1 + (size_t)l * DFF * DM, MREAL, DFF, DM, DM}; E.mode = 1; E.perm = 1; E.O = HB; E.ldc = DFF; E.rs_src = SSX; Em.need_rs = 1; }
                else             { g = pg8::Gemm{HB, W2 + (size_t)l * DM * DFF, MREAL, DM, DFF, DFF}; E.mode = (l == DEPTH - 1) ? 3 : 2; E.perm = 0; E.xb = XN; }
                Em.mode = E.mode; Em.O = E.O; Em.ldc = E.ldc; Em.xb = E.xb;
                pg8::StaticOrder S; S.init(MREAL, g.N, G, (int)blockIdx.x);
                pg8::gemm_phase<pg8::EpiAny, pg8::StaticOrder, true, true>(lds, g, S, E);
                if (E.mode != 3) meta_gemm(g.A + (size_t)MR0 * g.lda, g.lda, g.Bt, g.N, g.K, Em, gw, NGW, lane);
            }
            if (k == 1) {
                const float* cw = ap->in[I_CONVW] + l * 3 * 256;
                for (int it = blockIdx.x * 512 + tid; it < MV * 32; it += G * 512) {
                    const int m = it >> 5, c = (it & 31) * 8; const int t = m >= MR0 ? m - MR0 : (m & (SEQ - 1)) + NMETA; const bf16* pr = PROJ + (size_t)m * DINP;
                    const u32x4 cbv = *(const u32x4*)(pr + C_CB + c); float a[8];
#pragma unroll
                    for (int e = 0; e < 8; ++e) a[e] = 0.f;
#pragma unroll
                    for (int j = 0; j < 3; ++j) { const int tj = t - 2 + j; if (tj >= 0) { const int mj = (m >= MR0 || tj >= NMETA) ? m - (2 - j) : MR0 + tj;
                            const bf16* p2 = PROJ + (size_t)mj * DINP; const u32x4 ccv = *(const u32x4*)(p2 + C_CC + c), chv = *(const u32x4*)(p2 + C_CH + c);
                            const f32x4 w0 = *(const f32x4*)(cw + j * 256 + c), w1 = *(const f32x4*)(cw + j * 256 + c + 4);
#pragma unroll
                            for (int e = 0; e < 4; ++e) { const float wl = e < 2 ? w0[2 * e] : w1[2 * e - 4], wh = e < 2 ? w0[2 * e + 1] : w1[2 * e - 3];
                                a[2 * e] += wl * (bflo(ccv[e]) * bflo(chv[e])); a[2 * e + 1] += wh * (bfhi(ccv[e]) * bfhi(chv[e])); } } }
                    u32x4 o;
#pragma unroll
                    for (int e = 0; e < 4; ++e) o[e] = att::cvtpk(bflo(cbv[e]) * a[2 * e], bfhi(cbv[e]) * a[2 * e + 1]);
                    *(u32x4*)(MIX + (size_t)m * DM + c) = o;
                }
                for (int it = blockIdx.x * 512 + tid; it < MV * 32; it += G * 512) {
                    const int m = it >> 5, j = it & 31, w = j >> 4, h = (j >> 2) & 3, i0 = (j & 3) * 8; const int t = m >= MR0 ? m - MR0 : (m & (SEQ - 1)) + NMETA;
                    bf16* p = PROJ + (size_t)m * DINP + (w ? C_RK : C_RQ) + 64 * h + i0; const float sc = w ? 0.125f : 1.f;
                    const u32x4 x1 = *(const u32x4*)p, x2 = *(const u32x4*)(p + 32); const f32x4* cs = (const f32x4*)(RT + t * 32 + i0);
                    u32x4 o1, o2;
#pragma unroll
                    for (int e = 0; e < 4; ++e) { const f32x4 c4 = cs[e]; const float a0 = bflo(x1[e]), a1 = bfhi(x1[e]), b0 = bflo(x2[e]), b1 = bfhi(x2[e]);
                        o1[e] = att::cvtpk((a0 * c4.x - b0 * c4.y) * sc, (a1 * c4.z - b1 * c4.w) * sc); o2[e] = att::cvtpk((b0 * c4.x + a0 * c4.y) * sc, (b1 * c4.z + a1 * c4.w) * sc); }
                    *(u32x4*)p = o1; *(u32x4*)(p + 32) = o2;
                }
            }
        } else if (k == 2) {
            const float* qg = ap->in[I_QHG] + l * 96; const float* kg = ap->in[I_KHG] + l * 96;
            for (int it = blockIdx.x * 512 + tid; it < MV * 8; it += G * 512) {
                const int m = it >> 3, h = it & 7; const int t = m >= MR0 ? m - MR0 : (m & (SEQ - 1)) + NMETA;
                float sumq, sumkv;
                if (m < MR0) { const f32x4 sq4 = *(const f32x4*)(SSQ + (size_t)m * 4), sk4 = *(const f32x4*)(SSKV + (size_t)m * 4); sumq = (sq4.x + sq4.y) + (sq4.z + sq4.w); sumkv = (sk4.x + sk4.y) + (sk4.z + sk4.w); }
                else { sumq = 0.f; sumkv = 0.f; const bf16* pc = PROJ + (size_t)m * DINP + C_CQ;
                    for (int c = 0; c < 48; ++c) { const u32x4 v = *(const u32x4*)(pc + 8 * c); float s = 0.f;
#pragma unroll
                        for (int e = 0; e < 4; ++e) { const float a0 = bflo(v[e]), a1 = bfhi(v[e]); s += a0 * a0 + a1 * a1; }
                        if (c < 32) sumq += s; else sumkv += s; } }
                const float s_q = 1.0f / sqrtf(sumq * (1.f / 256.f) + EPS), s_kv = 1.0f / sqrtf(sumkv * (1.f / 128.f) + EPS);
                const f32x4* mt = (const f32x4*)(MT + t * 16);
                { bf16* q = QRAW + (size_t)m * 768 + 96 * h; u32x4 w[12]; float ss = 0.f;
#pragma unroll
                  for (int c = 0; c < 12; ++c) w[c] = *(const u32x4*)(q + 8 * c);
#pragma unroll
                  for (int c = 0; c < 12; ++c)
#pragma unroll
                      for (int e = 0; e < 4; ++e) { const float a0 = bflo(w[c][e]), a1 = bfhi(w[c][e]); ss += a0 * a0 + a1 * a1; }
                  const float rs = s_q * QSCALE / sqrtf(s_q * s_q * ss * (1.f / 96.f) + EPS);
#pragma unroll
                  for (int c = 0; c < 8; ++c) { u32x4 o;
#pragma unroll
                      for (int e = 0; e < 4; ++e) o[e] = att::cvtpk(bflo(w[c][e]) * rs * qg[8 * c + 2 * e], bfhi(w[c][e]) * rs * qg[8 * c + 2 * e + 1]);
                      *(u32x4*)(q + 8 * c) = o; }
#pragma unroll
                  for (int cc = 0; cc < 2; ++cc) { u32x4 o1, o2;
#pragma unroll
                      for (int e = 0; e < 4; ++e) { const int i = 8 * cc + 2 * e; const f32x4 c4 = mt[4 * cc + e];
                          const float a0 = bflo(w[8 + cc][e]) * rs * qg[64 + i], a1 = bfhi(w[8 + cc][e]) * rs * qg[64 + i + 1], b0 = bflo(w[10 + cc][e]) * rs * qg[80 + i], b1 = bfhi(w[10 + cc][e]) * rs * qg[80 + i + 1];
                          o1[e] = att::cvtpk(a0 * c4.x - b0 * c4.y, a1 * c4.z - b1 * c4.w); o2[e] = att::cvtpk(b0 * c4.x + a0 * c4.y, b1 * c4.z + a1 * c4.w); }
                      *(u32x4*)(q + 64 + 8 * cc) = o1; *(u32x4*)(q + 80 + 8 * cc) = o2; } }
                { bf16* kn = KVR + (size_t)m * 1024 + 128 * h; bf16* pr = PROJ + (size_t)m * DINP; bf16* ko = pr + 96 * h; u32x4 w[8], r[4]; float ssn = 0.f, ssr = 0.f;
#pragma unroll
                  for (int c = 0; c < 8; ++c) w[c] = *(const u32x4*)(kn + 8 * c);
#pragma unroll
                  for (int c = 0; c < 4; ++c) r[c] = *(const u32x4*)(pr + C_KR + 8 * c);
#pragma unroll
                  for (int c = 0; c < 8; ++c)
#pragma unroll
                      for (int e = 0; e < 4; ++e) { const float a0 = bflo(w[c][e]), a1 = bfhi(w[c][e]); ssn += a0 * a0 + a1 * a1; }
#pragma unroll
                  for (int c = 0; c < 4; ++c)
#pragma unroll
                      for (int e = 0; e < 4; ++e) { const float a0 = bflo(r[c][e]), a1 = bfhi(r[c][e]); ssr += a0 * a0 + a1 * a1; }
                  const float rs = 1.0f / sqrtf((s_kv * s_kv * ssn + ssr) * (1.f / 96.f) + EPS), rn = rs * s_kv;
#pragma unroll
                  for (int c = 0; c < 8; ++c) { u32x4 o;
#pragma unroll
                      for (int e = 0; e < 4; ++e) o[e] = att::cvtpk(bflo(w[c][e]) * rn * kg[8 * c + 2 * e], bfhi(w[c][e]) * rn * kg[8 * c + 2 * e + 1]);
                      *(u32x4*)(ko + 8 * c) = o; }
#pragma unroll
                  for (int cc = 0; cc < 2; ++cc) { u32x4 o1, o2;
#pragma unroll
                      for (int e = 0; e < 4; ++e) { const int i = 8 * cc + 2 * e; const f32x4 c4 = mt[4 * cc + e];
                          const float a0 = bflo(r[cc][e]) * rs * kg[64 + i], a1 = bfhi(r[cc][e]) * rs * kg[64 + i + 1], b0 = bflo(r[2 + cc][e]) * rs * kg[80 + i], b1 = bfhi(r[2 + cc][e]) * rs * kg[80 + i + 1];
                          o1[e] = att::cvtpk(a0 * c4.x - b0 * c4.y, a1 * c4.z - b1 * c4.w); o2[e] = att::cvtpk(b0 * c4.x + a0 * c4.y, b1 * c4.z + a1 * c4.w); }
                      *(u32x4*)(ko + 64 + 8 * cc) = o1; *(u32x4*)(ko + 80 + 8 * cc) = o2; }
#pragma unroll
                  for (int c = 0; c < 8; ++c) { const u32x4 v = *(const u32x4*)(kn + 64 + 8 * c); u32x4 o;
#pragma unroll
                      for (int e = 0; e < 4; ++e) o[e] = att::cvtpk(bflo(v[e]) * s_kv, bfhi(v[e]) * s_kv);
                      *(u32x4*)(kn + 64 + 8 * c) = o; } }
            }
        } else {
            for (int item = blockIdx.x; item < 524; item += G) {
                if (item < 256 || (item >= 512 && item < 520)) { const bool meta = item >= 512; const int b = meta ? 0 : item >> 3, h = item & 7;
                    const bf16* Qp = QRAW + 96 * h; const bf16* Kp = PROJ + 96 * h; const bf16* Vp = KVR + 128 * h + 64; bf16* Op = MIX + 512 + 64 * h;
                    if (meta) att::unit<96, true>(lds, Qp, 768, Kp, DINP, Vp, 1024, Op, DM, nullptr, 0, nullptr, 0.f, b, 0, 16);
                    else for (int blk = 8; blk >= 1; --blk) { const int q0 = 16 + 256 * (blk - 1);
                        att::unit<96, true>(lds, Qp, 768, Kp, DINP, Vp, 1024, Op, DM, nullptr, 0, nullptr, 0.f, b, q0, q0 + 256); }
                } else { const bool meta = item >= 520; const int it = item - 256, bh = it >> 1, hf = it & 1, b = meta ? 0 : bh >> 2, h = meta ? item - 520 : bh & 3;
                    const bf16* Pp = PROJ + 64 * h; bf16* Op = MIX + 256 + 64 * h; const float* gn = ap->in[I_RETG] + l * 256 + 64 * h;
                    const float lg2 = log2f(1.0f - exp2f(-5.0f - (float)h)); const unsigned bm = hf ? 0x0CCu : 0x132u;
                    if (meta) att::unit<64, false>(lds, Pp + C_RQ, DINP, Pp + C_RK, DINP, Pp + C_RV, DINP, Op, DM, Pp + C_RG, DINP, gn, lg2, b, 0, 16);
                    else for (int blk = 8; blk >= 1; --blk) { if (!((bm >> blk) & 1u)) continue; const int q0 = 16 + 256 * (blk - 1);
                        att::unit<64, false>(lds, Pp + C_RQ, DINP, Pp + C_RK, DINP, Pp + C_RV, DINP, Op, DM, Pp + C_RG, DINP, gn, lg2, b, q0, q0 + 256); }
                }
            }
        }
        if (ph + 1 < hi) grid.sync();
    }
}

extern "C" void kernel_launch(void* const* d_in, const int* in_sizes, int n_in, void* d_out, int out_size, void* d_ws, size_t ws_size, hipStream_t stream) {
    static int grid = 0;
    if (grid == 0) {
        if (n_in != 16 || out_size != MREAL * DM || ws_size < WS_END) { fprintf(stderr, "kernel_launch: unexpected shapes (n_in %d, out %d, ws %zu)\n", n_in, out_size, ws_size); grid = -1; return; }
        int dev = 0, cus = 0, per_cu = 0;
        if (hipGetDevice(&dev) != hipSuccess || hipDeviceGetAttribute(&cus, hipDeviceAttributeMultiprocessorCount, dev) != hipSuccess) { grid = -1; return; }
        if (hipFuncSetAttribute((const void*)hybrid_fwd, hipFuncAttributeMaxDynamicSharedMemorySize, LDS_BYTES) != hipSuccess) { fprintf(stderr, "kernel_launch: hipFuncSetAttribute failed\n"); grid = -1; return; }
        if (hipOccupancyMaxActiveBlocksPerMultiprocessor(&per_cu, (const void*)hybrid_fwd, NWAVES * 64, LDS_BYTES) != hipSuccess || per_cu < 1) { fprintf(stderr, "kernel_launch: occupancy query says %d\n", per_cu); per_cu = 1; }
        (void)hipGetLastError();
        grid = cus;
    }
    if (grid < 0) return;
    Args a{};
    for (int i = 0; i < 16; ++i) a.in[i] = (const float*)d_in[i];
    a.out = (float*)d_out; a.ws = (unsigned char*)d_ws;
#if MK_MULTI
    for (int ph = 0; ph < NPHASE; ++ph) { a.ph_lo = ph; a.ph_hi = ph + 1; hipLaunchKernelGGL(hybrid_fwd, dim3(grid), dim3(NWAVES * 64), LDS_BYTES, stream, a); }
#else
    a.ph_lo = 0; a.ph_hi = NPHASE;
    void* kargs[] = {&a};
    const hipError_t e = hipLaunchCooperativeKernel((const void*)hybrid_fwd, dim3(grid), dim3(NWAVES * 64), kargs, LDS_BYTES, stream);
    if (e != hipSuccess) fprintf(stderr, "kernel_launch: cooperative launch failed: %s (grid %d)\n", hipGetErrorString(e), grid);
#endif
}
```

```cpp
#include <hip/hip_runtime.h>
#include <hip/hip_cooperative_groups.h>
#include <cstdio>
#include <cstdint>
#include <cmath>
namespace cg = cooperative_groups;
#ifndef MK_MULTI
#define MK_MULTI 0
#endif
namespace pg8 {
#define PG8_LAS __attribute__((address_space(3)))
typedef unsigned short bf16_t;
typedef short bf16x8 __attribute__((ext_vector_type(8)));
typedef float f32x4 __attribute__((ext_vector_type(4)));
typedef unsigned u32x4 __attribute__((ext_vector_type(4)));
typedef unsigned u32x2 __attribute__((ext_vector_type(2)));
constexpr int BM = 256, BK = 64, HALF = 128, HTB = HALF * BK * 2  , STAGE_BYTES = 8 * HTB, NXCD = 8, WGM = 8;

__host__ __device__ __forceinline__ int lds_byte(int r, int c) { const int st = (r >> 4) * 2 + (c >> 5), rr = r & 15, cc = c & 31, ob = rr * 64 + cc * 2; return st * 1024 + (ob ^ (((ob >> 9) & 1) << 5)); }
__host__ __device__ __forceinline__ void stage_rc(int b, int& R, int& C) { const int st = b / 1024, sb = b % 1024, swz = sb ^ (((sb >> 9) & 1) << 5); R = (st >> 1) * 16 + swz / 64; C = (st & 1) * 32 + (swz % 64) / 2; }
__host__ __device__ __forceinline__ int perm32(int rho) { const int n = rho >> 4, i = rho & 15; return 8 * (i >> 2) + 4 * n + (i & 3); }

__device__ __forceinline__ int opaque_tid() { int t = threadIdx.x; asm volatile("" : "+v"(t)); return t; }
struct Unit { int pm, pn; };
struct Gemm { const bf16_t* A; const bf16_t* Bt; int M, N, K, lda; };

struct StaticOrder {
    int nM, nN, nwg, G, c;
    __host__ __device__ void init(int M, int N, int G_, int c_) { nM = M / BM; nN = N / BM; nwg = nM * nN; G = G_; c = c_; }
    __host__ __device__ bool next(int i, Unit& u) const {
        const long L = (long)i * G + c; if (L >= nwg) return false;
        int wgid = (int)L; { const int q = nwg / NXCD, r = nwg % NXCD, xcd = wgid % NXCD, off = wgid / NXCD; wgid = (xcd < r ? xcd * (q + 1) : r * (q + 1) + (xcd - r) * q) + off; }
        const int nig = WGM * nN, gid = wgid / nig, fm = gid * WGM, gsz = (nM - fm) < WGM ? (nM - fm) : WGM;
        u.pm = fm + ((wgid % nig) % gsz); u.pn = (wgid % nig) / gsz; return true;
    }
    __device__ __forceinline__ void a_ready(const Unit&) const {}
    __device__ __forceinline__ void done(const Unit&) const {}
};

__device__ __forceinline__ unsigned cvt_pk_bf16(float lo, float hi) { unsigned r; asm volatile("v_cvt_pk_bf16_f32 %0, %1, %2" : "=v"(r) : "v"(lo), "v"(hi)); return r; }
struct EpiAny {
    static constexpr bool AFTER_DRAIN = false;
    int mode, perm; bf16_t* O; int ldc; const float* xin; float* X; float* out; bf16_t* xb; float* ssx; const float* rs_src; float* ssq; float* sskv;
    __device__ __forceinline__ void operator()(const f32x4 (&acc)[2][2][4][2], const Unit& u, int wr, int wc, int fr, int fq) const {
        if (mode < 2) {
            const int row0 = u.pm * BM + wr * 64 + fr; const int col0 = u.pn * BM + wc * 32 + 8 * fq; const bool sq = mode == 1;
            const int sstile = ssq ? (u.pn == 7 ? 1 : (u.pn == 8 ? 2 : 0)) : 0;
#pragma unroll
            for (int ai = 0; ai < 2; ++ai)
#pragma unroll
                for (int m = 0; m < 4; ++m) { const int row = row0 + ai * HALF + m * 16; bf16_t* rowp = O + (size_t)row * ldc + col0;
                    float rs = 1.f;
                    if (rs_src) { const f32x4* p = (const f32x4*)(rs_src + (size_t)row * 16); const f32x4 a = (p[0] + p[1]) + (p[2] + p[3]); rs = 1.0f / sqrtf(((a[0] + a[1]) + (a[2] + a[3])) * (1.f / 1024.f) + 1e-6f); }
                    float part = 0.f;
#pragma unroll
                    for (int bj = 0; bj < 2; ++bj) { f32x4 v0 = acc[ai][bj][m][0] * rs, v1 = acc[ai][bj][m][1] * rs;
                        if (sq) {
#pragma unroll
                            for (int e = 0; e < 4; ++e) { const float a = fmaxf(v0[e], 0.f), b = fmaxf(v1[e], 0.f); v0[e] = a * a; v1[e] = b * b; } }
                        if (sstile == 1 || (sstile == 2 && bj == 0)) part += ((v0[0] * v0[0] + v0[1] * v0[1]) + (v0[2] * v0[2] + v0[3] * v0[3])) + ((v1[0] * v1[0] + v1[1] * v1[1]) + (v1[2] * v1[2] + v1[3] * v1[3]));
                        u32x4 w; w.x = cvt_pk_bf16(v0[0], v0[1]); w.y = cvt_pk_bf16(v0[2], v0[3]); w.z = cvt_pk_bf16(v1[0], v1[1]); w.w = cvt_pk_bf16(v1[2], v1[3]);
                        *(u32x4*)(rowp + bj * HALF) = w; }
                    if (sstile) { part += __shfl_xor(part, 16); part += __shfl_xor(part, 32); if (fq == 0) (sstile == 1 ? ssq : sskv)[(size_t)row * 4 + wc] = part; }
                }
        } else {
            const int col0 = u.pn * BM + wc * 32 + 4 * fq; const bool toout = mode == 3;
#pragma unroll
            for (int ai = 0; ai < 2; ++ai)
#pragma unroll
                for (int m = 0; m < 4; ++m) { const int r = u.pm * BM + ai * HALF + wr * 64 + m * 16 + fr; const float* xp = xin + (size_t)r * 1024 + col0;
                    float* op = (toout ? out : X) + (size_t)r * 1024 + col0; const bool wr_ok = true;
                    bf16_t* bp = xb + (size_t)r * 1024 + col0; float part = 0.f;
#pragma unroll
                    for (int bj = 0; bj < 2; ++bj)
#pragma unroll
                        for (int n = 0; n < 2; ++n) { const f32x4 v = *(const f32x4*)(xp + bj * HALF + n * 16) + acc[ai][bj][m][n]; if (wr_ok) *(f32x4*)(op + bj * HALF + n * 16) = v;
                            if (!toout) { part += (v[0] * v[0] + v[1] * v[1]) + (v[2] * v[2] + v[3] * v[3]); u32x2 w; w.x = cvt_pk_bf16(v[0], v[1]); w.y = cvt_pk_bf16(v[2], v[3]); *(u32x2*)(bp + bj * HALF + n * 16) = w; } }
                    if (!toout) { part += __shfl_xor(part, 16); part += __shfl_xor(part, 32); if (fq == 0) ssx[(size_t)r * 16 + u.pn * 4 + wc] = part; }
                    asm volatile("" ::: "memory"); }
        }
    }
};

template <class Epi, class Sched, bool ALIGN_EPI = false, bool SP2 = false>
__device__ __forceinline__ void gemm_phase(PG8_LAS unsigned char* lds, const Gemm g, const Sched& S, const Epi& E, const int tid_in) {
    int tid_o = tid_in; asm volatile("" : "+v"(tid_o));
    const int tid = tid_o, wid = __builtin_amdgcn_readfirstlane(tid >> 6), lane = tid & 63, wr = wid >> 2, wc = wid & 3, fr = lane & 15, fq = lane >> 4;
    const int K = g.K, nt = K / BK;
    unsigned voffA[2], voffB[2];
#pragma unroll
    for (int i = 0; i < 2; ++i) { int R, C; stage_rc(tid * 16 + i * 8192, R, C); const int Rb = E.perm ? ((R & ~31) + perm32(R & 31)) : R;
        voffA[i] = (unsigned)(R * g.lda + C) * 2u; voffB[i] = (unsigned)(Rb * K + C) * 2u; }
    const size_t kstep = (size_t)(BK * 2);
    const size_t hstepA = (size_t)HALF * g.lda * 2, hstepB = (size_t)HALF * K * 2;
    const size_t tstepA = 2 * hstepA, tstepB = 2 * hstepB;
    const unsigned ldsw = (unsigned)wid * 1024u;
    const int aoff = lds_byte(wr * 64 + fr, fq * 8), boff = lds_byte(wc * 32 + fr, fq * 8);
#define PG8_SA(b, h) (((b) * 2 + (h)) * HTB)
#define PG8_SB(b, h) ((4 + (b) * 2 + (h)) * HTB)
#define PG8_STAGE(bufoff, gbase, voff) do { _Pragma("unroll") for (int _i = 0; _i < 2; ++_i) \
        __builtin_amdgcn_global_load_lds((const unsigned*)((const char*)(gbase) + (voff)[_i]), (PG8_LAS unsigned*)(lds + (bufoff) + ldsw + _i * 8192), 16, 0, 0); } while (0)
#define PG8_LDA(dst, b, h) do { _Pragma("unroll") for (int m = 0; m < 4; ++m) _Pragma("unroll") for (int k = 0; k < 2; ++k) dst[m][k] = *(const PG8_LAS bf16x8*)(lds + PG8_SA(b, h) + aoff + m * 2048 + k * 1024); } while (0)
#define PG8_LDB(dst, b, h) do { _Pragma("unroll") for (int n = 0; n < 2; ++n) _Pragma("unroll") for (int k = 0; k < 2; ++k) dst[n][k] = *(const PG8_LAS bf16x8*)(lds + PG8_SB(b, h) + boff + n * 2048 + k * 1024); } while (0)
#define PG8_MMA(ai, bj, At, Bt) do { __builtin_amdgcn_s_setprio(1); _Pragma("unroll") for (int m = 0; m < 4; ++m) _Pragma("unroll") for (int n = 0; n < 2; ++n) _Pragma("unroll") for (int k = 0; k < 2; ++k) \
        acc[ai][bj][m][n] = __builtin_amdgcn_mfma_f32_16x16x32_bf16(Bt[n][k], At[m][k], acc[ai][bj][m][n], 0, 0, 0); __builtin_amdgcn_s_setprio(0); } while (0)
#define PG8_WAIT_V(n) asm volatile("s_waitcnt vmcnt(" #n ")" ::: "memory")
#define PG8_WAIT_L(n) asm volatile("s_waitcnt lgkmcnt(" #n ")" ::: "memory")
#define PG8_BAR __builtin_amdgcn_s_barrier()
#define PG8_SCHED __builtin_amdgcn_sched_barrier(0)
    Unit cur, nxt; int ui = 0;
    if (!S.next(0, cur)) return;
    f32x4 acc[2][2][4][2];
#pragma unroll
    for (int a = 0; a < 2; ++a)
#pragma unroll
        for (int b = 0; b < 2; ++b)
#pragma unroll
            for (int m = 0; m < 4; ++m)
#pragma unroll
                for (int n = 0; n < 2; ++n) acc[a][b][m][n] = (f32x4){0.f, 0.f, 0.f, 0.f};
    bf16x8 At[4][2], B0[2][2], B1[2][2];
    const char* cA = (const char*)g.A + (size_t)cur.pm * tstepA; const char* cB = (const char*)g.Bt + (size_t)cur.pn * tstepB;
    S.a_ready(cur);
    if constexpr (SP2) {
        PG8_STAGE(PG8_SB(0, 0), cB, voffB); PG8_STAGE(PG8_SB(0, 1), cB + hstepB, voffB); PG8_STAGE(PG8_SA(0, 0), cA, voffA); PG8_STAGE(PG8_SA(0, 1), cA + hstepA, voffA);
        if (wr == 1) PG8_BAR;
        PG8_WAIT_V(2); PG8_BAR;
        PG8_STAGE(PG8_SB(1, 0), cB + kstep, voffB); PG8_STAGE(PG8_SA(1, 0), cA + kstep, voffA); PG8_STAGE(PG8_SB(1, 1), cB + hstepB + kstep, voffB);
        PG8_WAIT_V(6); PG8_BAR;
    } else {
        PG8_STAGE(PG8_SB(0, 0), cB, voffB); PG8_STAGE(PG8_SA(0, 0), cA, voffA); PG8_STAGE(PG8_SB(0, 1), cB + hstepB, voffB); PG8_STAGE(PG8_SA(0, 1), cA + hstepA, voffA);
        if (wr == 1) PG8_BAR;
        PG8_WAIT_V(4); PG8_BAR;
        PG8_STAGE(PG8_SB(1, 0), cB + kstep, voffB); PG8_STAGE(PG8_SA(1, 0), cA + kstep, voffA); PG8_STAGE(PG8_SB(1, 1), cB + hstepB + kstep, voffB);
        PG8_WAIT_V(6); PG8_BAR;
    }
    for (;;) {
        const bool has_next = S.next(ui + 1, nxt);
        const char* nA = has_next ? (const char*)g.A + (size_t)nxt.pm * tstepA : cA; const char* nB = has_next ? (const char*)g.Bt + (size_t)nxt.pn * tstepB : cB;
        for (int t = 0; t < nt; t += 2) {
            const bool last = (t == nt - 2);
            const char* a1 = cA + (size_t)(t + 1) * kstep;
            const char* a2 = last ? nA : cA + (size_t)(t + 2) * kstep; const char* b2 = last ? nB : cB + (size_t)(t + 2) * kstep;
            const char* a3 = a2 + kstep; const char* b3 = b2 + kstep;
            if (last && has_next) S.a_ready(nxt);
            if constexpr (SP2) {
            PG8_LDB(B0, 0, 0); PG8_LDB(B1, 0, 1); PG8_SCHED; PG8_LDA(At, 0, 0); PG8_STAGE(PG8_SA(1, 1), a1 + hstepA, voffA);
            PG8_WAIT_V(8); PG8_WAIT_L(0); PG8_BAR; PG8_MMA(0, 0, At, B0); PG8_MMA(0, 1, At, B1); PG8_BAR; PG8_SCHED;
            PG8_LDA(At, 0, 1); PG8_STAGE(PG8_SB(0, 0), b2, voffB); PG8_STAGE(PG8_SB(0, 1), b2 + hstepB, voffB); PG8_STAGE(PG8_SA(0, 0), a2, voffA);
            PG8_WAIT_V(8); PG8_WAIT_L(0); PG8_BAR; PG8_MMA(1, 0, At, B0); PG8_MMA(1, 1, At, B1); PG8_BAR; PG8_SCHED;
            PG8_LDB(B0, 1, 0); PG8_LDB(B1, 1, 1); PG8_SCHED; PG8_LDA(At, 1, 0); PG8_STAGE(PG8_SA(0, 1), a2 + hstepA, voffA);
            PG8_WAIT_V(8); PG8_WAIT_L(0); PG8_BAR; PG8_MMA(0, 0, At, B0); PG8_MMA(0, 1, At, B1); PG8_BAR; PG8_SCHED;
            PG8_LDA(At, 1, 1); PG8_STAGE(PG8_SB(1, 0), b3, voffB); PG8_STAGE(PG8_SB(1, 1), b3 + hstepB, voffB); PG8_STAGE(PG8_SA(1, 0), a3, voffA);
            PG8_WAIT_V(8); PG8_WAIT_L(0); PG8_BAR; PG8_MMA(1, 0, At, B0); PG8_MMA(1, 1, At, B1); PG8_BAR; PG8_SCHED;
            } else {
            PG8_LDB(B0, 0, 0); PG8_SCHED; PG8_LDA(At, 0, 0); PG8_STAGE(PG8_SA(1, 1), a1 + hstepA, voffA);
            PG8_WAIT_L(8); PG8_BAR; PG8_WAIT_L(0); PG8_MMA(0, 0, At, B0); PG8_BAR; PG8_SCHED;
            PG8_LDB(B1, 0, 1); PG8_STAGE(PG8_SB(0, 0), b2, voffB);
            PG8_BAR; PG8_WAIT_L(0); PG8_MMA(0, 1, At, B1); PG8_BAR;
            PG8_LDA(At, 0, 1); PG8_STAGE(PG8_SA(0, 0), a2, voffA);
            PG8_BAR; PG8_WAIT_L(0); PG8_MMA(1, 0, At, B0); PG8_BAR; PG8_SCHED;
            PG8_STAGE(PG8_SB(0, 1), b2 + hstepB, voffB);
            PG8_WAIT_V(6); PG8_BAR; PG8_MMA(1, 1, At, B1); PG8_BAR;
            PG8_LDB(B0, 1, 0); PG8_SCHED; PG8_LDA(At, 1, 0); PG8_STAGE(PG8_SA(0, 1), a2 + hstepA, voffA);
            PG8_WAIT_L(8); PG8_BAR; PG8_WAIT_L(0); PG8_MMA(0, 0, At, B0); PG8_BAR; PG8_SCHED;
            PG8_LDB(B1, 1, 1); PG8_STAGE(PG8_SB(1, 0), b3, voffB);
            PG8_BAR; PG8_WAIT_L(0); PG8_MMA(0, 1, At, B1); PG8_BAR;
            PG8_LDA(At, 1, 1); PG8_STAGE(PG8_SA(1, 0), a3, voffA);
            PG8_BAR; PG8_WAIT_L(0); PG8_MMA(1, 0, At, B0); PG8_BAR; PG8_SCHED;
            PG8_STAGE(PG8_SB(1, 1), b3 + hstepB, voffB);
            PG8_WAIT_V(6); PG8_BAR; PG8_MMA(1, 1, At, B1); PG8_BAR;
            }
        }
        if constexpr (ALIGN_EPI) { if (wr == 0) PG8_BAR; }
        if constexpr (!Epi::AFTER_DRAIN) { E(acc, cur, wr, wc, fr, fq); S.done(cur); }
        if (!has_next) break;
#pragma unroll
        for (int a = 0; a < 2; ++a)
#pragma unroll
            for (int b = 0; b < 2; ++b)
#pragma unroll
                for (int m = 0; m < 4; ++m)
#pragma unroll
                    for (int n = 0; n < 2; ++n) acc[a][b][m][n] = (f32x4){0.f, 0.f, 0.f, 0.f};
        cur = nxt; cA = nA; cB = nB; ++ui;
        if constexpr (ALIGN_EPI) { if (wr == 1) PG8_BAR; }
    }
    PG8_WAIT_V(0);
    if constexpr (!ALIGN_EPI) { if (wr == 0) PG8_BAR; }
    PG8_BAR;
    if constexpr (Epi::AFTER_DRAIN) { E.fused(acc, cur, wr, wc, fr, fq, lds, wid, lane); S.done(cur); }
#undef PG8_SA
#undef PG8_SB
#undef PG8_STAGE
#undef PG8_LDA
#undef PG8_LDB
#undef PG8_MMA
#undef PG8_WAIT_V
#undef PG8_WAIT_L
#undef PG8_BAR
#undef PG8_SCHED
}
}

#define GAS __attribute__((address_space(1)))
#define LAS __attribute__((address_space(3)))
typedef unsigned short bf16;
typedef unsigned u32x4 __attribute__((ext_vector_type(4)));
typedef unsigned u32x2 __attribute__((ext_vector_type(2)));
typedef float f32x4 __attribute__((ext_vector_type(4)));
typedef float f32x2 __attribute__((ext_vector_type(2)));
typedef short bf16x8 __attribute__((ext_vector_type(8)));
typedef float f32x16 __attribute__((ext_vector_type(16)));
constexpr int DM = 1024, BATCH = 32, SEQ = 2048, NMETA = 16, TT = SEQ + NMETA, DIN = 2208, DINP = 2304, DFF = 4096, DEPTH = 2;
constexpr int MREAL = BATCH * SEQ, MR0 = MREAL, MV = MREAL + NMETA, M = MREAL + 256;
static_assert(MREAL % 256 == 0, "row tiles");
__device__ __forceinline__ int rowof(int b, int t) { return t < NMETA ? MR0 + t : b * SEQ + (t - NMETA); }
constexpr int C_CB = 0, C_CC = 256, C_CH = 512, C_RQ = 768, C_RK = 1024, C_RV = 1280, C_RG = 1536, C_CQ = 1792, C_CKV = 2048, C_KR = 2176;
constexpr float EPS = 1e-6f;
constexpr float QSCALE = 0.10206207261596575f * 1.4426950408889634f;
constexpr size_t MiB = 1u << 20;
constexpr size_t WS_RT = 1 * MiB, WS_MT = 1 * MiB + 768 * 1024;
constexpr size_t WS_WIN = 4 * MiB, WS_WUQ = 13 * MiB, WS_WUKV = 14 * MiB, WS_WOUT = 15 * MiB, WS_W1 = 19 * MiB, WS_W2 = 35 * MiB;
constexpr size_t WS_X = 52 * MiB, WS_XN = 310 * MiB, WS_PROJ = 440 * MiB, WS_QRAW = 731 * MiB, WS_KV = 828 * MiB, WS_H = 440 * MiB, WS_SSX = 958 * MiB, WS_SSQ = 964 * MiB, WS_SSKV = 966 * MiB, WS_END = 968 * MiB;
static_assert(WS_X + (size_t)M * DM * 4 <= WS_XN && WS_XN + (size_t)M * DM * 2 <= WS_PROJ && WS_PROJ + (size_t)M * DINP * 2 <= WS_QRAW && WS_QRAW + (size_t)M * 768 * 2 <= WS_KV &&
              WS_KV + (size_t)M * 1024 * 2 <= WS_SSX && WS_H + (size_t)M * DFF * 2 <= WS_SSX && WS_SSX + (size_t)M * 64 <= WS_SSQ && WS_SSQ + (size_t)M * 16 <= WS_SSKV && WS_SSKV + (size_t)M * 16 <= WS_END, "d_ws map");
constexpr int NWAVES = 8, LDS_BYTES = 147456;

__device__ __forceinline__ unsigned f2bf(float f) { unsigned u = __builtin_bit_cast(unsigned, f); return (u + 0x7fffu + ((u >> 16) & 1u)) >> 16; }
__device__ __forceinline__ unsigned pk2(float lo, float hi) { return f2bf(lo) | (f2bf(hi) << 16); }
__device__ __forceinline__ float bflo(unsigned w) { return __uint_as_float(w << 16); }
__device__ __forceinline__ float bfhi(unsigned w) { return __uint_as_float(w & 0xffff0000u); }
__device__ __forceinline__ float bf1(bf16 h) { return __uint_as_float((unsigned)h << 16); }
__device__ __forceinline__ float wave_sum(float v) {
#pragma unroll
    for (int o = 1; o < 64; o <<= 1) v += __shfl_xor(v, o);
    return v;
}
__device__ __forceinline__ float half_sum(float v) {
#pragma unroll
    for (int o = 1; o < 32; o <<= 1) v += __shfl_xor(v, o);
    return v;
}

namespace att {
typedef float f32x2_t __attribute__((ext_vector_type(2))); typedef __bf16 bf16x2_t __attribute__((ext_vector_type(2)));
__device__ __forceinline__ unsigned cvtpk(float lo, float hi) { f32x2_t v = {lo, hi}; bf16x2_t b = __builtin_convertvector(v, bf16x2_t); return __builtin_bit_cast(unsigned, b); }
constexpr int VP = 144;
__device__ __forceinline__ float xhalf_max(float v) { auto rr = __builtin_amdgcn_permlane32_swap(__float_as_uint(v), __float_as_uint(v), false, false); return fmaxf(__uint_as_float(rr[0]), __uint_as_float(rr[1])); }
__device__ __forceinline__ float xhalf_sum(float v) { auto rr = __builtin_amdgcn_permlane32_swap(__float_as_uint(v), __float_as_uint(v), false, false); return __uint_as_float(rr[0]) + __uint_as_float(rr[1]); }
template <int DQK, bool SM>
__device__ __forceinline__ void unit(LAS unsigned char* lds, const bf16* Q, int ldq, const bf16* K, int ldk, const bf16* V, int ldv, bf16* O, int ldo,
                                     const bf16* G, int ldg, const float* gain, float lg2, int b, int q0, int qend, const int tid_in) {
    constexpr int KP = DQK * 2 + 16, CH = DQK / 8, ND = DQK / 16, KB = 64 * KP, VB = 64 * VP, SB = KB + VB;
    int tid_o = tid_in; asm volatile("" : "+v"(tid_o));
    const int tid = tid_o, lane = tid & 63, wid = __builtin_amdgcn_readfirstlane(tid >> 6), r32 = lane & 31, hi = lane >> 5;
    const int q0w = q0 + 32 * wid, tq = q0w + r32;
    const bool wact = q0w < qend;
    bf16x8 qr[ND];
    const int qrow = rowof(b, tq < TT ? tq : TT - 1);
    { const bf16* qp = Q + (size_t)qrow * ldq + 8 * hi;
#pragma unroll
      for (int d0 = 0; d0 < ND; ++d0) qr[d0] = *(const bf16x8*)(qp + 16 * d0); }
    const int ntiles = (qend - 1) / 64 + 1;
    const int nw = wact ? ((q0w + 31) / 64 + 1 < ntiles ? (q0w + 31) / 64 + 1 : ntiles) : 0;
    const int nfull = (q0w + 1) / 64;
    const int kkey0 = tid / CH, kch0 = tid % CH, kkey1 = (tid + 512) / CH, kch1 = (tid + 512) % CH;
    const bool has2 = (64 * CH > 512) && (tid + 512 < 64 * CH);
    const int vkey = tid & 63, vch = tid >> 6;
    const int pr32 = (r32 & 0x13) | ((r32 & 4) << 1) | ((r32 & 8) >> 1);
    const int koff = pr32 * KP + 16 * hi, voff = KB + r32 * VP + 16 * hi;
    u32x4 kreg0, kreg1 = {0u, 0u, 0u, 0u}, vreg;
#define ATT_LOAD(j) do { int r0_ = 64 * (j) + kkey0; r0_ = r0_ < TT ? r0_ : TT - 1; kreg0 = *(const u32x4*)(K + (size_t)rowof(b, r0_) * ldk + 8 * kch0); \
        if (has2) { int r1_ = 64 * (j) + kkey1; r1_ = r1_ < TT ? r1_ : TT - 1; kreg1 = *(const u32x4*)(K + (size_t)rowof(b, r1_) * ldk + 8 * kch1); } \
        int rv_ = 64 * (j) + vkey; rv_ = rv_ < TT ? rv_ : TT - 1; vreg = *(const u32x4*)(V + (size_t)rowof(b, rv_) * ldv + 8 * vch); } while (0)
#define ATT_STORE(so) do { *(LAS u32x4*)(lds + (so) + kkey0 * KP + 16 * kch0) = kreg0; if (has2) *(LAS u32x4*)(lds + (so) + kkey1 * KP + 16 * kch1) = kreg1; \
        LAS unsigned char* vd_ = lds + (so) + KB + (8 * vch) * VP + 2 * vkey; \
        _Pragma("unroll") for (int i_ = 0; i_ < 8; ++i_) { const unsigned w_ = vreg[i_ >> 1]; *(LAS unsigned short*)(vd_ + i_ * VP) = (unsigned short)((i_ & 1) ? (w_ >> 16) : (w_ & 0xffffu)); } } while (0)
#define ATT_KREAD(so) do { const LAS unsigned char* kb_ = lds + (so) + koff; \
        _Pragma("unroll") for (int d0 = 0; d0 < ND; ++d0) { kf0[d0] = *(const LAS bf16x8*)(kb_ + 32 * d0); kf1[d0] = *(const LAS bf16x8*)(kb_ + 32 * KP + 32 * d0); } } while (0)
#define ATT_VREAD(so) do { const LAS unsigned char* vb_ = lds + (so) + voff; \
        _Pragma("unroll") for (int ks = 0; ks < 4; ++ks) { vf0[ks] = *(const LAS bf16x8*)(vb_ + 32 * ks); vf1[ks] = *(const LAS bf16x8*)(vb_ + 32 * VP + 32 * ks); } } while (0)
#define ATT_QKM(S0, S1) do { \
        _Pragma("unroll") for (int r_ = 0; r_ < 16; ++r_) { S0[r_] = 0.f; S1[r_] = 0.f; } \
        _Pragma("unroll") for (int d0 = 0; d0 < ND; ++d0) { \
            S0 = __builtin_amdgcn_mfma_f32_32x32x16_bf16(kf0[d0], qr[d0], S0, 0, 0, 0); S1 = __builtin_amdgcn_mfma_f32_32x32x16_bf16(kf1[d0], qr[d0], S1, 0, 0, 0); } } while (0)
#define ATT_TILE(j, so, MASK) do { const int kbase_ = 64 * (j) + 8 * hi; \
        if (SM) { \
            if (MASK) { _Pragma("unroll") for (int r = 0; r < 16; ++r) { const int kk = kbase_ + 16 * (r >> 3) + (r & 7); if (kk > tq) s0[r] = -INFINITY; if (kk + 32 > tq) s1[r] = -INFINITY; } } \
            float mx = fmaxf(s0[0], s1[0]); \
            _Pragma("unroll") for (int r = 1; r < 16; ++r) mx = fmaxf(mx, fmaxf(s0[r], s1[r])); \
            mx = xhalf_max(mx); \
            const float mn = fmaxf(m_run, mx), alpha = __builtin_amdgcn_exp2f(m_run - mn); m_run = mn; \
            float ps = 0.f; \
            _Pragma("unroll") for (int r = 0; r < 16; ++r) { s0[r] = __builtin_amdgcn_exp2f(s0[r] - mn); s1[r] = __builtin_amdgcn_exp2f(s1[r] - mn); ps += s0[r] + s1[r]; } \
            l_run = l_run * alpha + ps; \
            _Pragma("unroll") for (int r = 0; r < 16; ++r) { o0[r] *= alpha; o1[r] *= alpha; } \
        } else { \
            const float rf0 = __builtin_amdgcn_exp2f(lg2 * (float)(tq - kbase_)), rf1 = rf0 * c32; \
            _Pragma("unroll") for (int r = 0; r < 16; ++r) { s0[r] = (s0[r] * cfac[r]) * rf0; s1[r] = (s1[r] * cfac[r]) * rf1; } \
            if (MASK) { _Pragma("unroll") for (int r = 0; r < 16; ++r) { const int kk = kbase_ + 16 * (r >> 3) + (r & 7); if (kk > tq) s0[r] = 0.f; if (kk + 32 > tq) s1[r] = 0.f; } } \
        } \
        u32x4 pw[4]; \
        _Pragma("unroll") for (int ks = 0; ks < 2; ++ks) { \
            pw[ks] = (u32x4){cvtpk(s0[8 * ks], s0[8 * ks + 1]), cvtpk(s0[8 * ks + 2], s0[8 * ks + 3]), cvtpk(s0[8 * ks + 4], s0[8 * ks + 5]), cvtpk(s0[8 * ks + 6], s0[8 * ks + 7])}; \
            pw[2 + ks] = (u32x4){cvtpk(s1[8 * ks], s1[8 * ks + 1]), cvtpk(s1[8 * ks + 2], s1[8 * ks + 3]), cvtpk(s1[8 * ks + 4], s1[8 * ks + 5]), cvtpk(s1[8 * ks + 6], s1[8 * ks + 7])}; } \
        _Pragma("unroll") for (int ks = 0; ks < 4; ++ks) { const bf16x8 pf_ = __builtin_bit_cast(bf16x8, pw[ks]); \
            o0 = __builtin_amdgcn_mfma_f32_32x32x16_bf16(vf0[ks], pf_, o0, 0, 0, 0); o1 = __builtin_amdgcn_mfma_f32_32x32x16_bf16(vf1[ks], pf_, o1, 0, 0, 0); } } while (0)
    f32x16 o0, o1, s0, s1, t0, t1; bf16x8 kf0[ND], kf1[ND], vf0[4], vf1[4];
#pragma unroll
    for (int r = 0; r < 16; ++r) { o0[r] = 0.f; o1[r] = 0.f; s0[r] = 0.f; s1[r] = 0.f; t0[r] = 0.f; t1[r] = 0.f; }
    float m_run = -INFINITY, l_run = 0.f;
    float cfac[16]; const float c32 = SM ? 0.f : __builtin_amdgcn_exp2f(-32.f * lg2);
#pragma unroll
    for (int r = 0; r < 16; ++r) cfac[r] = SM ? 0.f : __builtin_amdgcn_exp2f(-lg2 * (float)(16 * (r >> 3) + (r & 7)));
    int so_c = 0, so_n = SB, so_nn = 2 * SB;
    ATT_LOAD(0); ATT_STORE(0);
    if (ntiles > 1) { ATT_LOAD(1); ATT_STORE(SB); }
    __syncthreads();
    if (nw > 0) { ATT_KREAD(0); __builtin_amdgcn_sched_barrier(0); ATT_QKM(s0, s1); }
    for (int j = 0; j < ntiles; ++j) {
        if (j + 2 < ntiles) ATT_LOAD(j + 2);
        if (j + 1 < nw && j < nfull) {
            ATT_KREAD(so_n); ATT_VREAD(so_c); __builtin_amdgcn_sched_barrier(0);
            ATT_QKM(t0, t1);
            ATT_TILE(j, so_c, false);
#pragma unroll
            for (int r = 0; r < 16; ++r) { s0[r] = t0[r]; s1[r] = t1[r]; }
        } else if (j < nw) {
            if (j + 1 < nw) { ATT_KREAD(so_n); ATT_VREAD(so_c); __builtin_amdgcn_sched_barrier(0); ATT_QKM(t0, t1); } else { ATT_VREAD(so_c); }
            ATT_TILE(j, so_c, true);
#pragma unroll
            for (int r = 0; r < 16; ++r) { s0[r] = t0[r]; s1[r] = t1[r]; }
        }
        if (j + 2 < ntiles) ATT_STORE(so_nn);
        __syncthreads();
        { const int t_ = so_c; so_c = so_n; so_n = so_nn; so_nn = t_; }
    }
#undef ATT_LOAD
#undef ATT_STORE
#undef ATT_KREAD
#undef ATT_VREAD
#undef ATT_QKM
#undef ATT_TILE
    if (wact) {
        if (SM) {
            const float l = xhalf_sum(l_run), inv = 1.f / l;
            if (tq < qend) { bf16* op = O + (size_t)qrow * ldo + 4 * hi;
#pragma unroll
                for (int g = 0; g < 4; ++g) {
                    u32x2 a, bq; a.x = cvtpk(o0[4 * g] * inv, o0[4 * g + 1] * inv); a.y = cvtpk(o0[4 * g + 2] * inv, o0[4 * g + 3] * inv);
                    bq.x = cvtpk(o1[4 * g] * inv, o1[4 * g + 1] * inv); bq.y = cvtpk(o1[4 * g + 2] * inv, o1[4 * g + 3] * inv);
                    *(u32x2*)(op + 8 * g) = a; *(u32x2*)(op + 32 + 8 * g) = bq; } }
        } else {
            float ss = 0.f;
#pragma unroll
            for (int r = 0; r < 16; ++r) ss += o0[r] * o0[r] + o1[r] * o1[r];
            ss = xhalf_sum(ss);
            const float rs = 1.0f / sqrtf(ss * (1.f / 64.f) + EPS);
            if (tq < qend) { bf16* op = O + (size_t)qrow * ldo + 4 * hi; const bf16* gp = G + (size_t)qrow * ldg + 4 * hi; const float* gn = gain + 4 * hi;
#pragma unroll
                for (int g = 0; g < 4; ++g) {
#pragma unroll
                    for (int db = 0; db < 2; ++db) {
                        const u32x2 gw = *(const u32x2*)(gp + 32 * db + 8 * g); const f32x4 ga = *(const f32x4*)(gn + 32 * db + 8 * g);
                        float gv[4] = {bflo(gw.x), bfhi(gw.x), bflo(gw.y), bfhi(gw.y)}; float y[4];
#pragma unroll
                        for (int e = 0; e < 4; ++e) { const float ov = db ? o1[4 * g + e] : o0[4 * g + e]; const float sg = gv[e] / (1.f + __expf(-gv[e])); y[e] = ov * rs * ga[e] * sg; }
                        u32x2 w; w.x = cvtpk(y[0], y[1]); w.y = cvtpk(y[2], y[3]); *(u32x2*)(op + 32 * db + 8 * g) = w; } } }
        }
    }
}
}

struct Args { const float* in[16]; float* out; unsigned char* ws; int ph_lo, ph_hi; };
typedef const __attribute__((address_space(4))) Args* KArgsP;
#define RT   ((f32x2*)(ws + WS_RT))
#define MT   ((f32x2*)(ws + WS_MT))
#define WIN  ((bf16*)(ws + WS_WIN))
#define WUQ  ((bf16*)(ws + WS_WUQ))
#define WUKV ((bf16*)(ws + WS_WUKV))
#define WOUT ((bf16*)(ws + WS_WOUT))
#define W1   ((bf16*)(ws + WS_W1))
#define W2   ((bf16*)(ws + WS_W2))
#define XF   ((float*)(ws + WS_X))
#define XN   ((bf16*)(ws + WS_XN))
#define MIX  ((bf16*)(ws + WS_XN))
#define PROJ ((bf16*)(ws + WS_PROJ))
#define QRAW ((bf16*)(ws + WS_QRAW))
#define KVR  ((bf16*)(ws + WS_KV))
#define HB   ((bf16*)(ws + WS_H))
#define SSX  ((float*)(ws + WS_SSX))
#define SSQ  ((float*)(ws + WS_SSQ))
#define SSKV ((float*)(ws + WS_SSKV))
#define XB2  ((bf16*)(ap->out))
enum { I_X = 0, I_META, I_ANG, I_WIN, I_CONVW, I_RETG, I_QNG, I_WUQ, I_KVNG, I_WUKV, I_QHG, I_KHG, I_WOUT, I_MLPG, I_W1, I_W2 };
constexpr int NPP = 7, NPHASE = 1 + NPP * DEPTH;

__device__ __forceinline__ void p0_transpose_item(const float* W, const float* gk, int K, int N, bf16* WT, LAS float* scr, int item, int lane) {
    const int nblk = N / 32, kb = item / nblk, nb = item % nblk, k0 = 64 * kb, n0 = 32 * nb;
#pragma unroll 8
    for (int i = 0; i < 32; ++i) { const int kk = 2 * i + (lane >> 5); const float gv = gk ? gk[k0 + kk] : 1.f; scr[kk * 33 + (lane & 31)] = W[(size_t)(k0 + kk) * N + n0 + (lane & 31)] * gv; }
    asm volatile("s_waitcnt lgkmcnt(0)" ::: "memory");
    const int c = lane & 7;
#pragma unroll
    for (int j = 0; j < 4; ++j) { const int n = (lane >> 3) + 8 * j; const LAS float* s = scr + (8 * c) * 33 + n;
        u32x4 o; o.x = pk2(s[0 * 33], s[1 * 33]); o.y = pk2(s[2 * 33], s[3 * 33]); o.z = pk2(s[4 * 33], s[5 * 33]); o.w = pk2(s[6 * 33], s[7 * 33]);
        *(u32x4*)(WT + (size_t)(n0 + n) * K + k0 + 8 * c) = o; }
    asm volatile("s_waitcnt lgkmcnt(0)" ::: "memory");
}
__device__ __forceinline__ void row_prep(const float* xrow, float* xcopy, bf16* orow, float* ss16, int lane) {
    const f32x4* xr = (const f32x4*)xrow + lane;
    f32x4 v[4]; float s = 0.f;
#pragma unroll
    for (int j = 0; j < 4; ++j) { v[j] = xr[64 * j]; s += (v[j].x * v[j].x + v[j].y * v[j].y) + (v[j].z * v[j].z + v[j].w * v[j].w); }
    if (xcopy) { f32x4* xc = (f32x4*)xcopy + lane;
#pragma unroll
        for (int j = 0; j < 4; ++j) xc[64 * j] = v[j]; }
    const float tot = wave_sum(s);
    if (lane < 16) ss16[lane] = lane == 0 ? tot : 0.f;
    unsigned long long* o8 = (unsigned long long*)orow + lane;
#pragma unroll
    for (int j = 0; j < 4; ++j) o8[64 * j] = (unsigned long long)att::cvtpk(v[j].x, v[j].y) | ((unsigned long long)att::cvtpk(v[j].z, v[j].w) << 32);
}
__device__ __forceinline__ f32x2 cossin(float ang) {
    const float n = rintf(ang * 0.15915494309189535f);
    float r = fmaf(-n, 6.28125f, ang); r = fmaf(-n, 0.0019353071795864769f, r);
    const float rev = r * 0.15915494309189535f;
    f32x2 o; o.x = __builtin_amdgcn_cosf(rev); o.y = __builtin_amdgcn_sinf(rev); return o;
}

struct EpiMeta { int mode, need_rs; bf16* O; int ldc; const float* xin; float* X; bf16* xb; };
__device__ __forceinline__ void meta_gemm(const bf16* A, int lda, const bf16* Bt, int N, int K, const EpiMeta& E, int gw, int NGW, int lane) {
    for (int n = gw; n < N; n += NGW) {
        float acc[16], ssa[16];
#pragma unroll
        for (int r = 0; r < 16; ++r) { acc[r] = 0.f; ssa[r] = 0.f; }
        for (int c = lane; c < K / 8; c += 64) {
            const u32x4 w = *(const u32x4*)(Bt + (size_t)n * K + 8 * c);
            float wf[8];
#pragma unroll
            for (int e = 0; e < 4; ++e) { wf[2 * e] = bflo(w[e]); wf[2 * e + 1] = bfhi(w[e]); }
#pragma unroll
            for (int r = 0; r < 16; ++r) { const u32x4 a = *(const u32x4*)(A + (size_t)r * lda + 8 * c);
#pragma unroll
                for (int e = 0; e < 4; ++e) { const float a0 = bflo(a[e]), a1 = bfhi(a[e]); acc[r] += a0 * wf[2 * e] + a1 * wf[2 * e + 1]; ssa[r] += a0 * a0 + a1 * a1; } }
        }
        float mine = 0.f, myss = 0.f;
#pragma unroll
        for (int r = 0; r < 16; ++r) { const float s = wave_sum(acc[r]), q = E.need_rs ? wave_sum(ssa[r]) : 0.f; if (lane == r) { mine = s; myss = q; } }
        if (lane < 16) { const int r = lane;
            if (E.mode < 2) { float v = mine * (E.need_rs ? 1.0f / sqrtf(myss * (1.f / 1024.f) + EPS) : 1.f); if (E.mode == 1) { v = fmaxf(v, 0.f); v = v * v; } E.O[(size_t)(MR0 + r) * E.ldc + n] = (bf16)f2bf(v); }
            else { const float x = E.xin[(size_t)r * DM + n] + mine; E.X[(size_t)(MR0 + r) * DM + n] = x; E.xb[(size_t)(MR0 + r) * DM + n] = (bf16)f2bf(x); } }
    }
}

__global__ void __launch_bounds__(NWAVES * 64, 2) hybrid_fwd(Args args) {
    extern __shared__ __attribute__((aligned(16))) unsigned char lds_raw[];
    LAS unsigned char* lds = (LAS unsigned char*)lds_raw;
    cg::grid_group grid = cg::this_grid();
    const int G = gridDim.x, NGW = G * NWAVES;
    const int wave_s = __builtin_amdgcn_readfirstlane((int)threadIdx.x >> 6);
    const int lo = args.ph_lo, hi = args.ph_hi;
    for (int ph = lo; ph < hi; ++ph) {
        KArgsP ap = (KArgsP)__builtin_amdgcn_kernarg_segment_ptr(); asm volatile("" : "+s"(ap));
        unsigned char* const ws = ap->ws;
        int wave = wave_s; asm volatile("" : "+s"(wave));
        int lane = (int)__builtin_amdgcn_mbcnt_hi(~0u, __builtin_amdgcn_mbcnt_lo(~0u, 0u)); asm volatile("" : "+v"(lane));
        const int tid = wave * 64 + lane, gw = blockIdx.x * NWAVES + wave;
        const int l = ph == 0 ? 0 : (ph - 1) / NPP, k = ph == 0 ? -1 : (ph - 1) % NPP;
        if (k == -1) {
            LAS float* scr = (LAS float*)(lds + wave * 16384);
            constexpr int I_IN = 16 * 69, I_UQ = 4 * 24, I_UKV = 2 * 32, I_O = 16 * 32, I_1 = 16 * 128, I_2 = 64 * 32, I_L = I_IN + I_UQ + I_UKV + I_O + I_1 + I_2;
            for (int it = gw; it < DEPTH * I_L; it += NGW) {
                const int ll = it / I_L; int r = it - ll * I_L;
                if (r < I_IN) { p0_transpose_item(ap->in[I_WIN] + (size_t)ll * DM * DIN, ap->in[I_ANG] + ll * DM, DM, DIN, WIN + (size_t)ll * DINP * DM, scr, r, lane); continue; } r -= I_IN;
                if (r < I_UQ) { p0_transpose_item(ap->in[I_WUQ] + (size_t)ll * 256 * 768, ap->in[I_QNG] + ll * 256, 256, 768, WUQ + (size_t)ll * 768 * 256, scr, r, lane); continue; } r -= I_UQ;
                if (r < I_UKV) { p0_transpose_item(ap->in[I_WUKV] + (size_t)ll * 128 * 1024, ap->in[I_KVNG] + ll * 128, 128, 1024, WUKV + (size_t)ll * 1024 * 128, scr, r, lane); continue; } r -= I_UKV;
                if (r < I_O) { p0_transpose_item(ap->in[I_WOUT] + (size_t)ll * DM * DM, nullptr, DM, DM, WOUT + (size_t)ll * DM * DM, scr, r, lane); continue; } r -= I_O;
                if (r < I_1) { p0_transpose_item(ap->in[I_W1] + (size_t)ll * DM * DFF, ap->in[I_MLPG] + ll * DM, DM, DFF, W1 + (size_t)ll * DFF * DM, scr, r, lane); continue; } r -= I_1;
                p0_transpose_item(ap->in[I_W2] + (size_t)ll * DFF * DM, nullptr, DFF, DM, W2 + (size_t)ll * DM * DFF, scr, r, lane);
            }
            for (int it = gw; it < DEPTH * (DINP - DIN); it += NGW) {
                const int ll = it / (DINP - DIN), r = DIN + it % (DINP - DIN); u32x4* p = (u32x4*)(WIN + ((size_t)ll * DINP + r) * DM) + lane;
                p[0] = (u32x4){0u, 0u, 0u, 0u}; p[64] = (u32x4){0u, 0u, 0u, 0u};
            }
            for (int e = blockIdx.x * 512 + tid; e < TT * 32; e += G * 512) { const int t = e >> 5, i = e & 31; const float inv = exp2f(-13.287712379549449f * (float)(2 * i) * (1.f / 64.f)); RT[e] = cossin((float)t * inv); }
            for (int e = blockIdx.x * 512 + tid; e < TT * 16; e += G * 512) { const int t = e >> 4, i = e & 15; const float inv = exp2f(-13.287712379549449f * (float)(2 * i) * (1.f / 32.f)); MT[e] = cossin((float)t * inv); }
            for (int m = gw; m < MV; m += NGW) {
                const float* src = m >= MR0 ? ap->in[I_META] + (size_t)(m - MR0) * DM : ap->in[I_X] + (size_t)m * DM;
                row_prep(src, m >= MR0 ? XF + (size_t)m * DM : nullptr, XN + (size_t)m * DM, SSX + (size_t)m * 16, lane); }
        } else if (k == 0 || k == 1 || k == 4 || k == 5 || k == 6) {
            const int ng = k == 1 ? 2 : 1;
            for (int gi = 0; gi < ng; ++gi) {
                pg8::Gemm g; pg8::EpiAny E; E.xin = (l == 0 && k == 4) ? ap->in[I_X] : XF; E.X = XF; E.out = ap->out; E.O = nullptr; E.ldc = 0; E.xb = nullptr; E.ssx = SSX; E.rs_src = nullptr; E.ssq = nullptr; E.sskv = nullptr;
                EpiMeta Em; Em.need_rs = 0; Em.O = nullptr; Em.ldc = 0; Em.xin = (l == 0 && k == 4) ? ap->in[I_META] : XF + (size_t)MR0 * DM; Em.X = XF; Em.xb = nullptr;
                if (k == 0)      { g = pg8::Gemm{XN, WIN + (size_t)l * DINP * DM, MREAL, DINP, DM, DM}; E.mode = 0; E.perm = 1; E.O = PROJ; E.ldc = DINP; E.rs_src = SSX; E.ssq = SSQ; E.sskv = SSKV; Em.need_rs = 1; }
                else if (k == 1 && gi == 0) { g = pg8::Gemm{PROJ + C_CQ, WUQ + (size_t)l * 768 * 256, MREAL, 768, 256, DINP}; E.mode = 0; E.perm = 1; E.O = QRAW; E.ldc = 768; }
                else if (k == 1) { g = pg8::Gemm{PROJ + C_CKV, WUKV + (size_t)l * 1024 * 128, MREAL, 1024, 128, DINP}; E.mode = 0; E.perm = 1; E.O = KVR; E.ldc = 1024; }
                else if (k == 4) { g = pg8::Gemm{MIX, WOUT + (size_t)l * DM * DM, MREAL, DM, DM, DM}; E.mode = 2; E.perm = 0; E.xb = XB2; }
                else if (k == 5) { g = pg8::Gemm{XB2, W1 + (size_t)l * DFF * DM, MREAL, DFF, DM, DM}; E.mode = 1; E.perm = 1; E.O = HB; E.ldc = DFF; E.rs_src = SSX; Em.need_rs = 1; }
                else             { g = pg8::Gemm{HB, W2 + (size_t)l * DM * DFF, MREAL, DM, DFF, DFF}; E.mode = (l == DEPTH - 1) ? 3 : 2; E.perm = 0; E.xb = XN; }
                Em.mode = E.mode; Em.O = E.O; Em.ldc = E.ldc; Em.xb = E.xb;
                pg8::StaticOrder S; S.init(MREAL, g.N, G, (int)blockIdx.x);
                pg8::gemm_phase<pg8::EpiAny, pg8::StaticOrder, true, true>(lds, g, S, E, tid);
                if (E.mode != 3) meta_gemm(g.A + (size_t)MR0 * g.lda, g.lda, g.Bt, g.N, g.K, Em, gw, NGW, lane);
            }
            if (k == 1) {
                const float* cw = ap->in[I_CONVW] + l * 3 * 256;
                for (int it = blockIdx.x * 512 + tid; it < MV * 32; it += G * 512) {
                    const int m = it >> 5, c = (it & 31) * 8; const int t = m >= MR0 ? m - MR0 : (m & (SEQ - 1)) + NMETA; const bf16* pr = PROJ + (size_t)m * DINP;
                    const u32x4 cbv = *(const u32x4*)(pr + C_CB + c); float a[8];
#pragma unroll
                    for (int e = 0; e < 8; ++e) a[e] = 0.f;
#pragma unroll
                    for (int j = 0; j < 3; ++j) { const int tj = t - 2 + j; if (tj >= 0) { const int mj = (m >= MR0 || tj >= NMETA) ? m - (2 - j) : MR0 + tj;
                            const bf16* p2 = PROJ + (size_t)mj * DINP; const u32x4 ccv = *(const u32x4*)(p2 + C_CC + c), chv = *(const u32x4*)(p2 + C_CH + c);
                            const f32x4 w0 = *(const f32x4*)(cw + j * 256 + c), w1 = *(const f32x4*)(cw + j * 256 + c + 4);
#pragma unroll
                            for (int e = 0; e < 4; ++e) { const float wl = e < 2 ? w0[2 * e] : w1[2 * e - 4], wh = e < 2 ? w0[2 * e + 1] : w1[2 * e - 3];
                                a[2 * e] += wl * (bflo(ccv[e]) * bflo(chv[e])); a[2 * e + 1] += wh * (bfhi(ccv[e]) * bfhi(chv[e])); } } }
                    u32x4 o;
#pragma unroll
                    for (int e = 0; e < 4; ++e) o[e] = att::cvtpk(bflo(cbv[e]) * a[2 * e], bfhi(cbv[e]) * a[2 * e + 1]);
                    *(u32x4*)(MIX + (size_t)m * DM + c) = o;
                }
                for (int it = blockIdx.x * 512 + tid; it < MV * 32; it += G * 512) {
                    const int m = it >> 5, j = it & 31, w = j >> 4, h = (j >> 2) & 3, i0 = (j & 3) * 8; const int t = m >= MR0 ? m - MR0 : (m & (SEQ - 1)) + NMETA;
                    bf16* p = PROJ + (size_t)m * DINP + (w ? C_RK : C_RQ) + 64 * h + i0; const float sc = w ? 0.125f : 1.f;
                    const u32x4 x1 = *(const u32x4*)p, x2 = *(const u32x4*)(p + 32); const f32x4* cs = (const f32x4*)(RT + t * 32 + i0);
                    u32x4 o1, o2;
#pragma unroll
                    for (int e = 0; e < 4; ++e) { const f32x4 c4 = cs[e]; const float a0 = bflo(x1[e]), a1 = bfhi(x1[e]), b0 = bflo(x2[e]), b1 = bfhi(x2[e]);
                        o1[e] = att::cvtpk((a0 * c4.x - b0 * c4.y) * sc, (a1 * c4.z - b1 * c4.w) * sc); o2[e] = att::cvtpk((b0 * c4.x + a0 * c4.y) * sc, (b1 * c4.z + a1 * c4.w) * sc); }
                    *(u32x4*)p = o1; *(u32x4*)(p + 32) = o2;
                }
            }
        } else if (k == 2) {
            const float* qg = ap->in[I_QHG] + l * 96; const float* kg = ap->in[I_KHG] + l * 96;
            for (int it = blockIdx.x * 512 + tid; it < MV * 8; it += G * 512) {
                const int m = it >> 3, h = it & 7; const int t = m >= MR0 ? m - MR0 : (m & (SEQ - 1)) + NMETA;
                float sumq, sumkv;
                if (m < MR0) { const f32x4 sq4 = *(const f32x4*)(SSQ + (size_t)m * 4), sk4 = *(const f32x4*)(SSKV + (size_t)m * 4); sumq = (sq4.x + sq4.y) + (sq4.z + sq4.w); sumkv = (sk4.x + sk4.y) + (sk4.z + sk4.w); }
                else { sumq = 0.f; sumkv = 0.f; const bf16* pc = PROJ + (size_t)m * DINP + C_CQ;
                    for (int c = 0; c < 48; ++c) { const u32x4 v = *(const u32x4*)(pc + 8 * c); float s = 0.f;
#pragma unroll
                        for (int e = 0; e < 4; ++e) { const float a0 = bflo(v[e]), a1 = bfhi(v[e]); s += a0 * a0 + a1 * a1; }
                        if (c < 32) sumq += s; else sumkv += s; } }
                const float s_q = 1.0f / sqrtf(sumq * (1.f / 256.f) + EPS), s_kv = 1.0f / sqrtf(sumkv * (1.f / 128.f) + EPS);
                const f32x4* mt = (const f32x4*)(MT + t * 16);
                { bf16* q = QRAW + (size_t)m * 768 + 96 * h; u32x4 w[12]; float ss = 0.f;
#pragma unroll
                  for (int c = 0; c < 12; ++c) w[c] = *(const u32x4*)(q + 8 * c);
#pragma unroll
                  for (int c = 0; c < 12; ++c)
#pragma unroll
                      for (int e = 0; e < 4; ++e) { const float a0 = bflo(w[c][e]), a1 = bfhi(w[c][e]); ss += a0 * a0 + a1 * a1; }
                  const float rs = s_q * QSCALE / sqrtf(s_q * s_q * ss * (1.f / 96.f) + EPS);
#pragma unroll
                  for (int c = 0; c < 8; ++c) { u32x4 o;
#pragma unroll
                      for (int e = 0; e < 4; ++e) o[e] = att::cvtpk(bflo(w[c][e]) * rs * qg[8 * c + 2 * e], bfhi(w[c][e]) * rs * qg[8 * c + 2 * e + 1]);
                      *(u32x4*)(q + 8 * c) = o; }
#pragma unroll
                  for (int cc = 0; cc < 2; ++cc) { u32x4 o1, o2;
#pragma unroll
                      for (int e = 0; e < 4; ++e) { const int i = 8 * cc + 2 * e; const f32x4 c4 = mt[4 * cc + e];
                          const float a0 = bflo(w[8 + cc][e]) * rs * qg[64 + i], a1 = bfhi(w[8 + cc][e]) * rs * qg[64 + i + 1], b0 = bflo(w[10 + cc][e]) * rs * qg[80 + i], b1 = bfhi(w[10 + cc][e]) * rs * qg[80 + i + 1];
                          o1[e] = att::cvtpk(a0 * c4.x - b0 * c4.y, a1 * c4.z - b1 * c4.w); o2[e] = att::cvtpk(b0 * c4.x + a0 * c4.y, b1 * c4.z + a1 * c4.w); }
                      *(u32x4*)(q + 64 + 8 * cc) = o1; *(u32x4*)(q + 80 + 8 * cc) = o2; } }
                { bf16* kn = KVR + (size_t)m * 1024 + 128 * h; bf16* pr = PROJ + (size_t)m * DINP; bf16* ko = pr + 96 * h; u32x4 w[8], r[4]; float ssn = 0.f, ssr = 0.f;
#pragma unroll
                  for (int c = 0; c < 8; ++c) w[c] = *(const u32x4*)(kn + 8 * c);
#pragma unroll
                  for (int c = 0; c < 4; ++c) r[c] = *(const u32x4*)(pr + C_KR + 8 * c);
#pragma unroll
                  for (int c = 0; c < 8; ++c)
#pragma unroll
                      for (int e = 0; e < 4; ++e) { const float a0 = bflo(w[c][e]), a1 = bfhi(w[c][e]); ssn += a0 * a0 + a1 * a1; }
#pragma unroll
                  for (int c = 0; c < 4; ++c)
#pragma unroll
                      for (int e = 0; e < 4; ++e) { const float a0 = bflo(r[c][e]), a1 = bfhi(r[c][e]); ssr += a0 * a0 + a1 * a1; }
                  const float rs = 1.0f / sqrtf((s_kv * s_kv * ssn + ssr) * (1.f / 96.f) + EPS), rn = rs * s_kv;
#pragma unroll
                  for (int c = 0; c < 8; ++c) { u32x4 o;
#pragma unroll
                      for (int e = 0; e < 4; ++e) o[e] = att::cvtpk(bflo(w[c][e]) * rn * kg[8 * c + 2 * e], bfhi(w[c][e]) * rn * kg[8 * c + 2 * e + 1]);
                      *(u32x4*)(ko + 8 * c) = o; }
#pragma unroll
                  for (int cc = 0; cc < 2; ++cc) { u32x4 o1, o2;
#pragma unroll
                      for (int e = 0; e < 4; ++e) { const int i = 8 * cc + 2 * e; const f32x4 c4 = mt[4 * cc + e];
                          const float a0 = bflo(r[cc][e]) * rs * kg[64 + i], a1 = bfhi(r[cc][e]) * rs * kg[64 + i + 1], b0 = bflo(r[2 + cc][e]) * rs * kg[80 + i], b1 = bfhi(r[2 + cc][e]) * rs * kg[80 + i + 1];
                          o1[e] = att::cvtpk(a0 * c4.x - b0 * c4.y, a1 * c4.z - b1 * c4.w); o2[e] = att::cvtpk(b0 * c4.x + a0 * c4.y, b1 * c4.z + a1 * c4.w); }
                      *(u32x4*)(ko + 64 + 8 * cc) = o1; *(u32x4*)(ko + 80 + 8 * cc) = o2; }
#pragma unroll
                  for (int c = 0; c < 8; ++c) { const u32x4 v = *(const u32x4*)(kn + 64 + 8 * c); u32x4 o;
#pragma unroll
                      for (int e = 0; e < 4; ++e) o[e] = att::cvtpk(bflo(v[e]) * s_kv, bfhi(v[e]) * s_kv);
                      *(u32x4*)(kn + 64 + 8 * c) = o; } }
            }
        } else {
            for (int item = blockIdx.x; item < 524; item += G) {
                if (item < 256 || (item >= 512 && item < 520)) { const bool meta = item >= 512; const int b = meta ? 0 : item >> 3, h = item & 7;
                    const bf16* Qp = QRAW + 96 * h; const bf16* Kp = PROJ + 96 * h; const bf16* Vp = KVR + 128 * h + 64; bf16* Op = MIX + 512 + 64 * h;
                    if (meta) att::unit<96, true>(lds, Qp, 768, Kp, DINP, Vp, 1024, Op, DM, nullptr, 0, nullptr, 0.f, b, 0, 16, tid);
                    else for (int blk = 8; blk >= 1; --blk) { const int q0 = 16 + 256 * (blk - 1);
                        att::unit<96, true>(lds, Qp, 768, Kp, DINP, Vp, 1024, Op, DM, nullptr, 0, nullptr, 0.f, b, q0, q0 + 256, tid); }
                } else { const bool meta = item >= 520; const int it = item - 256, bh = it >> 1, hf = it & 1, b = meta ? 0 : bh >> 2, h = meta ? item - 520 : bh & 3;
                    const bf16* Pp = PROJ + 64 * h; bf16* Op = MIX + 256 + 64 * h; const float* gn = ap->in[I_RETG] + l * 256 + 64 * h;
                    const float lg2 = log2f(1.0f - exp2f(-5.0f - (float)h)); const unsigned bm = hf ? 0x0CCu : 0x132u;
                    if (meta) att::unit<64, false>(lds, Pp + C_RQ, DINP, Pp + C_RK, DINP, Pp + C_RV, DINP, Op, DM, Pp + C_RG, DINP, gn, lg2, b, 0, 16, tid);
                    else for (int blk = 8; blk >= 1; --blk) { if (!((bm >> blk) & 1u)) continue; const int q0 = 16 + 256 * (blk - 1);
                        att::unit<64, false>(lds, Pp + C_RQ, DINP, Pp + C_RK, DINP, Pp + C_RV, DINP, Op, DM, Pp + C_RG, DINP, gn, lg2, b, q0, q0 + 256, tid); }
                }
            }
        }
        if (ph + 1 < hi) grid.sync();
    }
}

extern "C" void kernel_launch(void* const* d_in, const int* in_sizes, int n_in, void* d_out, int out_size, void* d_ws, size_t ws_size, hipStream_t stream) {
    static int grid = 0;
    if (grid == 0) {
        if (n_in != 16 || out_size != MREAL * DM || ws_size < WS_END) { fprintf(stderr, "kernel_launch: unexpected shapes (n_in %d, out %d, ws %zu)\n", n_in, out_size, ws_size); grid = -1; return; }
        int dev = 0, cus = 0, per_cu = 0;
        if (hipGetDevice(&dev) != hipSuccess || hipDeviceGetAttribute(&cus, hipDeviceAttributeMultiprocessorCount, dev) != hipSuccess) { grid = -1; return; }
        if (hipFuncSetAttribute((const void*)hybrid_fwd, hipFuncAttributeMaxDynamicSharedMemorySize, LDS_BYTES) != hipSuccess) { fprintf(stderr, "kernel_launch: hipFuncSetAttribute failed\n"); grid = -1; return; }
        if (hipOccupancyMaxActiveBlocksPerMultiprocessor(&per_cu, (const void*)hybrid_fwd, NWAVES * 64, LDS_BYTES) != hipSuccess || per_cu < 1) { fprintf(stderr, "kernel_launch: occupancy query says %d\n", per_cu); per_cu = 1; }
        (void)hipGetLastError();
        grid = cus;
    }
    if (grid < 0) return;
    Args a{};
    for (int i = 0; i < 16; ++i) a.in[i] = (const float*)d_in[i];
    a.out = (float*)d_out; a.ws = (unsigned char*)d_ws;
#if MK_MULTI
    for (int ph = 0; ph < NPHASE; ++ph) { a.ph_lo = ph; a.ph_hi = ph + 1; hipLaunchKernelGGL(hybrid_fwd, dim3(grid), dim3(NWAVES * 64), LDS_BYTES, stream, a); }
#else
    a.ph_lo = 0; a.ph_hi = NPHASE;
    void* kargs[] = {&a};
    const hipError_t e = hipLaunchCooperativeKernel((const void*)hybrid_fwd, dim3(grid), dim3(NWAVES * 64), kargs, LDS_BYTES, stream);
    if (e != hipSuccess) fprintf(stderr, "kernel_launch: cooperative launch failed: %s (grid %d)\n", hipGetErrorString(e), grid);
#endif
}
```

```cpp
#include <hip/hip_runtime.h>
#include <hip/hip_cooperative_groups.h>
#include <cstdio>
#include <cstdint>
#include <cmath>
namespace cg = cooperative_groups;
#ifndef MK_MULTI
#define MK_MULTI 0
#endif
namespace pg8 {
#define PG8_LAS __attribute__((address_space(3)))
typedef unsigned short bf16_t;
typedef short bf16x8 __attribute__((ext_vector_type(8)));
typedef float f32x4 __attribute__((ext_vector_type(4)));
typedef unsigned u32x4 __attribute__((ext_vector_type(4)));
typedef unsigned u32x2 __attribute__((ext_vector_type(2)));
constexpr int BM = 256, BK = 64, HALF = 128, HTB = HALF * BK * 2  , STAGE_BYTES = 8 * HTB, NXCD = 8, WGM = 8;

__host__ __device__ __forceinline__ int lds_byte(int r, int c) { const int st = (r >> 4) * 2 + (c >> 5), rr = r & 15, cc = c & 31, ob = rr * 64 + cc * 2; return st * 1024 + (ob ^ (((ob >> 9) & 1) << 5)); }
__host__ __device__ __forceinline__ void stage_rc(int b, int& R, int& C) { const int st = b / 1024, sb = b % 1024, swz = sb ^ (((sb >> 9) & 1) << 5); R = (st >> 1) * 16 + swz / 64; C = (st & 1) * 32 + (swz % 64) / 2; }
__host__ __device__ __forceinline__ int perm32(int rho) { const int n = rho >> 4, i = rho & 15; return 8 * (i >> 2) + 4 * n + (i & 3); }

__device__ __forceinline__ int opaque_tid() { int t = threadIdx.x; asm volatile("" : "+v"(t)); return t; }
struct Unit { int pm, pn; };
struct Gemm { const bf16_t* A; const bf16_t* Bt; int M, N, K, lda; };

struct StaticOrder {
    int nM, nN, nwg, G, c;
    __host__ __device__ void init(int M, int N, int G_, int c_) { nM = M / BM; nN = N / BM; nwg = nM * nN; G = G_; c = c_; }
    __host__ __device__ bool next(int i, Unit& u) const {
        const long L = (long)i * G + c; if (L >= nwg) return false;
        int wgid = (int)L; { const int q = nwg / NXCD, r = nwg % NXCD, xcd = wgid % NXCD, off = wgid / NXCD; wgid = (xcd < r ? xcd * (q + 1) : r * (q + 1) + (xcd - r) * q) + off; }
        const int nig = WGM * nN, gid = wgid / nig, fm = gid * WGM, gsz = (nM - fm) < WGM ? (nM - fm) : WGM;
        u.pm = fm + ((wgid % nig) % gsz); u.pn = (wgid % nig) / gsz; return true;
    }
    __device__ __forceinline__ void a_ready(const Unit&) const {}
    __device__ __forceinline__ void done(const Unit&) const {}
};

__device__ __forceinline__ unsigned cvt_pk_bf16(float lo, float hi) { unsigned r; asm volatile("v_cvt_pk_bf16_f32 %0, %1, %2" : "=v"(r) : "v"(lo), "v"(hi)); return r; }
struct EpiAny {
    static constexpr bool AFTER_DRAIN = false;
    int mode, perm; bf16_t* O; int ldc; const float* xin; float* X; float* out; bf16_t* xb; float* ssx; const float* rs_src; float* ssq; float* sskv;
    __device__ __forceinline__ void operator()(const f32x4 (&acc)[2][2][4][2], const Unit& u, int wr, int wc, int fr, int fq) const {
        if (mode < 2) {
            const int row0 = u.pm * BM + wr * 64 + fr; const int col0 = u.pn * BM + wc * 32 + 8 * fq; const bool sq = mode == 1;
            const int sstile = ssq ? (u.pn == 7 ? 1 : (u.pn == 8 ? 2 : 0)) : 0;
#pragma unroll
            for (int ai = 0; ai < 2; ++ai)
#pragma unroll
                for (int m = 0; m < 4; ++m) { const int row = row0 + ai * HALF + m * 16; bf16_t* rowp = O + (size_t)row * ldc + col0;
                    float rs = 1.f;
                    if (rs_src) { const f32x4* p = (const f32x4*)(rs_src + (size_t)row * 16); const f32x4 a = (p[0] + p[1]) + (p[2] + p[3]); rs = 1.0f / sqrtf(((a[0] + a[1]) + (a[2] + a[3])) * (1.f / 1024.f) + 1e-6f); }
                    float part = 0.f;
#pragma unroll
                    for (int bj = 0; bj < 2; ++bj) { f32x4 v0 = acc[ai][bj][m][0] * rs, v1 = acc[ai][bj][m][1] * rs;
                        if (sq) {
#pragma unroll
                            for (int e = 0; e < 4; ++e) { const float a = fmaxf(v0[e], 0.f), b = fmaxf(v1[e], 0.f); v0[e] = a * a; v1[e] = b * b; } }
                        if (sstile == 1 || (sstile == 2 && bj == 0)) part += ((v0[0] * v0[0] + v0[1] * v0[1]) + (v0[2] * v0[2] + v0[3] * v0[3])) + ((v1[0] * v1[0] + v1[1] * v1[1]) + (v1[2] * v1[2] + v1[3] * v1[3]));
                        u32x4 w; w.x = cvt_pk_bf16(v0[0], v0[1]); w.y = cvt_pk_bf16(v0[2], v0[3]); w.z = cvt_pk_bf16(v1[0], v1[1]); w.w = cvt_pk_bf16(v1[2], v1[3]);
                        *(u32x4*)(rowp + bj * HALF) = w; }
                    if (sstile) { part += __shfl_xor(part, 16); part += __shfl_xor(part, 32); if (fq == 0) (sstile == 1 ? ssq : sskv)[(size_t)row * 4 + wc] = part; }
                }
        } else {
            const int col0 = u.pn * BM + wc * 32 + 4 * fq; const bool toout = mode == 3;
#pragma unroll
            for (int ai = 0; ai < 2; ++ai)
#pragma unroll
                for (int m = 0; m < 4; ++m) { const int r = u.pm * BM + ai * HALF + wr * 64 + m * 16 + fr; const float* xp = xin + (size_t)r * 1024 + col0;
                    float* op = (toout ? out : X) + (size_t)r * 1024 + col0; const bool wr_ok = true;
                    bf16_t* bp = xb + (size_t)r * 1024 + col0; float part = 0.f;
#pragma unroll
                    for (int bj = 0; bj < 2; ++bj)
#pragma unroll
                        for (int n = 0; n < 2; ++n) { const f32x4 v = *(const f32x4*)(xp + bj * HALF + n * 16) + acc[ai][bj][m][n]; if (wr_ok) *(f32x4*)(op + bj * HALF + n * 16) = v;
                            if (!toout) { part += (v[0] * v[0] + v[1] * v[1]) + (v[2] * v[2] + v[3] * v[3]); u32x2 w; w.x = cvt_pk_bf16(v[0], v[1]); w.y = cvt_pk_bf16(v[2], v[3]); *(u32x2*)(bp + bj * HALF + n * 16) = w; } }
                    if (!toout) { part += __shfl_xor(part, 16); part += __shfl_xor(part, 32); if (fq == 0) ssx[(size_t)r * 16 + u.pn * 4 + wc] = part; }
                    asm volatile("" ::: "memory"); }
        }
    }
};

template <class Epi, class Sched, bool ALIGN_EPI = false, bool SP2 = false>
__device__ __forceinline__ void gemm_phase(PG8_LAS unsigned char* lds, const Gemm g, const Sched& S, const Epi& E, const int tid_in) {
    int tid_o = tid_in; asm volatile("" : "+v"(tid_o));
    const int tid = tid_o, wid = __builtin_amdgcn_readfirstlane(tid >> 6), lane = tid & 63, wr = wid >> 2, wc = wid & 3, fr = lane & 15, fq = lane >> 4;
    const int K = g.K, nt = K / BK;
    unsigned voffA[2], voffB[2];
#pragma unroll
    for (int i = 0; i < 2; ++i) { int R, C; stage_rc(tid * 16 + i * 8192, R, C); const int Rb = E.perm ? ((R & ~31) + perm32(R & 31)) : R;
        voffA[i] = (unsigned)(R * g.lda + C) * 2u; voffB[i] = (unsigned)(Rb * K + C) * 2u; }
    const size_t kstep = (size_t)(BK * 2);
    const size_t hstepA = (size_t)HALF * g.lda * 2, hstepB = (size_t)HALF * K * 2;
    const size_t tstepA = 2 * hstepA, tstepB = 2 * hstepB;
    const unsigned ldsw = (unsigned)wid * 1024u;
    const int aoff = lds_byte(wr * 64 + fr, fq * 8), boff = lds_byte(wc * 32 + fr, fq * 8);
#define PG8_SA(b, h) (((b) * 2 + (h)) * HTB)
#define PG8_SB(b, h) ((4 + (b) * 2 + (h)) * HTB)
#define PG8_STAGE(bufoff, gbase, voff) do { _Pragma("unroll") for (int _i = 0; _i < 2; ++_i) \
        __builtin_amdgcn_global_load_lds((const unsigned*)((const char*)(gbase) + (voff)[_i]), (PG8_LAS unsigned*)(lds + (bufoff) + ldsw + _i * 8192), 16, 0, 0); } while (0)
#define PG8_LDA(dst, b, h) do { _Pragma("unroll") for (int m = 0; m < 4; ++m) _Pragma("unroll") for (int k = 0; k < 2; ++k) dst[m][k] = *(const PG8_LAS bf16x8*)(lds + PG8_SA(b, h) + aoff + m * 2048 + k * 1024); } while (0)
#define PG8_LDB(dst, b, h) do { _Pragma("unroll") for (int n = 0; n < 2; ++n) _Pragma("unroll") for (int k = 0; k < 2; ++k) dst[n][k] = *(const PG8_LAS bf16x8*)(lds + PG8_SB(b, h) + boff + n * 2048 + k * 1024); } while (0)
#define PG8_MMA(ai, bj, At, Bt) do { __builtin_amdgcn_s_setprio(1); _Pragma("unroll") for (int m = 0; m < 4; ++m) _Pragma("unroll") for (int n = 0; n < 2; ++n) _Pragma("unroll") for (int k = 0; k < 2; ++k) \
        acc[ai][bj][m][n] = __builtin_amdgcn_mfma_f32_16x16x32_bf16(Bt[n][k], At[m][k], acc[ai][bj][m][n], 0, 0, 0); __builtin_amdgcn_s_setprio(0); } while (0)
#define PG8_WAIT_V(n) asm volatile("s_waitcnt vmcnt(" #n ")" ::: "memory")
#define PG8_WAIT_L(n) asm volatile("s_waitcnt lgkmcnt(" #n ")" ::: "memory")
#define PG8_BAR __builtin_amdgcn_s_barrier()
#define PG8_SCHED __builtin_amdgcn_sched_barrier(0)
    Unit cur, nxt; int ui = 0;
    if (!S.next(0, cur)) return;
    f32x4 acc[2][2][4][2];
#pragma unroll
    for (int a = 0; a < 2; ++a)
#pragma unroll
        for (int b = 0; b < 2; ++b)
#pragma unroll
            for (int m = 0; m < 4; ++m)
#pragma unroll
                for (int n = 0; n < 2; ++n) acc[a][b][m][n] = (f32x4){0.f, 0.f, 0.f, 0.f};
    bf16x8 At[4][2], B0[2][2], B1[2][2];
    const char* cA = (const char*)g.A + (size_t)cur.pm * tstepA; const char* cB = (const char*)g.Bt + (size_t)cur.pn * tstepB;
    S.a_ready(cur);
    if constexpr (SP2) {
        PG8_STAGE(PG8_SB(0, 0), cB, voffB); PG8_STAGE(PG8_SB(0, 1), cB + hstepB, voffB); PG8_STAGE(PG8_SA(0, 0), cA, voffA); PG8_STAGE(PG8_SA(0, 1), cA + hstepA, voffA);
        if (wr == 1) PG8_BAR;
        PG8_WAIT_V(2); PG8_BAR;
        PG8_STAGE(PG8_SB(1, 0), cB + kstep, voffB); PG8_STAGE(PG8_SA(1, 0), cA + kstep, voffA); PG8_STAGE(PG8_SB(1, 1), cB + hstepB + kstep, voffB);
        PG8_WAIT_V(6); PG8_BAR;
    } else {
        PG8_STAGE(PG8_SB(0, 0), cB, voffB); PG8_STAGE(PG8_SA(0, 0), cA, voffA); PG8_STAGE(PG8_SB(0, 1), cB + hstepB, voffB); PG8_STAGE(PG8_SA(0, 1), cA + hstepA, voffA);
        if (wr == 1) PG8_BAR;
        PG8_WAIT_V(4); PG8_BAR;
        PG8_STAGE(PG8_SB(1, 0), cB + kstep, voffB); PG8_STAGE(PG8_SA(1, 0), cA + kstep, voffA); PG8_STAGE(PG8_SB(1, 1), cB + hstepB + kstep, voffB);
        PG8_WAIT_V(6); PG8_BAR;
    }
    for (;;) {
        const bool has_next = S.next(ui + 1, nxt);
        const char* nA = has_next ? (const char*)g.A + (size_t)nxt.pm * tstepA : cA; const char* nB = has_next ? (const char*)g.Bt + (size_t)nxt.pn * tstepB : cB;
        for (int t = 0; t < nt; t += 2) {
            const bool last = (t == nt - 2);
            const char* a1 = cA + (size_t)(t + 1) * kstep;
            const char* a2 = last ? nA : cA + (size_t)(t + 2) * kstep; const char* b2 = last ? nB : cB + (size_t)(t + 2) * kstep;
            const char* a3 = a2 + kstep; const char* b3 = b2 + kstep;
            if (last && has_next) S.a_ready(nxt);
            if constexpr (SP2) {
            PG8_LDB(B0, 0, 0); PG8_LDB(B1, 0, 1); PG8_SCHED; PG8_LDA(At, 0, 0); PG8_STAGE(PG8_SA(1, 1), a1 + hstepA, voffA);
            PG8_WAIT_V(8); PG8_WAIT_L(0); PG8_BAR; PG8_MMA(0, 0, At, B0); PG8_MMA(0, 1, At, B1); PG8_BAR; PG8_SCHED;
            PG8_LDA(At, 0, 1); PG8_STAGE(PG8_SB(0, 0), b2, voffB); PG8_STAGE(PG8_SB(0, 1), b2 + hstepB, voffB); PG8_STAGE(PG8_SA(0, 0), a2, voffA);
            PG8_WAIT_V(8); PG8_WAIT_L(0); PG8_BAR; PG8_MMA(1, 0, At, B0); PG8_MMA(1, 1, At, B1); PG8_BAR; PG8_SCHED;
            PG8_LDB(B0, 1, 0); PG8_LDB(B1, 1, 1); PG8_SCHED; PG8_LDA(At, 1, 0); PG8_STAGE(PG8_SA(0, 1), a2 + hstepA, voffA);
            PG8_WAIT_V(8); PG8_WAIT_L(0); PG8_BAR; PG8_MMA(0, 0, At, B0); PG8_MMA(0, 1, At, B1); PG8_BAR; PG8_SCHED;
            PG8_LDA(At, 1, 1); PG8_STAGE(PG8_SB(1, 0), b3, voffB); PG8_STAGE(PG8_SB(1, 1), b3 + hstepB, voffB); PG8_STAGE(PG8_SA(1, 0), a3, voffA);
            PG8_WAIT_V(8); PG8_WAIT_L(0); PG8_BAR; PG8_MMA(1, 0, At, B0); PG8_MMA(1, 1, At, B1); PG8_BAR; PG8_SCHED;
            } else {
            PG8_LDB(B0, 0, 0); PG8_SCHED; PG8_LDA(At, 0, 0); PG8_STAGE(PG8_SA(1, 1), a1 + hstepA, voffA);
            PG8_WAIT_L(8); PG8_BAR; PG8_WAIT_L(0); PG8_MMA(0, 0, At, B0); PG8_BAR; PG8_SCHED;
            PG8_LDB(B1, 0, 1); PG8_STAGE(PG8_SB(0, 0), b2, voffB);
            PG8_BAR; PG8_WAIT_L(0); PG8_MMA(0, 1, At, B1); PG8_BAR;
            PG8_LDA(At, 0, 1); PG8_STAGE(PG8_SA(0, 0), a2, voffA);
            PG8_BAR; PG8_WAIT_L(0); PG8_MMA(1, 0, At, B0); PG8_BAR; PG8_SCHED;
            PG8_STAGE(PG8_SB(0, 1), b2 + hstepB, voffB);
            PG8_WAIT_V(6); PG8_BAR; PG8_MMA(1, 1, At, B1); PG8_BAR;
            PG8_LDB(B0, 1, 0); PG8_SCHED; PG8_LDA(At, 1, 0); PG8_STAGE(PG8_SA(0, 1), a2 + hstepA, voffA);
            PG8_WAIT_L(8); PG8_BAR; PG8_WAIT_L(0); PG8_MMA(0, 0, At, B0); PG8_BAR; PG8_SCHED;
            PG8_LDB(B1, 1, 1); PG8_STAGE(PG8_SB(1, 0), b3, voffB);
            PG8_BAR; PG8_WAIT_L(0); PG8_MMA(0, 1, At, B1); PG8_BAR;
            PG8_LDA(At, 1, 1); PG8_STAGE(PG8_SA(1, 0), a3, voffA);
            PG8_BAR; PG8_WAIT_L(0); PG8_MMA(1, 0, At, B0); PG8_BAR; PG8_SCHED;
            PG8_STAGE(PG8_SB(1, 1), b3 + hstepB, voffB);
            PG8_WAIT_V(6); PG8_BAR; PG8_MMA(1, 1, At, B1); PG8_BAR;
            }
        }
        if constexpr (ALIGN_EPI) { if (wr == 0) PG8_BAR; }
        if constexpr (!Epi::AFTER_DRAIN) { E(acc, cur, wr, wc, fr, fq); S.done(cur); }
        if (!has_next) break;
#pragma unroll
        for (int a = 0; a < 2; ++a)
#pragma unroll
            for (int b = 0; b < 2; ++b)
#pragma unroll
                for (int m = 0; m < 4; ++m)
#pragma unroll
                    for (int n = 0; n < 2; ++n) acc[a][b][m][n] = (f32x4){0.f, 0.f, 0.f, 0.f};
        cur = nxt; cA = nA; cB = nB; ++ui;
        if constexpr (ALIGN_EPI) { if (wr == 1) PG8_BAR; }
    }
    PG8_WAIT_V(0);
    if constexpr (!ALIGN_EPI) { if (wr == 0) PG8_BAR; }
    PG8_BAR;
    if constexpr (Epi::AFTER_DRAIN) { E.fused(acc, cur, wr, wc, fr, fq, lds, wid, lane); S.done(cur); }
#undef PG8_SA
#undef PG8_SB
#undef PG8_STAGE
#undef PG8_LDA
#undef PG8_LDB
#undef PG8_MMA
#undef PG8_WAIT_V
#undef PG8_WAIT_L
#undef PG8_BAR
#undef PG8_SCHED
}
}

#define GAS __attribute__((address_space(1)))
#define LAS __attribute__((address_space(3)))
typedef unsigned short bf16;
typedef unsigned u32x4 __attribute__((ext_vector_type(4)));
typedef unsigned u32x2 __attribute__((ext_vector_type(2)));
typedef float f32x4 __attribute__((ext_vector_type(4)));
typedef float f32x2 __attribute__((ext_vector_type(2)));
typedef short bf16x8 __attribute__((ext_vector_type(8)));
typedef float f32x16 __attribute__((ext_vector_type(16)));
constexpr int DM = 1024, BATCH = 32, SEQ = 2048, NMETA = 16, TT = SEQ + NMETA, DIN = 2208, DINP = 2304, DFF = 4096, DEPTH = 2;
constexpr int MREAL = BATCH * SEQ, MR0 = MREAL, MV = MREAL + NMETA, M = MREAL + 256;
static_assert(MREAL % 256 == 0, "row tiles");
__device__ __forceinline__ int rowof(int b, int t) { return t < NMETA ? MR0 + t : b * SEQ + (t - NMETA); }
constexpr int C_CB = 0, C_CC = 256, C_CH = 512, C_RQ = 768, C_RK = 1024, C_RV = 1280, C_RG = 1536, C_CQ = 1792, C_CKV = 2048, C_KR = 2176;
constexpr float EPS = 1e-6f;
constexpr float QSCALE = 0.10206207261596575f * 1.4426950408889634f;
constexpr size_t MiB = 1u << 20;
constexpr size_t WS_RT = 1 * MiB, WS_MT = 1 * MiB + 768 * 1024;
constexpr size_t WS_WIN = 4 * MiB, WS_WUQ = 13 * MiB, WS_WUKV = 14 * MiB, WS_WOUT = 15 * MiB, WS_W1 = 19 * MiB, WS_W2 = 35 * MiB;
constexpr size_t WS_X = 52 * MiB, WS_XN = 310 * MiB, WS_PROJ = 440 * MiB, WS_QRAW = 731 * MiB, WS_KV = 828 * MiB, WS_H = 440 * MiB, WS_SSX = 958 * MiB, WS_SSQ = 964 * MiB, WS_SSKV = 966 * MiB, WS_END = 968 * MiB;
static_assert(WS_X + (size_t)M * DM * 4 <= WS_XN && WS_XN + (size_t)M * DM * 2 <= WS_PROJ && WS_PROJ + (size_t)M * DINP * 2 <= WS_QRAW && WS_QRAW + (size_t)M * 768 * 2 <= WS_KV &&
              WS_KV + (size_t)M * 1024 * 2 <= WS_SSX && WS_H + (size_t)M * DFF * 2 <= WS_SSX && WS_SSX + (size_t)M * 64 <= WS_SSQ && WS_SSQ + (size_t)M * 16 <= WS_SSKV && WS_SSKV + (size_t)M * 16 <= WS_END, "d_ws map");
constexpr int NWAVES = 8, LDS_BYTES = 147456;

__device__ __forceinline__ unsigned f2bf(float f) { unsigned u = __builtin_bit_cast(unsigned, f); return (u + 0x7fffu + ((u >> 16) & 1u)) >> 16; }
__device__ __forceinline__ unsigned pk2(float lo, float hi) { return f2bf(lo) | (f2bf(hi) << 16); }
__device__ __forceinline__ float bflo(unsigned w) { return __uint_as_float(w << 16); }
__device__ __forceinline__ float bfhi(unsigned w) { return __uint_as_float(w & 0xffff0000u); }
__device__ __forceinline__ float bf1(bf16 h) { return __uint_as_float((unsigned)h << 16); }
__device__ __forceinline__ float wave_sum(float v) {
#pragma unroll
    for (int o = 1; o < 64; o <<= 1) v += __shfl_xor(v, o);
    return v;
}
__device__ __forceinline__ float half_sum(float v) {
#pragma unroll
    for (int o = 1; o < 32; o <<= 1) v += __shfl_xor(v, o);
    return v;
}

namespace att {
typedef float f32x2_t __attribute__((ext_vector_type(2))); typedef __bf16 bf16x2_t __attribute__((ext_vector_type(2)));
__device__ __forceinline__ unsigned cvtpk(float lo, float hi) { f32x2_t v = {lo, hi}; bf16x2_t b = __builtin_convertvector(v, bf16x2_t); return __builtin_bit_cast(unsigned, b); }
constexpr int VP = 144;
__device__ __forceinline__ float xhalf_max(float v) { auto rr = __builtin_amdgcn_permlane32_swap(__float_as_uint(v), __float_as_uint(v), false, false); return fmaxf(__uint_as_float(rr[0]), __uint_as_float(rr[1])); }
__device__ __forceinline__ float xhalf_sum(float v) { auto rr = __builtin_amdgcn_permlane32_swap(__float_as_uint(v), __float_as_uint(v), false, false); return __uint_as_float(rr[0]) + __uint_as_float(rr[1]); }
template <int DQK, bool SM>
__device__ __forceinline__ void unit(LAS unsigned char* lds, const bf16* Q, int ldq, const bf16* K, int ldk, const bf16* V, int ldv, bf16* O, int ldo,
                                     const bf16* G, int ldg, const float* gain, float lg2, int b, int q0, int qend, const int tid_in) {
    constexpr int KP = DQK * 2 + 16, CH = DQK / 8, ND = DQK / 16, KB = 64 * KP, VB = 64 * VP, SB = KB + VB;
    int tid_o = tid_in; asm volatile("" : "+v"(tid_o));
    const int tid = tid_o, lane = tid & 63, wid = __builtin_amdgcn_readfirstlane(tid >> 6), r32 = lane & 31, hi = lane >> 5;
    const int q0w = q0 + 32 * wid, tq = q0w + r32;
    const bool wact = q0w < qend;
    bf16x8 qr[ND];
    const int qrow = rowof(b, tq < TT ? tq : TT - 1);
    { const bf16* qp = Q + (size_t)qrow * ldq + 8 * hi;
#pragma unroll
      for (int d0 = 0; d0 < ND; ++d0) qr[d0] = *(const bf16x8*)(qp + 16 * d0); }
    const int ntiles = (qend - 1) / 64 + 1;
    const int nw = wact ? ((q0w + 31) / 64 + 1 < ntiles ? (q0w + 31) / 64 + 1 : ntiles) : 0;
    const int nfull = (q0w + 1) / 64;
    const int kkey0 = tid / CH, kch0 = tid % CH, kkey1 = (tid + 512) / CH, kch1 = (tid + 512) % CH;
    const bool has2 = (64 * CH > 512) && (tid + 512 < 64 * CH);
    const int vkey = tid & 63, vch = tid >> 6;
    const int pr32 = (r32 & 0x13) | ((r32 & 4) << 1) | ((r32 & 8) >> 1);
    const int koff = pr32 * KP + 16 * hi, voff = KB + r32 * VP + 16 * hi;
    u32x4 kreg0, kreg1 = {0u, 0u, 0u, 0u}, vreg;
#define ATT_LOAD(j) do { int r0_ = 64 * (j) + kkey0; r0_ = r0_ < TT ? r0_ : TT - 1; kreg0 = *(const u32x4*)(K + (size_t)rowof(b, r0_) * ldk + 8 * kch0); \
        if (has2) { int r1_ = 64 * (j) + kkey1; r1_ = r1_ < TT ? r1_ : TT - 1; kreg1 = *(const u32x4*)(K + (size_t)rowof(b, r1_) * ldk + 8 * kch1); } \
        int rv_ = 64 * (j) + vkey; rv_ = rv_ < TT ? rv_ : TT - 1; vreg = *(const u32x4*)(V + (size_t)rowof(b, rv_) * ldv + 8 * vch); } while (0)
#define ATT_STORE(so) do { *(LAS u32x4*)(lds + (so) + kkey0 * KP + 16 * kch0) = kreg0; if (has2) *(LAS u32x4*)(lds + (so) + kkey1 * KP + 16 * kch1) = kreg1; \
        LAS unsigned char* vd_ = lds + (so) + KB + (8 * vch) * VP + 2 * vkey; \
        _Pragma("unroll") for (int i_ = 0; i_ < 8; ++i_) { const unsigned w_ = vreg[i_ >> 1]; *(LAS unsigned short*)(vd_ + i_ * VP) = (unsigned short)((i_ & 1) ? (w_ >> 16) : (w_ & 0xffffu)); } } while (0)
#define ATT_KREAD(so) do { const LAS unsigned char* kb_ = lds + (so) + koff; \
        _Pragma("unroll") for (int d0 = 0; d0 < ND; ++d0) { kf0[d0] = *(const LAS bf16x8*)(kb_ + 32 * d0); kf1[d0] = *(const LAS bf16x8*)(kb_ + 32 * KP + 32 * d0); } } while (0)
#define ATT_VREAD(so) do { const LAS unsigned char* vb_ = lds + (so) + voff; \
        _Pragma("unroll") for (int ks = 0; ks < 4; ++ks) { vf0[ks] = *(const LAS bf16x8*)(vb_ + 32 * ks); vf1[ks] = *(const LAS bf16x8*)(vb_ + 32 * VP + 32 * ks); } } while (0)
#define ATT_QKM(S0, S1) do { \
        _Pragma("unroll") for (int r_ = 0; r_ < 16; ++r_) { S0[r_] = 0.f; S1[r_] = 0.f; } \
        _Pragma("unroll") for (int d0 = 0; d0 < ND; ++d0) { \
            S0 = __builtin_amdgcn_mfma_f32_32x32x16_bf16(kf0[d0], qr[d0], S0, 0, 0, 0); S1 = __builtin_amdgcn_mfma_f32_32x32x16_bf16(kf1[d0], qr[d0], S1, 0, 0, 0); } } while (0)
#define ATT_TILE(j, so, MASK) do { const int kbase_ = 64 * (j) + 8 * hi; \
        if (SM) { \
            if (MASK) { _Pragma("unroll") for (int r = 0; r < 16; ++r) { const int kk = kbase_ + 16 * (r >> 3) + (r & 7); if (kk > tq) s0[r] = -INFINITY; if (kk + 32 > tq) s1[r] = -INFINITY; } } \
            float mx = fmaxf(s0[0], s1[0]); \
            _Pragma("unroll") for (int r = 1; r < 16; ++r) mx = fmaxf(mx, fmaxf(s0[r], s1[r])); \
            mx = xhalf_max(mx); \
            const float mn = fmaxf(m_run, mx), alpha = __builtin_amdgcn_exp2f(m_run - mn); m_run = mn; \
            float ps = 0.f; \
            _Pragma("unroll") for (int r = 0; r < 16; ++r) { s0[r] = __builtin_amdgcn_exp2f(s0[r] - mn); s1[r] = __builtin_amdgcn_exp2f(s1[r] - mn); ps += s0[r] + s1[r]; } \
            l_run = l_run * alpha + ps; \
            _Pragma("unroll") for (int r = 0; r < 16; ++r) { o0[r] *= alpha; o1[r] *= alpha; } \
        } else { \
            const float rf0 = __builtin_amdgcn_exp2f(lg2 * (float)(tq - kbase_)), rf1 = rf0 * c32; \
            _Pragma("unroll") for (int r = 0; r < 16; ++r) { s0[r] = (s0[r] * cfac[r]) * rf0; s1[r] = (s1[r] * cfac[r]) * rf1; } \
            if (MASK) { _Pragma("unroll") for (int r = 0; r < 16; ++r) { const int kk = kbase_ + 16 * (r >> 3) + (r & 7); if (kk > tq) s0[r] = 0.f; if (kk + 32 > tq) s1[r] = 0.f; } } \
        } \
        u32x4 pw[4]; \
        _Pragma("unroll") for (int ks = 0; ks < 2; ++ks) { \
            pw[ks] = (u32x4){cvtpk(s0[8 * ks], s0[8 * ks + 1]), cvtpk(s0[8 * ks + 2], s0[8 * ks + 3]), cvtpk(s0[8 * ks + 4], s0[8 * ks + 5]), cvtpk(s0[8 * ks + 6], s0[8 * ks + 7])}; \
            pw[2 + ks] = (u32x4){cvtpk(s1[8 * ks], s1[8 * ks + 1]), cvtpk(s1[8 * ks + 2], s1[8 * ks + 3]), cvtpk(s1[8 * ks + 4], s1[8 * ks + 5]), cvtpk(s1[8 * ks + 6], s1[8 * ks + 7])}; } \
        _Pragma("unroll") for (int ks = 0; ks < 4; ++ks) { const bf16x8 pf_ = __builtin_bit_cast(bf16x8, pw[ks]); \
            o0 = __builtin_amdgcn_mfma_f32_32x32x16_bf16(vf0[ks], pf_, o0, 0, 0, 0); o1 = __builtin_amdgcn_mfma_f32_32x32x16_bf16(vf1[ks], pf_, o1, 0, 0, 0); } } while (0)
    f32x16 o0, o1, s0, s1, t0, t1; bf16x8 kf0[ND], kf1[ND], vf0[4], vf1[4];
#pragma unroll
    for (int r = 0; r < 16; ++r) { o0[r] = 0.f; o1[r] = 0.f; s0[r] = 0.f; s1[r] = 0.f; t0[r] = 0.f; t1[r] = 0.f; }
    float m_run = -INFINITY, l_run = 0.f;
    float cfac[16]; const float c32 = SM ? 0.f : __builtin_amdgcn_exp2f(-32.f * lg2);
#pragma unroll
    for (int r = 0; r < 16; ++r) cfac[r] = SM ? 0.f : __builtin_amdgcn_exp2f(-lg2 * (float)(16 * (r >> 3) + (r & 7)));
    int so_c = 0, so_n = SB, so_nn = 2 * SB;
    ATT_LOAD(0); ATT_STORE(0);
    if (ntiles > 1) { ATT_LOAD(1); ATT_STORE(SB); }
    __syncthreads();
    if (nw > 0) { ATT_KREAD(0); __builtin_amdgcn_sched_barrier(0); ATT_QKM(s0, s1); }
    for (int j = 0; j < ntiles; ++j) {
        if (j + 2 < ntiles) ATT_LOAD(j + 2);
        if (j + 1 < nw && j < nfull) {
            if (SM || wid < 4) {
                ATT_KREAD(so_n); ATT_VREAD(so_c); __builtin_amdgcn_sched_barrier(0);
                ATT_QKM(t0, t1);
                ATT_TILE(j, so_c, false);
            } else {
                ATT_VREAD(so_c); __builtin_amdgcn_sched_barrier(0);
                ATT_TILE(j, so_c, false); __builtin_amdgcn_sched_barrier(0);
                ATT_KREAD(so_n); __builtin_amdgcn_sched_barrier(0);
                ATT_QKM(t0, t1);
            }
#pragma unroll
            for (int r = 0; r < 16; ++r) { s0[r] = t0[r]; s1[r] = t1[r]; }
        } else if (j < nw) {
            if (j + 1 < nw) { ATT_KREAD(so_n); ATT_VREAD(so_c); __builtin_amdgcn_sched_barrier(0); ATT_QKM(t0, t1); } else { ATT_VREAD(so_c); }
            ATT_TILE(j, so_c, true);
#pragma unroll
            for (int r = 0; r < 16; ++r) { s0[r] = t0[r]; s1[r] = t1[r]; }
        }
        if (j + 2 < ntiles) ATT_STORE(so_nn);
        __syncthreads();
        { const int t_ = so_c; so_c = so_n; so_n = so_nn; so_nn = t_; }
    }
#undef ATT_LOAD
#undef ATT_STORE
#undef ATT_KREAD
#undef ATT_VREAD
#undef ATT_QKM
#undef ATT_TILE
    if (wact) {
        if (SM) {
            const float l = xhalf_sum(l_run), inv = 1.f / l;
            if (tq < qend) { bf16* op = O + (size_t)qrow * ldo + 4 * hi;
#pragma unroll
                for (int g = 0; g < 4; ++g) {
                    u32x2 a, bq; a.x = cvtpk(o0[4 * g] * inv, o0[4 * g + 1] * inv); a.y = cvtpk(o0[4 * g + 2] * inv, o0[4 * g + 3] * inv);
                    bq.x = cvtpk(o1[4 * g] * inv, o1[4 * g + 1] * inv); bq.y = cvtpk(o1[4 * g + 2] * inv, o1[4 * g + 3] * inv);
                    *(u32x2*)(op + 8 * g) = a; *(u32x2*)(op + 32 + 8 * g) = bq; } }
        } else {
            float ss = 0.f;
#pragma unroll
            for (int r = 0; r < 16; ++r) ss += o0[r] * o0[r] + o1[r] * o1[r];
            ss = xhalf_sum(ss);
            const float rs = 1.0f / sqrtf(ss * (1.f / 64.f) + EPS);
            if (tq < qend) { bf16* op = O + (size_t)qrow * ldo + 4 * hi; const bf16* gp = G + (size_t)qrow * ldg + 4 * hi; const float* gn = gain + 4 * hi;
#pragma unroll
                for (int g = 0; g < 4; ++g) {
#pragma unroll
                    for (int db = 0; db < 2; ++db) {
                        const u32x2 gw = *(const u32x2*)(gp + 32 * db + 8 * g); const f32x4 ga = *(const f32x4*)(gn + 32 * db + 8 * g);
                        float gv[4] = {bflo(gw.x), bfhi(gw.x), bflo(gw.y), bfhi(gw.y)}; float y[4];
#pragma unroll
                        for (int e = 0; e < 4; ++e) { const float ov = db ? o1[4 * g + e] : o0[4 * g + e]; const float sg = gv[e] / (1.f + __expf(-gv[e])); y[e] = ov * rs * ga[e] * sg; }
                        u32x2 w; w.x = cvtpk(y[0], y[1]); w.y = cvtpk(y[2], y[3]); *(u32x2*)(op + 32 * db + 8 * g) = w; } } }
        }
    }
}
}

struct Args { const float* in[16]; float* out; unsigned char* ws; int ph_lo, ph_hi; };
typedef const __attribute__((address_space(4))) Args* KArgsP;
#define RT   ((f32x2*)(ws + WS_RT))
#define MT   ((f32x2*)(ws + WS_MT))
#define WIN  ((bf16*)(ws + WS_WIN))
#define WUQ  ((bf16*)(ws + WS_WUQ))
#define WUKV ((bf16*)(ws + WS_WUKV))
#define WOUT ((bf16*)(ws + WS_WOUT))
#define W1   ((bf16*)(ws + WS_W1))
#define W2   ((bf16*)(ws + WS_W2))
#define XF   ((float*)(ws + WS_X))
#define XN   ((bf16*)(ws + WS_XN))
#define MIX  ((bf16*)(ws + WS_XN))
#define PROJ ((bf16*)(ws + WS_PROJ))
#define QRAW ((bf16*)(ws + WS_QRAW))
#define KVR  ((bf16*)(ws + WS_KV))
#define HB   ((bf16*)(ws + WS_H))
#define SSX  ((float*)(ws + WS_SSX))
#define SSQ  ((float*)(ws + WS_SSQ))
#define SSKV ((float*)(ws + WS_SSKV))
#define XB2  ((bf16*)(ap->out))
enum { I_X = 0, I_META, I_ANG, I_WIN, I_CONVW, I_RETG, I_QNG, I_WUQ, I_KVNG, I_WUKV, I_QHG, I_KHG, I_WOUT, I_MLPG, I_W1, I_W2 };
constexpr int NPP = 7, NPHASE = 1 + NPP * DEPTH;

__device__ __forceinline__ void p0_transpose_item(const float* W, const float* gk, int K, int N, bf16* WT, LAS float* scr, int item, int lane) {
    const int nblk = N / 32, kb = item / nblk, nb = item % nblk, k0 = 64 * kb, n0 = 32 * nb;
#pragma unroll 8
    for (int i = 0; i < 32; ++i) { const int kk = 2 * i + (lane >> 5); const float gv = gk ? gk[k0 + kk] : 1.f; scr[kk * 33 + (lane & 31)] = W[(size_t)(k0 + kk) * N + n0 + (lane & 31)] * gv; }
    asm volatile("s_waitcnt lgkmcnt(0)" ::: "memory");
    const int c = lane & 7;
#pragma unroll
    for (int j = 0; j < 4; ++j) { const int n = (lane >> 3) + 8 * j; const LAS float* s = scr + (8 * c) * 33 + n;
        u32x4 o; o.x = pk2(s[0 * 33], s[1 * 33]); o.y = pk2(s[2 * 33], s[3 * 33]); o.z = pk2(s[4 * 33], s[5 * 33]); o.w = pk2(s[6 * 33], s[7 * 33]);
        *(u32x4*)(WT + (size_t)(n0 + n) * K + k0 + 8 * c) = o; }
    asm volatile("s_waitcnt lgkmcnt(0)" ::: "memory");
}
__device__ __forceinline__ void row_prep(const float* xrow, float* xcopy, bf16* orow, float* ss16, int lane) {
    const f32x4* xr = (const f32x4*)xrow + lane;
    f32x4 v[4]; float s = 0.f;
#pragma unroll
    for (int j = 0; j < 4; ++j) { v[j] = xr[64 * j]; s += (v[j].x * v[j].x + v[j].y * v[j].y) + (v[j].z * v[j].z + v[j].w * v[j].w); }
    if (xcopy) { f32x4* xc = (f32x4*)xcopy + lane;
#pragma unroll
        for (int j = 0; j < 4; ++j) xc[64 * j] = v[j]; }
    const float tot = wave_sum(s);
    if (lane < 16) ss16[lane] = lane == 0 ? tot : 0.f;
    unsigned long long* o8 = (unsigned long long*)orow + lane;
#pragma unroll
    for (int j = 0; j < 4; ++j) o8[64 * j] = (unsigned long long)att::cvtpk(v[j].x, v[j].y) | ((unsigned long long)att::cvtpk(v[j].z, v[j].w) << 32);
}
__device__ __forceinline__ f32x2 cossin(float ang) {
    const float n = rintf(ang * 0.15915494309189535f);
    float r = fmaf(-n, 6.28125f, ang); r = fmaf(-n, 0.0019353071795864769f, r);
    const float rev = r * 0.15915494309189535f;
    f32x2 o; o.x = __builtin_amdgcn_cosf(rev); o.y = __builtin_amdgcn_sinf(rev); return o;
}

struct EpiMeta { int mode, need_rs; bf16* O; int ldc; const float* xin; float* X; bf16* xb; };
__device__ __forceinline__ void meta_gemm(const bf16* A, int lda, const bf16* Bt, int N, int K, const EpiMeta& E, int gw, int NGW, int lane) {
    for (int n = gw; n < N; n += NGW) {
        float acc[16], ssa[16];
#pragma unroll
        for (int r = 0; r < 16; ++r) { acc[r] = 0.f; ssa[r] = 0.f; }
        for (int c = lane; c < K / 8; c += 64) {
            const u32x4 w = *(const u32x4*)(Bt + (size_t)n * K + 8 * c);
            float wf[8];
#pragma unroll
            for (int e = 0; e < 4; ++e) { wf[2 * e] = bflo(w[e]); wf[2 * e + 1] = bfhi(w[e]); }
#pragma unroll
            for (int r = 0; r < 16; ++r) { const u32x4 a = *(const u32x4*)(A + (size_t)r * lda + 8 * c);
#pragma unroll
                for (int e = 0; e < 4; ++e) { const float a0 = bflo(a[e]), a1 = bfhi(a[e]); acc[r] += a0 * wf[2 * e] + a1 * wf[2 * e + 1]; ssa[r] += a0 * a0 + a1 * a1; } }
        }
        float mine = 0.f, myss = 0.f;
#pragma unroll
        for (int r = 0; r < 16; ++r) { const float s = wave_sum(acc[r]), q = E.need_rs ? wave_sum(ssa[r]) : 0.f; if (lane == r) { mine = s; myss = q; } }
        if (lane < 16) { const int r = lane;
            if (E.mode < 2) { float v = mine * (E.need_rs ? 1.0f / sqrtf(myss * (1.f / 1024.f) + EPS) : 1.f); if (E.mode == 1) { v = fmaxf(v, 0.f); v = v * v; } E.O[(size_t)(MR0 + r) * E.ldc + n] = (bf16)f2bf(v); }
            else { const float x = E.xin[(size_t)r * DM + n] + mine; E.X[(size_t)(MR0 + r) * DM + n] = x; E.xb[(size_t)(MR0 + r) * DM + n] = (bf16)f2bf(x); } }
    }
}

__global__ void __launch_bounds__(NWAVES * 64, 2) hybrid_fwd(Args args) {
    extern __shared__ __attribute__((aligned(16))) unsigned char lds_raw[];
    LAS unsigned char* lds = (LAS unsigned char*)lds_raw;
    cg::grid_group grid = cg::this_grid();
    const int G = gridDim.x, NGW = G * NWAVES;
    const int wave_s = __builtin_amdgcn_readfirstlane((int)threadIdx.x >> 6);
    const int lo = args.ph_lo, hi = args.ph_hi;
    for (int ph = lo; ph < hi; ++ph) {
        KArgsP ap = (KArgsP)__builtin_amdgcn_kernarg_segment_ptr(); asm volatile("" : "+s"(ap));
        unsigned char* const ws = ap->ws;
        int wave = wave_s; asm volatile("" : "+s"(wave));
        int lane = (int)__builtin_amdgcn_mbcnt_hi(~0u, __builtin_amdgcn_mbcnt_lo(~0u, 0u)); asm volatile("" : "+v"(lane));
        const int tid = wave * 64 + lane, gw = blockIdx.x * NWAVES + wave;
        const int l = ph == 0 ? 0 : (ph - 1) / NPP, k = ph == 0 ? -1 : (ph - 1) % NPP;
        if (k == -1) {
            LAS float* scr = (LAS float*)(lds + wave * 16384);
            constexpr int I_IN = 16 * 69, I_UQ = 4 * 24, I_UKV = 2 * 32, I_O = 16 * 32, I_1 = 16 * 128, I_2 = 64 * 32, I_L = I_IN + I_UQ + I_UKV + I_O + I_1 + I_2;
            for (int it = gw; it < DEPTH * I_L; it += NGW) {
                const int ll = it / I_L; int r = it - ll * I_L;
                if (r < I_IN) { p0_transpose_item(ap->in[I_WIN] + (size_t)ll * DM * DIN, ap->in[I_ANG] + ll * DM, DM, DIN, WIN + (size_t)ll * DINP * DM, scr, r, lane); continue; } r -= I_IN;
                if (r < I_UQ) { p0_transpose_item(ap->in[I_WUQ] + (size_t)ll * 256 * 768, ap->in[I_QNG] + ll * 256, 256, 768, WUQ + (size_t)ll * 768 * 256, scr, r, lane); continue; } r -= I_UQ;
                if (r < I_UKV) { p0_transpose_item(ap->in[I_WUKV] + (size_t)ll * 128 * 1024, ap->in[I_KVNG] + ll * 128, 128, 1024, WUKV + (size_t)ll * 1024 * 128, scr, r, lane); continue; } r -= I_UKV;
                if (r < I_O) { p0_transpose_item(ap->in[I_WOUT] + (size_t)ll * DM * DM, nullptr, DM, DM, WOUT + (size_t)ll * DM * DM, scr, r, lane); continue; } r -= I_O;
                if (r < I_1) { p0_transpose_item(ap->in[I_W1] + (size_t)ll * DM * DFF, ap->in[I_MLPG] + ll * DM, DM, DFF, W1 + (size_t)ll * DFF * DM, scr, r, lane); continue; } r -= I_1;
                p0_transpose_item(ap->in[I_W2] + (size_t)ll * DFF * DM, nullptr, DFF, DM, W2 + (size_t)ll * DM * DFF, scr, r, lane);
            }
            for (int it = gw; it < DEPTH * (DINP - DIN); it += NGW) {
                const int ll = it / (DINP - DIN), r = DIN + it % (DINP - DIN); u32x4* p = (u32x4*)(WIN + ((size_t)ll * DINP + r) * DM) + lane;
                p[0] = (u32x4){0u, 0u, 0u, 0u}; p[64] = (u32x4){0u, 0u, 0u, 0u};
            }
            for (int e = blockIdx.x * 512 + tid; e < TT * 32; e += G * 512) { const int t = e >> 5, i = e & 31; const float inv = exp2f(-13.287712379549449f * (float)(2 * i) * (1.f / 64.f)); RT[e] = cossin((float)t * inv); }
            for (int e = blockIdx.x * 512 + tid; e < TT * 16; e += G * 512) { const int t = e >> 4, i = e & 15; const float inv = exp2f(-13.287712379549449f * (float)(2 * i) * (1.f / 32.f)); MT[e] = cossin((float)t * inv); }
            for (int m = gw; m < MV; m += NGW) {
                const float* src = m >= MR0 ? ap->in[I_META] + (size_t)(m - MR0) * DM : ap->in[I_X] + (size_t)m * DM;
                row_prep(src, m >= MR0 ? XF + (size_t)m * DM : nullptr, XN + (size_t)m * DM, SSX + (size_t)m * 16, lane); }
        } else if (k == 0 || k == 1 || k == 4 || k == 5 || k == 6) {
            const int ng = k == 1 ? 2 : 1;
            for (int gi = 0; gi < ng; ++gi) {
                pg8::Gemm g; pg8::EpiAny E; E.xin = (l == 0 && k == 4) ? ap->in[I_X] : XF; E.X = XF; E.out = ap->out; E.O = nullptr; E.ldc = 0; E.xb = nullptr; E.ssx = SSX; E.rs_src = nullptr; E.ssq = nullptr; E.sskv = nullptr;
                EpiMeta Em; Em.need_rs = 0; Em.O = nullptr; Em.ldc = 0; Em.xin = (l == 0 && k == 4) ? ap->in[I_META] : XF + (size_t)MR0 * DM; Em.X = XF; Em.xb = nullptr;
                if (k == 0)      { g = pg8::Gemm{XN, WIN + (size_t)l * DINP * DM, MREAL, DINP, DM, DM}; E.mode = 0; E.perm = 1; E.O = PROJ; E.ldc = DINP; E.rs_src = SSX; E.ssq = SSQ; E.sskv = SSKV; Em.need_rs = 1; }
                else if (k == 1 && gi == 0) { g = pg8::Gemm{PROJ + C_CQ, WUQ + (size_t)l * 768 * 256, MREAL, 768, 256, DINP}; E.mode = 0; E.perm = 1; E.O = QRAW; E.ldc = 768; }
                else if (k == 1) { g = pg8::Gemm{PROJ + C_CKV, WUKV + (size_t)l * 1024 * 128, MREAL, 1024, 128, DINP}; E.mode = 0; E.perm = 1; E.O = KVR; E.ldc = 1024; }
                else if (k == 4) { g = pg8::Gemm{MIX, WOUT + (size_t)l * DM * DM, MREAL, DM, DM, DM}; E.mode = 2; E.perm = 0; E.xb = XB2; }
                else if (k == 5) { g = pg8::Gemm{XB2, W1 + (size_t)l * DFF * DM, MREAL, DFF, DM, DM}; E.mode = 1; E.perm = 1; E.O = HB; E.ldc = DFF; E.rs_src = SSX; Em.need_rs = 1; }
                else             { g = pg8::Gemm{HB, W2 + (size_t)l * DM * DFF, MREAL, DM, DFF, DFF}; E.mode = (l == DEPTH - 1) ? 3 : 2; E.perm = 0; E.xb = XN; }
                Em.mode = E.mode; Em.O = E.O; Em.ldc = E.ldc; Em.xb = E.xb;
                pg8::StaticOrder S; S.init(MREAL, g.N, G, (int)blockIdx.x);
                pg8::gemm_phase<pg8::EpiAny, pg8::StaticOrder, true, true>(lds, g, S, E, tid);
                if (E.mode != 3) meta_gemm(g.A + (size_t)MR0 * g.lda, g.lda, g.Bt, g.N, g.K, Em, gw, NGW, lane);
            }
            if (k == 1) {
                const float* cw = ap->in[I_CONVW] + l * 3 * 256;
                for (int it = blockIdx.x * 512 + tid; it < MV * 32; it += G * 512) {
                    const int m = it >> 5, c = (it & 31) * 8; const int t = m >= MR0 ? m - MR0 : (m & (SEQ - 1)) + NMETA; const bf16* pr = PROJ + (size_t)m * DINP;
                    const u32x4 cbv = *(const u32x4*)(pr + C_CB + c); float a[8];
#pragma unroll
                    for (int e = 0; e < 8; ++e) a[e] = 0.f;
#pragma unroll
                    for (int j = 0; j < 3; ++j) { const int tj = t - 2 + j; if (tj >= 0) { const int mj = (m >= MR0 || tj >= NMETA) ? m - (2 - j) : MR0 + tj;
                            const bf16* p2 = PROJ + (size_t)mj * DINP; const u32x4 ccv = *(const u32x4*)(p2 + C_CC + c), chv = *(const u32x4*)(p2 + C_CH + c);
                            const f32x4 w0 = *(const f32x4*)(cw + j * 256 + c), w1 = *(const f32x4*)(cw + j * 256 + c + 4);
#pragma unroll
                            for (int e = 0; e < 4; ++e) { const float wl = e < 2 ? w0[2 * e] : w1[2 * e - 4], wh = e < 2 ? w0[2 * e + 1] : w1[2 * e - 3];
                                a[2 * e] += wl * (bflo(ccv[e]) * bflo(chv[e])); a[2 * e + 1] += wh * (bfhi(ccv[e]) * bfhi(chv[e])); } } }
                    u32x4 o;
#pragma unroll
                    for (int e = 0; e < 4; ++e) o[e] = att::cvtpk(bflo(cbv[e]) * a[2 * e], bfhi(cbv[e]) * a[2 * e + 1]);
                    *(u32x4*)(MIX + (size_t)m * DM + c) = o;
                }
                for (int it = blockIdx.x * 512 + tid; it < MV * 32; it += G * 512) {
                    const int m = it >> 5, j = it & 31, w = j >> 4, h = (j >> 2) & 3, i0 = (j & 3) * 8; const int t = m >= MR0 ? m - MR0 : (m & (SEQ - 1)) + NMETA;
                    bf16* p = PROJ + (size_t)m * DINP + (w ? C_RK : C_RQ) + 64 * h + i0; const float sc = w ? 0.125f : 1.f;
                    const u32x4 x1 = *(const u32x4*)p, x2 = *(const u32x4*)(p + 32); const f32x4* cs = (const f32x4*)(RT + t * 32 + i0);
                    u32x4 o1, o2;
#pragma unroll
                    for (int e = 0; e < 4; ++e) { const f32x4 c4 = cs[e]; const float a0 = bflo(x1[e]), a1 = bfhi(x1[e]), b0 = bflo(x2[e]), b1 = bfhi(x2[e]);
                        o1[e] = att::cvtpk((a0 * c4.x - b0 * c4.y) * sc, (a1 * c4.z - b1 * c4.w) * sc); o2[e] = att::cvtpk((b0 * c4.x + a0 * c4.y) * sc, (b1 * c4.z + a1 * c4.w) * sc); }
                    *(u32x4*)p = o1; *(u32x4*)(p + 32) = o2;
                }
            }
        } else if (k == 2) {
            const float* qg = ap->in[I_QHG] + l * 96; const float* kg = ap->in[I_KHG] + l * 96;
            for (int it = blockIdx.x * 512 + tid; it < MV * 8; it += G * 512) {
                const int m = it >> 3, h = it & 7; const int t = m >= MR0 ? m - MR0 : (m & (SEQ - 1)) + NMETA;
                float sumq, sumkv;
                if (m < MR0) { const f32x4 sq4 = *(const f32x4*)(SSQ + (size_t)m * 4), sk4 = *(const f32x4*)(SSKV + (size_t)m * 4); sumq = (sq4.x + sq4.y) + (sq4.z + sq4.w); sumkv = (sk4.x + sk4.y) + (sk4.z + sk4.w); }
                else { sumq = 0.f; sumkv = 0.f; const bf16* pc = PROJ + (size_t)m * DINP + C_CQ;
                    for (int c = 0; c < 48; ++c) { const u32x4 v = *(const u32x4*)(pc + 8 * c); float s = 0.f;
#pragma unroll
                        for (int e = 0; e < 4; ++e) { const float a0 = bflo(v[e]), a1 = bfhi(v[e]); s += a0 * a0 + a1 * a1; }
                        if (c < 32) sumq += s; else sumkv += s; } }
                const float s_q = 1.0f / sqrtf(sumq * (1.f / 256.f) + EPS), s_kv = 1.0f / sqrtf(sumkv * (1.f / 128.f) + EPS);
                const f32x4* mt = (const f32x4*)(MT + t * 16);
                { bf16* q = QRAW + (size_t)m * 768 + 96 * h; u32x4 w[12]; float ss = 0.f;
#pragma unroll
                  for (int c = 0; c < 12; ++c) w[c] = *(const u32x4*)(q + 8 * c);
#pragma unroll
                  for (int c = 0; c < 12; ++c)
#pragma unroll
                      for (int e = 0; e < 4; ++e) { const float a0 = bflo(w[c][e]), a1 = bfhi(w[c][e]); ss += a0 * a0 + a1 * a1; }
                  const float rs = s_q * QSCALE / sqrtf(s_q * s_q * ss * (1.f / 96.f) + EPS);
#pragma unroll
                  for (int c = 0; c < 8; ++c) { u32x4 o;
#pragma unroll
                      for (int e = 0; e < 4; ++e) o[e] = att::cvtpk(bflo(w[c][e]) * rs * qg[8 * c + 2 * e], bfhi(w[c][e]) * rs * qg[8 * c + 2 * e + 1]);
                      *(u32x4*)(q + 8 * c) = o; }
#pragma unroll
                  for (int cc = 0; cc < 2; ++cc) { u32x4 o1, o2;
#pragma unroll
                      for (int e = 0; e < 4; ++e) { const int i = 8 * cc + 2 * e; const f32x4 c4 = mt[4 * cc + e];
                          const float a0 = bflo(w[8 + cc][e]) * rs * qg[64 + i], a1 = bfhi(w[8 + cc][e]) * rs * qg[64 + i + 1], b0 = bflo(w[10 + cc][e]) * rs * qg[80 + i], b1 = bfhi(w[10 + cc][e]) * rs * qg[80 + i + 1];
                          o1[e] = att::cvtpk(a0 * c4.x - b0 * c4.y, a1 * c4.z - b1 * c4.w); o2[e] = att::cvtpk(b0 * c4.x + a0 * c4.y, b1 * c4.z + a1 * c4.w); }
                      *(u32x4*)(q + 64 + 8 * cc) = o1; *(u32x4*)(q + 80 + 8 * cc) = o2; } }
                { bf16* kn = KVR + (size_t)m * 1024 + 128 * h; bf16* pr = PROJ + (size_t)m * DINP; bf16* ko = pr + 96 * h; u32x4 w[8], r[4]; float ssn = 0.f, ssr = 0.f;
#pragma unroll
                  for (int c = 0; c < 8; ++c) w[c] = *(const u32x4*)(kn + 8 * c);
#pragma unroll
                  for (int c = 0; c < 4; ++c) r[c] = *(const u32x4*)(pr + C_KR + 8 * c);
#pragma unroll
                  for (int c = 0; c < 8; ++c)
#pragma unroll
                      for (int e = 0; e < 4; ++e) { const float a0 = bflo(w[c][e]), a1 = bfhi(w[c][e]); ssn += a0 * a0 + a1 * a1; }
#pragma unroll
                  for (int c = 0; c < 4; ++c)
#pragma unroll
                      for (int e = 0; e < 4; ++e) { const float a0 = bflo(r[c][e]), a1 = bfhi(r[c][e]); ssr += a0 * a0 + a1 * a1; }
                  const float rs = 1.0f / sqrtf((s_kv * s_kv * ssn + ssr) * (1.f / 96.f) + EPS), rn = rs * s_kv;
#pragma unroll
                  for (int c = 0; c < 8; ++c) { u32x4 o;
#pragma unroll
                      for (int e = 0; e < 4; ++e) o[e] = att::cvtpk(bflo(w[c][e]) * rn * kg[8 * c + 2 * e], bfhi(w[c][e]) * rn * kg[8 * c + 2 * e + 1]);
                      *(u32x4*)(ko + 8 * c) = o; }
#pragma unroll
                  for (int cc = 0; cc < 2; ++cc) { u32x4 o1, o2;
#pragma unroll
                      for (int e = 0; e < 4; ++e) { const int i = 8 * cc + 2 * e; const f32x4 c4 = mt[4 * cc + e];
                          const float a0 = bflo(r[cc][e]) * rs * kg[64 + i], a1 = bfhi(r[cc][e]) * rs * kg[64 + i + 1], b0 = bflo(r[2 + cc][e]) * rs * kg[80 + i], b1 = bfhi(r[2 + cc][e]) * rs * kg[80 + i + 1];
                          o1[e] = att::cvtpk(a0 * c4.x - b0 * c4.y, a1 * c4.z - b1 * c4.w); o2[e] = att::cvtpk(b0 * c4.x + a0 * c4.y, b1 * c4.z + a1 * c4.w); }
                      *(u32x4*)(ko + 64 + 8 * cc) = o1; *(u32x4*)(ko + 80 + 8 * cc) = o2; }
#pragma unroll
                  for (int c = 0; c < 8; ++c) { const u32x4 v = *(const u32x4*)(kn + 64 + 8 * c); u32x4 o;
#pragma unroll
                      for (int e = 0; e < 4; ++e) o[e] = att::cvtpk(bflo(v[e]) * s_kv, bfhi(v[e]) * s_kv);
                      *(u32x4*)(kn + 64 + 8 * c) = o; } }
            }
        } else {
            for (int item = blockIdx.x; item < 524; item += G) {
                if (item < 256 || (item >= 512 && item < 520)) { const bool meta = item >= 512; const int b = meta ? 0 : item >> 3, h = item & 7;
                    const bf16* Qp = QRAW + 96 * h; const bf16* Kp = PROJ + 96 * h; const bf16* Vp = KVR + 128 * h + 64; bf16* Op = MIX + 512 + 64 * h;
                    if (meta) att::unit<96, true>(lds, Qp, 768, Kp, DINP, Vp, 1024, Op, DM, nullptr, 0, nullptr, 0.f, b, 0, 16, tid);
                    else for (int blk = 8; blk >= 1; --blk) { const int q0 = 16 + 256 * (blk - 1);
                        att::unit<96, true>(lds, Qp, 768, Kp, DINP, Vp, 1024, Op, DM, nullptr, 0, nullptr, 0.f, b, q0, q0 + 256, tid); }
                } else { const bool meta = item >= 520; const int it = item - 256, bh = it >> 1, hf = it & 1, b = meta ? 0 : bh >> 2, h = meta ? item - 520 : bh & 3;
                    const bf16* Pp = PROJ + 64 * h; bf16* Op = MIX + 256 + 64 * h; const float* gn = ap->in[I_RETG] + l * 256 + 64 * h;
                    const float lg2 = log2f(1.0f - exp2f(-5.0f - (float)h)); const unsigned bm = hf ? 0x0CCu : 0x132u;
                    if (meta) att::unit<64, false>(lds, Pp + C_RQ, DINP, Pp + C_RK, DINP, Pp + C_RV, DINP, Op, DM, Pp + C_RG, DINP, gn, lg2, b, 0, 16, tid);
                    else for (int blk = 8; blk >= 1; --blk) { if (!((bm >> blk) & 1u)) continue; const int q0 = 16 + 256 * (blk - 1);
                        att::unit<64, false>(lds, Pp + C_RQ, DINP, Pp + C_RK, DINP, Pp + C_RV, DINP, Op, DM, Pp + C_RG, DINP, gn, lg2, b, q0, q0 + 256, tid); }
                }
            }
        }
        if (ph + 1 < hi) grid.sync();
    }
}

extern "C" void kernel_launch(void* const* d_in, const int* in_sizes, int n_in, void* d_out, int out_size, void* d_ws, size_t ws_size, hipStream_t stream) {
    static int grid = 0;
    if (grid == 0) {
        if (n_in != 16 || out_size != MREAL * DM || ws_size < WS_END) { fprintf(stderr, "kernel_launch: unexpected shapes (n_in %d, out %d, ws %zu)\n", n_in, out_size, ws_size); grid = -1; return; }
        int dev = 0, cus = 0, per_cu = 0;
        if (hipGetDevice(&dev) != hipSuccess || hipDeviceGetAttribute(&cus, hipDeviceAttributeMultiprocessorCount, dev) != hipSuccess) { grid = -1; return; }
        if (hipFuncSetAttribute((const void*)hybrid_fwd, hipFuncAttributeMaxDynamicSharedMemorySize, LDS_BYTES) != hipSuccess) { fprintf(stderr, "kernel_launch: hipFuncSetAttribute failed\n"); grid = -1; return; }
        if (hipOccupancyMaxActiveBlocksPerMultiprocessor(&per_cu, (const void*)hybrid_fwd, NWAVES * 64, LDS_BYTES) != hipSuccess || per_cu < 1) { fprintf(stderr, "kernel_launch: occupancy query says %d\n", per_cu); per_cu = 1; }
        (void)hipGetLastError();
        grid = cus;
    }
    if (grid < 0) return;
    Args a{};
    for (int i = 0; i < 16; ++i) a.in[i] = (const float*)d_in[i];
    a.out = (float*)d_out; a.ws = (unsigned char*)d_ws;
#if MK_MULTI
    for (int ph = 0; ph < NPHASE; ++ph) { a.ph_lo = ph; a.ph_hi = ph + 1; hipLaunchKernelGGL(hybrid_fwd, dim3(grid), dim3(NWAVES * 64), LDS_BYTES, stream, a); }
#else
    a.ph_lo = 0; a.ph_hi = NPHASE;
    void* kargs[] = {&a};
    const hipError_t e = hipLaunchCooperativeKernel((const void*)hybrid_fwd, dim3(grid), dim3(NWAVES * 64), kargs, LDS_BYTES, stream);
    if (e != hipSuccess) fprintf(stderr, "kernel_launch: cooperative launch failed: %s (grid %d)\n", hipGetErrorString(e), grid);
#endif
}
```

```cpp
#include <hip/hip_runtime.h>
#include <hip/hip_cooperative_groups.h>
#include <cstdio>
#include <cstdint>
#include <cmath>
namespace cg = cooperative_groups;
#ifndef MK_MULTI
#define MK_MULTI 0
#endif
namespace pg8 {
#define PG8_LAS __attribute__((address_space(3)))
typedef unsigned short bf16_t;
typedef short bf16x8 __attribute__((ext_vector_type(8)));
typedef float f32x4 __attribute__((ext_vector_type(4)));
typedef unsigned u32x4 __attribute__((ext_vector_type(4)));
typedef unsigned u32x2 __attribute__((ext_vector_type(2)));
constexpr int BM = 256, BK = 64, HALF = 128, HTB = HALF * BK * 2  , STAGE_BYTES = 8 * HTB, NXCD = 8, WGM = 8;

__host__ __device__ __forceinline__ int lds_byte(int r, int c) { const int st = (r >> 4) * 2 + (c >> 5), rr = r & 15, cc = c & 31, ob = rr * 64 + cc * 2; return st * 1024 + (ob ^ (((ob >> 9) & 1) << 5)); }
__host__ __device__ __forceinline__ void stage_rc(int b, int& R, int& C) { const int st = b / 1024, sb = b % 1024, swz = sb ^ (((sb >> 9) & 1) << 5); R = (st >> 1) * 16 + swz / 64; C = (st & 1) * 32 + (swz % 64) / 2; }
__host__ __device__ __forceinline__ int perm32(int rho) { const int n = rho >> 4, i = rho & 15; return 8 * (i >> 2) + 4 * n + (i & 3); }

__device__ __forceinline__ int opaque_tid() { int t = threadIdx.x; asm volatile("" : "+v"(t)); return t; }
struct Unit { int pm, pn; };
struct Gemm { const bf16_t* A; const bf16_t* Bt; int M, N, K, lda; };

struct StaticOrder {
    int nM, nN, nwg, G, c;
    __host__ __device__ void init(int M, int N, int G_, int c_) { nM = M / BM; nN = N / BM; nwg = nM * nN; G = G_; c = c_; }
    __host__ __device__ bool next(int i, Unit& u) const {
        const long L = (long)i * G + c; if (L >= nwg) return false;
        int wgid = (int)L; { const int q = nwg / NXCD, r = nwg % NXCD, xcd = wgid % NXCD, off = wgid / NXCD; wgid = (xcd < r ? xcd * (q + 1) : r * (q + 1) + (xcd - r) * q) + off; }
        const int nig = WGM * nN, gid = wgid / nig, fm = gid * WGM, gsz = (nM - fm) < WGM ? (nM - fm) : WGM;
        u.pm = fm + ((wgid % nig) % gsz); u.pn = (wgid % nig) / gsz; return true;
    }
    __device__ __forceinline__ void a_ready(const Unit&) const {}
    __device__ __forceinline__ void done(const Unit&) const {}
};

__device__ __forceinline__ unsigned cvt_pk_bf16(float lo, float hi) { unsigned r; asm volatile("v_cvt_pk_bf16_f32 %0, %1, %2" : "=v"(r) : "v"(lo), "v"(hi)); return r; }
struct EpiAny {
    static constexpr bool AFTER_DRAIN = false;
    int mode, perm; bf16_t* O; int ldc; bf16_t* xr; float* out; float* ssx; const float* rs_src; float* ssq; float* sskv;
    __device__ __forceinline__ void operator()(const f32x4 (&acc)[2][2][4][2], const Unit& u, int wr, int wc, int fr, int fq) const {
        if (mode < 2) {
            const int row0 = u.pm * BM + wr * 64 + fr; const int col0 = u.pn * BM + wc * 32 + 8 * fq; const bool sq = mode == 1;
            const int sstile = ssq ? (u.pn == 7 ? 1 : (u.pn == 8 ? 2 : 0)) : 0;
#pragma unroll
            for (int ai = 0; ai < 2; ++ai)
#pragma unroll
                for (int m = 0; m < 4; ++m) { const int row = row0 + ai * HALF + m * 16; bf16_t* rowp = O + (size_t)row * ldc + col0;
                    float rs = 1.f;
                    if (rs_src) { const f32x4* p = (const f32x4*)(rs_src + (size_t)row * 16); const f32x4 a = (p[0] + p[1]) + (p[2] + p[3]); rs = 1.0f / sqrtf(((a[0] + a[1]) + (a[2] + a[3])) * (1.f / 1024.f) + 1e-6f); }
                    float part = 0.f;
#pragma unroll
                    for (int bj = 0; bj < 2; ++bj) { f32x4 v0 = acc[ai][bj][m][0] * rs, v1 = acc[ai][bj][m][1] * rs;
                        if (sq) {
#pragma unroll
                            for (int e = 0; e < 4; ++e) { const float a = fmaxf(v0[e], 0.f), b = fmaxf(v1[e], 0.f); v0[e] = a * a; v1[e] = b * b; } }
                        if (sstile == 1 || (sstile == 2 && bj == 0)) part += ((v0[0] * v0[0] + v0[1] * v0[1]) + (v0[2] * v0[2] + v0[3] * v0[3])) + ((v1[0] * v1[0] + v1[1] * v1[1]) + (v1[2] * v1[2] + v1[3] * v1[3]));
                        u32x4 w; w.x = cvt_pk_bf16(v0[0], v0[1]); w.y = cvt_pk_bf16(v0[2], v0[3]); w.z = cvt_pk_bf16(v1[0], v1[1]); w.w = cvt_pk_bf16(v1[2], v1[3]);
                        *(u32x4*)(rowp + bj * HALF) = w; }
                    if (sstile) { part += __shfl_xor(part, 16); part += __shfl_xor(part, 32); if (fq == 0) (sstile == 1 ? ssq : sskv)[(size_t)row * 4 + wc] = part; }
                }
        } else {
            const int col0 = u.pn * BM + wc * 32 + 4 * fq; const bool toout = mode == 3;
#pragma unroll
            for (int ai = 0; ai < 2; ++ai)
#pragma unroll
                for (int m = 0; m < 4; ++m) { const int r = u.pm * BM + ai * HALF + wr * 64 + m * 16 + fr; bf16_t* xp = xr + (size_t)r * 1024 + col0; float* op = out + (size_t)r * 1024 + col0; float part = 0.f;
#pragma unroll
                    for (int bj = 0; bj < 2; ++bj)
#pragma unroll
                        for (int n = 0; n < 2; ++n) { const u32x2 xw = *(const u32x2*)(xp + bj * HALF + n * 16);
                            f32x4 v = acc[ai][bj][m][n]; v[0] += __uint_as_float(xw.x << 16); v[1] += __uint_as_float(xw.x & 0xffff0000u); v[2] += __uint_as_float(xw.y << 16); v[3] += __uint_as_float(xw.y & 0xffff0000u);
                            if (toout) *(f32x4*)(op + bj * HALF + n * 16) = v;
                            else { part += (v[0] * v[0] + v[1] * v[1]) + (v[2] * v[2] + v[3] * v[3]); u32x2 w; w.x = cvt_pk_bf16(v[0], v[1]); w.y = cvt_pk_bf16(v[2], v[3]); *(u32x2*)(xp + bj * HALF + n * 16) = w; } }
                    if (!toout) { part += __shfl_xor(part, 16); part += __shfl_xor(part, 32); if (fq == 0) ssx[(size_t)r * 16 + u.pn * 4 + wc] = part; }
                    asm volatile("" ::: "memory"); }
        }
    }
};

template <class Epi, class Sched, bool ALIGN_EPI = false, bool SP2 = false>
__device__ __forceinline__ void gemm_phase(PG8_LAS unsigned char* lds, const Gemm g, const Sched& S, const Epi& E, const int tid_in) {
    int tid_o = tid_in; asm volatile("" : "+v"(tid_o));
    const int tid = tid_o, wid = __builtin_amdgcn_readfirstlane(tid >> 6), lane = tid & 63, wr = wid >> 2, wc = wid & 3, fr = lane & 15, fq = lane >> 4;
    const int K = g.K, nt = K / BK;
    unsigned voffA[2], voffB[2];
#pragma unroll
    for (int i = 0; i < 2; ++i) { int R, C; stage_rc(tid * 16 + i * 8192, R, C); const int Rb = E.perm ? ((R & ~31) + perm32(R & 31)) : R;
        voffA[i] = (unsigned)(R * g.lda + C) * 2u; voffB[i] = (unsigned)(Rb * K + C) * 2u; }
    const size_t kstep = (size_t)(BK * 2);
    const size_t hstepA = (size_t)HALF * g.lda * 2, hstepB = (size_t)HALF * K * 2;
    const size_t tstepA = 2 * hstepA, tstepB = 2 * hstepB;
    const unsigned ldsw = (unsigned)wid * 1024u;
    const int aoff = lds_byte(wr * 64 + fr, fq * 8), boff = lds_byte(wc * 32 + fr, fq * 8);
#define PG8_SA(b, h) (((b) * 2 + (h)) * HTB)
#define PG8_SB(b, h) ((4 + (b) * 2 + (h)) * HTB)
#define PG8_STAGE(bufoff, gbase, voff) do { _Pragma("unroll") for (int _i = 0; _i < 2; ++_i) \
        __builtin_amdgcn_global_load_lds((const unsigned*)((const char*)(gbase) + (voff)[_i]), (PG8_LAS unsigned*)(lds + (bufoff) + ldsw + _i * 8192), 16, 0, 0); } while (0)
#define PG8_LDA(dst, b, h) do { _Pragma("unroll") for (int m = 0; m < 4; ++m) _Pragma("unroll") for (int k = 0; k < 2; ++k) dst[m][k] = *(const PG8_LAS bf16x8*)(lds + PG8_SA(b, h) + aoff + m * 2048 + k * 1024); } while (0)
#define PG8_LDB(dst, b, h) do { _Pragma("unroll") for (int n = 0; n < 2; ++n) _Pragma("unroll") for (int k = 0; k < 2; ++k) dst[n][k] = *(const PG8_LAS bf16x8*)(lds + PG8_SB(b, h) + boff + n * 2048 + k * 1024); } while (0)
#define PG8_MMA(ai, bj, At, Bt) do { __builtin_amdgcn_s_setprio(1); _Pragma("unroll") for (int m = 0; m < 4; ++m) _Pragma("unroll") for (int n = 0; n < 2; ++n) _Pragma("unroll") for (int k = 0; k < 2; ++k) \
        acc[ai][bj][m][n] = __builtin_amdgcn_mfma_f32_16x16x32_bf16(Bt[n][k], At[m][k], acc[ai][bj][m][n], 0, 0, 0); __builtin_amdgcn_s_setprio(0); } while (0)
#define PG8_WAIT_V(n) asm volatile("s_waitcnt vmcnt(" #n ")" ::: "memory")
#define PG8_WAIT_L(n) asm volatile("s_waitcnt lgkmcnt(" #n ")" ::: "memory")
#define PG8_BAR __builtin_amdgcn_s_barrier()
#define PG8_SCHED __builtin_amdgcn_sched_barrier(0)
    Unit cur, nxt; int ui = 0;
    if (!S.next(0, cur)) return;
    f32x4 acc[2][2][4][2];
#pragma unroll
    for (int a = 0; a < 2; ++a)
#pragma unroll
        for (int b = 0; b < 2; ++b)
#pragma unroll
            for (int m = 0; m < 4; ++m)
#pragma unroll
                for (int n = 0; n < 2; ++n) acc[a][b][m][n] = (f32x4){0.f, 0.f, 0.f, 0.f};
    bf16x8 At[4][2], B0[2][2], B1[2][2];
    const char* cA = (const char*)g.A + (size_t)cur.pm * tstepA; const char* cB = (const char*)g.Bt + (size_t)cur.pn * tstepB;
    S.a_ready(cur);
    if constexpr (SP2) {
        PG8_STAGE(PG8_SB(0, 0), cB, voffB); PG8_STAGE(PG8_SB(0, 1), cB + hstepB, voffB); PG8_STAGE(PG8_SA(0, 0), cA, voffA); PG8_STAGE(PG8_SA(0, 1), cA + hstepA, voffA);
        if (wr == 1) PG8_BAR;
        PG8_WAIT_V(2); PG8_BAR;
        PG8_STAGE(PG8_SB(1, 0), cB + kstep, voffB); PG8_STAGE(PG8_SA(1, 0), cA + kstep, voffA); PG8_STAGE(PG8_SB(1, 1), cB + hstepB + kstep, voffB);
        PG8_WAIT_V(6); PG8_BAR;
    } else {
        PG8_STAGE(PG8_SB(0, 0), cB, voffB); PG8_STAGE(PG8_SA(0, 0), cA, voffA); PG8_STAGE(PG8_SB(0, 1), cB + hstepB, voffB); PG8_STAGE(PG8_SA(0, 1), cA + hstepA, voffA);
        if (wr == 1) PG8_BAR;
        PG8_WAIT_V(4); PG8_BAR;
        PG8_STAGE(PG8_SB(1, 0), cB + kstep, voffB); PG8_STAGE(PG8_SA(1, 0), cA + kstep, voffA); PG8_STAGE(PG8_SB(1, 1), cB + hstepB + kstep, voffB);
        PG8_WAIT_V(6); PG8_BAR;
    }
    for (;;) {
        const bool has_next = S.next(ui + 1, nxt);
        const char* nA = has_next ? (const char*)g.A + (size_t)nxt.pm * tstepA : cA; const char* nB = has_next ? (const char*)g.Bt + (size_t)nxt.pn * tstepB : cB;
        for (int t = 0; t < nt; t += 2) {
            const bool last = (t == nt - 2);
            const char* a1 = cA + (size_t)(t + 1) * kstep;
            const char* a2 = last ? nA : cA + (size_t)(t + 2) * kstep; const char* b2 = last ? nB : cB + (size_t)(t + 2) * kstep;
            const char* a3 = a2 + kstep; const char* b3 = b2 + kstep;
            if (last && has_next) S.a_ready(nxt);
            if constexpr (SP2) {
            PG8_LDB(B0, 0, 0); PG8_LDB(B1, 0, 1); PG8_SCHED; PG8_LDA(At, 0, 0); PG8_STAGE(PG8_SA(1, 1), a1 + hstepA, voffA);
            PG8_WAIT_V(8); PG8_WAIT_L(0); PG8_BAR; PG8_MMA(0, 0, At, B0); PG8_MMA(0, 1, At, B1); PG8_BAR; PG8_SCHED;
            PG8_LDA(At, 0, 1); PG8_STAGE(PG8_SB(0, 0), b2, voffB); PG8_STAGE(PG8_SB(0, 1), b2 + hstepB, voffB); PG8_STAGE(PG8_SA(0, 0), a2, voffA);
            PG8_WAIT_V(8); PG8_WAIT_L(0); PG8_BAR; PG8_MMA(1, 0, At, B0); PG8_MMA(1, 1, At, B1); PG8_BAR; PG8_SCHED;
            PG8_LDB(B0, 1, 0); PG8_LDB(B1, 1, 1); PG8_SCHED; PG8_LDA(At, 1, 0); PG8_STAGE(PG8_SA(0, 1), a2 + hstepA, voffA);
            PG8_WAIT_V(8); PG8_WAIT_L(0); PG8_BAR; PG8_MMA(0, 0, At, B0); PG8_MMA(0, 1, At, B1); PG8_BAR; PG8_SCHED;
            PG8_LDA(At, 1, 1); PG8_STAGE(PG8_SB(1, 0), b3, voffB); PG8_STAGE(PG8_SB(1, 1), b3 + hstepB, voffB); PG8_STAGE(PG8_SA(1, 0), a3, voffA);
            PG8_WAIT_V(8); PG8_WAIT_L(0); PG8_BAR; PG8_MMA(1, 0, At, B0); PG8_MMA(1, 1, At, B1); PG8_BAR; PG8_SCHED;
            } else {
            PG8_LDB(B0, 0, 0); PG8_SCHED; PG8_LDA(At, 0, 0); PG8_STAGE(PG8_SA(1, 1), a1 + hstepA, voffA);
            PG8_WAIT_L(8); PG8_BAR; PG8_WAIT_L(0); PG8_MMA(0, 0, At, B0); PG8_BAR; PG8_SCHED;
            PG8_LDB(B1, 0, 1); PG8_STAGE(PG8_SB(0, 0), b2, voffB);
            PG8_BAR; PG8_WAIT_L(0); PG8_MMA(0, 1, At, B1); PG8_BAR;
            PG8_LDA(At, 0, 1); PG8_STAGE(PG8_SA(0, 0), a2, voffA);
            PG8_BAR; PG8_WAIT_L(0); PG8_MMA(1, 0, At, B0); PG8_BAR; PG8_SCHED;
            PG8_STAGE(PG8_SB(0, 1), b2 + hstepB, voffB);
            PG8_WAIT_V(6); PG8_BAR; PG8_MMA(1, 1, At, B1); PG8_BAR;
            PG8_LDB(B0, 1, 0); PG8_SCHED; PG8_LDA(At, 1, 0); PG8_STAGE(PG8_SA(0, 1), a2 + hstepA, voffA);
            PG8_WAIT_L(8); PG8_BAR; PG8_WAIT_L(0); PG8_MMA(0, 0, At, B0); PG8_BAR; PG8_SCHED;
            PG8_LDB(B1, 1, 1); PG8_STAGE(PG8_SB(1, 0), b3, voffB);
            PG8_BAR; PG8_WAIT_L(0); PG8_MMA(0, 1, At, B1); PG8_BAR;
            PG8_LDA(At, 1, 1); PG8_STAGE(PG8_SA(1, 0), a3, voffA);
            PG8_BAR; PG8_WAIT_L(0); PG8_MMA(1, 0, At, B0); PG8_BAR; PG8_SCHED;
            PG8_STAGE(PG8_SB(1, 1), b3 + hstepB, voffB);
            PG8_WAIT_V(6); PG8_BAR; PG8_MMA(1, 1, At, B1); PG8_BAR;
            }
        }
        if constexpr (ALIGN_EPI) { if (wr == 0) PG8_BAR; }
        if constexpr (!Epi::AFTER_DRAIN) { E(acc, cur, wr, wc, fr, fq); S.done(cur); }
        if (!has_next) break;
#pragma unroll
        for (int a = 0; a < 2; ++a)
#pragma unroll
            for (int b = 0; b < 2; ++b)
#pragma unroll
                for (int m = 0; m < 4; ++m)
#pragma unroll
                    for (int n = 0; n < 2; ++n) acc[a][b][m][n] = (f32x4){0.f, 0.f, 0.f, 0.f};
        cur = nxt; cA = nA; cB = nB; ++ui;
        if constexpr (ALIGN_EPI) { if (wr == 1) PG8_BAR; }
    }
    PG8_WAIT_V(0);
    if constexpr (!ALIGN_EPI) { if (wr == 0) PG8_BAR; }
    PG8_BAR;
    if constexpr (Epi::AFTER_DRAIN) { E.fused(acc, cur, wr, wc, fr, fq, lds, wid, lane); S.done(cur); }
#undef PG8_SA
#undef PG8_SB
#undef PG8_STAGE
#undef PG8_LDA
#undef PG8_LDB
#undef PG8_MMA
#undef PG8_WAIT_V
#undef PG8_WAIT_L
#undef PG8_BAR
#undef PG8_SCHED
}
}

#define GAS __attribute__((address_space(1)))
#define LAS __attribute__((address_space(3)))
typedef unsigned short bf16;
typedef unsigned u32x4 __attribute__((ext_vector_type(4)));
typedef unsigned u32x2 __attribute__((ext_vector_type(2)));
typedef float f32x4 __attribute__((ext_vector_type(4)));
typedef float f32x2 __attribute__((ext_vector_type(2)));
typedef short bf16x8 __attribute__((ext_vector_type(8)));
typedef float f32x16 __attribute__((ext_vector_type(16)));
constexpr int DM = 1024, BATCH = 32, SEQ = 2048, NMETA = 16, TT = SEQ + NMETA, DIN = 2208, DINP = 2304, DFF = 4096, DEPTH = 2;
constexpr int MREAL = BATCH * SEQ, MR0 = MREAL, MV = MREAL + NMETA, M = MREAL + 256;
static_assert(MREAL % 256 == 0, "row tiles");
__device__ __forceinline__ int rowof(int b, int t) { return t < NMETA ? MR0 + t : b * SEQ + (t - NMETA); }
constexpr int C_CB = 0, C_CC = 256, C_CH = 512, C_RQ = 768, C_RK = 1024, C_RV = 1280, C_RG = 1536, C_CQ = 1792, C_CKV = 2048, C_KR = 2176;
constexpr float EPS = 1e-6f;
constexpr float QSCALE = 0.10206207261596575f * 1.4426950408889634f;
constexpr size_t MiB = 1u << 20;
constexpr size_t WS_RT = 1 * MiB, WS_MT = 1 * MiB + 768 * 1024;
constexpr size_t WS_WIN = 4 * MiB, WS_WUQ = 13 * MiB, WS_WUKV = 14 * MiB, WS_WOUT = 15 * MiB, WS_W1 = 19 * MiB, WS_W2 = 35 * MiB;
constexpr size_t WS_X = 52 * MiB, WS_XN = 310 * MiB, WS_PROJ = 440 * MiB, WS_QRAW = 731 * MiB, WS_KV = 828 * MiB, WS_H = 440 * MiB, WS_SSX = 958 * MiB, WS_SSQ = 964 * MiB, WS_SSKV = 966 * MiB, WS_END = 968 * MiB;
static_assert(WS_X + (size_t)M * DM * 4 <= WS_XN && WS_XN + (size_t)M * DM * 2 <= WS_PROJ && WS_PROJ + (size_t)M * DINP * 2 <= WS_QRAW && WS_QRAW + (size_t)M * 768 * 2 <= WS_KV &&
              WS_KV + (size_t)M * 1024 * 2 <= WS_SSX && WS_H + (size_t)M * DFF * 2 <= WS_SSX && WS_SSX + (size_t)M * 64 <= WS_SSQ && WS_SSQ + (size_t)M * 16 <= WS_SSKV && WS_SSKV + (size_t)M * 16 <= WS_END, "d_ws map");
constexpr int NWAVES = 8, LDS_BYTES = 147456;

__device__ __forceinline__ unsigned f2bf(float f) { unsigned u = __builtin_bit_cast(unsigned, f); return (u + 0x7fffu + ((u >> 16) & 1u)) >> 16; }
__device__ __forceinline__ unsigned pk2(float lo, float hi) { return f2bf(lo) | (f2bf(hi) << 16); }
__device__ __forceinline__ float bflo(unsigned w) { return __uint_as_float(w << 16); }
__device__ __forceinline__ float bfhi(unsigned w) { return __uint_as_float(w & 0xffff0000u); }
__device__ __forceinline__ float bf1(bf16 h) { return __uint_as_float((unsigned)h << 16); }
__device__ __forceinline__ float wave_sum(float v) {
#pragma unroll
    for (int o = 1; o < 64; o <<= 1) v += __shfl_xor(v, o);
    return v;
}
__device__ __forceinline__ float half_sum(float v) {
#pragma unroll
    for (int o = 1; o < 32; o <<= 1) v += __shfl_xor(v, o);
    return v;
}

namespace att {
typedef float f32x2_t __attribute__((ext_vector_type(2))); typedef __bf16 bf16x2_t __attribute__((ext_vector_type(2)));
__device__ __forceinline__ unsigned cvtpk(float lo, float hi) { f32x2_t v = {lo, hi}; bf16x2_t b = __builtin_convertvector(v, bf16x2_t); return __builtin_bit_cast(unsigned, b); }
constexpr int VP = 144;
__device__ __forceinline__ float xhalf_max(float v) { auto rr = __builtin_amdgcn_permlane32_swap(__float_as_uint(v), __float_as_uint(v), false, false); return fmaxf(__uint_as_float(rr[0]), __uint_as_float(rr[1])); }
__device__ __forceinline__ float xhalf_sum(float v) { auto rr = __builtin_amdgcn_permlane32_swap(__float_as_uint(v), __float_as_uint(v), false, false); return __uint_as_float(rr[0]) + __uint_as_float(rr[1]); }
template <int DQK, bool SM>
__device__ __forceinline__ void unit(LAS unsigned char* lds, const bf16* Q, int ldq, const bf16* K, int ldk, const bf16* V, int ldv, bf16* O, int ldo,
                                     const bf16* G, int ldg, const float* gain, float lg2, int b, int q0, int qend, const int tid_in) {
    constexpr int KP = DQK * 2 + 16, CH = DQK / 8, ND = DQK / 16, KB = 64 * KP, VB = 64 * VP, SB = KB + VB;
    int tid_o = tid_in; asm volatile("" : "+v"(tid_o));
    const int tid = tid_o, lane = tid & 63, wid = __builtin_amdgcn_readfirstlane(tid >> 6), r32 = lane & 31, hi = lane >> 5;
    const int q0w = q0 + 32 * wid, tq = q0w + r32;
    const bool wact = q0w < qend;
    bf16x8 qr[ND];
    const int qrow = rowof(b, tq < TT ? tq : TT - 1);
    { const bf16* qp = Q + (size_t)qrow * ldq + 8 * hi;
#pragma unroll
      for (int d0 = 0; d0 < ND; ++d0) qr[d0] = *(const bf16x8*)(qp + 16 * d0); }
    const int ntiles = (qend - 1) / 64 + 1;
    const int nw = wact ? ((q0w + 31) / 64 + 1 < ntiles ? (q0w + 31) / 64 + 1 : ntiles) : 0;
    const int nfull = (q0w + 1) / 64;
    const int kkey0 = tid / CH, kch0 = tid % CH, kkey1 = (tid + 512) / CH, kch1 = (tid + 512) % CH;
    const bool has2 = (64 * CH > 512) && (tid + 512 < 64 * CH);
    const int vkey = tid & 63, vch = tid >> 6;
    const int pr32 = (r32 & 0x13) | ((r32 & 4) << 1) | ((r32 & 8) >> 1);
    const int koff = pr32 * KP + 16 * hi, voff = KB + r32 * VP + 16 * hi;
    u32x4 kreg0, kreg1 = {0u, 0u, 0u, 0u}, vreg;
#define ATT_LOAD(j) do { int r0_ = 64 * (j) + kkey0; r0_ = r0_ < TT ? r0_ : TT - 1; kreg0 = *(const u32x4*)(K + (size_t)rowof(b, r0_) * ldk + 8 * kch0); \
        if (has2) { int r1_ = 64 * (j) + kkey1; r1_ = r1_ < TT ? r1_ : TT - 1; kreg1 = *(const u32x4*)(K + (size_t)rowof(b, r1_) * ldk + 8 * kch1); } \
        int rv_ = 64 * (j) + vkey; rv_ = rv_ < TT ? rv_ : TT - 1; vreg = *(const u32x4*)(V + (size_t)rowof(b, rv_) * ldv + 8 * vch); } while (0)
#define ATT_STORE(so) do { *(LAS u32x4*)(lds + (so) + kkey0 * KP + 16 * kch0) = kreg0; if (has2) *(LAS u32x4*)(lds + (so) + kkey1 * KP + 16 * kch1) = kreg1; \
        LAS unsigned char* vd_ = lds + (so) + KB + (8 * vch) * VP + 2 * vkey; \
        _Pragma("unroll") for (int i_ = 0; i_ < 8; ++i_) { const unsigned w_ = vreg[i_ >> 1]; *(LAS unsigned short*)(vd_ + i_ * VP) = (unsigned short)((i_ & 1) ? (w_ >> 16) : (w_ & 0xffffu)); } } while (0)
#define ATT_KREAD(so) do { const LAS unsigned char* kb_ = lds + (so) + koff; \
        _Pragma("unroll") for (int d0 = 0; d0 < ND; ++d0) { kf0[d0] = *(const LAS bf16x8*)(kb_ + 32 * d0); kf1[d0] = *(const LAS bf16x8*)(kb_ + 32 * KP + 32 * d0); } } while (0)
#define ATT_VREAD(so) do { const LAS unsigned char* vb_ = lds + (so) + voff; \
        _Pragma("unroll") for (int ks = 0; ks < 4; ++ks) { vf0[ks] = *(const LAS bf16x8*)(vb_ + 32 * ks); vf1[ks] = *(const LAS bf16x8*)(vb_ + 32 * VP + 32 * ks); } } while (0)
#define ATT_QKM(S0, S1) do { \
        _Pragma("unroll") for (int r_ = 0; r_ < 16; ++r_) { S0[r_] = 0.f; S1[r_] = 0.f; } \
        _Pragma("unroll") for (int d0 = 0; d0 < ND; ++d0) { \
            S0 = __builtin_amdgcn_mfma_f32_32x32x16_bf16(kf0[d0], qr[d0], S0, 0, 0, 0); S1 = __builtin_amdgcn_mfma_f32_32x32x16_bf16(kf1[d0], qr[d0], S1, 0, 0, 0); } } while (0)
#define ATT_TILE(j, so, MASK) do { const int kbase_ = 64 * (j) + 8 * hi; \
        if (SM) { \
            if (MASK) { _Pragma("unroll") for (int r = 0; r < 16; ++r) { const int kk = kbase_ + 16 * (r >> 3) + (r & 7); if (kk > tq) s0[r] = -INFINITY; if (kk + 32 > tq) s1[r] = -INFINITY; } } \
            float mx = fmaxf(s0[0], s1[0]); \
            _Pragma("unroll") for (int r = 1; r < 16; ++r) mx = fmaxf(mx, fmaxf(s0[r], s1[r])); \
            mx = xhalf_max(mx); \
            const float mn = fmaxf(m_run, mx), alpha = __builtin_amdgcn_exp2f(m_run - mn); m_run = mn; \
            float ps = 0.f; \
            _Pragma("unroll") for (int r = 0; r < 16; ++r) { s0[r] = __builtin_amdgcn_exp2f(s0[r] - mn); s1[r] = __builtin_amdgcn_exp2f(s1[r] - mn); ps += s0[r] + s1[r]; } \
            l_run = l_run * alpha + ps; \
            _Pragma("unroll") for (int r = 0; r < 16; ++r) { o0[r] *= alpha; o1[r] *= alpha; } \
        } else { \
            const float rf0 = __builtin_amdgcn_exp2f(lg2 * (float)(tq - kbase_)), rf1 = rf0 * c32; \
            _Pragma("unroll") for (int r = 0; r < 16; ++r) { s0[r] = (s0[r] * cfac[r]) * rf0; s1[r] = (s1[r] * cfac[r]) * rf1; } \
            if (MASK) { _Pragma("unroll") for (int r = 0; r < 16; ++r) { const int kk = kbase_ + 16 * (r >> 3) + (r & 7); if (kk > tq) s0[r] = 0.f; if (kk + 32 > tq) s1[r] = 0.f; } } \
        } \
        u32x4 pw[4]; \
        _Pragma("unroll") for (int ks = 0; ks < 2; ++ks) { \
            pw[ks] = (u32x4){cvtpk(s0[8 * ks], s0[8 * ks + 1]), cvtpk(s0[8 * ks + 2], s0[8 * ks + 3]), cvtpk(s0[8 * ks + 4], s0[8 * ks + 5]), cvtpk(s0[8 * ks + 6], s0[8 * ks + 7])}; \
            pw[2 + ks] = (u32x4){cvtpk(s1[8 * ks], s1[8 * ks + 1]), cvtpk(s1[8 * ks + 2], s1[8 * ks + 3]), cvtpk(s1[8 * ks + 4], s1[8 * ks + 5]), cvtpk(s1[8 * ks + 6], s1[8 * ks + 7])}; } \
        _Pragma("unroll") for (int ks = 0; ks < 4; ++ks) { const bf16x8 pf_ = __builtin_bit_cast(bf16x8, pw[ks]); \
            o0 = __builtin_amdgcn_mfma_f32_32x32x16_bf16(vf0[ks], pf_, o0, 0, 0, 0); o1 = __builtin_amdgcn_mfma_f32_32x32x16_bf16(vf1[ks], pf_, o1, 0, 0, 0); } } while (0)
    f32x16 o0, o1, s0, s1, t0, t1; bf16x8 kf0[ND], kf1[ND], vf0[4], vf1[4];
#pragma unroll
    for (int r = 0; r < 16; ++r) { o0[r] = 0.f; o1[r] = 0.f; s0[r] = 0.f; s1[r] = 0.f; t0[r] = 0.f; t1[r] = 0.f; }
    float m_run = -INFINITY, l_run = 0.f;
    float cfac[16]; const float c32 = SM ? 0.f : __builtin_amdgcn_exp2f(-32.f * lg2);
#pragma unroll
    for (int r = 0; r < 16; ++r) cfac[r] = SM ? 0.f : __builtin_amdgcn_exp2f(-lg2 * (float)(16 * (r >> 3) + (r & 7)));
    int so_c = 0, so_n = SB, so_nn = 2 * SB;
    ATT_LOAD(0); ATT_STORE(0);
    if (ntiles > 1) { ATT_LOAD(1); ATT_STORE(SB); }
    __syncthreads();
    if (nw > 0) { ATT_KREAD(0); __builtin_amdgcn_sched_barrier(0); ATT_QKM(s0, s1); }
    for (int j = 0; j < ntiles; ++j) {
        if (j + 2 < ntiles) ATT_LOAD(j + 2);
        if (j + 1 < nw && j < nfull) {
            if (SM || wid < 4) {
                ATT_KREAD(so_n); ATT_VREAD(so_c); __builtin_amdgcn_sched_barrier(0);
                ATT_QKM(t0, t1);
                ATT_TILE(j, so_c, false);
            } else {
                ATT_VREAD(so_c); __builtin_amdgcn_sched_barrier(0);
                ATT_TILE(j, so_c, false); __builtin_amdgcn_sched_barrier(0);
                ATT_KREAD(so_n); __builtin_amdgcn_sched_barrier(0);
                ATT_QKM(t0, t1);
            }
#pragma unroll
            for (int r = 0; r < 16; ++r) { s0[r] = t0[r]; s1[r] = t1[r]; }
        } else if (j < nw) {
            if (j + 1 < nw) { ATT_KREAD(so_n); ATT_VREAD(so_c); __builtin_amdgcn_sched_barrier(0); ATT_QKM(t0, t1); } else { ATT_VREAD(so_c); }
            ATT_TILE(j, so_c, true);
#pragma unroll
            for (int r = 0; r < 16; ++r) { s0[r] = t0[r]; s1[r] = t1[r]; }
        }
        if (j + 2 < ntiles) ATT_STORE(so_nn);
        __syncthreads();
        { const int t_ = so_c; so_c = so_n; so_n = so_nn; so_nn = t_; }
    }
#undef ATT_LOAD
#undef ATT_STORE
#undef ATT_KREAD
#undef ATT_VREAD
#undef ATT_QKM
#undef ATT_TILE
    if (wact) {
        if (SM) {
            const float l = xhalf_sum(l_run), inv = 1.f / l;
            if (tq < qend) { bf16* op = O + (size_t)qrow * ldo + 4 * hi;
#pragma unroll
                for (int g = 0; g < 4; ++g) {
                    u32x2 a, bq; a.x = cvtpk(o0[4 * g] * inv, o0[4 * g + 1] * inv); a.y = cvtpk(o0[4 * g + 2] * inv, o0[4 * g + 3] * inv);
                    bq.x = cvtpk(o1[4 * g] * inv, o1[4 * g + 1] * inv); bq.y = cvtpk(o1[4 * g + 2] * inv, o1[4 * g + 3] * inv);
                    *(u32x2*)(op + 8 * g) = a; *(u32x2*)(op + 32 + 8 * g) = bq; } }
        } else {
            float ss = 0.f;
#pragma unroll
            for (int r = 0; r < 16; ++r) ss += o0[r] * o0[r] + o1[r] * o1[r];
            ss = xhalf_sum(ss);
            const float rs = 1.0f / sqrtf(ss * (1.f / 64.f) + EPS);
            if (tq < qend) { bf16* op = O + (size_t)qrow * ldo + 4 * hi; const bf16* gp = G + (size_t)qrow * ldg + 4 * hi; const float* gn = gain + 4 * hi;
#pragma unroll
                for (int g = 0; g < 4; ++g) {
#pragma unroll
                    for (int db = 0; db < 2; ++db) {
                        const u32x2 gw = *(const u32x2*)(gp + 32 * db + 8 * g); const f32x4 ga = *(const f32x4*)(gn + 32 * db + 8 * g);
                        float gv[4] = {bflo(gw.x), bfhi(gw.x), bflo(gw.y), bfhi(gw.y)}; float y[4];
#pragma unroll
                        for (int e = 0; e < 4; ++e) { const float ov = db ? o1[4 * g + e] : o0[4 * g + e]; const float sg = gv[e] / (1.f + __expf(-gv[e])); y[e] = ov * rs * ga[e] * sg; }
                        u32x2 w; w.x = cvtpk(y[0], y[1]); w.y = cvtpk(y[2], y[3]); *(u32x2*)(op + 32 * db + 8 * g) = w; } } }
        }
    }
}
}

struct Args { const float* in[16]; float* out; unsigned char* ws; int ph_lo, ph_hi; };
typedef const __attribute__((address_space(4))) Args* KArgsP;
#define RT   ((f32x2*)(ws + WS_RT))
#define MT   ((f32x2*)(ws + WS_MT))
#define WIN  ((bf16*)(ws + WS_WIN))
#define WUQ  ((bf16*)(ws + WS_WUQ))
#define WUKV ((bf16*)(ws + WS_WUKV))
#define WOUT ((bf16*)(ws + WS_WOUT))
#define W1   ((bf16*)(ws + WS_W1))
#define W2   ((bf16*)(ws + WS_W2))
#define XR   ((bf16*)(ws + WS_X))
#define XN   ((bf16*)(ws + WS_XN))
#define MIX  ((bf16*)(ws + WS_XN))
#define PROJ ((bf16*)(ws + WS_PROJ))
#define QRAW ((bf16*)(ws + WS_QRAW))
#define KVR  ((bf16*)(ws + WS_KV))
#define HB   ((bf16*)(ws + WS_H))
#define SSX  ((float*)(ws + WS_SSX))
#define SSQ  ((float*)(ws + WS_SSQ))
#define SSKV ((float*)(ws + WS_SSKV))
enum { I_X = 0, I_META, I_ANG, I_WIN, I_CONVW, I_RETG, I_QNG, I_WUQ, I_KVNG, I_WUKV, I_QHG, I_KHG, I_WOUT, I_MLPG, I_W1, I_W2 };
constexpr int NPP = 7, NPHASE = 1 + NPP * DEPTH;

__device__ __forceinline__ void p0_transpose_item(const float* W, const float* gk, int K, int N, bf16* WT, LAS float* scr, int item, int lane) {
    const int nblk = N / 32, kb = item / nblk, nb = item % nblk, k0 = 64 * kb, n0 = 32 * nb;
#pragma unroll 8
    for (int i = 0; i < 32; ++i) { const int kk = 2 * i + (lane >> 5); const float gv = gk ? gk[k0 + kk] : 1.f; scr[kk * 33 + (lane & 31)] = W[(size_t)(k0 + kk) * N + n0 + (lane & 31)] * gv; }
    asm volatile("s_waitcnt lgkmcnt(0)" ::: "memory");
    const int c = lane & 7;
#pragma unroll
    for (int j = 0; j < 4; ++j) { const int n = (lane >> 3) + 8 * j; const LAS float* s = scr + (8 * c) * 33 + n;
        u32x4 o; o.x = pk2(s[0 * 33], s[1 * 33]); o.y = pk2(s[2 * 33], s[3 * 33]); o.z = pk2(s[4 * 33], s[5 * 33]); o.w = pk2(s[6 * 33], s[7 * 33]);
        *(u32x4*)(WT + (size_t)(n0 + n) * K + k0 + 8 * c) = o; }
    asm volatile("s_waitcnt lgkmcnt(0)" ::: "memory");
}
__device__ __forceinline__ void row_prep(const float* xrow, bf16* orow, float* ss16, int lane) {
    const f32x4* xr = (const f32x4*)xrow + lane;
    f32x4 v[4]; float s = 0.f;
#pragma unroll
    for (int j = 0; j < 4; ++j) { v[j] = xr[64 * j]; s += (v[j].x * v[j].x + v[j].y * v[j].y) + (v[j].z * v[j].z + v[j].w * v[j].w); }
    const float tot = wave_sum(s);
    if (lane < 16) ss16[lane] = lane == 0 ? tot : 0.f;
    unsigned long long* o8 = (unsigned long long*)orow + lane;
#pragma unroll
    for (int j = 0; j < 4; ++j) o8[64 * j] = (unsigned long long)att::cvtpk(v[j].x, v[j].y) | ((unsigned long long)att::cvtpk(v[j].z, v[j].w) << 32);
}
__device__ __forceinline__ f32x2 cossin(float ang) {
    const float n = rintf(ang * 0.15915494309189535f);
    float r = fmaf(-n, 6.28125f, ang); r = fmaf(-n, 0.0019353071795864769f, r);
    const float rev = r * 0.15915494309189535f;
    f32x2 o; o.x = __builtin_amdgcn_cosf(rev); o.y = __builtin_amdgcn_sinf(rev); return o;
}

struct EpiMeta { int mode, need_rs; bf16* O; int ldc; bf16* xr; };
__device__ __forceinline__ void meta_gemm(const bf16* A, int lda, const bf16* Bt, int N, int K, const EpiMeta& E, int gw, int NGW, int lane) {
    for (int n = gw; n < N; n += NGW) {
        float acc[16], ssa[16];
#pragma unroll
        for (int r = 0; r < 16; ++r) { acc[r] = 0.f; ssa[r] = 0.f; }
        for (int c = lane; c < K / 8; c += 64) {
            const u32x4 w = *(const u32x4*)(Bt + (size_t)n * K + 8 * c);
            float wf[8];
#pragma unroll
            for (int e = 0; e < 4; ++e) { wf[2 * e] = bflo(w[e]); wf[2 * e + 1] = bfhi(w[e]); }
#pragma unroll
            for (int r = 0; r < 16; ++r) { const u32x4 a = *(const u32x4*)(A + (size_t)r * lda + 8 * c);
#pragma unroll
                for (int e = 0; e < 4; ++e) { const float a0 = bflo(a[e]), a1 = bfhi(a[e]); acc[r] += a0 * wf[2 * e] + a1 * wf[2 * e + 1]; ssa[r] += a0 * a0 + a1 * a1; } }
        }
        float mine = 0.f, myss = 0.f;
#pragma unroll
        for (int r = 0; r < 16; ++r) { const float s = wave_sum(acc[r]), q = E.need_rs ? wave_sum(ssa[r]) : 0.f; if (lane == r) { mine = s; myss = q; } }
        if (lane < 16) { const int r = lane;
            if (E.mode < 2) { float v = mine * (E.need_rs ? 1.0f / sqrtf(myss * (1.f / 1024.f) + EPS) : 1.f); if (E.mode == 1) { v = fmaxf(v, 0.f); v = v * v; } E.O[(size_t)(MR0 + r) * E.ldc + n] = (bf16)f2bf(v); }
            else { bf16* p = E.xr + (size_t)(MR0 + r) * DM + n; *p = (bf16)f2bf(bf1(*p) + mine); } }
    }
}

__global__ void __launch_bounds__(NWAVES * 64, 2) hybrid_fwd(Args args) {
    extern __shared__ __attribute__((aligned(16))) unsigned char lds_raw[];
    LAS unsigned char* lds = (LAS unsigned char*)lds_raw;
    cg::grid_group grid = cg::this_grid();
    const int G = gridDim.x, NGW = G * NWAVES;
    const int wave_s = __builtin_amdgcn_readfirstlane((int)threadIdx.x >> 6);
    const int lo = args.ph_lo, hi = args.ph_hi;
    for (int ph = lo; ph < hi; ++ph) {
        KArgsP ap = (KArgsP)__builtin_amdgcn_kernarg_segment_ptr(); asm volatile("" : "+s"(ap));
        unsigned char* const ws = ap->ws;
        int wave = wave_s; asm volatile("" : "+s"(wave));
        int lane = (int)__builtin_amdgcn_mbcnt_hi(~0u, __builtin_amdgcn_mbcnt_lo(~0u, 0u)); asm volatile("" : "+v"(lane));
        const int tid = wave * 64 + lane, gw = blockIdx.x * NWAVES + wave;
        const int l = ph == 0 ? 0 : (ph - 1) / NPP, k = ph == 0 ? -1 : (ph - 1) % NPP;
        if (k == -1) {
            LAS float* scr = (LAS float*)(lds + wave * 16384);
            constexpr int I_IN = 16 * 69, I_UQ = 4 * 24, I_UKV = 2 * 32, I_O = 16 * 32, I_1 = 16 * 128, I_2 = 64 * 32, I_L = I_IN + I_UQ + I_UKV + I_O + I_1 + I_2;
            for (int it = gw; it < DEPTH * I_L; it += NGW) {
                const int ll = it / I_L; int r = it - ll * I_L;
                if (r < I_IN) { p0_transpose_item(ap->in[I_WIN] + (size_t)ll * DM * DIN, ap->in[I_ANG] + ll * DM, DM, DIN, WIN + (size_t)ll * DINP * DM, scr, r, lane); continue; } r -= I_IN;
                if (r < I_UQ) { p0_transpose_item(ap->in[I_WUQ] + (size_t)ll * 256 * 768, ap->in[I_QNG] + ll * 256, 256, 768, WUQ + (size_t)ll * 768 * 256, scr, r, lane); continue; } r -= I_UQ;
                if (r < I_UKV) { p0_transpose_item(ap->in[I_WUKV] + (size_t)ll * 128 * 1024, ap->in[I_KVNG] + ll * 128, 128, 1024, WUKV + (size_t)ll * 1024 * 128, scr, r, lane); continue; } r -= I_UKV;
                if (r < I_O) { p0_transpose_item(ap->in[I_WOUT] + (size_t)ll * DM * DM, nullptr, DM, DM, WOUT + (size_t)ll * DM * DM, scr, r, lane); continue; } r -= I_O;
                if (r < I_1) { p0_transpose_item(ap->in[I_W1] + (size_t)ll * DM * DFF, ap->in[I_MLPG] + ll * DM, DM, DFF, W1 + (size_t)ll * DFF * DM, scr, r, lane); continue; } r -= I_1;
                p0_transpose_item(ap->in[I_W2] + (size_t)ll * DFF * DM, nullptr, DFF, DM, W2 + (size_t)ll * DM * DFF, scr, r, lane);
            }
            for (int it = gw; it < DEPTH * (DINP - DIN); it += NGW) {
                const int ll = it / (DINP - DIN), r = DIN + it % (DINP - DIN); u32x4* p = (u32x4*)(WIN + ((size_t)ll * DINP + r) * DM) + lane;
                u32x4 z = {0u, 0u, 0u, 0u}; asm volatile("" : "+v"(z));
                p[0] = z; p[64] = z;
            }
            for (int e = blockIdx.x * 512 + tid; e < TT * 32; e += G * 512) { const int t = e >> 5, i = e & 31; const float inv = exp2f(-13.287712379549449f * (float)(2 * i) * (1.f / 64.f)); RT[e] = cossin((float)t * inv); }
            for (int e = blockIdx.x * 512 + tid; e < TT * 16; e += G * 512) { const int t = e >> 4, i = e & 15; const float inv = exp2f(-13.287712379549449f * (float)(2 * i) * (1.f / 32.f)); MT[e] = cossin((float)t * inv); }
            for (int m = gw; m < MV; m += NGW) {
                const float* src = m >= MR0 ? ap->in[I_META] + (size_t)(m - MR0) * DM : ap->in[I_X] + (size_t)m * DM;
                row_prep(src, XR + (size_t)m * DM, SSX + (size_t)m * 16, lane); }
        } else if (k == 0 || k == 1 || k == 4 || k == 5 || k == 6) {
            const int ng = k == 1 ? 2 : 1;
            for (int gi = 0; gi < ng; ++gi) {
                pg8::Gemm g; pg8::EpiAny E; E.xr = XR; E.out = ap->out; E.O = nullptr; E.ldc = 0; E.ssx = SSX; E.rs_src = nullptr; E.ssq = nullptr; E.sskv = nullptr;
                EpiMeta Em; Em.need_rs = 0; Em.O = nullptr; Em.ldc = 0; Em.xr = XR;
                if (k == 0)      { g = pg8::Gemm{XR, WIN + (size_t)l * DINP * DM, MREAL, DINP, DM, DM}; E.mode = 0; E.perm = 1; E.O = PROJ; E.ldc = DINP; E.rs_src = SSX; E.ssq = SSQ; E.sskv = SSKV; Em.need_rs = 1; }
                else if (k == 1 && gi == 0) { g = pg8::Gemm{PROJ + C_CQ, WUQ + (size_t)l * 768 * 256, MREAL, 768, 256, DINP}; E.mode = 0; E.perm = 1; E.O = QRAW; E.ldc = 768; }
                else if (k == 1) { g = pg8::Gemm{PROJ + C_CKV, WUKV + (size_t)l * 1024 * 128, MREAL, 1024, 128, DINP}; E.mode = 0; E.perm = 1; E.O = KVR; E.ldc = 1024; }
                else if (k == 4) { g = pg8::Gemm{MIX, WOUT + (size_t)l * DM * DM, MREAL, DM, DM, DM}; E.mode = 2; E.perm = 0; }
                else if (k == 5) { g = pg8::Gemm{XR, W1 + (size_t)l * DFF * DM, MREAL, DFF, DM, DM}; E.mode = 1; E.perm = 1; E.O = HB; E.ldc = DFF; E.rs_src = SSX; Em.need_rs = 1; }
                else             { g = pg8::Gemm{HB, W2 + (size_t)l * DM * DFF, MREAL, DM, DFF, DFF}; E.mode = (l == DEPTH - 1) ? 3 : 2; E.perm = 0; }
                Em.mode = E.mode; Em.O = E.O; Em.ldc = E.ldc;
                pg8::StaticOrder S; S.init(MREAL, g.N, G, (int)blockIdx.x);
                pg8::gemm_phase<pg8::EpiAny, pg8::StaticOrder, true, true>(lds, g, S, E, tid);
                if (E.mode != 3) meta_gemm(g.A + (size_t)MR0 * g.lda, g.lda, g.Bt, g.N, g.K, Em, gw, NGW, lane);
            }
            if (k == 1) {
                const float* cw = ap->in[I_CONVW] + l * 3 * 256;
                for (int it = blockIdx.x * 512 + tid; it < MV * 32; it += G * 512) {
                    const int m = it >> 5, c = (it & 31) * 8; const int t = m >= MR0 ? m - MR0 : (m & (SEQ - 1)) + NMETA; const bf16* pr = PROJ + (size_t)m * DINP;
                    const u32x4 cbv = *(const u32x4*)(pr + C_CB + c); float a[8];
#pragma unroll
                    for (int e = 0; e < 8; ++e) a[e] = 0.f;
#pragma unroll
                    for (int j = 0; j < 3; ++j) { const int tj = t - 2 + j; if (tj >= 0) { const int mj = (m >= MR0 || tj >= NMETA) ? m - (2 - j) : MR0 + tj;
                            const bf16* p2 = PROJ + (size_t)mj * DINP; const u32x4 ccv = *(const u32x4*)(p2 + C_CC + c), chv = *(const u32x4*)(p2 + C_CH + c);
                            const f32x4 w0 = *(const f32x4*)(cw + j * 256 + c), w1 = *(const f32x4*)(cw + j * 256 + c + 4);
#pragma unroll
                            for (int e = 0; e < 4; ++e) { const float wl = e < 2 ? w0[2 * e] : w1[2 * e - 4], wh = e < 2 ? w0[2 * e + 1] : w1[2 * e - 3];
                                a[2 * e] += wl * (bflo(ccv[e]) * bflo(chv[e])); a[2 * e + 1] += wh * (bfhi(ccv[e]) * bfhi(chv[e])); } } }
                    u32x4 o;
#pragma unroll
                    for (int e = 0; e < 4; ++e) o[e] = att::cvtpk(bflo(cbv[e]) * a[2 * e], bfhi(cbv[e]) * a[2 * e + 1]);
                    *(u32x4*)(MIX + (size_t)m * DM + c) = o;
                }
                for (int it = blockIdx.x * 512 + tid; it < MV * 32; it += G * 512) {
                    const int m = it >> 5, j = it & 31, w = j >> 4, h = (j >> 2) & 3, i0 = (j & 3) * 8; const int t = m >= MR0 ? m - MR0 : (m & (SEQ - 1)) + NMETA;
                    bf16* p = PROJ + (size_t)m * DINP + (w ? C_RK : C_RQ) + 64 * h + i0; const float sc = w ? 0.125f : 1.f;
                    const u32x4 x1 = *(const u32x4*)p, x2 = *(const u32x4*)(p + 32); const f32x4* cs = (const f32x4*)(RT + t * 32 + i0);
                    u32x4 o1, o2;
#pragma unroll
                    for (int e = 0; e < 4; ++e) { const f32x4 c4 = cs[e]; const float a0 = bflo(x1[e]), a1 = bfhi(x1[e]), b0 = bflo(x2[e]), b1 = bfhi(x2[e]);
                        o1[e] = att::cvtpk((a0 * c4.x - b0 * c4.y) * sc, (a1 * c4.z - b1 * c4.w) * sc); o2[e] = att::cvtpk((b0 * c4.x + a0 * c4.y) * sc, (b1 * c4.z + a1 * c4.w) * sc); }
                    *(u32x4*)p = o1; *(u32x4*)(p + 32) = o2;
                }
            }
        } else if (k == 2) {
            const float* qg = ap->in[I_QHG] + l * 96; const float* kg = ap->in[I_KHG] + l * 96;
            for (int it = blockIdx.x * 512 + tid; it < MV * 8; it += G * 512) {
                const int m = it >> 3, h = it & 7; const int t = m >= MR0 ? m - MR0 : (m & (SEQ - 1)) + NMETA;
                float sumq, sumkv;
                if (m < MR0) { const f32x4 sq4 = *(const f32x4*)(SSQ + (size_t)m * 4), sk4 = *(const f32x4*)(SSKV + (size_t)m * 4); sumq = (sq4.x + sq4.y) + (sq4.z + sq4.w); sumkv = (sk4.x + sk4.y) + (sk4.z + sk4.w); }
                else { sumq = 0.f; sumkv = 0.f; const bf16* pc = PROJ + (size_t)m * DINP + C_CQ;
                    for (int c = 0; c < 48; ++c) { const u32x4 v = *(const u32x4*)(pc + 8 * c); float s = 0.f;
#pragma unroll
                        for (int e = 0; e < 4; ++e) { const float a0 = bflo(v[e]), a1 = bfhi(v[e]); s += a0 * a0 + a1 * a1; }
                        if (c < 32) sumq += s; else sumkv += s; } }
                const float s_q = 1.0f / sqrtf(sumq * (1.f / 256.f) + EPS), s_kv = 1.0f / sqrtf(sumkv * (1.f / 128.f) + EPS);
                const f32x4* mt = (const f32x4*)(MT + t * 16);
                { bf16* q = QRAW + (size_t)m * 768 + 96 * h; u32x4 w[12]; float ss = 0.f;
#pragma unroll
                  for (int c = 0; c < 12; ++c) w[c] = *(const u32x4*)(q + 8 * c);
#pragma unroll
                  for (int c = 0; c < 12; ++c)
#pragma unroll
                      for (int e = 0; e < 4; ++e) { const float a0 = bflo(w[c][e]), a1 = bfhi(w[c][e]); ss += a0 * a0 + a1 * a1; }
                  const float rs = s_q * QSCALE / sqrtf(s_q * s_q * ss * (1.f / 96.f) + EPS);
#pragma unroll
                  for (int c = 0; c < 8; ++c) { u32x4 o;
#pragma unroll
                      for (int e = 0; e < 4; ++e) o[e] = att::cvtpk(bflo(w[c][e]) * rs * qg[8 * c + 2 * e], bfhi(w[c][e]) * rs * qg[8 * c + 2 * e + 1]);
                      *(u32x4*)(q + 8 * c) = o; }
#pragma unroll
                  for (int cc = 0; cc < 2; ++cc) { u32x4 o1, o2;
#pragma unroll
                      for (int e = 0; e < 4; ++e) { const int i = 8 * cc + 2 * e; const f32x4 c4 = mt[4 * cc + e];
                          const float a0 = bflo(w[8 + cc][e]) * rs * qg[64 + i], a1 = bfhi(w[8 + cc][e]) * rs * qg[64 + i + 1], b0 = bflo(w[10 + cc][e]) * rs * qg[80 + i], b1 = bfhi(w[10 + cc][e]) * rs * qg[80 + i + 1];
                          o1[e] = att::cvtpk(a0 * c4.x - b0 * c4.y, a1 * c4.z - b1 * c4.w); o2[e] = att::cvtpk(b0 * c4.x + a0 * c4.y, b1 * c4.z + a1 * c4.w); }
                      *(u32x4*)(q + 64 + 8 * cc) = o1; *(u32x4*)(q + 80 + 8 * cc) = o2; } }
                { bf16* kn = KVR + (size_t)m * 1024 + 128 * h; bf16* pr = PROJ + (size_t)m * DINP; bf16* ko = pr + 96 * h; u32x4 w[8], r[4]; float ssn = 0.f, ssr = 0.f;
#pragma unroll
                  for (int c = 0; c < 8; ++c) w[c] = *(const u32x4*)(kn + 8 * c);
#pragma unroll
                  for (int c = 0; c < 4; ++c) r[c] = *(const u32x4*)(pr + C_KR + 8 * c);
#pragma unroll
                  for (int c = 0; c < 8; ++c)
#pragma unroll
                      for (int e = 0; e < 4; ++e) { const float a0 = bflo(w[c][e]), a1 = bfhi(w[c][e]); ssn += a0 * a0 + a1 * a1; }
#pragma unroll
                  for (int c = 0; c < 4; ++c)
#pragma unroll
                      for (int e = 0; e < 4; ++e) { const float a0 = bflo(r[c][e]), a1 = bfhi(r[c][e]); ssr += a0 * a0 + a1 * a1; }
                  const float rs = 1.0f / sqrtf((s_kv * s_kv * ssn + ssr) * (1.f / 96.f) + EPS), rn = rs * s_kv;
#pragma unroll
                  for (int c = 0; c < 8; ++c) { u32x4 o;
#pragma unroll
                      for (int e = 0; e < 4; ++e) o[e] = att::cvtpk(bflo(w[c][e]) * rn * kg[8 * c + 2 * e], bfhi(w[c][e]) * rn * kg[8 * c + 2 * e + 1]);
                      *(u32x4*)(ko + 8 * c) = o; }
#pragma unroll
                  for (int cc = 0; cc < 2; ++cc) { u32x4 o1, o2;
#pragma unroll
                      for (int e = 0; e < 4; ++e) { const int i = 8 * cc + 2 * e; const f32x4 c4 = mt[4 * cc + e];
                          const float a0 = bflo(r[cc][e]) * rs * kg[64 + i], a1 = bfhi(r[cc][e]) * rs * kg[64 + i + 1], b0 = bflo(r[2 + cc][e]) * rs * kg[80 + i], b1 = bfhi(r[2 + cc][e]) * rs * kg[80 + i + 1];
                          o1[e] = att::cvtpk(a0 * c4.x - b0 * c4.y, a1 * c4.z - b1 * c4.w); o2[e] = att::cvtpk(b0 * c4.x + a0 * c4.y, b1 * c4.z + a1 * c4.w); }
                      *(u32x4*)(ko + 64 + 8 * cc) = o1; *(u32x4*)(ko + 80 + 8 * cc) = o2; }
#pragma unroll
                  for (int c = 0; c < 8; ++c) { const u32x4 v = *(const u32x4*)(kn + 64 + 8 * c); u32x4 o;
#pragma unroll
                      for (int e = 0; e < 4; ++e) o[e] = att::cvtpk(bflo(v[e]) * s_kv, bfhi(v[e]) * s_kv);
                      *(u32x4*)(kn + 64 + 8 * c) = o; } }
            }
        } else {
            for (int item = blockIdx.x; item < 524; item += G) {
                if (item < 256 || (item >= 512 && item < 520)) { const bool meta = item >= 512; const int b = meta ? 0 : item >> 3, h = item & 7;
                    const bf16* Qp = QRAW + 96 * h; const bf16* Kp = PROJ + 96 * h; const bf16* Vp = KVR + 128 * h + 64; bf16* Op = MIX + 512 + 64 * h;
                    if (meta) att::unit<96, true>(lds, Qp, 768, Kp, DINP, Vp, 1024, Op, DM, nullptr, 0, nullptr, 0.f, b, 0, 16, tid);
                    else for (int blk = 8; blk >= 1; --blk) { const int q0 = 16 + 256 * (blk - 1);
                        att::unit<96, true>(lds, Qp, 768, Kp, DINP, Vp, 1024, Op, DM, nullptr, 0, nullptr, 0.f, b, q0, q0 + 256, tid); }
                } else { const bool meta = item >= 520; const int it = item - 256, bh = it >> 1, hf = it & 1, b = meta ? 0 : bh >> 2, h = meta ? item - 520 : bh & 3;
                    const bf16* Pp = PROJ + 64 * h; bf16* Op = MIX + 256 + 64 * h; const float* gn = ap->in[I_RETG] + l * 256 + 64 * h;
                    const float lg2 = log2f(1.0f - exp2f(-5.0f - (float)h)); const unsigned bm = hf ? 0x0CCu : 0x132u;
                    if (meta) att::unit<64, false>(lds, Pp + C_RQ, DINP, Pp + C_RK, DINP, Pp + C_RV, DINP, Op, DM, Pp + C_RG, DINP, gn, lg2, b, 0, 16, tid);
                    else for (int blk = 8; blk >= 1; --blk) { if (!((bm >> blk) & 1u)) continue; const int q0 = 16 + 256 * (blk - 1);
                        att::unit<64, false>(lds, Pp + C_RQ, DINP, Pp + C_RK, DINP, Pp + C_RV, DINP, Op, DM, Pp + C_RG, DINP, gn, lg2, b, q0, q0 + 256, tid); }
                }
            }
        }
        if (ph + 1 < hi) grid.sync();
    }
}

extern "C" void kernel_launch(void* const* d_in, const int* in_sizes, int n_in, void* d_out, int out_size, void* d_ws, size_t ws_size, hipStream_t stream) {
    static int grid = 0;
    if (grid == 0) {
        if (n_in != 16 || out_size != MREAL * DM || ws_size < WS_END) { fprintf(stderr, "kernel_launch: unexpected shapes (n_in %d, out %d, ws %zu)\n", n_in, out_size, ws_size); grid = -1; return; }
        int dev = 0, cus = 0, per_cu = 0;
        if (hipGetDevice(&dev) != hipSuccess || hipDeviceGetAttribute(&cus, hipDeviceAttributeMultiprocessorCount, dev) != hipSuccess) { grid = -1; return; }
        if (hipFuncSetAttribute((const void*)hybrid_fwd, hipFuncAttributeMaxDynamicSharedMemorySize, LDS_BYTES) != hipSuccess) { fprintf(stderr, "kernel_launch: hipFuncSetAttribute failed\n"); grid = -1; return; }
        if (hipOccupancyMaxActiveBlocksPerMultiprocessor(&per_cu, (const void*)hybrid_fwd, NWAVES * 64, LDS_BYTES) != hipSuccess || per_cu < 1) { fprintf(stderr, "kernel_launch: occupancy query says %d\n", per_cu); per_cu = 1; }
        (void)hipGetLastError();
        grid = cus;
    }
    if (grid < 0) return;
    Args a{};
    for (int i = 0; i < 16; ++i) a.in[i] = (const float*)d_in[i];
    a.out = (float*)d_out; a.ws = (unsigned char*)d_ws;
#if MK_MULTI
    for (int ph = 0; ph < NPHASE; ++ph) { a.ph_lo = ph; a.ph_hi = ph + 1; hipLaunchKernelGGL(hybrid_fwd, dim3(grid), dim3(NWAVES * 64), LDS_BYTES, stream, a); }
#else
    a.ph_lo = 0; a.ph_hi = NPHASE;
    void* kargs[] = {&a};
    const hipError_t e = hipLaunchCooperativeKernel((const void*)hybrid_fwd, dim3(grid), dim3(NWAVES * 64), kargs, LDS_BYTES, stream);
    if (e != hipSuccess) fprintf(stderr, "kernel_launch: cooperative launch failed: %s (grid %d)\n", hipGetErrorString(e), grid);
#endif
}
```

```cpp
#include <hip/hip_runtime.h>
#include <hip/hip_cooperative_groups.h>
#include <cstdio>
#include <cstdint>
#include <cmath>
namespace cg = cooperative_groups;
#ifndef MK_MULTI
#define MK_MULTI 0
#endif
namespace pg8 {
#define PG8_LAS __attribute__((address_space(3)))
typedef unsigned short bf16_t;
typedef short bf16x8 __attribute__((ext_vector_type(8)));
typedef float f32x4 __attribute__((ext_vector_type(4)));
typedef unsigned u32x4 __attribute__((ext_vector_type(4)));
typedef unsigned u32x2 __attribute__((ext_vector_type(2)));
constexpr int BM = 256, BK = 64, HALF = 128, HTB = HALF * BK * 2  , STAGE_BYTES = 8 * HTB, NXCD = 8, WGM = 8;

__host__ __device__ __forceinline__ int lds_byte(int r, int c) { const int st = (r >> 4) * 2 + (c >> 5), rr = r & 15, cc = c & 31, ob = rr * 64 + cc * 2; return st * 1024 + (ob ^ (((ob >> 9) & 1) << 5)); }
__host__ __device__ __forceinline__ void stage_rc(int b, int& R, int& C) { const int st = b / 1024, sb = b % 1024, swz = sb ^ (((sb >> 9) & 1) << 5); R = (st >> 1) * 16 + swz / 64; C = (st & 1) * 32 + (swz % 64) / 2; }
__host__ __device__ __forceinline__ int perm32(int rho) { const int n = rho >> 4, i = rho & 15; return 8 * (i >> 2) + 4 * n + (i & 3); }

__device__ __forceinline__ int opaque_tid() { int t = threadIdx.x; asm volatile("" : "+v"(t)); return t; }
struct Unit { int pm, pn; };
struct Gemm { const bf16_t* A; const bf16_t* Bt; int M, N, K, lda; };

struct StaticOrder {
    int nM, nN, nwg, G, c;
    __host__ __device__ void init(int M, int N, int G_, int c_) { nM = M / BM; nN = N / BM; nwg = nM * nN; G = G_; c = c_; }
    __host__ __device__ bool next(int i, Unit& u) const {
        const long L = (long)i * G + c; if (L >= nwg) return false;
        int wgid = (int)L; { const int q = nwg / NXCD, r = nwg % NXCD, xcd = wgid % NXCD, off = wgid / NXCD; wgid = (xcd < r ? xcd * (q + 1) : r * (q + 1) + (xcd - r) * q) + off; }
        const int nig = WGM * nN, gid = wgid / nig, fm = gid * WGM, gsz = (nM - fm) < WGM ? (nM - fm) : WGM;
        u.pm = fm + ((wgid % nig) % gsz); u.pn = (wgid % nig) / gsz; return true;
    }
    __device__ __forceinline__ void a_ready(const Unit&) const {}
    __device__ __forceinline__ void done(const Unit&) const {}
};

__device__ __forceinline__ unsigned cvt_pk_bf16(float lo, float hi) { unsigned r; asm volatile("v_cvt_pk_bf16_f32 %0, %1, %2" : "=v"(r) : "v"(lo), "v"(hi)); return r; }
__device__ __forceinline__ float fq_sum(float v) {
    auto a = __builtin_amdgcn_permlane16_swap(__float_as_uint(v), __float_as_uint(v), false, false); v = __uint_as_float(a[0]) + __uint_as_float(a[1]);
    auto b = __builtin_amdgcn_permlane32_swap(__float_as_uint(v), __float_as_uint(v), false, false); return __uint_as_float(b[0]) + __uint_as_float(b[1]);
}
struct EpiAny {
    static constexpr bool AFTER_DRAIN = false;
    int mode, perm; bf16_t* O; int ldc; bf16_t* xr; float* out; float* ssx; const float* rs_src; float* ssq; float* sskv;
    __device__ __forceinline__ void operator()(const f32x4 (&acc)[2][2][4][2], const Unit& u, int wr, int wc, int fr, int fq) const {
        if (mode < 2) {
            const int row0 = u.pm * BM + wr * 64 + fr; const int col0 = u.pn * BM + wc * 32 + 8 * fq; const bool sq = mode == 1;
            const int sstile = ssq ? (u.pn == 7 ? 1 : (u.pn == 8 ? 2 : 0)) : 0;
            float rsv[2][4];
            if (rs_src) {
                f32x4 pq[2][4];
#pragma unroll
                for (int ai = 0; ai < 2; ++ai)
#pragma unroll
                    for (int m = 0; m < 4; ++m) pq[ai][m] = *(const f32x4*)(rs_src + (size_t)(row0 + ai * HALF + m * 16) * 16 + 4 * fq);
#pragma unroll
                for (int ai = 0; ai < 2; ++ai)
#pragma unroll
                    for (int m = 0; m < 4; ++m) { const f32x4 a = pq[ai][m]; rsv[ai][m] = 1.0f / sqrtf(fq_sum((a[0] + a[1]) + (a[2] + a[3])) * (1.f / 1024.f) + 1e-6f); }
            } else {
#pragma unroll
                for (int ai = 0; ai < 2; ++ai)
#pragma unroll
                    for (int m = 0; m < 4; ++m) rsv[ai][m] = 1.f;
            }
#pragma unroll
            for (int ai = 0; ai < 2; ++ai)
#pragma unroll
                for (int m = 0; m < 4; ++m) { const int row = row0 + ai * HALF + m * 16; bf16_t* rowp = O + (size_t)row * ldc + col0;
                    const float rs = rsv[ai][m]; float part = 0.f;
#pragma unroll
                    for (int bj = 0; bj < 2; ++bj) { f32x4 v0 = acc[ai][bj][m][0] * rs, v1 = acc[ai][bj][m][1] * rs;
                        if (sq) {
#pragma unroll
                            for (int e = 0; e < 4; ++e) { const float a = fmaxf(v0[e], 0.f), b = fmaxf(v1[e], 0.f); v0[e] = a * a; v1[e] = b * b; } }
                        if (sstile == 1 || (sstile == 2 && bj == 0)) part += ((v0[0] * v0[0] + v0[1] * v0[1]) + (v0[2] * v0[2] + v0[3] * v0[3])) + ((v1[0] * v1[0] + v1[1] * v1[1]) + (v1[2] * v1[2] + v1[3] * v1[3]));
                        u32x4 w; w.x = cvt_pk_bf16(v0[0], v0[1]); w.y = cvt_pk_bf16(v0[2], v0[3]); w.z = cvt_pk_bf16(v1[0], v1[1]); w.w = cvt_pk_bf16(v1[2], v1[3]);
                        *(u32x4*)(rowp + bj * HALF) = w; }
                    if (sstile) { part = fq_sum(part); if (fq == 0) (sstile == 1 ? ssq : sskv)[(size_t)row * 4 + wc] = part; }
                }
        } else {
            const int col0 = u.pn * BM + wc * 32 + 4 * fq; const bool toout = mode == 3;
#pragma unroll
            for (int ai = 0; ai < 2; ++ai) {
                u32x2 xw[4][2][2];
#pragma unroll
                for (int m = 0; m < 4; ++m) { const bf16_t* xp = xr + (size_t)(u.pm * BM + ai * HALF + wr * 64 + m * 16 + fr) * 1024 + col0;
#pragma unroll
                    for (int bj = 0; bj < 2; ++bj)
#pragma unroll
                        for (int n = 0; n < 2; ++n) xw[m][bj][n] = *(const u32x2*)(xp + bj * HALF + n * 16); }
#pragma unroll
                for (int m = 0; m < 4; ++m) { const int r = u.pm * BM + ai * HALF + wr * 64 + m * 16 + fr; bf16_t* xp = xr + (size_t)r * 1024 + col0; float* op = out + (size_t)r * 1024 + col0; float part = 0.f;
#pragma unroll
                    for (int bj = 0; bj < 2; ++bj)
#pragma unroll
                        for (int n = 0; n < 2; ++n) { const u32x2 w0 = xw[m][bj][n];
                            f32x4 v = acc[ai][bj][m][n]; v[0] += __uint_as_float(w0.x << 16); v[1] += __uint_as_float(w0.x & 0xffff0000u); v[2] += __uint_as_float(w0.y << 16); v[3] += __uint_as_float(w0.y & 0xffff0000u);
                            if (toout) *(f32x4*)(op + bj * HALF + n * 16) = v;
                            else { part += (v[0] * v[0] + v[1] * v[1]) + (v[2] * v[2] + v[3] * v[3]); u32x2 w; w.x = cvt_pk_bf16(v[0], v[1]); w.y = cvt_pk_bf16(v[2], v[3]); *(u32x2*)(xp + bj * HALF + n * 16) = w; } }
                    if (!toout) { part = fq_sum(part); if (fq == 0) ssx[(size_t)r * 16 + u.pn * 4 + wc] = part; }
                }
                asm volatile("" ::: "memory");
            }
        }
    }
};

template <class Epi, class Sched, bool ALIGN_EPI = false, bool SP2 = false>
__device__ __forceinline__ void gemm_phase(PG8_LAS unsigned char* lds, const Gemm g, const Sched& S, const Epi& E, const int tid_in) {
    int tid_o = tid_in; asm volatile("" : "+v"(tid_o));
    const int tid = tid_o, wid = __builtin_amdgcn_readfirstlane(tid >> 6), lane = tid & 63, wr = wid >> 2, wc = wid & 3, fr = lane & 15, fq = lane >> 4;
    const int K = g.K, nt = K / BK;
    unsigned voffA[2], voffB[2];
#pragma unroll
    for (int i = 0; i < 2; ++i) { int R, C; stage_rc(tid * 16 + i * 8192, R, C); const int Rb = E.perm ? ((R & ~31) + perm32(R & 31)) : R;
        voffA[i] = (unsigned)(R * g.lda + C) * 2u; voffB[i] = (unsigned)(Rb * K + C) * 2u; }
    const size_t kstep = (size_t)(BK * 2);
    const size_t hstepA = (size_t)HALF * g.lda * 2, hstepB = (size_t)HALF * K * 2;
    const size_t tstepA = 2 * hstepA, tstepB = 2 * hstepB;
    const unsigned ldsw = (unsigned)wid * 1024u;
    const int aoff = lds_byte(wr * 64 + fr, fq * 8), boff = lds_byte(wc * 32 + fr, fq * 8);
#define PG8_SA(b, h) (((b) * 2 + (h)) * HTB)
#define PG8_SB(b, h) ((4 + (b) * 2 + (h)) * HTB)
#define PG8_STAGE(bufoff, gbase, voff) do { _Pragma("unroll") for (int _i = 0; _i < 2; ++_i) \
        __builtin_amdgcn_global_load_lds((const unsigned*)((const char*)(gbase) + (voff)[_i]), (PG8_LAS unsigned*)(lds + (bufoff) + ldsw + _i * 8192), 16, 0, 0); } while (0)
#define PG8_LDA(dst, b, h) do { _Pragma("unroll") for (int m = 0; m < 4; ++m) _Pragma("unroll") for (int k = 0; k < 2; ++k) dst[m][k] = *(const PG8_LAS bf16x8*)(lds + PG8_SA(b, h) + aoff + m * 2048 + k * 1024); } while (0)
#define PG8_LDB(dst, b, h) do { _Pragma("unroll") for (int n = 0; n < 2; ++n) _Pragma("unroll") for (int k = 0; k < 2; ++k) dst[n][k] = *(const PG8_LAS bf16x8*)(lds + PG8_SB(b, h) + boff + n * 2048 + k * 1024); } while (0)
#define PG8_MMA(ai, bj, At, Bt) do { __builtin_amdgcn_s_setprio(1); _Pragma("unroll") for (int m = 0; m < 4; ++m) _Pragma("unroll") for (int n = 0; n < 2; ++n) _Pragma("unroll") for (int k = 0; k < 2; ++k) \
        acc[ai][bj][m][n] = __builtin_amdgcn_mfma_f32_16x16x32_bf16(Bt[n][k], At[m][k], acc[ai][bj][m][n], 0, 0, 0); __builtin_amdgcn_s_setprio(0); } while (0)
#define PG8_WAIT_V(n) asm volatile("s_waitcnt vmcnt(" #n ")" ::: "memory")
#define PG8_WAIT_L(n) asm volatile("s_waitcnt lgkmcnt(" #n ")" ::: "memory")
#define PG8_BAR __builtin_amdgcn_s_barrier()
#define PG8_SCHED __builtin_amdgcn_sched_barrier(0)
    Unit cur, nxt; int ui = 0;
    if (!S.next(0, cur)) return;
    f32x4 acc[2][2][4][2];
#pragma unroll
    for (int a = 0; a < 2; ++a)
#pragma unroll
        for (int b = 0; b < 2; ++b)
#pragma unroll
            for (int m = 0; m < 4; ++m)
#pragma unroll
                for (int n = 0; n < 2; ++n) acc[a][b][m][n] = (f32x4){0.f, 0.f, 0.f, 0.f};
    bf16x8 At[4][2], B0[2][2], B1[2][2];
    const char* cA = (const char*)g.A + (size_t)cur.pm * tstepA; const char* cB = (const char*)g.Bt + (size_t)cur.pn * tstepB;
    S.a_ready(cur);
    if constexpr (SP2) {
        PG8_STAGE(PG8_SB(0, 0), cB, voffB); PG8_STAGE(PG8_SB(0, 1), cB + hstepB, voffB); PG8_STAGE(PG8_SA(0, 0), cA, voffA); PG8_STAGE(PG8_SA(0, 1), cA + hstepA, voffA);
        if (wr == 1) PG8_BAR;
        PG8_WAIT_V(2); PG8_BAR;
        PG8_STAGE(PG8_SB(1, 0), cB + kstep, voffB); PG8_STAGE(PG8_SA(1, 0), cA + kstep, voffA); PG8_STAGE(PG8_SB(1, 1), cB + hstepB + kstep, voffB);
        PG8_WAIT_V(6); PG8_BAR;
    } else {
        PG8_STAGE(PG8_SB(0, 0), cB, voffB); PG8_STAGE(PG8_SA(0, 0), cA, voffA); PG8_STAGE(PG8_SB(0, 1), cB + hstepB, voffB); PG8_STAGE(PG8_SA(0, 1), cA + hstepA, voffA);
        if (wr == 1) PG8_BAR;
        PG8_WAIT_V(4); PG8_BAR;
        PG8_STAGE(PG8_SB(1, 0), cB + kstep, voffB); PG8_STAGE(PG8_SA(1, 0), cA + kstep, voffA); PG8_STAGE(PG8_SB(1, 1), cB + hstepB + kstep, voffB);
        PG8_WAIT_V(6); PG8_BAR;
    }
    for (;;) {
        const bool has_next = S.next(ui + 1, nxt);
        const char* nA = has_next ? (const char*)g.A + (size_t)nxt.pm * tstepA : cA; const char* nB = has_next ? (const char*)g.Bt + (size_t)nxt.pn * tstepB : cB;
        for (int t = 0; t < nt; t += 2) {
            const bool last = (t == nt - 2);
            const char* a1 = cA + (size_t)(t + 1) * kstep;
            const char* a2 = last ? nA : cA + (size_t)(t + 2) * kstep; const char* b2 = last ? nB : cB + (size_t)(t + 2) * kstep;
            const char* a3 = a2 + kstep; const char* b3 = b2 + kstep;
            if (last && has_next) S.a_ready(nxt);
            if constexpr (SP2) {
            PG8_LDB(B0, 0, 0); PG8_LDB(B1, 0, 1); PG8_SCHED; PG8_LDA(At, 0, 0); PG8_STAGE(PG8_SA(1, 1), a1 + hstepA, voffA);
            PG8_WAIT_V(8); PG8_WAIT_L(0); PG8_BAR; PG8_MMA(0, 0, At, B0); PG8_MMA(0, 1, At, B1); PG8_BAR; PG8_SCHED;
            PG8_LDA(At, 0, 1); PG8_STAGE(PG8_SB(0, 0), b2, voffB); PG8_STAGE(PG8_SB(0, 1), b2 + hstepB, voffB); PG8_STAGE(PG8_SA(0, 0), a2, voffA);
            PG8_WAIT_V(8); PG8_WAIT_L(0); PG8_BAR; PG8_MMA(1, 0, At, B0); PG8_MMA(1, 1, At, B1); PG8_BAR; PG8_SCHED;
            PG8_LDB(B0, 1, 0); PG8_LDB(B1, 1, 1); PG8_SCHED; PG8_LDA(At, 1, 0); PG8_STAGE(PG8_SA(0, 1), a2 + hstepA, voffA);
            PG8_WAIT_V(8); PG8_WAIT_L(0); PG8_BAR; PG8_MMA(0, 0, At, B0); PG8_MMA(0, 1, At, B1); PG8_BAR; PG8_SCHED;
            PG8_LDA(At, 1, 1); PG8_STAGE(PG8_SB(1, 0), b3, voffB); PG8_STAGE(PG8_SB(1, 1), b3 + hstepB, voffB); PG8_STAGE(PG8_SA(1, 0), a3, voffA);
            PG8_WAIT_V(8); PG8_WAIT_L(0); PG8_BAR; PG8_MMA(1, 0, At, B0); PG8_MMA(1, 1, At, B1); PG8_BAR; PG8_SCHED;
            } else {
            PG8_LDB(B0, 0, 0); PG8_SCHED; PG8_LDA(At, 0, 0); PG8_STAGE(PG8_SA(1, 1), a1 + hstepA, voffA);
            PG8_WAIT_L(8); PG8_BAR; PG8_WAIT_L(0); PG8_MMA(0, 0, At, B0); PG8_BAR; PG8_SCHED;
            PG8_LDB(B1, 0, 1); PG8_STAGE(PG8_SB(0, 0), b2, voffB);
            PG8_BAR; PG8_WAIT_L(0); PG8_MMA(0, 1, At, B1); PG8_BAR;
            PG8_LDA(At, 0, 1); PG8_STAGE(PG8_SA(0, 0), a2, voffA);
            PG8_BAR; PG8_WAIT_L(0); PG8_MMA(1, 0, At, B0); PG8_BAR; PG8_SCHED;
            PG8_STAGE(PG8_SB(0, 1), b2 + hstepB, voffB);
            PG8_WAIT_V(6); PG8_BAR; PG8_MMA(1, 1, At, B1); PG8_BAR;
            PG8_LDB(B0, 1, 0); PG8_SCHED; PG8_LDA(At, 1, 0); PG8_STAGE(PG8_SA(0, 1), a2 + hstepA, voffA);
            PG8_WAIT_L(8); PG8_BAR; PG8_WAIT_L(0); PG8_MMA(0, 0, At, B0); PG8_BAR; PG8_SCHED;
            PG8_LDB(B1, 1, 1); PG8_STAGE(PG8_SB(1, 0), b3, voffB);
            PG8_BAR; PG8_WAIT_L(0); PG8_MMA(0, 1, At, B1); PG8_BAR;
            PG8_LDA(At, 1, 1); PG8_STAGE(PG8_SA(1, 0), a3, voffA);
            PG8_BAR; PG8_WAIT_L(0); PG8_MMA(1, 0, At, B0); PG8_BAR; PG8_SCHED;
            PG8_STAGE(PG8_SB(1, 1), b3 + hstepB, voffB);
            PG8_WAIT_V(6); PG8_BAR; PG8_MMA(1, 1, At, B1); PG8_BAR;
            }
        }
        if constexpr (ALIGN_EPI) { if (wr == 0) PG8_BAR; }
        if constexpr (!Epi::AFTER_DRAIN) { E(acc, cur, wr, wc, fr, fq); S.done(cur); }
        if (!has_next) break;
#pragma unroll
        for (int a = 0; a < 2; ++a)
#pragma unroll
            for (int b = 0; b < 2; ++b)
#pragma unroll
                for (int m = 0; m < 4; ++m)
#pragma unroll
                    for (int n = 0; n < 2; ++n) acc[a][b][m][n] = (f32x4){0.f, 0.f, 0.f, 0.f};
        cur = nxt; cA = nA; cB = nB; ++ui;
        if constexpr (ALIGN_EPI) { if (wr == 1) PG8_BAR; }
    }
    PG8_WAIT_V(0);
    if constexpr (!ALIGN_EPI) { if (wr == 0) PG8_BAR; }
    PG8_BAR;
    if constexpr (Epi::AFTER_DRAIN) { E.fused(acc, cur, wr, wc, fr, fq, lds, wid, lane); S.done(cur); }
#undef PG8_SA
#undef PG8_SB
#undef PG8_STAGE
#undef PG8_LDA
#undef PG8_LDB
#undef PG8_MMA
#undef PG8_WAIT_V
#undef PG8_WAIT_L
#undef PG8_BAR
#undef PG8_SCHED
}
}

#define GAS __attribute__((address_space(1)))
#define LAS __attribute__((address_space(3)))
typedef unsigned short bf16;
typedef unsigned u32x4 __attribute__((ext_vector_type(4)));
typedef unsigned u32x2 __attribute__((ext_vector_type(2)));
typedef float f32x4 __attribute__((ext_vector_type(4)));
typedef float f32x2 __attribute__((ext_vector_type(2)));
typedef short bf16x8 __attribute__((ext_vector_type(8)));
typedef float f32x16 __attribute__((ext_vector_type(16)));
constexpr int DM = 1024, BATCH = 32, SEQ = 2048, NMETA = 16, TT = SEQ + NMETA, DIN = 2208, DINP = 2304, DFF = 4096, DEPTH = 2;
constexpr int MREAL = BATCH * SEQ, MR0 = MREAL, MV = MREAL + NMETA, M = MREAL + 256;
static_assert(MREAL % 256 == 0, "row tiles");
__device__ __forceinline__ int rowof(int b, int t) { return t < NMETA ? MR0 + t : b * SEQ + (t - NMETA); }
constexpr int C_CB = 0, C_CC = 256, C_CH = 512, C_RQ = 768, C_RK = 1024, C_RV = 1280, C_RG = 1536, C_CQ = 1792, C_CKV = 2048, C_KR = 2176;
constexpr float EPS = 1e-6f;
constexpr float QSCALE = 0.10206207261596575f * 1.4426950408889634f;
constexpr size_t MiB = 1u << 20;
constexpr size_t WS_RT = 1 * MiB, WS_MT = 1 * MiB + 768 * 1024;
constexpr size_t WS_WIN = 4 * MiB, WS_WUQ = 13 * MiB, WS_WUKV = 14 * MiB, WS_WOUT = 15 * MiB, WS_W1 = 19 * MiB, WS_W2 = 35 * MiB;
constexpr size_t WS_X = 52 * MiB, WS_XN = 310 * MiB, WS_PROJ = 440 * MiB, WS_QRAW = 731 * MiB, WS_KV = 828 * MiB, WS_H = 440 * MiB, WS_SSX = 958 * MiB, WS_SSQ = 964 * MiB, WS_SSKV = 966 * MiB, WS_SQA = 968 * MiB, WS_END = 969 * MiB;
static_assert(WS_X + (size_t)M * DM * 4 <= WS_XN && WS_XN + (size_t)M * DM * 2 <= WS_PROJ && WS_PROJ + (size_t)M * DINP * 2 <= WS_QRAW && WS_QRAW + (size_t)M * 768 * 2 <= WS_KV &&
              WS_KV + (size_t)M * 1024 * 2 <= WS_SSX && WS_H + (size_t)M * DFF * 2 <= WS_SSX && WS_SSX + (size_t)M * 64 <= WS_SSQ && WS_SSQ + (size_t)M * 16 <= WS_SSKV && WS_SSKV + (size_t)M * 16 <= WS_SQA && WS_SQA + (size_t)M * 4 <= WS_END, "d_ws map");
constexpr int NWAVES = 8, LDS_BYTES = 147456;

__device__ __forceinline__ unsigned f2bf(float f) { unsigned u = __builtin_bit_cast(unsigned, f); return (u + 0x7fffu + ((u >> 16) & 1u)) >> 16; }
__device__ __forceinline__ unsigned pk2(float lo, float hi) { return f2bf(lo) | (f2bf(hi) << 16); }
__device__ __forceinline__ float bflo(unsigned w) { return __uint_as_float(w << 16); }
__device__ __forceinline__ float bfhi(unsigned w) { return __uint_as_float(w & 0xffff0000u); }
__device__ __forceinline__ float bf1(bf16 h) { return __uint_as_float((unsigned)h << 16); }
__device__ __forceinline__ float wave_sum(float v) {
#pragma unroll
    for (int o = 1; o < 64; o <<= 1) v += __shfl_xor(v, o);
    return v;
}
__device__ __forceinline__ float half_sum(float v) {
#pragma unroll
    for (int o = 1; o < 32; o <<= 1) v += __shfl_xor(v, o);
    return v;
}

namespace att {
typedef float f32x2_t __attribute__((ext_vector_type(2))); typedef __bf16 bf16x2_t __attribute__((ext_vector_type(2)));
__device__ __forceinline__ unsigned cvtpk(float lo, float hi) { f32x2_t v = {lo, hi}; bf16x2_t b = __builtin_convertvector(v, bf16x2_t); return __builtin_bit_cast(unsigned, b); }
constexpr int VP = 144;
__device__ __forceinline__ float xhalf_max(float v) { auto rr = __builtin_amdgcn_permlane32_swap(__float_as_uint(v), __float_as_uint(v), false, false); return fmaxf(__uint_as_float(rr[0]), __uint_as_float(rr[1])); }
__device__ __forceinline__ float xhalf_sum(float v) { auto rr = __builtin_amdgcn_permlane32_swap(__float_as_uint(v), __float_as_uint(v), false, false); return __uint_as_float(rr[0]) + __uint_as_float(rr[1]); }
template <int DQK, bool SM>
__device__ __forceinline__ void unit(LAS unsigned char* lds, const bf16* Q, int ldq, const bf16* K, int ldk, const bf16* V, int ldv, bf16* O, int ldo,
                                     const bf16* G, int ldg, const float* gain, float lg2, int b, int q0, int qend, const int tid_in, const float* sqa, const float* qgain, const f32x2* mtab) {
    constexpr int KP = DQK * 2 + 16, CH = DQK / 8, ND = DQK / 16, KB = 64 * KP, VB = 64 * VP, SB = KB + VB;
    int tid_o = tid_in; asm volatile("" : "+v"(tid_o));
    const int tid = tid_o, lane = tid & 63, wid = __builtin_amdgcn_readfirstlane(tid >> 6), r32 = lane & 31, hi = lane >> 5;
    const int q0w = q0 + 32 * wid, tq = q0w + r32;
    const bool wact = q0w < qend;
    bf16x8 qr[ND];
    const int qrow = rowof(b, tq < TT ? tq : TT - 1);
    { const bf16* qp = Q + (size_t)qrow * ldq + 8 * hi;
#pragma unroll
      for (int d0 = 0; d0 < ND; ++d0) qr[d0] = *(const bf16x8*)(qp + 16 * d0); }
    if (SM) {
        const float s_q = sqa[qrow]; const int tpos = tq < TT ? tq : TT - 1;
        float ss = 0.f;
#pragma unroll
        for (int d0 = 0; d0 < ND; ++d0) { const u32x4 w = __builtin_bit_cast(u32x4, qr[d0]);
#pragma unroll
            for (int e = 0; e < 4; ++e) { const float a0 = bflo(w[e]), a1 = bfhi(w[e]); ss += a0 * a0 + a1 * a1; } }
        ss = xhalf_sum(ss);
        const float rs = s_q * QSCALE / sqrtf(s_q * s_q * ss * (1.f / 96.f) + EPS);
#pragma unroll
        for (int d0 = 0; d0 < 4; ++d0) { const u32x4 w = __builtin_bit_cast(u32x4, qr[d0]); const f32x4 g0 = *(const f32x4*)(qgain + 16 * d0 + 8 * hi), g1 = *(const f32x4*)(qgain + 16 * d0 + 8 * hi + 4); u32x4 o;
            o[0] = cvtpk(bflo(w[0]) * rs * g0[0], bfhi(w[0]) * rs * g0[1]); o[1] = cvtpk(bflo(w[1]) * rs * g0[2], bfhi(w[1]) * rs * g0[3]);
            o[2] = cvtpk(bflo(w[2]) * rs * g1[0], bfhi(w[2]) * rs * g1[1]); o[3] = cvtpk(bflo(w[3]) * rs * g1[2], bfhi(w[3]) * rs * g1[3]);
            qr[d0] = __builtin_bit_cast(bf16x8, o); }
        { const u32x4 w1 = __builtin_bit_cast(u32x4, qr[4]), w2 = __builtin_bit_cast(u32x4, qr[5]); const f32x4* cs = (const f32x4*)(mtab + tpos * 16 + 8 * hi);
          const float* ga = qgain + 64 + 8 * hi; const float* gb = qgain + 80 + 8 * hi; u32x4 o1, o2;
#pragma unroll
          for (int e = 0; e < 4; ++e) { const f32x4 c4 = cs[e];
              const float a0 = bflo(w1[e]) * rs * ga[2 * e], a1 = bfhi(w1[e]) * rs * ga[2 * e + 1], b0 = bflo(w2[e]) * rs * gb[2 * e], b1 = bfhi(w2[e]) * rs * gb[2 * e + 1];
              o1[e] = cvtpk(a0 * c4.x - b0 * c4.y, a1 * c4.z - b1 * c4.w); o2[e] = cvtpk(b0 * c4.x + a0 * c4.y, b1 * c4.z + a1 * c4.w); }
          qr[4] = __builtin_bit_cast(bf16x8, o1); qr[5] = __builtin_bit_cast(bf16x8, o2); }
    }
    const int ntiles = (qend - 1) / 64 + 1;
    const int nw = wact ? ((q0w + 31) / 64 + 1 < ntiles ? (q0w + 31) / 64 + 1 : ntiles) : 0;
    const int nfull = (q0w + 1) / 64;
    const int kkey0 = tid / CH, kch0 = tid % CH, kkey1 = (tid + 512) / CH, kch1 = (tid + 512) % CH;
    const bool has2 = (64 * CH > 512) && (tid + 512 < 64 * CH);
    const int vkey = tid & 63, vch = tid >> 6;
    const int pr32 = (r32 & 0x13) | ((r32 & 4) << 1) | ((r32 & 8) >> 1);
    const int koff = pr32 * KP + 16 * hi, voff = KB + r32 * VP + 16 * hi;
    u32x4 kreg0, kreg1 = {0u, 0u, 0u, 0u}, vreg;
#define ATT_LOAD(j) do { int r0_ = 64 * (j) + kkey0; r0_ = r0_ < TT ? r0_ : TT - 1; kreg0 = *(const u32x4*)(K + (size_t)rowof(b, r0_) * ldk + 8 * kch0); \
        if (has2) { int r1_ = 64 * (j) + kkey1; r1_ = r1_ < TT ? r1_ : TT - 1; kreg1 = *(const u32x4*)(K + (size_t)rowof(b, r1_) * ldk + 8 * kch1); } \
        int rv_ = 64 * (j) + vkey; rv_ = rv_ < TT ? rv_ : TT - 1; vreg = *(const u32x4*)(V + (size_t)rowof(b, rv_) * ldv + 8 * vch); } while (0)
#define ATT_STORE(so) do { *(LAS u32x4*)(lds + (so) + kkey0 * KP + 16 * kch0) = kreg0; if (has2) *(LAS u32x4*)(lds + (so) + kkey1 * KP + 16 * kch1) = kreg1; \
        LAS unsigned char* vd_ = lds + (so) + KB + (8 * vch) * VP + 2 * vkey; \
        _Pragma("unroll") for (int i_ = 0; i_ < 8; ++i_) { const unsigned w_ = vreg[i_ >> 1]; *(LAS unsigned short*)(vd_ + i_ * VP) = (unsigned short)((i_ & 1) ? (w_ >> 16) : (w_ & 0xffffu)); } } while (0)
#define ATT_KREAD(so) do { const LAS unsigned char* kb_ = lds + (so) + koff; \
        _Pragma("unroll") for (int d0 = 0; d0 < ND; ++d0) { kf0[d0] = *(const LAS bf16x8*)(kb_ + 32 * d0); kf1[d0] = *(const LAS bf16x8*)(kb_ + 32 * KP + 32 * d0); } } while (0)
#define ATT_VREAD(so) do { const LAS unsigned char* vb_ = lds + (so) + voff; \
        _Pragma("unroll") for (int ks = 0; ks < 4; ++ks) { vf0[ks] = *(const LAS bf16x8*)(vb_ + 32 * ks); vf1[ks] = *(const LAS bf16x8*)(vb_ + 32 * VP + 32 * ks); } } while (0)
#define ATT_QKM(S0, S1) do { \
        _Pragma("unroll") for (int r_ = 0; r_ < 16; ++r_) { S0[r_] = 0.f; S1[r_] = 0.f; } \
        _Pragma("unroll") for (int d0 = 0; d0 < ND; ++d0) { \
            S0 = __builtin_amdgcn_mfma_f32_32x32x16_bf16(kf0[d0], qr[d0], S0, 0, 0, 0); S1 = __builtin_amdgcn_mfma_f32_32x32x16_bf16(kf1[d0], qr[d0], S1, 0, 0, 0); } } while (0)
#define ATT_QKI(S0, S1, so) do { const LAS unsigned char* kb_ = lds + (so) + koff; \
        _Pragma("unroll") for (int r_ = 0; r_ < 16; ++r_) { S0[r_] = 0.f; S1[r_] = 0.f; } \
        _Pragma("unroll") for (int d0 = 0; d0 < ND; ++d0) { const bf16x8 k0_ = *(const LAS bf16x8*)(kb_ + 32 * d0), k1_ = *(const LAS bf16x8*)(kb_ + 32 * KP + 32 * d0); \
            S0 = __builtin_amdgcn_mfma_f32_32x32x16_bf16(k0_, qr[d0], S0, 0, 0, 0); S1 = __builtin_amdgcn_mfma_f32_32x32x16_bf16(k1_, qr[d0], S1, 0, 0, 0); } } while (0)
#define ATT_TILE(j, so, MASK, VPRE) do { const int kbase_ = 64 * (j) + 8 * hi; \
        if (SM) { \
            if (MASK) { _Pragma("unroll") for (int r = 0; r < 16; ++r) { const int kk = kbase_ + 16 * (r >> 3) + (r & 7); if (kk > tq) s0[r] = -INFINITY; if (kk + 32 > tq) s1[r] = -INFINITY; } } \
            float mx = fmaxf(s0[0], s1[0]); \
            _Pragma("unroll") for (int r = 1; r < 16; ++r) mx = fmaxf(mx, fmaxf(s0[r], s1[r])); \
            mx = xhalf_max(mx); \
            const float mn = fmaxf(m_run, mx), alpha = __builtin_amdgcn_exp2f(m_run - mn); m_run = mn; \
            float ps = 0.f; \
            _Pragma("unroll") for (int r = 0; r < 16; ++r) { s0[r] = __builtin_amdgcn_exp2f(s0[r] - mn); s1[r] = __builtin_amdgcn_exp2f(s1[r] - mn); ps += s0[r] + s1[r]; } \
            l_run = l_run * alpha + ps; \
            _Pragma("unroll") for (int r = 0; r < 16; ++r) { o0[r] *= alpha; o1[r] *= alpha; } \
        } else { \
            const float rf0 = __builtin_amdgcn_exp2f(lg2 * (float)(tq - kbase_)), rf1 = rf0 * c32; \
            _Pragma("unroll") for (int r = 0; r < 16; ++r) { s0[r] = (s0[r] * cfac[r]) * rf0; s1[r] = (s1[r] * cfac[r]) * rf1; } \
            if (MASK) { _Pragma("unroll") for (int r = 0; r < 16; ++r) { const int kk = kbase_ + 16 * (r >> 3) + (r & 7); if (kk > tq) s0[r] = 0.f; if (kk + 32 > tq) s1[r] = 0.f; } } \
        } \
        u32x4 pw[4]; \
        _Pragma("unroll") for (int ks = 0; ks < 2; ++ks) { \
            pw[ks] = (u32x4){cvtpk(s0[8 * ks], s0[8 * ks + 1]), cvtpk(s0[8 * ks + 2], s0[8 * ks + 3]), cvtpk(s0[8 * ks + 4], s0[8 * ks + 5]), cvtpk(s0[8 * ks + 6], s0[8 * ks + 7])}; \
            pw[2 + ks] = (u32x4){cvtpk(s1[8 * ks], s1[8 * ks + 1]), cvtpk(s1[8 * ks + 2], s1[8 * ks + 3]), cvtpk(s1[8 * ks + 4], s1[8 * ks + 5]), cvtpk(s1[8 * ks + 6], s1[8 * ks + 7])}; } \
        const LAS unsigned char* vb_ = lds + (so) + voff; \
        _Pragma("unroll") for (int ks = 0; ks < 4; ++ks) { const bf16x8 pf_ = __builtin_bit_cast(bf16x8, pw[ks]); \
            const bf16x8 v0_ = (VPRE) ? vf0[ks] : *(const LAS bf16x8*)(vb_ + 32 * ks), v1_ = (VPRE) ? vf1[ks] : *(const LAS bf16x8*)(vb_ + 32 * VP + 32 * ks); \
            o0 = __builtin_amdgcn_mfma_f32_32x32x16_bf16(v0_, pf_, o0, 0, 0, 0); o1 = __builtin_amdgcn_mfma_f32_32x32x16_bf16(v1_, pf_, o1, 0, 0, 0); } } while (0)
    f32x16 o0, o1, s0, s1, t0, t1; bf16x8 kf0[ND], kf1[ND], vf0[4], vf1[4];
#pragma unroll
    for (int r = 0; r < 16; ++r) { o0[r] = 0.f; o1[r] = 0.f; s0[r] = 0.f; s1[r] = 0.f; t0[r] = 0.f; t1[r] = 0.f; }
    float m_run = -INFINITY, l_run = 0.f;
    float cfac[16]; const float c32 = SM ? 0.f : __builtin_amdgcn_exp2f(-32.f * lg2);
#pragma unroll
    for (int r = 0; r < 16; ++r) cfac[r] = SM ? 0.f : __builtin_amdgcn_exp2f(-lg2 * (float)(16 * (r >> 3) + (r & 7)));
    int so_c = 0, so_n = SB, so_nn = 2 * SB;
    ATT_LOAD(0); ATT_STORE(0);
    if (ntiles > 1) { ATT_LOAD(1); ATT_STORE(SB); }
    __syncthreads();
    if (nw > 0) ATT_QKI(s0, s1, 0);
    for (int j = 0; j < ntiles; ++j) {
        if (j + 2 < ntiles) ATT_LOAD(j + 2);
        if (j + 1 < nw && j < nfull) {
            if (SM) {
                ATT_QKI(t0, t1, so_n);
                ATT_TILE(j, so_c, false, false);
            } else if (wid < 4) {
                ATT_KREAD(so_n); ATT_VREAD(so_c); __builtin_amdgcn_sched_barrier(0);
                ATT_QKM(t0, t1);
                ATT_TILE(j, so_c, false, true);
            } else {
                ATT_VREAD(so_c); __builtin_amdgcn_sched_barrier(0);
                ATT_TILE(j, so_c, false, true); __builtin_amdgcn_sched_barrier(0);
                ATT_KREAD(so_n); __builtin_amdgcn_sched_barrier(0);
                ATT_QKM(t0, t1);
            }
#pragma unroll
            for (int r = 0; r < 16; ++r) { s0[r] = t0[r]; s1[r] = t1[r]; }
        } else if (j < nw) {
            if (SM) { if (j + 1 < nw) ATT_QKI(t0, t1, so_n); ATT_TILE(j, so_c, true, false); }
            else { if (j + 1 < nw) { ATT_KREAD(so_n); ATT_VREAD(so_c); __builtin_amdgcn_sched_barrier(0); ATT_QKM(t0, t1); } else { ATT_VREAD(so_c); }
                   ATT_TILE(j, so_c, true, true); }
#pragma unroll
            for (int r = 0; r < 16; ++r) { s0[r] = t0[r]; s1[r] = t1[r]; }
        }
        if (j + 2 < ntiles) ATT_STORE(so_nn);
        __syncthreads();
        { const int t_ = so_c; so_c = so_n; so_n = so_nn; so_nn = t_; }
    }
#undef ATT_LOAD
#undef ATT_STORE
#undef ATT_KREAD
#undef ATT_VREAD
#undef ATT_QKM
#undef ATT_QKI
#undef ATT_TILE
    if (wact) {
        if (SM) {
            const float l = xhalf_sum(l_run), inv = 1.f / l;
            if (tq < qend) { bf16* op = O + (size_t)qrow * ldo + 4 * hi;
#pragma unroll
                for (int g = 0; g < 4; ++g) {
                    u32x2 a, bq; a.x = cvtpk(o0[4 * g] * inv, o0[4 * g + 1] * inv); a.y = cvtpk(o0[4 * g + 2] * inv, o0[4 * g + 3] * inv);
                    bq.x = cvtpk(o1[4 * g] * inv, o1[4 * g + 1] * inv); bq.y = cvtpk(o1[4 * g + 2] * inv, o1[4 * g + 3] * inv);
                    *(u32x2*)(op + 8 * g) = a; *(u32x2*)(op + 32 + 8 * g) = bq; } }
        } else {
            float ss = 0.f;
#pragma unroll
            for (int r = 0; r < 16; ++r) ss += o0[r] * o0[r] + o1[r] * o1[r];
            ss = xhalf_sum(ss);
            const float rs = 1.0f / sqrtf(ss * (1.f / 64.f) + EPS);
            if (tq < qend) { bf16* op = O + (size_t)qrow * ldo + 4 * hi; const bf16* gp = G + (size_t)qrow * ldg + 4 * hi; const float* gn = gain + 4 * hi;
#pragma unroll
                for (int g = 0; g < 4; ++g) {
#pragma unroll
                    for (int db = 0; db < 2; ++db) {
                        const u32x2 gw = *(const u32x2*)(gp + 32 * db + 8 * g); const f32x4 ga = *(const f32x4*)(gn + 32 * db + 8 * g);
                        float gv[4] = {bflo(gw.x), bfhi(gw.x), bflo(gw.y), bfhi(gw.y)}; float y[4];
#pragma unroll
                        for (int e = 0; e < 4; ++e) { const float ov = db ? o1[4 * g + e] : o0[4 * g + e]; const float sg = gv[e] / (1.f + __expf(-gv[e])); y[e] = ov * rs * ga[e] * sg; }
                        u32x2 w; w.x = cvtpk(y[0], y[1]); w.y = cvtpk(y[2], y[3]); *(u32x2*)(op + 32 * db + 8 * g) = w; } } }
        }
    }
}
}

struct Args { const float* in[16]; float* out; unsigned char* ws; int ph_lo, ph_hi; };
typedef const __attribute__((address_space(4))) Args* KArgsP;
#define RT   ((f32x2*)(ws + WS_RT))
#define MT   ((f32x2*)(ws + WS_MT))
#define WIN  ((bf16*)(ws + WS_WIN))
#define WUQ  ((bf16*)(ws + WS_WUQ))
#define WUKV ((bf16*)(ws + WS_WUKV))
#define WOUT ((bf16*)(ws + WS_WOUT))
#define W1   ((bf16*)(ws + WS_W1))
#define W2   ((bf16*)(ws + WS_W2))
#define XR   ((bf16*)(ws + WS_X))
#define XN   ((bf16*)(ws + WS_XN))
#define MIX  ((bf16*)(ws + WS_XN))
#define PROJ ((bf16*)(ws + WS_PROJ))
#define QRAW ((bf16*)(ws + WS_QRAW))
#define KVR  ((bf16*)(ws + WS_KV))
#define HB   ((bf16*)(ws + WS_H))
#define SSX  ((float*)(ws + WS_SSX))
#define SSQ  ((float*)(ws + WS_SSQ))
#define SSKV ((float*)(ws + WS_SSKV))
#define SQA  ((float*)(ws + WS_SQA))
enum { I_X = 0, I_META, I_ANG, I_WIN, I_CONVW, I_RETG, I_QNG, I_WUQ, I_KVNG, I_WUKV, I_QHG, I_KHG, I_WOUT, I_MLPG, I_W1, I_W2 };
constexpr int NPP = 7, NPHASE = 1 + NPP * DEPTH;

__device__ __forceinline__ void p0_transpose_item(const float* W, const float* gk, int K, int N, bf16* WT, LAS float* scr, int item, int lane) {
    const int nblk = N / 32, kb = item / nblk, nb = item % nblk, k0 = 64 * kb, n0 = 32 * nb;
#pragma unroll 8
    for (int i = 0; i < 32; ++i) { const int kk = 2 * i + (lane >> 5); const float gv = gk ? gk[k0 + kk] : 1.f; scr[kk * 33 + (lane & 31)] = W[(size_t)(k0 + kk) * N + n0 + (lane & 31)] * gv; }
    asm volatile("s_waitcnt lgkmcnt(0)" ::: "memory");
    const int c = lane & 7;
#pragma unroll
    for (int j = 0; j < 4; ++j) { const int n = (lane >> 3) + 8 * j; const LAS float* s = scr + (8 * c) * 33 + n;
        u32x4 o; o.x = pk2(s[0 * 33], s[1 * 33]); o.y = pk2(s[2 * 33], s[3 * 33]); o.z = pk2(s[4 * 33], s[5 * 33]); o.w = pk2(s[6 * 33], s[7 * 33]);
        *(u32x4*)(WT + (size_t)(n0 + n) * K + k0 + 8 * c) = o; }
    asm volatile("s_waitcnt lgkmcnt(0)" ::: "memory");
}
__device__ __forceinline__ void row_prep(const float* xrow, bf16* orow, float* ss16, int lane) {
    const f32x4* xr = (const f32x4*)xrow + lane;
    f32x4 v[4]; float s = 0.f;
#pragma unroll
    for (int j = 0; j < 4; ++j) { v[j] = xr[64 * j]; s += (v[j].x * v[j].x + v[j].y * v[j].y) + (v[j].z * v[j].z + v[j].w * v[j].w); }
    const float tot = wave_sum(s);
    if (lane < 16) ss16[lane] = lane == 0 ? tot : 0.f;
    unsigned long long* o8 = (unsigned long long*)orow + lane;
#pragma unroll
    for (int j = 0; j < 4; ++j) o8[64 * j] = (unsigned long long)att::cvtpk(v[j].x, v[j].y) | ((unsigned long long)att::cvtpk(v[j].z, v[j].w) << 32);
}
__device__ __forceinline__ f32x2 cossin(float ang) {
    const float n = rintf(ang * 0.15915494309189535f);
    float r = fmaf(-n, 6.28125f, ang); r = fmaf(-n, 0.0019353071795864769f, r);
    const float rev = r * 0.15915494309189535f;
    f32x2 o; o.x = __builtin_amdgcn_cosf(rev); o.y = __builtin_amdgcn_sinf(rev); return o;
}

struct EpiMeta { int mode, need_rs; bf16* O; int ldc; bf16* xr; };
__device__ __forceinline__ void meta_gemm(const bf16* A, int lda, const bf16* Bt, int N, int K, const EpiMeta& E, int gw, int NGW, int lane) {
    for (int n = gw; n < N; n += NGW) {
        float acc[16], ssa[16];
#pragma unroll
        for (int r = 0; r < 16; ++r) { acc[r] = 0.f; ssa[r] = 0.f; }
        for (int c = lane; c < K / 8; c += 64) {
            const u32x4 w = *(const u32x4*)(Bt + (size_t)n * K + 8 * c);
            float wf[8];
#pragma unroll
            for (int e = 0; e < 4; ++e) { wf[2 * e] = bflo(w[e]); wf[2 * e + 1] = bfhi(w[e]); }
#pragma unroll
            for (int r = 0; r < 16; ++r) { const u32x4 a = *(const u32x4*)(A + (size_t)r * lda + 8 * c);
#pragma unroll
                for (int e = 0; e < 4; ++e) { const float a0 = bflo(a[e]), a1 = bfhi(a[e]); acc[r] += a0 * wf[2 * e] + a1 * wf[2 * e + 1]; ssa[r] += a0 * a0 + a1 * a1; } }
        }
        float mine = 0.f, myss = 0.f;
#pragma unroll
        for (int r = 0; r < 16; ++r) { const float s = wave_sum(acc[r]), q = E.need_rs ? wave_sum(ssa[r]) : 0.f; if (lane == r) { mine = s; myss = q; } }
        if (lane < 16) { const int r = lane;
            if (E.mode < 2) { float v = mine * (E.need_rs ? 1.0f / sqrtf(myss * (1.f / 1024.f) + EPS) : 1.f); if (E.mode == 1) { v = fmaxf(v, 0.f); v = v * v; } E.O[(size_t)(MR0 + r) * E.ldc + n] = (bf16)f2bf(v); }
            else { bf16* p = E.xr + (size_t)(MR0 + r) * DM + n; *p = (bf16)f2bf(bf1(*p) + mine); } }
    }
}

__global__ void __launch_bounds__(NWAVES * 64, 2) hybrid_fwd(Args args) {
    extern __shared__ __attribute__((aligned(16))) unsigned char lds_raw[];
    LAS unsigned char* lds = (LAS unsigned char*)lds_raw;
    cg::grid_group grid = cg::this_grid();
    const int G = gridDim.x, NGW = G * NWAVES;
    const int wave_s = __builtin_amdgcn_readfirstlane((int)threadIdx.x >> 6);
    const int lo = args.ph_lo, hi = args.ph_hi;
    for (int ph = lo; ph < hi; ++ph) {
        KArgsP ap = (KArgsP)__builtin_amdgcn_kernarg_segment_ptr(); asm volatile("" : "+s"(ap));
        unsigned char* const ws = ap->ws;
        int wave = wave_s; asm volatile("" : "+s"(wave));
        int lane = (int)__builtin_amdgcn_mbcnt_hi(~0u, __builtin_amdgcn_mbcnt_lo(~0u, 0u)); asm volatile("" : "+v"(lane));
        const int tid = wave * 64 + lane, gw = blockIdx.x * NWAVES + wave;
        const int l = ph == 0 ? 0 : (ph - 1) / NPP, k = ph == 0 ? -1 : (ph - 1) % NPP;
        if (k == -1) {
            LAS float* scr = (LAS float*)(lds + wave * 16384);
            constexpr int I_IN = 16 * 69, I_UQ = 4 * 24, I_UKV = 2 * 32, I_O = 16 * 32, I_1 = 16 * 128, I_2 = 64 * 32, I_L = I_IN + I_UQ + I_UKV + I_O + I_1 + I_2;
            for (int it = gw; it < DEPTH * I_L; it += NGW) {
                const int ll = it / I_L; int r = it - ll * I_L;
                if (r < I_IN) { p0_transpose_item(ap->in[I_WIN] + (size_t)ll * DM * DIN, ap->in[I_ANG] + ll * DM, DM, DIN, WIN + (size_t)ll * DINP * DM, scr, r, lane); continue; } r -= I_IN;
                if (r < I_UQ) { p0_transpose_item(ap->in[I_WUQ] + (size_t)ll * 256 * 768, ap->in[I_QNG] + ll * 256, 256, 768, WUQ + (size_t)ll * 768 * 256, scr, r, lane); continue; } r -= I_UQ;
                if (r < I_UKV) { p0_transpose_item(ap->in[I_WUKV] + (size_t)ll * 128 * 1024, ap->in[I_KVNG] + ll * 128, 128, 1024, WUKV + (size_t)ll * 1024 * 128, scr, r, lane); continue; } r -= I_UKV;
                if (r < I_O) { p0_transpose_item(ap->in[I_WOUT] + (size_t)ll * DM * DM, nullptr, DM, DM, WOUT + (size_t)ll * DM * DM, scr, r, lane); continue; } r -= I_O;
                if (r < I_1) { p0_transpose_item(ap->in[I_W1] + (size_t)ll * DM * DFF, ap->in[I_MLPG] + ll * DM, DM, DFF, W1 + (size_t)ll * DFF * DM, scr, r, lane); continue; } r -= I_1;
                p0_transpose_item(ap->in[I_W2] + (size_t)ll * DFF * DM, nullptr, DFF, DM, W2 + (size_t)ll * DM * DFF, scr, r, lane);
            }
            for (int it = gw; it < DEPTH * (DINP - DIN); it += NGW) {
                const int ll = it / (DINP - DIN), r = DIN + it % (DINP - DIN); u32x4* p = (u32x4*)(WIN + ((size_t)ll * DINP + r) * DM) + lane;
                u32x4 z = {0u, 0u, 0u, 0u}; asm volatile("" : "+v"(z));
                p[0] = z; p[64] = z;
            }
            for (int e = blockIdx.x * 512 + tid; e < TT * 32; e += G * 512) { const int t = e >> 5, i = e & 31; const float inv = exp2f(-13.287712379549449f * (float)(2 * i) * (1.f / 64.f)); RT[e] = cossin((float)t * inv); }
            for (int e = blockIdx.x * 512 + tid; e < TT * 16; e += G * 512) { const int t = e >> 4, i = e & 15; const float inv = exp2f(-13.287712379549449f * (float)(2 * i) * (1.f / 32.f)); MT[e] = cossin((float)t * inv); }
            for (int m = gw; m < MV; m += NGW) {
                const float* src = m >= MR0 ? ap->in[I_META] + (size_t)(m - MR0) * DM : ap->in[I_X] + (size_t)m * DM;
                row_prep(src, XR + (size_t)m * DM, SSX + (size_t)m * 16, lane); }
        } else if (k == 0 || k == 1 || k == 4 || k == 5 || k == 6) {
            const int ng = k == 1 ? 2 : 1;
            for (int gi = 0; gi < ng; ++gi) {
                pg8::Gemm g; pg8::EpiAny E; E.xr = XR; E.out = ap->out; E.O = nullptr; E.ldc = 0; E.ssx = SSX; E.rs_src = nullptr; E.ssq = nullptr; E.sskv = nullptr;
                EpiMeta Em; Em.need_rs = 0; Em.O = nullptr; Em.ldc = 0; Em.xr = XR;
                if (k == 0)      { g = pg8::Gemm{XR, WIN + (size_t)l * DINP * DM, MREAL, DINP, DM, DM}; E.mode = 0; E.perm = 1; E.O = PROJ; E.ldc = DINP; E.rs_src = SSX; E.ssq = SSQ; E.sskv = SSKV; Em.need_rs = 1; }
                else if (k == 1 && gi == 0) { g = pg8::Gemm{PROJ + C_CQ, WUQ + (size_t)l * 768 * 256, MREAL, 768, 256, DINP}; E.mode = 0; E.perm = 1; E.O = QRAW; E.ldc = 768; }
                else if (k == 1) { g = pg8::Gemm{PROJ + C_CKV, WUKV + (size_t)l * 1024 * 128, MREAL, 1024, 128, DINP}; E.mode = 0; E.perm = 1; E.O = KVR; E.ldc = 1024; }
                else if (k == 4) { g = pg8::Gemm{MIX, WOUT + (size_t)l * DM * DM, MREAL, DM, DM, DM}; E.mode = 2; E.perm = 0; }
                else if (k == 5) { g = pg8::Gemm{XR, W1 + (size_t)l * DFF * DM, MREAL, DFF, DM, DM}; E.mode = 1; E.perm = 1; E.O = HB; E.ldc = DFF; E.rs_src = SSX; Em.need_rs = 1; }
                else             { g = pg8::Gemm{HB, W2 + (size_t)l * DM * DFF, MREAL, DM, DFF, DFF}; E.mode = (l == DEPTH - 1) ? 3 : 2; E.perm = 0; }
                Em.mode = E.mode; Em.O = E.O; Em.ldc = E.ldc;
                pg8::StaticOrder S; S.init(MREAL, g.N, G, (int)blockIdx.x);
                pg8::gemm_phase<pg8::EpiAny, pg8::StaticOrder, true, true>(lds, g, S, E, tid);
                if (E.mode != 3) meta_gemm(g.A + (size_t)MR0 * g.lda, g.lda, g.Bt, g.N, g.K, Em, gw, NGW, lane);
            }
            if (k == 1) {
                const float* cw = ap->in[I_CONVW] + l * 3 * 256;
                for (int it = blockIdx.x * 512 + tid; it < MV * 32; it += G * 512) {
                    const int m = it >> 5, c = (it & 31) * 8; const int t = m >= MR0 ? m - MR0 : (m & (SEQ - 1)) + NMETA; const bf16* pr = PROJ + (size_t)m * DINP;
                    const u32x4 cbv = *(const u32x4*)(pr + C_CB + c); float a[8];
#pragma unroll
                    for (int e = 0; e < 8; ++e) a[e] = 0.f;
#pragma unroll
                    for (int j = 0; j < 3; ++j) { const int tj = t - 2 + j; if (tj >= 0) { const int mj = (m >= MR0 || tj >= NMETA) ? m - (2 - j) : MR0 + tj;
                            const bf16* p2 = PROJ + (size_t)mj * DINP; const u32x4 ccv = *(const u32x4*)(p2 + C_CC + c), chv = *(const u32x4*)(p2 + C_CH + c);
                            const f32x4 w0 = *(const f32x4*)(cw + j * 256 + c), w1 = *(const f32x4*)(cw + j * 256 + c + 4);
#pragma unroll
                            for (int e = 0; e < 4; ++e) { const float wl = e < 2 ? w0[2 * e] : w1[2 * e - 4], wh = e < 2 ? w0[2 * e + 1] : w1[2 * e - 3];
                                a[2 * e] += wl * (bflo(ccv[e]) * bflo(chv[e])); a[2 * e + 1] += wh * (bfhi(ccv[e]) * bfhi(chv[e])); } } }
                    u32x4 o;
#pragma unroll
                    for (int e = 0; e < 4; ++e) o[e] = att::cvtpk(bflo(cbv[e]) * a[2 * e], bfhi(cbv[e]) * a[2 * e + 1]);
                    *(u32x4*)(MIX + (size_t)m * DM + c) = o;
                }
                for (int it = blockIdx.x * 512 + tid; it < MV * 32; it += G * 512) {
                    const int m = it >> 5, j = it & 31, w = j >> 4, h = (j >> 2) & 3, i0 = (j & 3) * 8; const int t = m >= MR0 ? m - MR0 : (m & (SEQ - 1)) + NMETA;
                    bf16* p = PROJ + (size_t)m * DINP + (w ? C_RK : C_RQ) + 64 * h + i0; const float sc = w ? 0.125f : 1.f;
                    const u32x4 x1 = *(const u32x4*)p, x2 = *(const u32x4*)(p + 32); const f32x4* cs = (const f32x4*)(RT + t * 32 + i0);
                    u32x4 o1, o2;
#pragma unroll
                    for (int e = 0; e < 4; ++e) { const f32x4 c4 = cs[e]; const float a0 = bflo(x1[e]), a1 = bfhi(x1[e]), b0 = bflo(x2[e]), b1 = bfhi(x2[e]);
                        o1[e] = att::cvtpk((a0 * c4.x - b0 * c4.y) * sc, (a1 * c4.z - b1 * c4.w) * sc); o2[e] = att::cvtpk((b0 * c4.x + a0 * c4.y) * sc, (b1 * c4.z + a1 * c4.w) * sc); }
                    *(u32x4*)p = o1; *(u32x4*)(p + 32) = o2;
                }
            }
        } else if (k == 2) {
            const float* kg = ap->in[I_KHG] + l * 96;
            for (int it = blockIdx.x * 512 + tid; it < MV * 8; it += G * 512) {
                const int m = it >> 3, h = it & 7; const int t = m >= MR0 ? m - MR0 : (m & (SEQ - 1)) + NMETA;
                float sumq, sumkv;
                if (m < MR0) { const f32x4 sq4 = *(const f32x4*)(SSQ + (size_t)m * 4), sk4 = *(const f32x4*)(SSKV + (size_t)m * 4); sumq = (sq4.x + sq4.y) + (sq4.z + sq4.w); sumkv = (sk4.x + sk4.y) + (sk4.z + sk4.w); }
                else { sumq = 0.f; sumkv = 0.f; const bf16* pc = PROJ + (size_t)m * DINP + C_CQ;
                    for (int c = 0; c < 48; ++c) { const u32x4 v = *(const u32x4*)(pc + 8 * c); float s = 0.f;
#pragma unroll
                        for (int e = 0; e < 4; ++e) { const float a0 = bflo(v[e]), a1 = bfhi(v[e]); s += a0 * a0 + a1 * a1; }
                        if (c < 32) sumq += s; else sumkv += s; } }
                const float s_q = 1.0f / sqrtf(sumq * (1.f / 256.f) + EPS), s_kv = 1.0f / sqrtf(sumkv * (1.f / 128.f) + EPS);
                const f32x4* mt = (const f32x4*)(MT + t * 16);
                if (h == 0) SQA[m] = s_q;
                { bf16* kn = KVR + (size_t)m * 1024 + 128 * h; bf16* pr = PROJ + (size_t)m * DINP; bf16* ko = pr + 96 * h; u32x4 w[8], r[4]; float ssn = 0.f, ssr = 0.f;
#pragma unroll
                  for (int c = 0; c < 8; ++c) w[c] = *(const u32x4*)(kn + 8 * c);
#pragma unroll
                  for (int c = 0; c < 4; ++c) r[c] = *(const u32x4*)(pr + C_KR + 8 * c);
#pragma unroll
                  for (int c = 0; c < 8; ++c)
#pragma unroll
                      for (int e = 0; e < 4; ++e) { const float a0 = bflo(w[c][e]), a1 = bfhi(w[c][e]); ssn += a0 * a0 + a1 * a1; }
#pragma unroll
                  for (int c = 0; c < 4; ++c)
#pragma unroll
                      for (int e = 0; e < 4; ++e) { const float a0 = bflo(r[c][e]), a1 = bfhi(r[c][e]); ssr += a0 * a0 + a1 * a1; }
                  const float rs = 1.0f / sqrtf((s_kv * s_kv * ssn + ssr) * (1.f / 96.f) + EPS), rn = rs * s_kv;
#pragma unroll
                  for (int c = 0; c < 8; ++c) { u32x4 o;
#pragma unroll
                      for (int e = 0; e < 4; ++e) o[e] = att::cvtpk(bflo(w[c][e]) * rn * kg[8 * c + 2 * e], bfhi(w[c][e]) * rn * kg[8 * c + 2 * e + 1]);
                      *(u32x4*)(ko + 8 * c) = o; }
#pragma unroll
                  for (int cc = 0; cc < 2; ++cc) { u32x4 o1, o2;
#pragma unroll
                      for (int e = 0; e < 4; ++e) { const int i = 8 * cc + 2 * e; const f32x4 c4 = mt[4 * cc + e];
                          const float a0 = bflo(r[cc][e]) * rs * kg[64 + i], a1 = bfhi(r[cc][e]) * rs * kg[64 + i + 1], b0 = bflo(r[2 + cc][e]) * rs * kg[80 + i], b1 = bfhi(r[2 + cc][e]) * rs * kg[80 + i + 1];
                          o1[e] = att::cvtpk(a0 * c4.x - b0 * c4.y, a1 * c4.z - b1 * c4.w); o2[e] = att::cvtpk(b0 * c4.x + a0 * c4.y, b1 * c4.z + a1 * c4.w); }
                      *(u32x4*)(ko + 64 + 8 * cc) = o1; *(u32x4*)(ko + 80 + 8 * cc) = o2; }
#pragma unroll
                  for (int c = 0; c < 8; ++c) { const u32x4 v = *(const u32x4*)(kn + 64 + 8 * c); u32x4 o;
#pragma unroll
                      for (int e = 0; e < 4; ++e) o[e] = att::cvtpk(bflo(v[e]) * s_kv, bfhi(v[e]) * s_kv);
                      *(u32x4*)(kn + 64 + 8 * c) = o; } }
            }
        } else {
            for (int item = blockIdx.x; item < 524; item += G) {
                if (item < 256 || (item >= 512 && item < 520)) { const bool meta = item >= 512; const int b = meta ? 0 : item >> 3, h = item & 7;
                    const bf16* Qp = QRAW + 96 * h; const bf16* Kp = PROJ + 96 * h; const bf16* Vp = KVR + 128 * h + 64; bf16* Op = MIX + 512 + 64 * h;
                    if (meta) att::unit<96, true>(lds, Qp, 768, Kp, DINP, Vp, 1024, Op, DM, nullptr, 0, nullptr, 0.f, b, 0, 16, tid, SQA, ap->in[I_QHG] + l * 96, MT);
                    else for (int blk = 8; blk >= 1; --blk) { const int q0 = 16 + 256 * (blk - 1);
                        att::unit<96, true>(lds, Qp, 768, Kp, DINP, Vp, 1024, Op, DM, nullptr, 0, nullptr, 0.f, b, q0, q0 + 256, tid, SQA, ap->in[I_QHG] + l * 96, MT); }
                } else { const bool meta = item >= 520; const int it = item - 256, bh = it >> 1, hf = it & 1, b = meta ? 0 : bh >> 2, h = meta ? item - 520 : bh & 3;
                    const bf16* Pp = PROJ + 64 * h; bf16* Op = MIX + 256 + 64 * h; const float* gn = ap->in[I_RETG] + l * 256 + 64 * h;
                    const float lg2 = log2f(1.0f - exp2f(-5.0f - (float)h)); const unsigned bm = hf ? 0x0CCu : 0x132u;
                    if (meta) att::unit<64, false>(lds, Pp + C_RQ, DINP, Pp + C_RK, DINP, Pp + C_RV, DINP, Op, DM, Pp + C_RG, DINP, gn, lg2, b, 0, 16, tid, nullptr, nullptr, nullptr);
                    else for (int blk = 8; blk >= 1; --blk) { if (!((bm >> blk) & 1u)) continue; const int q0 = 16 + 256 * (blk - 1);
                        att::unit<64, false>(lds, Pp + C_RQ, DINP, Pp + C_RK, DINP, Pp + C_RV, DINP, Op, DM, Pp + C_RG, DINP, gn, lg2, b, q0, q0 + 256, tid, nullptr, nullptr, nullptr); }
                }
            }
        }
        if (ph + 1 < hi) grid.sync();
    }
}

extern "C" void kernel_launch(void* const* d_in, const int* in_sizes, int n_in, void* d_out, int out_size, void* d_ws, size_t ws_size, hipStream_t stream) {
    static int grid = 0;
    if (grid == 0) {
        if (n_in != 16 || out_size != MREAL * DM || ws_size < WS_END) { fprintf(stderr, "kernel_launch: unexpected shapes (n_in %d, out %d, ws %zu)\n", n_in, out_size, ws_size); grid = -1; return; }
        int dev = 0, cus = 0, per_cu = 0;
        if (hipGetDevice(&dev) != hipSuccess || hipDeviceGetAttribute(&cus, hipDeviceAttributeMultiprocessorCount, dev) != hipSuccess) { grid = -1; return; }
        if (hipFuncSetAttribute((const void*)hybrid_fwd, hipFuncAttributeMaxDynamicSharedMemorySize, LDS_BYTES) != hipSuccess) { fprintf(stderr, "kernel_launch: hipFuncSetAttribute failed\n"); grid = -1; return; }
        if (hipOccupancyMaxActiveBlocksPerMultiprocessor(&per_cu, (const void*)hybrid_fwd, NWAVES * 64, LDS_BYTES) != hipSuccess || per_cu < 1) { fprintf(stderr, "kernel_launch: occupancy query says %d\n", per_cu); per_cu = 1; }
        (void)hipGetLastError();
        grid = cus;
    }
    if (grid < 0) return;
    Args a{};
    for (int i = 0; i < 16; ++i) a.in[i] = (const float*)d_in[i];
    a.out = (float*)d_out; a.ws = (unsigned char*)d_ws;
#if MK_MULTI
    for (int ph = 0; ph < NPHASE; ++ph) { a.ph_lo = ph; a.ph_hi = ph + 1; hipLaunchKernelGGL(hybrid_fwd, dim3(grid), dim3(NWAVES * 64), LDS_BYTES, stream, a); }
#else
    a.ph_lo = 0; a.ph_hi = NPHASE;
    void* kargs[] = {&a};
    const hipError_t e = hipLaunchCooperativeKernel((const void*)hybrid_fwd, dim3(grid), dim3(NWAVES * 64), kargs, LDS_BYTES, stream);
    if (e != hipSuccess) fprintf(stderr, "kernel_launch: cooperative launch failed: %s (grid %d)\n", hipGetErrorString(e), grid);
#endif
}
```

```cpp
#include <hip/hip_runtime.h>
#include <hip/hip_cooperative_groups.h>
#include <cstdio>
#include <cstdint>
#include <cmath>
namespace cg = cooperative_groups;
#ifndef MK_MULTI
#define MK_MULTI 0
#endif
namespace pg8 {
#define PG8_LAS __attribute__((address_space(3)))
typedef unsigned short bf16_t;
typedef short bf16x8 __attribute__((ext_vector_type(8)));
typedef float f32x4 __attribute__((ext_vector_type(4)));
typedef unsigned u32x4 __attribute__((ext_vector_type(4)));
typedef unsigned u32x2 __attribute__((ext_vector_type(2)));
constexpr int BM = 256, BK = 64, HALF = 128, HTB = HALF * BK * 2  , STAGE_BYTES = 8 * HTB, NXCD = 8, WGM = 8;

__host__ __device__ __forceinline__ int lds_byte(int r, int c) { const int st = (r >> 4) * 2 + (c >> 5), rr = r & 15, cc = c & 31, ob = rr * 64 + cc * 2; return st * 1024 + (ob ^ (((ob >> 9) & 1) << 5)); }
__host__ __device__ __forceinline__ void stage_rc(int b, int& R, int& C) { const int st = b / 1024, sb = b % 1024, swz = sb ^ (((sb >> 9) & 1) << 5); R = (st >> 1) * 16 + swz / 64; C = (st & 1) * 32 + (swz % 64) / 2; }
__host__ __device__ __forceinline__ int perm32(int rho) { const int n = rho >> 4, i = rho & 15; return 8 * (i >> 2) + 4 * n + (i & 3); }

__device__ __forceinline__ int opaque_tid() { int t = threadIdx.x; asm volatile("" : "+v"(t)); return t; }
struct Unit { int pm, pn; };
struct Gemm { const bf16_t* A; const bf16_t* Bt; int M, N, K, lda; };

struct StaticOrder {
    int nM, nN, nwg, G, c;
    __host__ __device__ void init(int M, int N, int G_, int c_) { nM = M / BM; nN = N / BM; nwg = nM * nN; G = G_; c = c_; }
    __host__ __device__ bool next(int i, Unit& u) const {
        const long L = (long)i * G + c; if (L >= nwg) return false;
        int wgid = (int)L; { const int q = nwg / NXCD, r = nwg % NXCD, xcd = wgid % NXCD, off = wgid / NXCD; wgid = (xcd < r ? xcd * (q + 1) : r * (q + 1) + (xcd - r) * q) + off; }
        const int nig = WGM * nN, gid = wgid / nig, fm = gid * WGM, gsz = (nM - fm) < WGM ? (nM - fm) : WGM;
        u.pm = fm + ((wgid % nig) % gsz); u.pn = (wgid % nig) / gsz; return true;
    }
    __device__ __forceinline__ void a_ready(const Unit&) const {}
    __device__ __forceinline__ void done(const Unit&) const {}
};

__device__ __forceinline__ unsigned cvt_pk_bf16(float lo, float hi) { unsigned r; asm volatile("v_cvt_pk_bf16_f32 %0, %1, %2" : "=v"(r) : "v"(lo), "v"(hi)); return r; }
__device__ __forceinline__ float fq_sum(float v) {
    auto a = __builtin_amdgcn_permlane16_swap(__float_as_uint(v), __float_as_uint(v), false, false); v = __uint_as_float(a[0]) + __uint_as_float(a[1]);
    auto b = __builtin_amdgcn_permlane32_swap(__float_as_uint(v), __float_as_uint(v), false, false); return __uint_as_float(b[0]) + __uint_as_float(b[1]);
}
struct EpiAny {
    static constexpr bool AFTER_DRAIN = false;
    int mode, perm; bf16_t* O; int ldc; bf16_t* xr; float* out; float* ssx; const float* rs_src; int rs_cnt; float rs_div; float* ssq; float* sskv;
    __device__ __forceinline__ void operator()(const f32x4 (&acc)[2][2][4][2], const Unit& u, int wr, int wc, int fr, int fq) const {
        if (mode < 2) {
            const int row0 = u.pm * BM + wr * 64 + fr; const int col0 = u.pn * BM + wc * 32 + 8 * fq; const bool sq = mode == 1;
            const int sstile = ssq ? (u.pn == 7 ? 1 : (u.pn == 8 ? 2 : 0)) : 0;
            float rsv[2][4];
            if (rs_src) {
                f32x4 pq[2][4]; const bool split = rs_cnt == 16;
#pragma unroll
                for (int ai = 0; ai < 2; ++ai)
#pragma unroll
                    for (int m = 0; m < 4; ++m) pq[ai][m] = *(const f32x4*)(rs_src + (size_t)(row0 + ai * HALF + m * 16) * rs_cnt + (split ? 4 * fq : 0));
#pragma unroll
                for (int ai = 0; ai < 2; ++ai)
#pragma unroll
                    for (int m = 0; m < 4; ++m) { const f32x4 a = pq[ai][m]; float t = (a[0] + a[1]) + (a[2] + a[3]); if (split) t = fq_sum(t); rsv[ai][m] = 1.0f / sqrtf(t * rs_div + 1e-6f); }
            } else {
#pragma unroll
                for (int ai = 0; ai < 2; ++ai)
#pragma unroll
                    for (int m = 0; m < 4; ++m) rsv[ai][m] = 1.f;
            }
#pragma unroll
            for (int ai = 0; ai < 2; ++ai)
#pragma unroll
                for (int m = 0; m < 4; ++m) { const int row = row0 + ai * HALF + m * 16; bf16_t* rowp = O + (size_t)row * ldc + col0;
                    const float rs = rsv[ai][m]; float part = 0.f;
#pragma unroll
                    for (int bj = 0; bj < 2; ++bj) { f32x4 v0 = acc[ai][bj][m][0] * rs, v1 = acc[ai][bj][m][1] * rs;
                        if (sq) {
#pragma unroll
                            for (int e = 0; e < 4; ++e) { const float a = fmaxf(v0[e], 0.f), b = fmaxf(v1[e], 0.f); v0[e] = a * a; v1[e] = b * b; } }
                        if (sstile == 1 || (sstile == 2 && bj == 0)) part += ((v0[0] * v0[0] + v0[1] * v0[1]) + (v0[2] * v0[2] + v0[3] * v0[3])) + ((v1[0] * v1[0] + v1[1] * v1[1]) + (v1[2] * v1[2] + v1[3] * v1[3]));
                        u32x4 w; w.x = cvt_pk_bf16(v0[0], v0[1]); w.y = cvt_pk_bf16(v0[2], v0[3]); w.z = cvt_pk_bf16(v1[0], v1[1]); w.w = cvt_pk_bf16(v1[2], v1[3]);
                        *(u32x4*)(rowp + bj * HALF) = w; }
                    if (sstile) { part = fq_sum(part); if (fq == 0) (sstile == 1 ? ssq : sskv)[(size_t)row * 4 + wc] = part; }
                }
        } else {
            const int col0 = u.pn * BM + wc * 32 + 4 * fq; const bool toout = mode == 3;
#pragma unroll
            for (int ai = 0; ai < 2; ++ai) {
                u32x2 xw[4][2][2];
#pragma unroll
                for (int m = 0; m < 4; ++m) { const bf16_t* xp = xr + (size_t)(u.pm * BM + ai * HALF + wr * 64 + m * 16 + fr) * 1024 + col0;
#pragma unroll
                    for (int bj = 0; bj < 2; ++bj)
#pragma unroll
                        for (int n = 0; n < 2; ++n) xw[m][bj][n] = *(const u32x2*)(xp + bj * HALF + n * 16); }
#pragma unroll
                for (int m = 0; m < 4; ++m) { const int r = u.pm * BM + ai * HALF + wr * 64 + m * 16 + fr; bf16_t* xp = xr + (size_t)r * 1024 + col0; float* op = out + (size_t)r * 1024 + col0; float part = 0.f;
#pragma unroll
                    for (int bj = 0; bj < 2; ++bj)
#pragma unroll
                        for (int n = 0; n < 2; ++n) { const u32x2 w0 = xw[m][bj][n];
                            f32x4 v = acc[ai][bj][m][n]; v[0] += __uint_as_float(w0.x << 16); v[1] += __uint_as_float(w0.x & 0xffff0000u); v[2] += __uint_as_float(w0.y << 16); v[3] += __uint_as_float(w0.y & 0xffff0000u);
                            if (toout) *(f32x4*)(op + bj * HALF + n * 16) = v;
                            else { part += (v[0] * v[0] + v[1] * v[1]) + (v[2] * v[2] + v[3] * v[3]); u32x2 w; w.x = cvt_pk_bf16(v[0], v[1]); w.y = cvt_pk_bf16(v[2], v[3]); *(u32x2*)(xp + bj * HALF + n * 16) = w; } }
                    if (!toout) { part = fq_sum(part); if (fq == 0) ssx[(size_t)r * 16 + u.pn * 4 + wc] = part; }
                }
                asm volatile("" ::: "memory");
            }
        }
    }
};

template <class Epi, class Sched, bool ALIGN_EPI = false, bool SP2 = false>
__device__ __forceinline__ void gemm_phase(PG8_LAS unsigned char* lds, const Gemm g, const Sched& S, const Epi& E, const int tid_in) {
    int tid_o = tid_in; asm volatile("" : "+v"(tid_o));
    const int tid = tid_o, wid = __builtin_amdgcn_readfirstlane(tid >> 6), lane = tid & 63, wr = wid >> 2, wc = wid & 3, fr = lane & 15, fq = lane >> 4;
    const int K = g.K, nt = K / BK;
    unsigned voffA[2], voffB[2];
#pragma unroll
    for (int i = 0; i < 2; ++i) { int R, C; stage_rc(tid * 16 + i * 8192, R, C); const int Rb = E.perm ? ((R & ~31) + perm32(R & 31)) : R;
        voffA[i] = (unsigned)(R * g.lda + C) * 2u; voffB[i] = (unsigned)(Rb * K + C) * 2u; }
    const size_t kstep = (size_t)(BK * 2);
    const size_t hstepA = (size_t)HALF * g.lda * 2, hstepB = (size_t)HALF * K * 2;
    const size_t tstepA = 2 * hstepA, tstepB = 2 * hstepB;
    const unsigned ldsw = (unsigned)wid * 1024u;
    const int aoff = lds_byte(wr * 64 + fr, fq * 8), boff = lds_byte(wc * 32 + fr, fq * 8);
#define PG8_SA(b, h) (((b) * 2 + (h)) * HTB)
#define PG8_SB(b, h) ((4 + (b) * 2 + (h)) * HTB)
#define PG8_STAGE(bufoff, gbase, voff) do { _Pragma("unroll") for (int _i = 0; _i < 2; ++_i) \
        __builtin_amdgcn_global_load_lds((const unsigned*)((const char*)(gbase) + (voff)[_i]), (PG8_LAS unsigned*)(lds + (bufoff) + ldsw + _i * 8192), 16, 0, 0); } while (0)
#define PG8_LDA(dst, b, h) do { _Pragma("unroll") for (int m = 0; m < 4; ++m) _Pragma("unroll") for (int k = 0; k < 2; ++k) dst[m][k] = *(const PG8_LAS bf16x8*)(lds + PG8_SA(b, h) + aoff + m * 2048 + k * 1024); } while (0)
#define PG8_LDB(dst, b, h) do { _Pragma("unroll") for (int n = 0; n < 2; ++n) _Pragma("unroll") for (int k = 0; k < 2; ++k) dst[n][k] = *(const PG8_LAS bf16x8*)(lds + PG8_SB(b, h) + boff + n * 2048 + k * 1024); } while (0)
#define PG8_MMA(ai, bj, At, Bt) do { __builtin_amdgcn_s_setprio(1); _Pragma("unroll") for (int m = 0; m < 4; ++m) _Pragma("unroll") for (int n = 0; n < 2; ++n) _Pragma("unroll") for (int k = 0; k < 2; ++k) \
        acc[ai][bj][m][n] = __builtin_amdgcn_mfma_f32_16x16x32_bf16(Bt[n][k], At[m][k], acc[ai][bj][m][n], 0, 0, 0); __builtin_amdgcn_s_setprio(0); } while (0)
#define PG8_WAIT_V(n) asm volatile("s_waitcnt vmcnt(" #n ")" ::: "memory")
#define PG8_WAIT_L(n) asm volatile("s_waitcnt lgkmcnt(" #n ")" ::: "memory")
#define PG8_BAR __builtin_amdgcn_s_barrier()
#define PG8_SCHED __builtin_amdgcn_sched_barrier(0)
    Unit cur, nxt; int ui = 0;
    if (!S.next(0, cur)) return;
    f32x4 acc[2][2][4][2];
#pragma unroll
    for (int a = 0; a < 2; ++a)
#pragma unroll
        for (int b = 0; b < 2; ++b)
#pragma unroll
            for (int m = 0; m < 4; ++m)
#pragma unroll
                for (int n = 0; n < 2; ++n) acc[a][b][m][n] = (f32x4){0.f, 0.f, 0.f, 0.f};
    bf16x8 At[4][2], B0[2][2], B1[2][2];
    const char* cA = (const char*)g.A + (size_t)cur.pm * tstepA; const char* cB = (const char*)g.Bt + (size_t)cur.pn * tstepB;
    S.a_ready(cur);
    if constexpr (SP2) {
        PG8_STAGE(PG8_SB(0, 0), cB, voffB); PG8_STAGE(PG8_SB(0, 1), cB + hstepB, voffB); PG8_STAGE(PG8_SA(0, 0), cA, voffA); PG8_STAGE(PG8_SA(0, 1), cA + hstepA, voffA);
        if (wr == 1) PG8_BAR;
        PG8_WAIT_V(2); PG8_BAR;
        PG8_STAGE(PG8_SB(1, 0), cB + kstep, voffB); PG8_STAGE(PG8_SA(1, 0), cA + kstep, voffA); PG8_STAGE(PG8_SB(1, 1), cB + hstepB + kstep, voffB);
        PG8_WAIT_V(6); PG8_BAR;
    } else {
        PG8_STAGE(PG8_SB(0, 0), cB, voffB); PG8_STAGE(PG8_SA(0, 0), cA, voffA); PG8_STAGE(PG8_SB(0, 1), cB + hstepB, voffB); PG8_STAGE(PG8_SA(0, 1), cA + hstepA, voffA);
        if (wr == 1) PG8_BAR;
        PG8_WAIT_V(4); PG8_BAR;
        PG8_STAGE(PG8_SB(1, 0), cB + kstep, voffB); PG8_STAGE(PG8_SA(1, 0), cA + kstep, voffA); PG8_STAGE(PG8_SB(1, 1), cB + hstepB + kstep, voffB);
        PG8_WAIT_V(6); PG8_BAR;
    }
    for (;;) {
        const bool has_next = S.next(ui + 1, nxt);
        const char* nA = has_next ? (const char*)g.A + (size_t)nxt.pm * tstepA : cA; const char* nB = has_next ? (const char*)g.Bt + (size_t)nxt.pn * tstepB : cB;
        for (int t = 0; t < nt; t += 2) {
            const bool last = (t == nt - 2);
            const char* a1 = cA + (size_t)(t + 1) * kstep;
            const char* a2 = last ? nA : cA + (size_t)(t + 2) * kstep; const char* b2 = last ? nB : cB + (size_t)(t + 2) * kstep;
            const char* a3 = a2 + kstep; const char* b3 = b2 + kstep;
            if (last && has_next) S.a_ready(nxt);
            if constexpr (SP2) {
            PG8_LDB(B0, 0, 0); PG8_LDB(B1, 0, 1); PG8_SCHED; PG8_LDA(At, 0, 0); PG8_STAGE(PG8_SA(1, 1), a1 + hstepA, voffA);
            PG8_WAIT_V(8); PG8_WAIT_L(0); PG8_BAR; PG8_MMA(0, 0, At, B0); PG8_MMA(0, 1, At, B1); PG8_BAR; PG8_SCHED;
            PG8_LDA(At, 0, 1); PG8_STAGE(PG8_SB(0, 0), b2, voffB); PG8_STAGE(PG8_SB(0, 1), b2 + hstepB, voffB); PG8_STAGE(PG8_SA(0, 0), a2, voffA);
            PG8_WAIT_V(8); PG8_WAIT_L(0); PG8_BAR; PG8_MMA(1, 0, At, B0); PG8_MMA(1, 1, At, B1); PG8_BAR; PG8_SCHED;
            PG8_LDB(B0, 1, 0); PG8_LDB(B1, 1, 1); PG8_SCHED; PG8_LDA(At, 1, 0); PG8_STAGE(PG8_SA(0, 1), a2 + hstepA, voffA);
            PG8_WAIT_V(8); PG8_WAIT_L(0); PG8_BAR; PG8_MMA(0, 0, At, B0); PG8_MMA(0, 1, At, B1); PG8_BAR; PG8_SCHED;
            PG8_LDA(At, 1, 1); PG8_STAGE(PG8_SB(1, 0), b3, voffB); PG8_STAGE(PG8_SB(1, 1), b3 + hstepB, voffB); PG8_STAGE(PG8_SA(1, 0), a3, voffA);
            PG8_WAIT_V(8); PG8_WAIT_L(0); PG8_BAR; PG8_MMA(1, 0, At, B0); PG8_MMA(1, 1, At, B1); PG8_BAR; PG8_SCHED;
            } else {
            PG8_LDB(B0, 0, 0); PG8_SCHED; PG8_LDA(At, 0, 0); PG8_STAGE(PG8_SA(1, 1), a1 + hstepA, voffA);
            PG8_WAIT_L(8); PG8_BAR; PG8_WAIT_L(0); PG8_MMA(0, 0, At, B0); PG8_BAR; PG8_SCHED;
            PG8_LDB(B1, 0, 1); PG8_STAGE(PG8_SB(0, 0), b2, voffB);
            PG8_BAR; PG8_WAIT_L(0); PG8_MMA(0, 1, At, B1); PG8_BAR;
            PG8_LDA(At, 0, 1); PG8_STAGE(PG8_SA(0, 0), a2, voffA);
            PG8_BAR; PG8_WAIT_L(0); PG8_MMA(1, 0, At, B0); PG8_BAR; PG8_SCHED;
            PG8_STAGE(PG8_SB(0, 1), b2 + hstepB, voffB);
            PG8_WAIT_V(6); PG8_BAR; PG8_MMA(1, 1, At, B1); PG8_BAR;
            PG8_LDB(B0, 1, 0); PG8_SCHED; PG8_LDA(At, 1, 0); PG8_STAGE(PG8_SA(0, 1), a2 + hstepA, voffA);
            PG8_WAIT_L(8); PG8_BAR; PG8_WAIT_L(0); PG8_MMA(0, 0, At, B0); PG8_BAR; PG8_SCHED;
            PG8_LDB(B1, 1, 1); PG8_STAGE(PG8_SB(1, 0), b3, voffB);
            PG8_BAR; PG8_WAIT_L(0); PG8_MMA(0, 1, At, B1); PG8_BAR;
            PG8_LDA(At, 1, 1); PG8_STAGE(PG8_SA(1, 0), a3, voffA);
            PG8_BAR; PG8_WAIT_L(0); PG8_MMA(1, 0, At, B0); PG8_BAR; PG8_SCHED;
            PG8_STAGE(PG8_SB(1, 1), b3 + hstepB, voffB);
            PG8_WAIT_V(6); PG8_BAR; PG8_MMA(1, 1, At, B1); PG8_BAR;
            }
        }
        if constexpr (ALIGN_EPI) { if (wr == 0) PG8_BAR; }
        if constexpr (!Epi::AFTER_DRAIN) { E(acc, cur, wr, wc, fr, fq); S.done(cur); }
        if (!has_next) break;
#pragma unroll
        for (int a = 0; a < 2; ++a)
#pragma unroll
            for (int b = 0; b < 2; ++b)
#pragma unroll
                for (int m = 0; m < 4; ++m)
#pragma unroll
                    for (int n = 0; n < 2; ++n) acc[a][b][m][n] = (f32x4){0.f, 0.f, 0.f, 0.f};
        cur = nxt; cA = nA; cB = nB; ++ui;
        if constexpr (ALIGN_EPI) { if (wr == 1) PG8_BAR; }
    }
    PG8_WAIT_V(0);
    if constexpr (!ALIGN_EPI) { if (wr == 0) PG8_BAR; }
    PG8_BAR;
    if constexpr (Epi::AFTER_DRAIN) { E.fused(acc, cur, wr, wc, fr, fq, lds, wid, lane); S.done(cur); }
#undef PG8_SA
#undef PG8_SB
#undef PG8_STAGE
#undef PG8_LDA
#undef PG8_LDB
#undef PG8_MMA
#undef PG8_WAIT_V
#undef PG8_WAIT_L
#undef PG8_BAR
#undef PG8_SCHED
}
}

#define GAS __attribute__((address_space(1)))
#define LAS __attribute__((address_space(3)))
typedef unsigned short bf16;
typedef unsigned u32x4 __attribute__((ext_vector_type(4)));
typedef unsigned u32x2 __attribute__((ext_vector_type(2)));
typedef float f32x4 __attribute__((ext_vector_type(4)));
typedef float f32x2 __attribute__((ext_vector_type(2)));
typedef short bf16x8 __attribute__((ext_vector_type(8)));
typedef float f32x16 __attribute__((ext_vector_type(16)));
constexpr int DM = 1024, BATCH = 32, SEQ = 2048, NMETA = 16, TT = SEQ + NMETA, DIN = 2208, DINP = 2304, DFF = 4096, DEPTH = 2;
constexpr int MREAL = BATCH * SEQ, MR0 = MREAL, MV = MREAL + NMETA, M = MREAL + 256;
static_assert(MREAL % 256 == 0, "row tiles");
__device__ __forceinline__ int rowof(int b, int t) { return t < NMETA ? MR0 + t : b * SEQ + (t - NMETA); }
constexpr int C_CB = 0, C_CC = 256, C_CH = 512, C_RQ = 768, C_RK = 1024, C_RV = 1280, C_RG = 1536, C_CQ = 1792, C_CKV = 2048, C_KR = 2176;
constexpr float EPS = 1e-6f;
constexpr float QSCALE = 0.10206207261596575f * 1.4426950408889634f;
constexpr size_t MiB = 1u << 20;
constexpr size_t WS_RT = 1 * MiB, WS_MT = 1 * MiB + 768 * 1024;
constexpr size_t WS_WIN = 4 * MiB, WS_WUQ = 13 * MiB, WS_WUKV = 14 * MiB, WS_WOUT = 15 * MiB, WS_W1 = 19 * MiB, WS_W2 = 35 * MiB;
constexpr size_t WS_X = 52 * MiB, WS_XN = 310 * MiB, WS_PROJ = 440 * MiB, WS_QRAW = 731 * MiB, WS_KV = 828 * MiB, WS_H = 440 * MiB, WS_SSX = 958 * MiB, WS_SSQ = 964 * MiB, WS_SSKV = 966 * MiB, WS_SQA = 968 * MiB, WS_END = 969 * MiB;
static_assert(WS_X + (size_t)M * DM * 4 <= WS_XN && WS_XN + (size_t)M * DM * 2 <= WS_PROJ && WS_PROJ + (size_t)M * DINP * 2 <= WS_QRAW && WS_QRAW + (size_t)M * 768 * 2 <= WS_KV &&
              WS_KV + (size_t)M * 1024 * 2 <= WS_SSX && WS_H + (size_t)M * DFF * 2 <= WS_SSX && WS_SSX + (size_t)M * 64 <= WS_SSQ && WS_SSQ + (size_t)M * 16 <= WS_SSKV && WS_SSKV + (size_t)M * 16 <= WS_SQA && WS_SQA + (size_t)M * 4 <= WS_END, "d_ws map");
constexpr int NWAVES = 8, LDS_BYTES = 147456;

__device__ __forceinline__ unsigned f2bf(float f) { unsigned u = __builtin_bit_cast(unsigned, f); return (u + 0x7fffu + ((u >> 16) & 1u)) >> 16; }
__device__ __forceinline__ unsigned pk2(float lo, float hi) { return f2bf(lo) | (f2bf(hi) << 16); }
__device__ __forceinline__ float bflo(unsigned w) { return __uint_as_float(w << 16); }
__device__ __forceinline__ float bfhi(unsigned w) { return __uint_as_float(w & 0xffff0000u); }
__device__ __forceinline__ float bf1(bf16 h) { return __uint_as_float((unsigned)h << 16); }
__device__ __forceinline__ float wave_sum(float v) {
#pragma unroll
    for (int o = 1; o < 64; o <<= 1) v += __shfl_xor(v, o);
    return v;
}
__device__ __forceinline__ float half_sum(float v) {
#pragma unroll
    for (int o = 1; o < 32; o <<= 1) v += __shfl_xor(v, o);
    return v;
}

namespace att {
typedef float f32x2_t __attribute__((ext_vector_type(2))); typedef __bf16 bf16x2_t __attribute__((ext_vector_type(2)));
__device__ __forceinline__ unsigned cvtpk(float lo, float hi) { f32x2_t v = {lo, hi}; bf16x2_t b = __builtin_convertvector(v, bf16x2_t); return __builtin_bit_cast(unsigned, b); }
constexpr int VP = 144;
__device__ __forceinline__ float xhalf_max(float v) { auto rr = __builtin_amdgcn_permlane32_swap(__float_as_uint(v), __float_as_uint(v), false, false); return fmaxf(__uint_as_float(rr[0]), __uint_as_float(rr[1])); }
__device__ __forceinline__ float xhalf_sum(float v) { auto rr = __builtin_amdgcn_permlane32_swap(__float_as_uint(v), __float_as_uint(v), false, false); return __uint_as_float(rr[0]) + __uint_as_float(rr[1]); }
template <int DQK, bool SM>
__device__ __forceinline__ void unit(LAS unsigned char* lds, const bf16* Q, int ldq, const bf16* K, int ldk, const bf16* V, int ldv, bf16* O, int ldo,
                                     const bf16* G, int ldg, const float* gain, float lg2, int b, int q0, int qend, const int tid_in, const float* sqa, const float* qgain, const f32x2* mtab) {
    constexpr int KP = DQK * 2 + 16, CH = DQK / 8, ND = DQK / 16, KB = 64 * KP, VB = 64 * VP, SB = KB + VB;
    int tid_o = tid_in; asm volatile("" : "+v"(tid_o));
    const int tid = tid_o, lane = tid & 63, wid = __builtin_amdgcn_readfirstlane(tid >> 6), r32 = lane & 31, hi = lane >> 5;
    const int q0w = q0 + 32 * wid, tq = q0w + r32;
    const bool wact = q0w < qend;
    bf16x8 qr[ND];
    const int qrow = rowof(b, tq < TT ? tq : TT - 1);
    { const bf16* qp = Q + (size_t)qrow * ldq + 8 * hi;
#pragma unroll
      for (int d0 = 0; d0 < ND; ++d0) qr[d0] = *(const bf16x8*)(qp + 16 * d0); }
    if (SM) {
        const int tpos = tq < TT ? tq : TT - 1;
        float ss = 0.f;
#pragma unroll
        for (int d0 = 0; d0 < ND; ++d0) { const u32x4 w = __builtin_bit_cast(u32x4, qr[d0]);
#pragma unroll
            for (int e = 0; e < 4; ++e) { const float a0 = bflo(w[e]), a1 = bfhi(w[e]); ss += a0 * a0 + a1 * a1; } }
        ss = xhalf_sum(ss);
        const float rs = QSCALE / sqrtf(ss * (1.f / 96.f) + EPS);
#pragma unroll
        for (int d0 = 0; d0 < 4; ++d0) { const u32x4 w = __builtin_bit_cast(u32x4, qr[d0]); const f32x4 g0 = *(const f32x4*)(qgain + 16 * d0 + 8 * hi), g1 = *(const f32x4*)(qgain + 16 * d0 + 8 * hi + 4); u32x4 o;
            o[0] = cvtpk(bflo(w[0]) * rs * g0[0], bfhi(w[0]) * rs * g0[1]); o[1] = cvtpk(bflo(w[1]) * rs * g0[2], bfhi(w[1]) * rs * g0[3]);
            o[2] = cvtpk(bflo(w[2]) * rs * g1[0], bfhi(w[2]) * rs * g1[1]); o[3] = cvtpk(bflo(w[3]) * rs * g1[2], bfhi(w[3]) * rs * g1[3]);
            qr[d0] = __builtin_bit_cast(bf16x8, o); }
        { const u32x4 w1 = __builtin_bit_cast(u32x4, qr[4]), w2 = __builtin_bit_cast(u32x4, qr[5]); const f32x4* cs = (const f32x4*)(mtab + tpos * 16 + 8 * hi);
          const float* ga = qgain + 64 + 8 * hi; const float* gb = qgain + 80 + 8 * hi; u32x4 o1, o2;
#pragma unroll
          for (int e = 0; e < 4; ++e) { const f32x4 c4 = cs[e];
              const float a0 = bflo(w1[e]) * rs * ga[2 * e], a1 = bfhi(w1[e]) * rs * ga[2 * e + 1], b0 = bflo(w2[e]) * rs * gb[2 * e], b1 = bfhi(w2[e]) * rs * gb[2 * e + 1];
              o1[e] = cvtpk(a0 * c4.x - b0 * c4.y, a1 * c4.z - b1 * c4.w); o2[e] = cvtpk(b0 * c4.x + a0 * c4.y, b1 * c4.z + a1 * c4.w); }
          qr[4] = __builtin_bit_cast(bf16x8, o1); qr[5] = __builtin_bit_cast(bf16x8, o2); }
    }
    const int ntiles = (qend - 1) / 64 + 1;
    const int nw = wact ? ((q0w + 31) / 64 + 1 < ntiles ? (q0w + 31) / 64 + 1 : ntiles) : 0;
    const int nfull = (q0w + 1) / 64;
    const int kkey0 = tid / CH, kch0 = tid % CH, kkey1 = (tid + 512) / CH, kch1 = (tid + 512) % CH;
    const bool has2 = (64 * CH > 512) && (tid + 512 < 64 * CH);
    const int vkey = tid & 63, vch = tid >> 6;
    const int pr32 = (r32 & 0x13) | ((r32 & 4) << 1) | ((r32 & 8) >> 1);
    const int koff = pr32 * KP + 16 * hi, voff = KB + r32 * VP + 16 * hi;
    u32x4 kreg0, kreg1 = {0u, 0u, 0u, 0u}, vreg;
#define ATT_LOAD(j) do { int r0_ = 64 * (j) + kkey0; r0_ = r0_ < TT ? r0_ : TT - 1; kreg0 = *(const u32x4*)(K + (size_t)rowof(b, r0_) * ldk + 8 * kch0); \
        if (has2) { int r1_ = 64 * (j) + kkey1; r1_ = r1_ < TT ? r1_ : TT - 1; kreg1 = *(const u32x4*)(K + (size_t)rowof(b, r1_) * ldk + 8 * kch1); } \
        int rv_ = 64 * (j) + vkey; rv_ = rv_ < TT ? rv_ : TT - 1; vreg = *(const u32x4*)(V + (size_t)rowof(b, rv_) * ldv + 8 * vch); } while (0)
#define ATT_STORE(so) do { *(LAS u32x4*)(lds + (so) + kkey0 * KP + 16 * kch0) = kreg0; if (has2) *(LAS u32x4*)(lds + (so) + kkey1 * KP + 16 * kch1) = kreg1; \
        LAS unsigned char* vd_ = lds + (so) + KB + (8 * vch) * VP + 2 * vkey; \
        _Pragma("unroll") for (int i_ = 0; i_ < 8; ++i_) { const unsigned w_ = vreg[i_ >> 1]; *(LAS unsigned short*)(vd_ + i_ * VP) = (unsigned short)((i_ & 1) ? (w_ >> 16) : (w_ & 0xffffu)); } } while (0)
#define ATT_KREAD(so) do { const LAS unsigned char* kb_ = lds + (so) + koff; \
        _Pragma("unroll") for (int d0 = 0; d0 < ND; ++d0) { kf0[d0] = *(const LAS bf16x8*)(kb_ + 32 * d0); kf1[d0] = *(const LAS bf16x8*)(kb_ + 32 * KP + 32 * d0); } } while (0)
#define ATT_VREAD(so) do { const LAS unsigned char* vb_ = lds + (so) + voff; \
        _Pragma("unroll") for (int ks = 0; ks < 4; ++ks) { vf0[ks] = *(const LAS bf16x8*)(vb_ + 32 * ks); vf1[ks] = *(const LAS bf16x8*)(vb_ + 32 * VP + 32 * ks); } } while (0)
#define ATT_QKM(S0, S1) do { \
        _Pragma("unroll") for (int r_ = 0; r_ < 16; ++r_) { S0[r_] = 0.f; S1[r_] = 0.f; } \
        _Pragma("unroll") for (int d0 = 0; d0 < ND; ++d0) { \
            S0 = __builtin_amdgcn_mfma_f32_32x32x16_bf16(kf0[d0], qr[d0], S0, 0, 0, 0); S1 = __builtin_amdgcn_mfma_f32_32x32x16_bf16(kf1[d0], qr[d0], S1, 0, 0, 0); } } while (0)
#define ATT_QKI(S0, S1, so) do { const LAS unsigned char* kb_ = lds + (so) + koff; \
        _Pragma("unroll") for (int r_ = 0; r_ < 16; ++r_) { S0[r_] = 0.f; S1[r_] = 0.f; } \
        _Pragma("unroll") for (int d0 = 0; d0 < ND; ++d0) { const bf16x8 k0_ = *(const LAS bf16x8*)(kb_ + 32 * d0), k1_ = *(const LAS bf16x8*)(kb_ + 32 * KP + 32 * d0); \
            S0 = __builtin_amdgcn_mfma_f32_32x32x16_bf16(k0_, qr[d0], S0, 0, 0, 0); S1 = __builtin_amdgcn_mfma_f32_32x32x16_bf16(k1_, qr[d0], S1, 0, 0, 0); } } while (0)
#define ATT_TILE(j, so, MASK, VPRE) do { const int kbase_ = 64 * (j) + 8 * hi; \
        if (SM) { \
            if (MASK) { _Pragma("unroll") for (int r = 0; r < 16; ++r) { const int kk = kbase_ + 16 * (r >> 3) + (r & 7); if (kk > tq) s0[r] = -INFINITY; if (kk + 32 > tq) s1[r] = -INFINITY; } } \
            float mx = fmaxf(s0[0], s1[0]); \
            _Pragma("unroll") for (int r = 1; r < 16; ++r) mx = fmaxf(mx, fmaxf(s0[r], s1[r])); \
            mx = xhalf_max(mx); \
            const float mn = fmaxf(m_run, mx), alpha = __builtin_amdgcn_exp2f(m_run - mn); m_run = mn; \
            float ps = 0.f; \
            _Pragma("unroll") for (int r = 0; r < 16; ++r) { s0[r] = __builtin_amdgcn_exp2f(s0[r] - mn); s1[r] = __builtin_amdgcn_exp2f(s1[r] - mn); ps += s0[r] + s1[r]; } \
            l_run = l_run * alpha + ps; \
            _Pragma("unroll") for (int r = 0; r < 16; ++r) { o0[r] *= alpha; o1[r] *= alpha; } \
        } else { \
            const float rf0 = __builtin_amdgcn_exp2f(lg2 * (float)(tq - kbase_)), rf1 = rf0 * c32; \
            _Pragma("unroll") for (int r = 0; r < 16; ++r) { s0[r] = (s0[r] * cfac[r]) * rf0; s1[r] = (s1[r] * cfac[r]) * rf1; } \
            if (MASK) { _Pragma("unroll") for (int r = 0; r < 16; ++r) { const int kk = kbase_ + 16 * (r >> 3) + (r & 7); if (kk > tq) s0[r] = 0.f; if (kk + 32 > tq) s1[r] = 0.f; } } \
        } \
        u32x4 pw[4]; \
        _Pragma("unroll") for (int ks = 0; ks < 2; ++ks) { \
            pw[ks] = (u32x4){cvtpk(s0[8 * ks], s0[8 * ks + 1]), cvtpk(s0[8 * ks + 2], s0[8 * ks + 3]), cvtpk(s0[8 * ks + 4], s0[8 * ks + 5]), cvtpk(s0[8 * ks + 6], s0[8 * ks + 7])}; \
            pw[2 + ks] = (u32x4){cvtpk(s1[8 * ks], s1[8 * ks + 1]), cvtpk(s1[8 * ks + 2], s1[8 * ks + 3]), cvtpk(s1[8 * ks + 4], s1[8 * ks + 5]), cvtpk(s1[8 * ks + 6], s1[8 * ks + 7])}; } \
        const LAS unsigned char* vb_ = lds + (so) + voff; \
        _Pragma("unroll") for (int ks = 0; ks < 4; ++ks) { const bf16x8 pf_ = __builtin_bit_cast(bf16x8, pw[ks]); \
            const bf16x8 v0_ = (VPRE) ? vf0[ks] : *(const LAS bf16x8*)(vb_ + 32 * ks), v1_ = (VPRE) ? vf1[ks] : *(const LAS bf16x8*)(vb_ + 32 * VP + 32 * ks); \
            o0 = __builtin_amdgcn_mfma_f32_32x32x16_bf16(v0_, pf_, o0, 0, 0, 0); o1 = __builtin_amdgcn_mfma_f32_32x32x16_bf16(v1_, pf_, o1, 0, 0, 0); } } while (0)
    f32x16 o0, o1, s0, s1, t0, t1; bf16x8 kf0[ND], kf1[ND], vf0[4], vf1[4];
#pragma unroll
    for (int r = 0; r < 16; ++r) { o0[r] = 0.f; o1[r] = 0.f; s0[r] = 0.f; s1[r] = 0.f; t0[r] = 0.f; t1[r] = 0.f; }
    float m_run = -INFINITY, l_run = 0.f;
    float cfac[16]; const float c32 = SM ? 0.f : __builtin_amdgcn_exp2f(-32.f * lg2);
#pragma unroll
    for (int r = 0; r < 16; ++r) cfac[r] = SM ? 0.f : __builtin_amdgcn_exp2f(-lg2 * (float)(16 * (r >> 3) + (r & 7)));
    int so_c = 0, so_n = SB, so_nn = 2 * SB;
    ATT_LOAD(0); ATT_STORE(0);
    if (ntiles > 1) { ATT_LOAD(1); ATT_STORE(SB); }
    __syncthreads();
    if (nw > 0) ATT_QKI(s0, s1, 0);
    for (int j = 0; j < ntiles; ++j) {
        if (j + 2 < ntiles) ATT_LOAD(j + 2);
        if (j + 1 < nw && j < nfull) {
            if (SM) {
                ATT_QKI(t0, t1, so_n);
                ATT_TILE(j, so_c, false, false);
            } else if (wid < 4) {
                ATT_KREAD(so_n); ATT_VREAD(so_c); __builtin_amdgcn_sched_barrier(0);
                ATT_QKM(t0, t1);
                ATT_TILE(j, so_c, false, true);
            } else {
                ATT_VREAD(so_c); __builtin_amdgcn_sched_barrier(0);
                ATT_TILE(j, so_c, false, true); __builtin_amdgcn_sched_barrier(0);
                ATT_KREAD(so_n); __builtin_amdgcn_sched_barrier(0);
                ATT_QKM(t0, t1);
            }
#pragma unroll
            for (int r = 0; r < 16; ++r) { s0[r] = t0[r]; s1[r] = t1[r]; }
        } else if (j < nw) {
            if (SM) { if (j + 1 < nw) ATT_QKI(t0, t1, so_n); ATT_TILE(j, so_c, true, false); }
            else { if (j + 1 < nw) { ATT_KREAD(so_n); ATT_VREAD(so_c); __builtin_amdgcn_sched_barrier(0); ATT_QKM(t0, t1); } else { ATT_VREAD(so_c); }
                   ATT_TILE(j, so_c, true, true); }
#pragma unroll
            for (int r = 0; r < 16; ++r) { s0[r] = t0[r]; s1[r] = t1[r]; }
        }
        if (j + 2 < ntiles) ATT_STORE(so_nn);
        __syncthreads();
        { const int t_ = so_c; so_c = so_n; so_n = so_nn; so_nn = t_; }
    }
#undef ATT_LOAD
#undef ATT_STORE
#undef ATT_KREAD
#undef ATT_VREAD
#undef ATT_QKM
#undef ATT_QKI
#undef ATT_TILE
    if (wact) {
        if (SM) {
            const float l = xhalf_sum(l_run), inv = 1.f / l;
            if (tq < qend) { bf16* op = O + (size_t)qrow * ldo + 4 * hi;
#pragma unroll
                for (int g = 0; g < 4; ++g) {
                    u32x2 a, bq; a.x = cvtpk(o0[4 * g] * inv, o0[4 * g + 1] * inv); a.y = cvtpk(o0[4 * g + 2] * inv, o0[4 * g + 3] * inv);
                    bq.x = cvtpk(o1[4 * g] * inv, o1[4 * g + 1] * inv); bq.y = cvtpk(o1[4 * g + 2] * inv, o1[4 * g + 3] * inv);
                    *(u32x2*)(op + 8 * g) = a; *(u32x2*)(op + 32 + 8 * g) = bq; } }
        } else {
            float ss = 0.f;
#pragma unroll
            for (int r = 0; r < 16; ++r) ss += o0[r] * o0[r] + o1[r] * o1[r];
            ss = xhalf_sum(ss);
            const float rs = 1.0f / sqrtf(ss * (1.f / 64.f) + EPS);
            if (tq < qend) { bf16* op = O + (size_t)qrow * ldo + 4 * hi; const bf16* gp = G + (size_t)qrow * ldg + 4 * hi; const float* gn = gain + 4 * hi;
#pragma unroll
                for (int g = 0; g < 4; ++g) {
#pragma unroll
                    for (int db = 0; db < 2; ++db) {
                        const u32x2 gw = *(const u32x2*)(gp + 32 * db + 8 * g); const f32x4 ga = *(const f32x4*)(gn + 32 * db + 8 * g);
                        float gv[4] = {bflo(gw.x), bfhi(gw.x), bflo(gw.y), bfhi(gw.y)}; float y[4];
#pragma unroll
                        for (int e = 0; e < 4; ++e) { const float ov = db ? o1[4 * g + e] : o0[4 * g + e]; const float sg = gv[e] / (1.f + __expf(-gv[e])); y[e] = ov * rs * ga[e] * sg; }
                        u32x2 w; w.x = cvtpk(y[0], y[1]); w.y = cvtpk(y[2], y[3]); *(u32x2*)(op + 32 * db + 8 * g) = w; } } }
        }
    }
}
}

struct Args { const float* in[16]; float* out; unsigned char* ws; int ph_lo, ph_hi; };
typedef const __attribute__((address_space(4))) Args* KArgsP;
#define RT   ((f32x2*)(ws + WS_RT))
#define MT   ((f32x2*)(ws + WS_MT))
#define WIN  ((bf16*)(ws + WS_WIN))
#define WUQ  ((bf16*)(ws + WS_WUQ))
#define WUKV ((bf16*)(ws + WS_WUKV))
#define WOUT ((bf16*)(ws + WS_WOUT))
#define W1   ((bf16*)(ws + WS_W1))
#define W2   ((bf16*)(ws + WS_W2))
#define XR   ((bf16*)(ws + WS_X))
#define XN   ((bf16*)(ws + WS_XN))
#define MIX  ((bf16*)(ws + WS_XN))
#define PROJ ((bf16*)(ws + WS_PROJ))
#define QRAW ((bf16*)(ws + WS_QRAW))
#define KVR  ((bf16*)(ws + WS_KV))
#define HB   ((bf16*)(ws + WS_H))
#define SSX  ((float*)(ws + WS_SSX))
#define SSQ  ((float*)(ws + WS_SSQ))
#define SSKV ((float*)(ws + WS_SSKV))
#define SQA  ((float*)(ws + WS_SQA))
enum { I_X = 0, I_META, I_ANG, I_WIN, I_CONVW, I_RETG, I_QNG, I_WUQ, I_KVNG, I_WUKV, I_QHG, I_KHG, I_WOUT, I_MLPG, I_W1, I_W2 };
constexpr int NPP = 7, NPHASE = 1 + NPP * DEPTH;

__device__ __forceinline__ void p0_transpose_item(const float* W, const float* gk, int K, int N, bf16* WT, LAS float* scr, int item, int lane) {
    const int nblk = N / 32, kb = item / nblk, nb = item % nblk, k0 = 64 * kb, n0 = 32 * nb;
#pragma unroll 8
    for (int i = 0; i < 32; ++i) { const int kk = 2 * i + (lane >> 5); const float gv = gk ? gk[k0 + kk] : 1.f; scr[kk * 33 + (lane & 31)] = W[(size_t)(k0 + kk) * N + n0 + (lane & 31)] * gv; }
    asm volatile("s_waitcnt lgkmcnt(0)" ::: "memory");
    const int c = lane & 7;
#pragma unroll
    for (int j = 0; j < 4; ++j) { const int n = (lane >> 3) + 8 * j; const LAS float* s = scr + (8 * c) * 33 + n;
        u32x4 o; o.x = pk2(s[0 * 33], s[1 * 33]); o.y = pk2(s[2 * 33], s[3 * 33]); o.z = pk2(s[4 * 33], s[5 * 33]); o.w = pk2(s[6 * 33], s[7 * 33]);
        *(u32x4*)(WT + (size_t)(n0 + n) * K + k0 + 8 * c) = o; }
    asm volatile("s_waitcnt lgkmcnt(0)" ::: "memory");
}
__device__ __forceinline__ void row_prep(const float* xrow, bf16* orow, float* ss16, int lane) {
    const f32x4* xr = (const f32x4*)xrow + lane;
    f32x4 v[4]; float s = 0.f;
#pragma unroll
    for (int j = 0; j < 4; ++j) { v[j] = xr[64 * j]; s += (v[j].x * v[j].x + v[j].y * v[j].y) + (v[j].z * v[j].z + v[j].w * v[j].w); }
    const float tot = wave_sum(s);
    if (lane < 16) ss16[lane] = lane == 0 ? tot : 0.f;
    unsigned long long* o8 = (unsigned long long*)orow + lane;
#pragma unroll
    for (int j = 0; j < 4; ++j) o8[64 * j] = (unsigned long long)att::cvtpk(v[j].x, v[j].y) | ((unsigned long long)att::cvtpk(v[j].z, v[j].w) << 32);
}
__device__ __forceinline__ f32x2 cossin(float ang) {
    const float n = rintf(ang * 0.15915494309189535f);
    float r = fmaf(-n, 6.28125f, ang); r = fmaf(-n, 0.0019353071795864769f, r);
    const float rev = r * 0.15915494309189535f;
    f32x2 o; o.x = __builtin_amdgcn_cosf(rev); o.y = __builtin_amdgcn_sinf(rev); return o;
}

struct EpiMeta { int mode, need_rs; float rs_div; bf16* O; int ldc; bf16* xr; };
__device__ __forceinline__ void meta_gemm(const bf16* A, int lda, const bf16* Bt, int N, int K, const EpiMeta& E, int gw, int NGW, int lane) {
    for (int n = gw; n < N; n += NGW) {
        float acc[16], ssa[16];
#pragma unroll
        for (int r = 0; r < 16; ++r) { acc[r] = 0.f; ssa[r] = 0.f; }
        for (int c = lane; c < K / 8; c += 64) {
            const u32x4 w = *(const u32x4*)(Bt + (size_t)n * K + 8 * c);
            float wf[8];
#pragma unroll
            for (int e = 0; e < 4; ++e) { wf[2 * e] = bflo(w[e]); wf[2 * e + 1] = bfhi(w[e]); }
#pragma unroll
            for (int r = 0; r < 16; ++r) { const u32x4 a = *(const u32x4*)(A + (size_t)r * lda + 8 * c);
#pragma unroll
                for (int e = 0; e < 4; ++e) { const float a0 = bflo(a[e]), a1 = bfhi(a[e]); acc[r] += a0 * wf[2 * e] + a1 * wf[2 * e + 1]; ssa[r] += a0 * a0 + a1 * a1; } }
        }
        float mine = 0.f, myss = 0.f;
#pragma unroll
        for (int r = 0; r < 16; ++r) { const float s = wave_sum(acc[r]), q = E.need_rs ? wave_sum(ssa[r]) : 0.f; if (lane == r) { mine = s; myss = q; } }
        if (lane < 16) { const int r = lane;
            if (E.mode < 2) { float v = mine * (E.need_rs ? 1.0f / sqrtf(myss * E.rs_div + EPS) : 1.f); if (E.mode == 1) { v = fmaxf(v, 0.f); v = v * v; } E.O[(size_t)(MR0 + r) * E.ldc + n] = (bf16)f2bf(v); }
            else { bf16* p = E.xr + (size_t)(MR0 + r) * DM + n; *p = (bf16)f2bf(bf1(*p) + mine); } }
    }
}

__global__ void __launch_bounds__(NWAVES * 64, 2) hybrid_fwd(Args args) {
    extern __shared__ __attribute__((aligned(16))) unsigned char lds_raw[];
    LAS unsigned char* lds = (LAS unsigned char*)lds_raw;
    cg::grid_group grid = cg::this_grid();
    const int G = gridDim.x, NGW = G * NWAVES;
    const int wave_s = __builtin_amdgcn_readfirstlane((int)threadIdx.x >> 6);
    const int lo = args.ph_lo, hi = args.ph_hi;
    for (int ph = lo; ph < hi; ++ph) {
        KArgsP ap = (KArgsP)__builtin_amdgcn_kernarg_segment_ptr(); asm volatile("" : "+s"(ap));
        unsigned char* const ws = ap->ws;
        int wave = wave_s; asm volatile("" : "+s"(wave));
        int lane = (int)__builtin_amdgcn_mbcnt_hi(~0u, __builtin_amdgcn_mbcnt_lo(~0u, 0u)); asm volatile("" : "+v"(lane));
        const int tid = wave * 64 + lane, gw = blockIdx.x * NWAVES + wave;
        const int l = ph == 0 ? 0 : (ph - 1) / NPP, k = ph == 0 ? -1 : (ph - 1) % NPP;
        if (k == -1) {
            LAS float* scr = (LAS float*)(lds + wave * 16384);
            constexpr int I_IN = 16 * 69, I_UQ = 4 * 24, I_UKV = 2 * 32, I_O = 16 * 32, I_1 = 16 * 128, I_2 = 64 * 32, I_L = I_IN + I_UQ + I_UKV + I_O + I_1 + I_2;
            for (int it = gw; it < DEPTH * I_L; it += NGW) {
                const int ll = it / I_L; int r = it - ll * I_L;
                if (r < I_IN) { p0_transpose_item(ap->in[I_WIN] + (size_t)ll * DM * DIN, ap->in[I_ANG] + ll * DM, DM, DIN, WIN + (size_t)ll * DINP * DM, scr, r, lane); continue; } r -= I_IN;
                if (r < I_UQ) { p0_transpose_item(ap->in[I_WUQ] + (size_t)ll * 256 * 768, ap->in[I_QNG] + ll * 256, 256, 768, WUQ + (size_t)ll * 768 * 256, scr, r, lane); continue; } r -= I_UQ;
                if (r < I_UKV) { p0_transpose_item(ap->in[I_WUKV] + (size_t)ll * 128 * 1024, ap->in[I_KVNG] + ll * 128, 128, 1024, WUKV + (size_t)ll * 1024 * 128, scr, r, lane); continue; } r -= I_UKV;
                if (r < I_O) { p0_transpose_item(ap->in[I_WOUT] + (size_t)ll * DM * DM, nullptr, DM, DM, WOUT + (size_t)ll * DM * DM, scr, r, lane); continue; } r -= I_O;
                if (r < I_1) { p0_transpose_item(ap->in[I_W1] + (size_t)ll * DM * DFF, ap->in[I_MLPG] + ll * DM, DM, DFF, W1 + (size_t)ll * DFF * DM, scr, r, lane); continue; } r -= I_1;
                p0_transpose_item(ap->in[I_W2] + (size_t)ll * DFF * DM, nullptr, DFF, DM, W2 + (size_t)ll * DM * DFF, scr, r, lane);
            }
            for (int it = gw; it < DEPTH * (DINP - DIN); it += NGW) {
                const int ll = it / (DINP - DIN), r = DIN + it % (DINP - DIN); u32x4* p = (u32x4*)(WIN + ((size_t)ll * DINP + r) * DM) + lane;
                u32x4 z = {0u, 0u, 0u, 0u}; asm volatile("" : "+v"(z));
                p[0] = z; p[64] = z;
            }
            for (int e = blockIdx.x * 512 + tid; e < TT * 32; e += G * 512) { const int t = e >> 5, i = e & 31; const float inv = exp2f(-13.287712379549449f * (float)(2 * i) * (1.f / 64.f)); RT[e] = cossin((float)t * inv); }
            for (int e = blockIdx.x * 512 + tid; e < TT * 16; e += G * 512) { const int t = e >> 4, i = e & 15; const float inv = exp2f(-13.287712379549449f * (float)(2 * i) * (1.f / 32.f)); MT[e] = cossin((float)t * inv); }
            for (int m = gw; m < MV; m += NGW) {
                const float* src = m >= MR0 ? ap->in[I_META] + (size_t)(m - MR0) * DM : ap->in[I_X] + (size_t)m * DM;
                row_prep(src, XR + (size_t)m * DM, SSX + (size_t)m * 16, lane); }
        } else if (k == 0 || k == 1 || k == 4 || k == 5 || k == 6) {
            const int ng = k == 1 ? 2 : 1;
            for (int gi = 0; gi < ng; ++gi) {
                pg8::Gemm g; pg8::EpiAny E; E.xr = XR; E.out = ap->out; E.O = nullptr; E.ldc = 0; E.ssx = SSX; E.rs_src = nullptr; E.rs_cnt = 16; E.rs_div = 1.f / 1024.f; E.ssq = nullptr; E.sskv = nullptr;
                EpiMeta Em; Em.need_rs = 0; Em.rs_div = 1.f / 1024.f; Em.O = nullptr; Em.ldc = 0; Em.xr = XR;
                if (k == 0)      { g = pg8::Gemm{XR, WIN + (size_t)l * DINP * DM, MREAL, DINP, DM, DM}; E.mode = 0; E.perm = 1; E.O = PROJ; E.ldc = DINP; E.rs_src = SSX; E.ssq = SSQ; E.sskv = SSKV; Em.need_rs = 1; }
                else if (k == 1 && gi == 0) { g = pg8::Gemm{PROJ + C_CQ, WUQ + (size_t)l * 768 * 256, MREAL, 768, 256, DINP}; E.mode = 0; E.perm = 1; E.O = QRAW; E.ldc = 768; E.rs_src = SSQ; E.rs_cnt = 4; E.rs_div = 1.f / 256.f; Em.need_rs = 1; Em.rs_div = 1.f / 256.f; }
                else if (k == 1) { g = pg8::Gemm{PROJ + C_CKV, WUKV + (size_t)l * 1024 * 128, MREAL, 1024, 128, DINP}; E.mode = 0; E.perm = 1; E.O = KVR; E.ldc = 1024; E.rs_src = SSKV; E.rs_cnt = 4; E.rs_div = 1.f / 128.f; Em.need_rs = 1; Em.rs_div = 1.f / 128.f; }
                else if (k == 4) { g = pg8::Gemm{MIX, WOUT + (size_t)l * DM * DM, MREAL, DM, DM, DM}; E.mode = 2; E.perm = 0; }
                else if (k == 5) { g = pg8::Gemm{XR, W1 + (size_t)l * DFF * DM, MREAL, DFF, DM, DM}; E.mode = 1; E.perm = 1; E.O = HB; E.ldc = DFF; E.rs_src = SSX; Em.need_rs = 1; }
                else             { g = pg8::Gemm{HB, W2 + (size_t)l * DM * DFF, MREAL, DM, DFF, DFF}; E.mode = (l == DEPTH - 1) ? 3 : 2; E.perm = 0; }
                Em.mode = E.mode; Em.O = E.O; Em.ldc = E.ldc;
                pg8::StaticOrder S; S.init(MREAL, g.N, G, (int)blockIdx.x);
                pg8::gemm_phase<pg8::EpiAny, pg8::StaticOrder, true, true>(lds, g, S, E, tid);
                if (E.mode != 3) meta_gemm(g.A + (size_t)MR0 * g.lda, g.lda, g.Bt, g.N, g.K, Em, gw, NGW, lane);
            }
            if (k == 1) {
                const float* cw = ap->in[I_CONVW] + l * 3 * 256;
                for (int it = blockIdx.x * 512 + tid; it < MV * 32; it += G * 512) {
                    const int m = it >> 5, c = (it & 31) * 8; const int t = m >= MR0 ? m - MR0 : (m & (SEQ - 1)) + NMETA; const bf16* pr = PROJ + (size_t)m * DINP;
                    const u32x4 cbv = *(const u32x4*)(pr + C_CB + c); float a[8];
#pragma unroll
                    for (int e = 0; e < 8; ++e) a[e] = 0.f;
#pragma unroll
                    for (int j = 0; j < 3; ++j) { const int tj = t - 2 + j; if (tj >= 0) { const int mj = (m >= MR0 || tj >= NMETA) ? m - (2 - j) : MR0 + tj;
                            const bf16* p2 = PROJ + (size_t)mj * DINP; const u32x4 ccv = *(const u32x4*)(p2 + C_CC + c), chv = *(const u32x4*)(p2 + C_CH + c);
                            const f32x4 w0 = *(const f32x4*)(cw + j * 256 + c), w1 = *(const f32x4*)(cw + j * 256 + c + 4);
#pragma unroll
                            for (int e = 0; e < 4; ++e) { const float wl = e < 2 ? w0[2 * e] : w1[2 * e - 4], wh = e < 2 ? w0[2 * e + 1] : w1[2 * e - 3];
                                a[2 * e] += wl * (bflo(ccv[e]) * bflo(chv[e])); a[2 * e + 1] += wh * (bfhi(ccv[e]) * bfhi(chv[e])); } } }
                    u32x4 o;
#pragma unroll
                    for (int e = 0; e < 4; ++e) o[e] = att::cvtpk(bflo(cbv[e]) * a[2 * e], bfhi(cbv[e]) * a[2 * e + 1]);
                    *(u32x4*)(MIX + (size_t)m * DM + c) = o;
                }
                for (int it = blockIdx.x * 512 + tid; it < MV * 32; it += G * 512) {
                    const int m = it >> 5, j = it & 31, w = j >> 4, h = (j >> 2) & 3, i0 = (j & 3) * 8; const int t = m >= MR0 ? m - MR0 : (m & (SEQ - 1)) + NMETA;
                    bf16* p = PROJ + (size_t)m * DINP + (w ? C_RK : C_RQ) + 64 * h + i0; const float sc = w ? 0.125f : 1.f;
                    const u32x4 x1 = *(const u32x4*)p, x2 = *(const u32x4*)(p + 32); const f32x4* cs = (const f32x4*)(RT + t * 32 + i0);
                    u32x4 o1, o2;
#pragma unroll
                    for (int e = 0; e < 4; ++e) { const f32x4 c4 = cs[e]; const float a0 = bflo(x1[e]), a1 = bfhi(x1[e]), b0 = bflo(x2[e]), b1 = bfhi(x2[e]);
                        o1[e] = att::cvtpk((a0 * c4.x - b0 * c4.y) * sc, (a1 * c4.z - b1 * c4.w) * sc); o2[e] = att::cvtpk((b0 * c4.x + a0 * c4.y) * sc, (b1 * c4.z + a1 * c4.w) * sc); }
                    *(u32x4*)p = o1; *(u32x4*)(p + 32) = o2;
                }
            }
        } else if (k == 2) {
            const float* kg = ap->in[I_KHG] + l * 96;
            for (int it = blockIdx.x * 512 + tid; it < MV * 8; it += G * 512) {
                const int m = it >> 3, h = it & 7; const int t = m >= MR0 ? m - MR0 : (m & (SEQ - 1)) + NMETA;
                const f32x4* mt = (const f32x4*)(MT + t * 16);
                { bf16* kn = KVR + (size_t)m * 1024 + 128 * h; bf16* pr = PROJ + (size_t)m * DINP; bf16* ko = pr + 96 * h; u32x4 w[8], r[4]; float ssn = 0.f, ssr = 0.f;
#pragma unroll
                  for (int c = 0; c < 8; ++c) w[c] = *(const u32x4*)(kn + 8 * c);
#pragma unroll
                  for (int c = 0; c < 4; ++c) r[c] = *(const u32x4*)(pr + C_KR + 8 * c);
#pragma unroll
                  for (int c = 0; c < 8; ++c)
#pragma unroll
                      for (int e = 0; e < 4; ++e) { const float a0 = bflo(w[c][e]), a1 = bfhi(w[c][e]); ssn += a0 * a0 + a1 * a1; }
#pragma unroll
                  for (int c = 0; c < 4; ++c)
#pragma unroll
                      for (int e = 0; e < 4; ++e) { const float a0 = bflo(r[c][e]), a1 = bfhi(r[c][e]); ssr += a0 * a0 + a1 * a1; }
                  const float rs = 1.0f / sqrtf((ssn + ssr) * (1.f / 96.f) + EPS), rn = rs;
#pragma unroll
                  for (int c = 0; c < 8; ++c) { u32x4 o;
#pragma unroll
                      for (int e = 0; e < 4; ++e) o[e] = att::cvtpk(bflo(w[c][e]) * rn * kg[8 * c + 2 * e], bfhi(w[c][e]) * rn * kg[8 * c + 2 * e + 1]);
                      *(u32x4*)(ko + 8 * c) = o; }
#pragma unroll
                  for (int cc = 0; cc < 2; ++cc) { u32x4 o1, o2;
#pragma unroll
                      for (int e = 0; e < 4; ++e) { const int i = 8 * cc + 2 * e; const f32x4 c4 = mt[4 * cc + e];
                          const float a0 = bflo(r[cc][e]) * rs * kg[64 + i], a1 = bfhi(r[cc][e]) * rs * kg[64 + i + 1], b0 = bflo(r[2 + cc][e]) * rs * kg[80 + i], b1 = bfhi(r[2 + cc][e]) * rs * kg[80 + i + 1];
                          o1[e] = att::cvtpk(a0 * c4.x - b0 * c4.y, a1 * c4.z - b1 * c4.w); o2[e] = att::cvtpk(b0 * c4.x + a0 * c4.y, b1 * c4.z + a1 * c4.w); }
                      *(u32x4*)(ko + 64 + 8 * cc) = o1; *(u32x4*)(ko + 80 + 8 * cc) = o2; }
                }
            }
        } else {
            for (int item = blockIdx.x; item < 524; item += G) {
                if (item < 256 || (item >= 512 && item < 520)) { const bool meta = item >= 512; const int b = meta ? 0 : item >> 3, h = item & 7;
                    const bf16* Qp = QRAW + 96 * h; const bf16* Kp = PROJ + 96 * h; const bf16* Vp = KVR + 128 * h + 64; bf16* Op = MIX + 512 + 64 * h;
                    if (meta) att::unit<96, true>(lds, Qp, 768, Kp, DINP, Vp, 1024, Op, DM, nullptr, 0, nullptr, 0.f, b, 0, 16, tid, SQA, ap->in[I_QHG] + l * 96, MT);
                    else for (int blk = 8; blk >= 1; --blk) { const int q0 = 16 + 256 * (blk - 1);
                        att::unit<96, true>(lds, Qp, 768, Kp, DINP, Vp, 1024, Op, DM, nullptr, 0, nullptr, 0.f, b, q0, q0 + 256, tid, SQA, ap->in[I_QHG] + l * 96, MT); }
                } else { const bool meta = item >= 520; const int it = item - 256, bh = it >> 1, hf = it & 1, b = meta ? 0 : bh >> 2, h = meta ? item - 520 : bh & 3;
                    const bf16* Pp = PROJ + 64 * h; bf16* Op = MIX + 256 + 64 * h; const float* gn = ap->in[I_RETG] + l * 256 + 64 * h;
                    const float lg2 = log2f(1.0f - exp2f(-5.0f - (float)h)); const unsigned bm = hf ? 0x0CCu : 0x132u;
                    if (meta) att::unit<64, false>(lds, Pp + C_RQ, DINP, Pp + C_RK, DINP, Pp + C_RV, DINP, Op, DM, Pp + C_RG, DINP, gn, lg2, b, 0, 16, tid, nullptr, nullptr, nullptr);
                    else for (int blk = 8; blk >= 1; --blk) { if (!((bm >> blk) & 1u)) continue; const int q0 = 16 + 256 * (blk - 1);
                        att::unit<64, false>(lds, Pp + C_RQ, DINP, Pp + C_RK, DINP, Pp + C_RV, DINP, Op, DM, Pp + C_RG, DINP, gn, lg2, b, q0, q0 + 256, tid, nullptr, nullptr, nullptr); }
                }
            }
        }
        if (ph + 1 < hi) grid.sync();
    }
}

extern "C" void kernel_launch(void* const* d_in, const int* in_sizes, int n_in, void* d_out, int out_size, void* d_ws, size_t ws_size, hipStream_t stream) {
    static int grid = 0;
    if (grid == 0) {
        if (n_in != 16 || out_size != MREAL * DM || ws_size < WS_END) { fprintf(stderr, "kernel_launch: unexpected shapes (n_in %d, out %d, ws %zu)\n", n_in, out_size, ws_size); grid = -1; return; }
        int dev = 0, cus = 0, per_cu = 0;
        if (hipGetDevice(&dev) != hipSuccess || hipDeviceGetAttribute(&cus, hipDeviceAttributeMultiprocessorCount, dev) != hipSuccess) { grid = -1; return; }
        if (hipFuncSetAttribute((const void*)hybrid_fwd, hipFuncAttributeMaxDynamicSharedMemorySize, LDS_BYTES) != hipSuccess) { fprintf(stderr, "kernel_launch: hipFuncSetAttribute failed\n"); grid = -1; return; }
        if (hipOccupancyMaxActiveBlocksPerMultiprocessor(&per_cu, (const void*)hybrid_fwd, NWAVES * 64, LDS_BYTES) != hipSuccess || per_cu < 1) { fprintf(stderr, "kernel_launch: occupancy query says %d\n", per_cu); per_cu = 1; }
        (void)hipGetLastError();
        grid = cus;
    }
    if (grid < 0) return;
    Args a{};
    for (int i = 0; i < 16; ++i) a.in[i] = (const float*)d_in[i];
    a.out = (float*)d_out; a.ws = (unsigned char*)d_ws;
#if MK_MULTI
    for (int ph = 0; ph < NPHASE; ++ph) { a.ph_lo = ph; a.ph_hi = ph + 1; hipLaunchKernelGGL(hybrid_fwd, dim3(grid), dim3(NWAVES * 64), LDS_BYTES, stream, a); }
#else
    a.ph_lo = 0; a.ph_hi = NPHASE;
    void* kargs[] = {&a};
    const hipError_t e = hipLaunchCooperativeKernel((const void*)hybrid_fwd, dim3(grid), dim3(NWAVES * 64), kargs, LDS_BYTES, stream);
    if (e != hipSuccess) fprintf(stderr, "kernel_launch: cooperative launch failed: %s (grid %d)\n", hipGetErrorString(e), grid);
#endif
}
```

```cpp
#include <hip/hip_runtime.h>
#include <hip/hip_cooperative_groups.h>
#include <cstdio>
#include <cstdint>
#include <cmath>
namespace cg = cooperative_groups;
#ifndef MK_MULTI
#define MK_MULTI 0
#endif
namespace pg8 {
#define PG8_LAS __attribute__((address_space(3)))
typedef unsigned short bf16_t;
typedef short bf16x8 __attribute__((ext_vector_type(8)));
typedef float f32x4 __attribute__((ext_vector_type(4)));
typedef unsigned u32x4 __attribute__((ext_vector_type(4)));
typedef unsigned u32x2 __attribute__((ext_vector_type(2)));
constexpr int BM = 256, BK = 64, HALF = 128, HTB = HALF * BK * 2  , STAGE_BYTES = 8 * HTB, NXCD = 8, WGM = 8;

__host__ __device__ __forceinline__ int lds_byte(int r, int c) { const int st = (r >> 4) * 2 + (c >> 5), rr = r & 15, cc = c & 31, ob = rr * 64 + cc * 2; return st * 1024 + (ob ^ (((ob >> 9) & 1) << 5)); }
__host__ __device__ __forceinline__ void stage_rc(int b, int& R, int& C) { const int st = b / 1024, sb = b % 1024, swz = sb ^ (((sb >> 9) & 1) << 5); R = (st >> 1) * 16 + swz / 64; C = (st & 1) * 32 + (swz % 64) / 2; }
__host__ __device__ __forceinline__ int perm32(int rho) { const int n = rho >> 4, i = rho & 15; return 8 * (i >> 2) + 4 * n + (i & 3); }

__device__ __forceinline__ int opaque_tid() { int t = threadIdx.x; asm volatile("" : "+v"(t)); return t; }
struct Unit { int pm, pn; };
struct Gemm { const bf16_t* A; const bf16_t* Bt; int M, N, K, lda; };

struct StaticOrder {
    int nM, nN, nwg, G, c;
    __host__ __device__ void init(int M, int N, int G_, int c_) { nM = M / BM; nN = N / BM; nwg = nM * nN; G = G_; c = c_; }
    __host__ __device__ bool next(int i, Unit& u) const {
        const long L = (long)i * G + c; if (L >= nwg) return false;
        int wgid = (int)L; { const int q = nwg / NXCD, r = nwg % NXCD, xcd = wgid % NXCD, off = wgid / NXCD; wgid = (xcd < r ? xcd * (q + 1) : r * (q + 1) + (xcd - r) * q) + off; }
        const int nig = WGM * nN, gid = wgid / nig, fm = gid * WGM, gsz = (nM - fm) < WGM ? (nM - fm) : WGM;
        u.pm = fm + ((wgid % nig) % gsz); u.pn = (wgid % nig) / gsz; return true;
    }
    __device__ __forceinline__ void a_ready(const Unit&) const {}
    __device__ __forceinline__ void done(const Unit&) const {}
};

__device__ __forceinline__ unsigned cvt_pk_bf16(float lo, float hi) { unsigned r; asm volatile("v_cvt_pk_bf16_f32 %0, %1, %2" : "=v"(r) : "v"(lo), "v"(hi)); return r; }
__device__ __forceinline__ float fq_sum(float v) {
    auto a = __builtin_amdgcn_permlane16_swap(__float_as_uint(v), __float_as_uint(v), false, false); v = __uint_as_float(a[0]) + __uint_as_float(a[1]);
    auto b = __builtin_amdgcn_permlane32_swap(__float_as_uint(v), __float_as_uint(v), false, false); return __uint_as_float(b[0]) + __uint_as_float(b[1]);
}
struct EpiAny {
    static constexpr bool AFTER_DRAIN = false;
    int mode, perm; bf16_t* O; int ldc; bf16_t* xr; float* out; float* ssx; const float* rs_src; int rs_cnt; float rs_div; float* ssq; float* sskv;
    __device__ __forceinline__ void operator()(const f32x4 (&acc)[2][2][4][2], const Unit& u, int wr, int wc, int fr, int fq) const {
        if (mode < 2) {
            const int row0 = u.pm * BM + wr * 64 + fr; const int col0 = u.pn * BM + wc * 32 + 8 * fq; const bool sq = mode == 1;
            const int sstile = ssq ? (u.pn == 7 ? 1 : (u.pn == 8 ? 2 : 0)) : 0;
            float rsv[2][4];
            if (rs_src) {
                f32x4 pq[2][4]; const bool split = rs_cnt == 16;
#pragma unroll
                for (int ai = 0; ai < 2; ++ai)
#pragma unroll
                    for (int m = 0; m < 4; ++m) pq[ai][m] = *(const f32x4*)(rs_src + (size_t)(row0 + ai * HALF + m * 16) * rs_cnt + (split ? 4 * fq : 0));
#pragma unroll
                for (int ai = 0; ai < 2; ++ai)
#pragma unroll
                    for (int m = 0; m < 4; ++m) { const f32x4 a = pq[ai][m]; float t = (a[0] + a[1]) + (a[2] + a[3]); if (split) t = fq_sum(t); rsv[ai][m] = 1.0f / sqrtf(t * rs_div + 1e-6f); }
            } else {
#pragma unroll
                for (int ai = 0; ai < 2; ++ai)
#pragma unroll
                    for (int m = 0; m < 4; ++m) rsv[ai][m] = 1.f;
            }
#pragma unroll
            for (int ai = 0; ai < 2; ++ai)
#pragma unroll
                for (int m = 0; m < 4; ++m) { const int row = row0 + ai * HALF + m * 16; bf16_t* rowp = O + (size_t)row * ldc + col0;
                    const float rs = rsv[ai][m]; float part = 0.f;
#pragma unroll
                    for (int bj = 0; bj < 2; ++bj) { f32x4 v0 = acc[ai][bj][m][0] * rs, v1 = acc[ai][bj][m][1] * rs;
                        if (sq) {
#pragma unroll
                            for (int e = 0; e < 4; ++e) { const float a = fmaxf(v0[e], 0.f), b = fmaxf(v1[e], 0.f); v0[e] = a * a; v1[e] = b * b; } }
                        if (sstile == 1 || (sstile == 2 && bj == 0)) part += ((v0[0] * v0[0] + v0[1] * v0[1]) + (v0[2] * v0[2] + v0[3] * v0[3])) + ((v1[0] * v1[0] + v1[1] * v1[1]) + (v1[2] * v1[2] + v1[3] * v1[3]));
                        u32x4 w; w.x = cvt_pk_bf16(v0[0], v0[1]); w.y = cvt_pk_bf16(v0[2], v0[3]); w.z = cvt_pk_bf16(v1[0], v1[1]); w.w = cvt_pk_bf16(v1[2], v1[3]);
                        *(u32x4*)(rowp + bj * HALF) = w; }
                    if (sstile) { part = fq_sum(part); if (fq == 0) (sstile == 1 ? ssq : sskv)[(size_t)row * 4 + wc] = part; }
                }
        } else {
            const int col0 = u.pn * BM + wc * 32 + 4 * fq; const bool toout = mode == 3;
#pragma unroll
            for (int ai = 0; ai < 2; ++ai) {
                u32x2 xw[4][2][2];
#pragma unroll
                for (int m = 0; m < 4; ++m) { const bf16_t* xp = xr + (size_t)(u.pm * BM + ai * HALF + wr * 64 + m * 16 + fr) * 1024 + col0;
#pragma unroll
                    for (int bj = 0; bj < 2; ++bj)
#pragma unroll
                        for (int n = 0; n < 2; ++n) xw[m][bj][n] = *(const u32x2*)(xp + bj * HALF + n * 16); }
#pragma unroll
                for (int m = 0; m < 4; ++m) { const int r = u.pm * BM + ai * HALF + wr * 64 + m * 16 + fr; bf16_t* xp = xr + (size_t)r * 1024 + col0; float* op = out + (size_t)r * 1024 + col0; float part = 0.f;
#pragma unroll
                    for (int bj = 0; bj < 2; ++bj)
#pragma unroll
                        for (int n = 0; n < 2; ++n) { const u32x2 w0 = xw[m][bj][n];
                            f32x4 v = acc[ai][bj][m][n]; v[0] += __uint_as_float(w0.x << 16); v[1] += __uint_as_float(w0.x & 0xffff0000u); v[2] += __uint_as_float(w0.y << 16); v[3] += __uint_as_float(w0.y & 0xffff0000u);
                            if (toout) *(f32x4*)(op + bj * HALF + n * 16) = v;
                            else { part += (v[0] * v[0] + v[1] * v[1]) + (v[2] * v[2] + v[3] * v[3]); u32x2 w; w.x = cvt_pk_bf16(v[0], v[1]); w.y = cvt_pk_bf16(v[2], v[3]); *(u32x2*)(xp + bj * HALF + n * 16) = w; } }
                    if (!toout) { part = fq_sum(part); if (fq == 0) ssx[(size_t)r * 16 + u.pn * 4 + wc] = part; }
                }
                asm volatile("" ::: "memory");
            }
        }
    }
};

template <class Epi, class Sched, bool ALIGN_EPI = false, bool SP2 = false>
__device__ __forceinline__ void gemm_phase(PG8_LAS unsigned char* lds, const Gemm g, const Sched& S, const Epi& E, const int tid_in) {
    int tid_o = tid_in; asm volatile("" : "+v"(tid_o));
    const int tid = tid_o, wid = __builtin_amdgcn_readfirstlane(tid >> 6), lane = tid & 63, wr = wid >> 2, wc = wid & 3, fr = lane & 15, fq = lane >> 4;
    const int K = g.K, nt = K / BK;
    unsigned voffA[2], voffB[2];
#pragma unroll
    for (int i = 0; i < 2; ++i) { int R, C; stage_rc(tid * 16 + i * 8192, R, C); const int Rb = E.perm ? ((R & ~31) + perm32(R & 31)) : R;
        voffA[i] = (unsigned)(R * g.lda + C) * 2u; voffB[i] = (unsigned)(Rb * K + C) * 2u; }
    const size_t kstep = (size_t)(BK * 2);
    const size_t hstepA = (size_t)HALF * g.lda * 2, hstepB = (size_t)HALF * K * 2;
    const size_t tstepA = 2 * hstepA, tstepB = 2 * hstepB;
    const unsigned ldsw = (unsigned)wid * 1024u;
    const int aoff = lds_byte(wr * 64 + fr, fq * 8), boff = lds_byte(wc * 32 + fr, fq * 8);
#define PG8_SA(b, h) (((b) * 2 + (h)) * HTB)
#define PG8_SB(b, h) ((4 + (b) * 2 + (h)) * HTB)
#define PG8_STAGE(bufoff, gbase, voff) do { _Pragma("unroll") for (int _i = 0; _i < 2; ++_i) \
        __builtin_amdgcn_global_load_lds((const unsigned*)((const char*)(gbase) + (voff)[_i]), (PG8_LAS unsigned*)(lds + (bufoff) + ldsw + _i * 8192), 16, 0, 0); } while (0)
#define PG8_LDA(dst, b, h) do { _Pragma("unroll") for (int m = 0; m < 4; ++m) _Pragma("unroll") for (int k = 0; k < 2; ++k) dst[m][k] = *(const PG8_LAS bf16x8*)(lds + PG8_SA(b, h) + aoff + m * 2048 + k * 1024); } while (0)
#define PG8_LDB(dst, b, h) do { _Pragma("unroll") for (int n = 0; n < 2; ++n) _Pragma("unroll") for (int k = 0; k < 2; ++k) dst[n][k] = *(const PG8_LAS bf16x8*)(lds + PG8_SB(b, h) + boff + n * 2048 + k * 1024); } while (0)
#define PG8_MMA(ai, bj, At, Bt) do { __builtin_amdgcn_s_setprio(1); _Pragma("unroll") for (int m = 0; m < 4; ++m) _Pragma("unroll") for (int n = 0; n < 2; ++n) _Pragma("unroll") for (int k = 0; k < 2; ++k) \
        acc[ai][bj][m][n] = __builtin_amdgcn_mfma_f32_16x16x32_bf16(Bt[n][k], At[m][k], acc[ai][bj][m][n], 0, 0, 0); __builtin_amdgcn_s_setprio(0); } while (0)
#define PG8_WAIT_V(n) asm volatile("s_waitcnt vmcnt(" #n ")" ::: "memory")
#define PG8_WAIT_L(n) asm volatile("s_waitcnt lgkmcnt(" #n ")" ::: "memory")
#define PG8_BAR __builtin_amdgcn_s_barrier()
#define PG8_SCHED __builtin_amdgcn_sched_barrier(0)
    Unit cur, nxt; int ui = 0;
    if (!S.next(0, cur)) return;
    f32x4 acc[2][2][4][2];
#pragma unroll
    for (int a = 0; a < 2; ++a)
#pragma unroll
        for (int b = 0; b < 2; ++b)
#pragma unroll
            for (int m = 0; m < 4; ++m)
#pragma unroll
                for (int n = 0; n < 2; ++n) acc[a][b][m][n] = (f32x4){0.f, 0.f, 0.f, 0.f};
    bf16x8 At[4][2], B0[2][2], B1[2][2];
    const char* cA = (const char*)g.A + (size_t)cur.pm * tstepA; const char* cB = (const char*)g.Bt + (size_t)cur.pn * tstepB;
    S.a_ready(cur);
    if constexpr (SP2) {
        PG8_STAGE(PG8_SB(0, 0), cB, voffB); PG8_STAGE(PG8_SB(0, 1), cB + hstepB, voffB); PG8_STAGE(PG8_SA(0, 0), cA, voffA); PG8_STAGE(PG8_SA(0, 1), cA + hstepA, voffA);
        if (wr == 1) PG8_BAR;
        PG8_WAIT_V(2); PG8_BAR;
        PG8_STAGE(PG8_SB(1, 0), cB + kstep, voffB); PG8_STAGE(PG8_SA(1, 0), cA + kstep, voffA); PG8_STAGE(PG8_SB(1, 1), cB + hstepB + kstep, voffB);
        PG8_WAIT_V(6); PG8_BAR;
    } else {
        PG8_STAGE(PG8_SB(0, 0), cB, voffB); PG8_STAGE(PG8_SA(0, 0), cA, voffA); PG8_STAGE(PG8_SB(0, 1), cB + hstepB, voffB); PG8_STAGE(PG8_SA(0, 1), cA + hstepA, voffA);
        if (wr == 1) PG8_BAR;
        PG8_WAIT_V(4); PG8_BAR;
        PG8_STAGE(PG8_SB(1, 0), cB + kstep, voffB); PG8_STAGE(PG8_SA(1, 0), cA + kstep, voffA); PG8_STAGE(PG8_SB(1, 1), cB + hstepB + kstep, voffB);
        PG8_WAIT_V(6); PG8_BAR;
    }
    for (;;) {
        const bool has_next = S.next(ui + 1, nxt);
        const char* nA = has_next ? (const char*)g.A + (size_t)nxt.pm * tstepA : cA; const char* nB = has_next ? (const char*)g.Bt + (size_t)nxt.pn * tstepB : cB;
        for (int t = 0; t < nt; t += 2) {
            const bool last = (t == nt - 2);
            const char* a1 = cA + (size_t)(t + 1) * kstep;
            const char* a2 = last ? nA : cA + (size_t)(t + 2) * kstep; const char* b2 = last ? nB : cB + (size_t)(t + 2) * kstep;
            const char* a3 = a2 + kstep; const char* b3 = b2 + kstep;
            if (last && has_next) S.a_ready(nxt);
            if constexpr (SP2) {
            PG8_LDB(B0, 0, 0); PG8_LDB(B1, 0, 1); PG8_SCHED; PG8_LDA(At, 0, 0); PG8_STAGE(PG8_SA(1, 1), a1 + hstepA, voffA);
            PG8_WAIT_V(8); PG8_WAIT_L(0); PG8_BAR; PG8_MMA(0, 0, At, B0); PG8_MMA(0, 1, At, B1); PG8_BAR; PG8_SCHED;
            PG8_LDA(At, 0, 1); PG8_STAGE(PG8_SB(0, 0), b2, voffB); PG8_STAGE(PG8_SB(0, 1), b2 + hstepB, voffB); PG8_STAGE(PG8_SA(0, 0), a2, voffA);
            PG8_WAIT_V(8); PG8_WAIT_L(0); PG8_BAR; PG8_MMA(1, 0, At, B0); PG8_MMA(1, 1, At, B1); PG8_BAR; PG8_SCHED;
            PG8_LDB(B0, 1, 0); PG8_LDB(B1, 1, 1); PG8_SCHED; PG8_LDA(At, 1, 0); PG8_STAGE(PG8_SA(0, 1), a2 + hstepA, voffA);
            PG8_WAIT_V(8); PG8_WAIT_L(0); PG8_BAR; PG8_MMA(0, 0, At, B0); PG8_MMA(0, 1, At, B1); PG8_BAR; PG8_SCHED;
            PG8_LDA(At, 1, 1); PG8_STAGE(PG8_SB(1, 0), b3, voffB); PG8_STAGE(PG8_SB(1, 1), b3 + hstepB, voffB); PG8_STAGE(PG8_SA(1, 0), a3, voffA);
            PG8_WAIT_V(8); PG8_WAIT_L(0); PG8_BAR; PG8_MMA(1, 0, At, B0); PG8_MMA(1, 1, At, B1); PG8_BAR; PG8_SCHED;
            } else {
            PG8_LDB(B0, 0, 0); PG8_SCHED; PG8_LDA(At, 0, 0); PG8_STAGE(PG8_SA(1, 1), a1 + hstepA, voffA);
            PG8_WAIT_L(8); PG8_BAR; PG8_WAIT_L(0); PG8_MMA(0, 0, At, B0); PG8_BAR; PG8_SCHED;
            PG8_LDB(B1, 0, 1); PG8_STAGE(PG8_SB(0, 0), b2, voffB);
            PG8_BAR; PG8_WAIT_L(0); PG8_MMA(0, 1, At, B1); PG8_BAR;
            PG8_LDA(At, 0, 1); PG8_STAGE(PG8_SA(0, 0), a2, voffA);
            PG8_BAR; PG8_WAIT_L(0); PG8_MMA(1, 0, At, B0); PG8_BAR; PG8_SCHED;
            PG8_STAGE(PG8_SB(0, 1), b2 + hstepB, voffB);
            PG8_WAIT_V(6); PG8_BAR; PG8_MMA(1, 1, At, B1); PG8_BAR;
            PG8_LDB(B0, 1, 0); PG8_SCHED; PG8_LDA(At, 1, 0); PG8_STAGE(PG8_SA(0, 1), a2 + hstepA, voffA);
            PG8_WAIT_L(8); PG8_BAR; PG8_WAIT_L(0); PG8_MMA(0, 0, At, B0); PG8_BAR; PG8_SCHED;
            PG8_LDB(B1, 1, 1); PG8_STAGE(PG8_SB(1, 0), b3, voffB);
            PG8_BAR; PG8_WAIT_L(0); PG8_MMA(0, 1, At, B1); PG8_BAR;
            PG8_LDA(At, 1, 1); PG8_STAGE(PG8_SA(1, 0), a3, voffA);
            PG8_BAR; PG8_WAIT_L(0); PG8_MMA(1, 0, At, B0); PG8_BAR; PG8_SCHED;
            PG8_STAGE(PG8_SB(1, 1), b3 + hstepB, voffB);
            PG8_WAIT_V(6); PG8_BAR; PG8_MMA(1, 1, At, B1); PG8_BAR;
            }
        }
        if constexpr (ALIGN_EPI) { if (wr == 0) PG8_BAR; }
        if constexpr (!Epi::AFTER_DRAIN) { E(acc, cur, wr, wc, fr, fq); S.done(cur); }
        if (!has_next) break;
#pragma unroll
        for (int a = 0; a < 2; ++a)
#pragma unroll
            for (int b = 0; b < 2; ++b)
#pragma unroll
                for (int m = 0; m < 4; ++m)
#pragma unroll
                    for (int n = 0; n < 2; ++n) acc[a][b][m][n] = (f32x4){0.f, 0.f, 0.f, 0.f};
        cur = nxt; cA = nA; cB = nB; ++ui;
        if constexpr (ALIGN_EPI) { if (wr == 1) PG8_BAR; }
    }
    PG8_WAIT_V(0);
    if constexpr (!ALIGN_EPI) { if (wr == 0) PG8_BAR; }
    PG8_BAR;
    if constexpr (Epi::AFTER_DRAIN) { E.fused(acc, cur, wr, wc, fr, fq, lds, wid, lane); S.done(cur); }
#undef PG8_SA
#undef PG8_SB
#undef PG8_STAGE
#undef PG8_LDA
#undef PG8_LDB
#undef PG8_MMA
#undef PG8_WAIT_V
#undef PG8_WAIT_L
#undef PG8_BAR
#undef PG8_SCHED
}
}

#define GAS __attribute__((address_space(1)))
#define LAS __attribute__((address_space(3)))
typedef unsigned short bf16;
typedef unsigned u32x4 __attribute__((ext_vector_type(4)));
typedef unsigned u32x2 __attribute__((ext_vector_type(2)));
typedef float f32x4 __attribute__((ext_vector_type(4)));
typedef float f32x2 __attribute__((ext_vector_type(2)));
typedef short bf16x8 __attribute__((ext_vector_type(8)));
typedef float f32x16 __attribute__((ext_vector_type(16)));
constexpr int DM = 1024, BATCH = 32, SEQ = 2048, NMETA = 16, TT = SEQ + NMETA, DIN = 2208, DINP = 2304, DFF = 4096, DEPTH = 2;
constexpr int MREAL = BATCH * SEQ, MR0 = MREAL, MV = MREAL + NMETA, M = MREAL + 256;
static_assert(MREAL % 256 == 0, "row tiles");
__device__ __forceinline__ int rowof(int b, int t) { return t < NMETA ? MR0 + t : b * SEQ + (t - NMETA); }
constexpr int C_CB = 0, C_CC = 256, C_CH = 512, C_RQ = 768, C_RK = 1024, C_RV = 1280, C_RG = 1536, C_CQ = 1792, C_CKV = 2048, C_KR = 2176;
constexpr float EPS = 1e-6f;
constexpr float QSCALE = 0.10206207261596575f * 1.4426950408889634f;
constexpr size_t MiB = 1u << 20;
constexpr size_t WS_RT = 1 * MiB, WS_MT = 1 * MiB + 768 * 1024;
constexpr size_t WS_WIN = 4 * MiB, WS_WUQ = 13 * MiB, WS_WUKV = 14 * MiB, WS_WOUT = 15 * MiB, WS_W1 = 19 * MiB, WS_W2 = 35 * MiB;
constexpr size_t WS_X = 52 * MiB, WS_XN = 310 * MiB, WS_PROJ = 440 * MiB, WS_QRAW = 731 * MiB, WS_KV = 828 * MiB, WS_H = 440 * MiB, WS_SSX = 958 * MiB, WS_SSQ = 964 * MiB, WS_SSKV = 966 * MiB, WS_SQA = 968 * MiB, WS_END = 969 * MiB;
static_assert(WS_X + (size_t)M * DM * 4 <= WS_XN && WS_XN + (size_t)M * DM * 2 <= WS_PROJ && WS_PROJ + (size_t)M * DINP * 2 <= WS_QRAW && WS_QRAW + (size_t)M * 768 * 2 <= WS_KV &&
              WS_KV + (size_t)M * 1024 * 2 <= WS_SSX && WS_H + (size_t)M * DFF * 2 <= WS_SSX && WS_SSX + (size_t)M * 64 <= WS_SSQ && WS_SSQ + (size_t)M * 16 <= WS_SSKV && WS_SSKV + (size_t)M * 16 <= WS_SQA && WS_SQA + (size_t)M * 4 <= WS_END, "d_ws map");
constexpr int NWAVES = 8, LDS_BYTES = 147456, XB_LDS_OFF = 131072 + 256;

__device__ __forceinline__ unsigned f2bf(float f) { unsigned u = __builtin_bit_cast(unsigned, f); return (u + 0x7fffu + ((u >> 16) & 1u)) >> 16; }
__device__ __forceinline__ unsigned pk2(float lo, float hi) { return f2bf(lo) | (f2bf(hi) << 16); }
__device__ __forceinline__ float bflo(unsigned w) { return __uint_as_float(w << 16); }
__device__ __forceinline__ float bfhi(unsigned w) { return __uint_as_float(w & 0xffff0000u); }
__device__ __forceinline__ float bf1(bf16 h) { return __uint_as_float((unsigned)h << 16); }
__device__ __forceinline__ float wave_sum(float v) {
#pragma unroll
    for (int o = 1; o < 64; o <<= 1) v += __shfl_xor(v, o);
    return v;
}
__device__ __forceinline__ float half_sum(float v) {
#pragma unroll
    for (int o = 1; o < 32; o <<= 1) v += __shfl_xor(v, o);
    return v;
}

namespace att {
typedef float f32x2_t __attribute__((ext_vector_type(2))); typedef __bf16 bf16x2_t __attribute__((ext_vector_type(2)));
__device__ __forceinline__ unsigned cvtpk(float lo, float hi) { f32x2_t v = {lo, hi}; bf16x2_t b = __builtin_convertvector(v, bf16x2_t); return __builtin_bit_cast(unsigned, b); }
constexpr int VP = 144;
__device__ __forceinline__ float xhalf_max(float v) { auto rr = __builtin_amdgcn_permlane32_swap(__float_as_uint(v), __float_as_uint(v), false, false); return fmaxf(__uint_as_float(rr[0]), __uint_as_float(rr[1])); }
__device__ __forceinline__ float xhalf_sum(float v) { auto rr = __builtin_amdgcn_permlane32_swap(__float_as_uint(v), __float_as_uint(v), false, false); return __uint_as_float(rr[0]) + __uint_as_float(rr[1]); }
template <int DQK, bool SM>
__device__ __forceinline__ void unit(LAS unsigned char* lds, const bf16* Q, int ldq, const bf16* K, int ldk, const bf16* V, int ldv, bf16* O, int ldo,
                                     const bf16* G, int ldg, const float* gain, float lg2, int b, int q0, int qend, const int tid_in, const float* sqa, const float* qgain, const f32x2* mtab) {
    constexpr int KP = DQK * 2 + 16, CH = DQK / 8, ND = DQK / 16, KB = 64 * KP, VB = 64 * VP, SB = KB + VB;
    int tid_o = tid_in; asm volatile("" : "+v"(tid_o));
    const int tid = tid_o, lane = tid & 63, wid = __builtin_amdgcn_readfirstlane(tid >> 6), r32 = lane & 31, hi = lane >> 5;
    const int q0w = q0 + 32 * wid, tq = q0w + r32;
    const bool wact = q0w < qend;
    bf16x8 qr[ND];
    const int qrow = rowof(b, tq < TT ? tq : TT - 1);
    { const bf16* qp = Q + (size_t)qrow * ldq + 8 * hi;
#pragma unroll
      for (int d0 = 0; d0 < ND; ++d0) qr[d0] = *(const bf16x8*)(qp + 16 * d0); }
    if (SM) {
        const int tpos = tq < TT ? tq : TT - 1;
        float ss = 0.f;
#pragma unroll
        for (int d0 = 0; d0 < ND; ++d0) { const u32x4 w = __builtin_bit_cast(u32x4, qr[d0]);
#pragma unroll
            for (int e = 0; e < 4; ++e) { const float a0 = bflo(w[e]), a1 = bfhi(w[e]); ss += a0 * a0 + a1 * a1; } }
        ss = xhalf_sum(ss);
        const float rs = QSCALE / sqrtf(ss * (1.f / 96.f) + EPS);
#pragma unroll
        for (int d0 = 0; d0 < 4; ++d0) { const u32x4 w = __builtin_bit_cast(u32x4, qr[d0]); const f32x4 g0 = *(const f32x4*)(qgain + 16 * d0 + 8 * hi), g1 = *(const f32x4*)(qgain + 16 * d0 + 8 * hi + 4); u32x4 o;
            o[0] = cvtpk(bflo(w[0]) * rs * g0[0], bfhi(w[0]) * rs * g0[1]); o[1] = cvtpk(bflo(w[1]) * rs * g0[2], bfhi(w[1]) * rs * g0[3]);
            o[2] = cvtpk(bflo(w[2]) * rs * g1[0], bfhi(w[2]) * rs * g1[1]); o[3] = cvtpk(bflo(w[3]) * rs * g1[2], bfhi(w[3]) * rs * g1[3]);
            qr[d0] = __builtin_bit_cast(bf16x8, o); }
        { const u32x4 w1 = __builtin_bit_cast(u32x4, qr[4]), w2 = __builtin_bit_cast(u32x4, qr[5]); const f32x4* cs = (const f32x4*)(mtab + tpos * 16 + 8 * hi);
          const float* ga = qgain + 64 + 8 * hi; const float* gb = qgain + 80 + 8 * hi; u32x4 o1, o2;
#pragma unroll
          for (int e = 0; e < 4; ++e) { const f32x4 c4 = cs[e];
              const float a0 = bflo(w1[e]) * rs * ga[2 * e], a1 = bfhi(w1[e]) * rs * ga[2 * e + 1], b0 = bflo(w2[e]) * rs * gb[2 * e], b1 = bfhi(w2[e]) * rs * gb[2 * e + 1];
              o1[e] = cvtpk(a0 * c4.x - b0 * c4.y, a1 * c4.z - b1 * c4.w); o2[e] = cvtpk(b0 * c4.x + a0 * c4.y, b1 * c4.z + a1 * c4.w); }
          qr[4] = __builtin_bit_cast(bf16x8, o1); qr[5] = __builtin_bit_cast(bf16x8, o2); }
    }
    const int ntiles = (qend - 1) / 64 + 1;
    const int nw = wact ? ((q0w + 31) / 64 + 1 < ntiles ? (q0w + 31) / 64 + 1 : ntiles) : 0;
    const int nfull = (q0w + 1) / 64;
    const int kkey0 = tid / CH, kch0 = tid % CH, kkey1 = (tid + 512) / CH, kch1 = (tid + 512) % CH;
    const bool has2 = (64 * CH > 512) && (tid + 512 < 64 * CH);
    const int vkey = tid & 63, vch = tid >> 6;
    const int pr32 = (r32 & 0x13) | ((r32 & 4) << 1) | ((r32 & 8) >> 1);
    const int koff = pr32 * KP + 16 * hi, voff = KB + r32 * VP + 16 * hi;
    u32x4 kreg0, kreg1 = {0u, 0u, 0u, 0u}, vreg;
#define ATT_LOAD(j) do { int r0_ = 64 * (j) + kkey0; r0_ = r0_ < TT ? r0_ : TT - 1; kreg0 = *(const u32x4*)(K + (size_t)rowof(b, r0_) * ldk + 8 * kch0); \
        if (has2) { int r1_ = 64 * (j) + kkey1; r1_ = r1_ < TT ? r1_ : TT - 1; kreg1 = *(const u32x4*)(K + (size_t)rowof(b, r1_) * ldk + 8 * kch1); } \
        int rv_ = 64 * (j) + vkey; rv_ = rv_ < TT ? rv_ : TT - 1; vreg = *(const u32x4*)(V + (size_t)rowof(b, rv_) * ldv + 8 * vch); } while (0)
#define ATT_STORE(so) do { *(LAS u32x4*)(lds + (so) + kkey0 * KP + 16 * kch0) = kreg0; if (has2) *(LAS u32x4*)(lds + (so) + kkey1 * KP + 16 * kch1) = kreg1; \
        LAS unsigned char* vd_ = lds + (so) + KB + (8 * vch) * VP + 2 * vkey; \
        _Pragma("unroll") for (int i_ = 0; i_ < 8; ++i_) { const unsigned w_ = vreg[i_ >> 1]; *(LAS unsigned short*)(vd_ + i_ * VP) = (unsigned short)((i_ & 1) ? (w_ >> 16) : (w_ & 0xffffu)); } } while (0)
#define ATT_KREAD(so) do { const LAS unsigned char* kb_ = lds + (so) + koff; \
        _Pragma("unroll") for (int d0 = 0; d0 < ND; ++d0) { kf0[d0] = *(const LAS bf16x8*)(kb_ + 32 * d0); kf1[d0] = *(const LAS bf16x8*)(kb_ + 32 * KP + 32 * d0); } } while (0)
#define ATT_VREAD(so) do { const LAS unsigned char* vb_ = lds + (so) + voff; \
        _Pragma("unroll") for (int ks = 0; ks < 4; ++ks) { vf0[ks] = *(const LAS bf16x8*)(vb_ + 32 * ks); vf1[ks] = *(const LAS bf16x8*)(vb_ + 32 * VP + 32 * ks); } } while (0)
#define ATT_QKM(S0, S1) do { \
        _Pragma("unroll") for (int r_ = 0; r_ < 16; ++r_) { S0[r_] = 0.f; S1[r_] = 0.f; } \
        _Pragma("unroll") for (int d0 = 0; d0 < ND; ++d0) { \
            S0 = __builtin_amdgcn_mfma_f32_32x32x16_bf16(kf0[d0], qr[d0], S0, 0, 0, 0); S1 = __builtin_amdgcn_mfma_f32_32x32x16_bf16(kf1[d0], qr[d0], S1, 0, 0, 0); } } while (0)
#define ATT_QKI(S0, S1, so) do { const LAS unsigned char* kb_ = lds + (so) + koff; \
        _Pragma("unroll") for (int r_ = 0; r_ < 16; ++r_) { S0[r_] = 0.f; S1[r_] = 0.f; } \
        _Pragma("unroll") for (int d0 = 0; d0 < ND; ++d0) { const bf16x8 k0_ = *(const LAS bf16x8*)(kb_ + 32 * d0), k1_ = *(const LAS bf16x8*)(kb_ + 32 * KP + 32 * d0); \
            S0 = __builtin_amdgcn_mfma_f32_32x32x16_bf16(k0_, qr[d0], S0, 0, 0, 0); S1 = __builtin_amdgcn_mfma_f32_32x32x16_bf16(k1_, qr[d0], S1, 0, 0, 0); } } while (0)
#define ATT_TILE(j, so, MASK, VPRE) do { const int kbase_ = 64 * (j) + 8 * hi; \
        if (SM) { \
            if (MASK) { _Pragma("unroll") for (int r = 0; r < 16; ++r) { const int kk = kbase_ + 16 * (r >> 3) + (r & 7); if (kk > tq) s0[r] = -INFINITY; if (kk + 32 > tq) s1[r] = -INFINITY; } } \
            float mx = fmaxf(s0[0], s1[0]); \
            _Pragma("unroll") for (int r = 1; r < 16; ++r) mx = fmaxf(mx, fmaxf(s0[r], s1[r])); \
            mx = xhalf_max(mx); \
            const float mn = fmaxf(m_run, mx), alpha = __builtin_amdgcn_exp2f(m_run - mn); m_run = mn; \
            float ps = 0.f; \
            _Pragma("unroll") for (int r = 0; r < 16; ++r) { s0[r] = __builtin_amdgcn_exp2f(s0[r] - mn); s1[r] = __builtin_amdgcn_exp2f(s1[r] - mn); ps += s0[r] + s1[r]; } \
            l_run = l_run * alpha + ps; \
            _Pragma("unroll") for (int r = 0; r < 16; ++r) { o0[r] *= alpha; o1[r] *= alpha; } \
        } else { \
            const float rf0 = __builtin_amdgcn_exp2f(lg2 * (float)(tq - kbase_)), rf1 = rf0 * c32; \
            _Pragma("unroll") for (int r = 0; r < 16; ++r) { s0[r] = (s0[r] * cfac[r]) * rf0; s1[r] = (s1[r] * cfac[r]) * rf1; } \
            if (MASK) { _Pragma("unroll") for (int r = 0; r < 16; ++r) { const int kk = kbase_ + 16 * (r >> 3) + (r & 7); if (kk > tq) s0[r] = 0.f; if (kk + 32 > tq) s1[r] = 0.f; } } \
        } \
        u32x4 pw[4]; \
        _Pragma("unroll") for (int ks = 0; ks < 2; ++ks) { \
            pw[ks] = (u32x4){cvtpk(s0[8 * ks], s0[8 * ks + 1]), cvtpk(s0[8 * ks + 2], s0[8 * ks + 3]), cvtpk(s0[8 * ks + 4], s0[8 * ks + 5]), cvtpk(s0[8 * ks + 6], s0[8 * ks + 7])}; \
            pw[2 + ks] = (u32x4){cvtpk(s1[8 * ks], s1[8 * ks + 1]), cvtpk(s1[8 * ks + 2], s1[8 * ks + 3]), cvtpk(s1[8 * ks + 4], s1[8 * ks + 5]), cvtpk(s1[8 * ks + 6], s1[8 * ks + 7])}; } \
        const LAS unsigned char* vb_ = lds + (so) + voff; \
        _Pragma("unroll") for (int ks = 0; ks < 4; ++ks) { const bf16x8 pf_ = __builtin_bit_cast(bf16x8, pw[ks]); \
            const bf16x8 v0_ = (VPRE) ? vf0[ks] : *(const LAS bf16x8*)(vb_ + 32 * ks), v1_ = (VPRE) ? vf1[ks] : *(const LAS bf16x8*)(vb_ + 32 * VP + 32 * ks); \
            o0 = __builtin_amdgcn_mfma_f32_32x32x16_bf16(v0_, pf_, o0, 0, 0, 0); o1 = __builtin_amdgcn_mfma_f32_32x32x16_bf16(v1_, pf_, o1, 0, 0, 0); } } while (0)
    f32x16 o0, o1, s0, s1, t0, t1; bf16x8 kf0[ND], kf1[ND], vf0[4], vf1[4];
#pragma unroll
    for (int r = 0; r < 16; ++r) { o0[r] = 0.f; o1[r] = 0.f; s0[r] = 0.f; s1[r] = 0.f; t0[r] = 0.f; t1[r] = 0.f; }
    float m_run = -INFINITY, l_run = 0.f;
    float cfac[16]; const float c32 = SM ? 0.f : __builtin_amdgcn_exp2f(-32.f * lg2);
#pragma unroll
    for (int r = 0; r < 16; ++r) cfac[r] = SM ? 0.f : __builtin_amdgcn_exp2f(-lg2 * (float)(16 * (r >> 3) + (r & 7)));
    int so_c = 0, so_n = SB, so_nn = 2 * SB;
    ATT_LOAD(0); ATT_STORE(0);
    if (ntiles > 1) { ATT_LOAD(1); ATT_STORE(SB); }
    __syncthreads();
    if (nw > 0) ATT_QKI(s0, s1, 0);
    for (int j = 0; j < ntiles; ++j) {
        if (j + 2 < ntiles) ATT_LOAD(j + 2);
        if (j + 1 < nw && j < nfull) {
            if (SM) {
                ATT_QKI(t0, t1, so_n);
                ATT_TILE(j, so_c, false, false);
            } else if (wid < 4) {
                ATT_KREAD(so_n); ATT_VREAD(so_c); __builtin_amdgcn_sched_barrier(0);
                ATT_QKM(t0, t1);
                ATT_TILE(j, so_c, false, true);
            } else {
                ATT_VREAD(so_c); __builtin_amdgcn_sched_barrier(0);
                ATT_TILE(j, so_c, false, true); __builtin_amdgcn_sched_barrier(0);
                ATT_KREAD(so_n); __builtin_amdgcn_sched_barrier(0);
                ATT_QKM(t0, t1);
            }
#pragma unroll
            for (int r = 0; r < 16; ++r) { s0[r] = t0[r]; s1[r] = t1[r]; }
        } else if (j < nw) {
            if (SM) { if (j + 1 < nw) ATT_QKI(t0, t1, so_n); ATT_TILE(j, so_c, true, false); }
            else { if (j + 1 < nw) { ATT_KREAD(so_n); ATT_VREAD(so_c); __builtin_amdgcn_sched_barrier(0); ATT_QKM(t0, t1); } else { ATT_VREAD(so_c); }
                   ATT_TILE(j, so_c, true, true); }
#pragma unroll
            for (int r = 0; r < 16; ++r) { s0[r] = t0[r]; s1[r] = t1[r]; }
        }
        if (j + 2 < ntiles) ATT_STORE(so_nn);
        __syncthreads();
        { const int t_ = so_c; so_c = so_n; so_n = so_nn; so_nn = t_; }
    }
#undef ATT_LOAD
#undef ATT_STORE
#undef ATT_KREAD
#undef ATT_VREAD
#undef ATT_QKM
#undef ATT_QKI
#undef ATT_TILE
    if (wact) {
        if (SM) {
            const float l = xhalf_sum(l_run), inv = 1.f / l;
            if (tq < qend) { bf16* op = O + (size_t)qrow * ldo + 4 * hi;
#pragma unroll
                for (int g = 0; g < 4; ++g) {
                    u32x2 a, bq; a.x = cvtpk(o0[4 * g] * inv, o0[4 * g + 1] * inv); a.y = cvtpk(o0[4 * g + 2] * inv, o0[4 * g + 3] * inv);
                    bq.x = cvtpk(o1[4 * g] * inv, o1[4 * g + 1] * inv); bq.y = cvtpk(o1[4 * g + 2] * inv, o1[4 * g + 3] * inv);
                    *(u32x2*)(op + 8 * g) = a; *(u32x2*)(op + 32 + 8 * g) = bq; } }
        } else {
            float ss = 0.f;
#pragma unroll
            for (int r = 0; r < 16; ++r) ss += o0[r] * o0[r] + o1[r] * o1[r];
            ss = xhalf_sum(ss);
            const float rs = 1.0f / sqrtf(ss * (1.f / 64.f) + EPS);
            if (tq < qend) { bf16* op = O + (size_t)qrow * ldo + 4 * hi; const bf16* gp = G + (size_t)qrow * ldg + 4 * hi; const float* gn = gain + 4 * hi;
#pragma unroll
                for (int g = 0; g < 4; ++g) {
#pragma unroll
                    for (int db = 0; db < 2; ++db) {
                        const u32x2 gw = *(const u32x2*)(gp + 32 * db + 8 * g); const f32x4 ga = *(const f32x4*)(gn + 32 * db + 8 * g);
                        float gv[4] = {bflo(gw.x), bfhi(gw.x), bflo(gw.y), bfhi(gw.y)}; float y[4];
#pragma unroll
                        for (int e = 0; e < 4; ++e) { const float ov = db ? o1[4 * g + e] : o0[4 * g + e]; const float sg = gv[e] / (1.f + __expf(-gv[e])); y[e] = ov * rs * ga[e] * sg; }
                        u32x2 w; w.x = cvtpk(y[0], y[1]); w.y = cvtpk(y[2], y[3]); *(u32x2*)(op + 32 * db + 8 * g) = w; } } }
        }
    }
}
}

struct Args { const float* in[16]; float* out; unsigned char* ws; int ph_lo, ph_hi; };
typedef const __attribute__((address_space(4))) Args* KArgsP;
#define RT   ((f32x2*)(ws + WS_RT))
#define MT   ((f32x2*)(ws + WS_MT))
#define WIN  ((bf16*)(ws + WS_WIN))
#define WUQ  ((bf16*)(ws + WS_WUQ))
#define WUKV ((bf16*)(ws + WS_WUKV))
#define WOUT ((bf16*)(ws + WS_WOUT))
#define W1   ((bf16*)(ws + WS_W1))
#define W2   ((bf16*)(ws + WS_W2))
#define XR   ((bf16*)(ws + WS_X))
#define XN   ((bf16*)(ws + WS_XN))
#define MIX  ((bf16*)(ws + WS_XN))
#define PROJ ((bf16*)(ws + WS_PROJ))
#define QRAW ((bf16*)(ws + WS_QRAW))
#define KVR  ((bf16*)(ws + WS_KV))
#define HB   ((bf16*)(ws + WS_H))
#define SSX  ((float*)(ws + WS_SSX))
#define SSQ  ((float*)(ws + WS_SSQ))
#define SSKV ((float*)(ws + WS_SSKV))
#define SQA  ((float*)(ws + WS_SQA))
enum { I_X = 0, I_META, I_ANG, I_WIN, I_CONVW, I_RETG, I_QNG, I_WUQ, I_KVNG, I_WUKV, I_QHG, I_KHG, I_WOUT, I_MLPG, I_W1, I_W2 };
constexpr int NPP = 7, NPHASE = 1 + NPP * DEPTH;

__device__ __forceinline__ void p0_transpose_item(const float* W, const float* gk, int K, int N, bf16* WT, LAS float* scr, int item, int lane) {
    const int nblk = N / 32, kb = item / nblk, nb = item % nblk, k0 = 64 * kb, n0 = 32 * nb;
#pragma unroll 8
    for (int i = 0; i < 32; ++i) { const int kk = 2 * i + (lane >> 5); const float gv = gk ? gk[k0 + kk] : 1.f; scr[kk * 33 + (lane & 31)] = W[(size_t)(k0 + kk) * N + n0 + (lane & 31)] * gv; }
    asm volatile("s_waitcnt lgkmcnt(0)" ::: "memory");
    const int c = lane & 7;
#pragma unroll
    for (int j = 0; j < 4; ++j) { const int n = (lane >> 3) + 8 * j; const LAS float* s = scr + (8 * c) * 33 + n;
        u32x4 o; o.x = pk2(s[0 * 33], s[1 * 33]); o.y = pk2(s[2 * 33], s[3 * 33]); o.z = pk2(s[4 * 33], s[5 * 33]); o.w = pk2(s[6 * 33], s[7 * 33]);
        *(u32x4*)(WT + (size_t)(n0 + n) * K + k0 + 8 * c) = o; }
    asm volatile("s_waitcnt lgkmcnt(0)" ::: "memory");
}
__device__ __forceinline__ void row_prep(const float* xrow, bf16* orow, float* ss16, int lane) {
    const f32x4* xr = (const f32x4*)xrow + lane;
    f32x4 v[4]; float s = 0.f;
#pragma unroll
    for (int j = 0; j < 4; ++j) { v[j] = xr[64 * j]; s += (v[j].x * v[j].x + v[j].y * v[j].y) + (v[j].z * v[j].z + v[j].w * v[j].w); }
    const float tot = wave_sum(s);
    if (lane < 16) ss16[lane] = lane == 0 ? tot : 0.f;
    unsigned long long* o8 = (unsigned long long*)orow + lane;
#pragma unroll
    for (int j = 0; j < 4; ++j) o8[64 * j] = (unsigned long long)att::cvtpk(v[j].x, v[j].y) | ((unsigned long long)att::cvtpk(v[j].z, v[j].w) << 32);
}
__device__ __forceinline__ f32x2 cossin(float ang) {
    const float n = rintf(ang * 0.15915494309189535f);
    float r = fmaf(-n, 6.28125f, ang); r = fmaf(-n, 0.0019353071795864769f, r);
    const float rev = r * 0.15915494309189535f;
    f32x2 o; o.x = __builtin_amdgcn_cosf(rev); o.y = __builtin_amdgcn_sinf(rev); return o;
}

#define XB_TMO      128
#define XB_XCNT(j)  (256  + 64 * (j))
#define XB_XSUB(j)  (1280 + 64 * (j))
#define XB_XGEN(j)  (2304 + 64 * (j))
#define XB_TOP      3328
#define XB_TOPGEN   3392
#define XCD_BAR_WORDS 3456
#define XB_SPIN_CAP (1u << 18)

__device__ __forceinline__ unsigned xb_ld(unsigned* p)              { return __hip_atomic_load(p, __ATOMIC_RELAXED, __HIP_MEMORY_SCOPE_AGENT); }
__device__ __forceinline__ unsigned xb_add(unsigned* p, unsigned v) { return __hip_atomic_fetch_add(p, v, __ATOMIC_RELAXED, __HIP_MEMORY_SCOPE_AGENT); }
__device__ __forceinline__ unsigned xb_xcc_id() { return (unsigned)__builtin_amdgcn_s_getreg((3 << 11) | 20) & 0xFu; }
#define XB_SPIN(cond, bar) do { unsigned _sp = 0; while (cond) { __builtin_amdgcn_s_sleep(1); \
    if ((++_sp & 255u) == 0u) { if (xb_ld(&(bar)[XB_TMO])) break; if (_sp > XB_SPIN_CAP) { atomicAdd(&(bar)[XB_TMO], 1u); break; } } } } while (0)

struct XcdBarrier {
    unsigned* bar; unsigned x;
    volatile LAS unsigned* st;
};

__device__ __forceinline__ XcdBarrier xcd_barrier_post(unsigned* bar, volatile LAS unsigned* st) {
    XcdBarrier b; b.bar = bar; b.x = xb_xcc_id(); b.st = st;
    if (threadIdx.x == 0) (void)xb_add(&bar[XB_XCNT(b.x)], 1u);
    return b;
}
__device__ __forceinline__ void xcd_barrier_complete(unsigned* bar, unsigned x, unsigned& nloc, unsigned& nx) {
    const unsigned G = gridDim.x * gridDim.y * gridDim.z;
    unsigned sum, cnt, mine, sp = 0u;
    for (;;) {
        sum = 0u; cnt = 0u; mine = 0u;
#pragma unroll
        for (unsigned j = 0; j < 16; ++j) { const unsigned c = xb_ld(&bar[XB_XCNT(j)]); sum += c; cnt += (c > 0u) ? 1u : 0u; mine = (j == x) ? c : mine; }
        if (sum == G) break;
        __builtin_amdgcn_s_sleep(1);
        if ((++sp & 255u) == 0u) { if (xb_ld(&bar[XB_TMO])) break; if (sp > XB_SPIN_CAP) { atomicAdd(&bar[XB_TMO], 1u); break; } }
    }
    nloc = mine > 0u ? mine : 1u; nx = cnt > 0u ? cnt : 1u;
}

__device__ __forceinline__ void xcd_barrier(const XcdBarrier& b) {
    asm volatile("s_waitcnt vmcnt(0)" ::: "memory");
    __syncthreads();
    if (threadIdx.x == 0) {
        unsigned* bar = b.bar;
        __builtin_amdgcn_s_waitcnt(0);
        unsigned nloc = b.st[0], nx = b.st[1];
        if (nloc == 0u) { xcd_barrier_complete(bar, b.x, nloc, nx); b.st[0] = nloc; b.st[1] = nx; }
        const unsigned old = xb_add(&bar[XB_XSUB(b.x)], 1u);
        const unsigned gen = old / nloc;
        if (old + 1u == (gen + 1u) * nloc) {
            __builtin_amdgcn_fence(__ATOMIC_RELEASE, "agent");
            asm volatile("s_waitcnt vmcnt(0)" ::: "memory");
            const unsigned og = xb_add(&bar[XB_TOP], 1u);
            const unsigned tg = og / nx;
            if (og + 1u == (tg + 1u) * nx) xb_add(&bar[XB_TOPGEN], 1u);
            else XB_SPIN(xb_ld(&bar[XB_TOPGEN]) == tg, bar);
            __builtin_amdgcn_fence(__ATOMIC_ACQUIRE, "agent");
            xb_add(&bar[XB_XGEN(b.x)], 1u);
            asm volatile("s_waitcnt vmcnt(0)" ::: "memory");
        } else {
            XB_SPIN(xb_ld(&bar[XB_XGEN(b.x)]) == gen, bar);
            __builtin_amdgcn_fence(__ATOMIC_ACQUIRE, "agent");
            asm volatile("s_waitcnt vmcnt(0)" ::: "memory");
        }
    }
    __syncthreads();
}

struct EpiMeta { int mode, need_rs; float rs_div; bf16* O; int ldc; bf16* xr; };
__device__ __forceinline__ void meta_gemm(const bf16* A, int lda, const bf16* Bt, int N, int K, const EpiMeta& E, int gw, int NGW, int lane) {
    for (int n = gw; n < N; n += NGW) {
        float acc[16], ssa[16];
#pragma unroll
        for (int r = 0; r < 16; ++r) { acc[r] = 0.f; ssa[r] = 0.f; }
        for (int c = lane; c < K / 8; c += 64) {
            const u32x4 w = *(const u32x4*)(Bt + (size_t)n * K + 8 * c);
            float wf[8];
#pragma unroll
            for (int e = 0; e < 4; ++e) { wf[2 * e] = bflo(w[e]); wf[2 * e + 1] = bfhi(w[e]); }
#pragma unroll
            for (int r = 0; r < 16; ++r) { const u32x4 a = *(const u32x4*)(A + (size_t)r * lda + 8 * c);
#pragma unroll
                for (int e = 0; e < 4; ++e) { const float a0 = bflo(a[e]), a1 = bfhi(a[e]); acc[r] += a0 * wf[2 * e] + a1 * wf[2 * e + 1]; ssa[r] += a0 * a0 + a1 * a1; } }
        }
        float mine = 0.f, myss = 0.f;
#pragma unroll
        for (int r = 0; r < 16; ++r) { const float s = wave_sum(acc[r]), q = E.need_rs ? wave_sum(ssa[r]) : 0.f; if (lane == r) { mine = s; myss = q; } }
        if (lane < 16) { const int r = lane;
            if (E.mode < 2) { float v = mine * (E.need_rs ? 1.0f / sqrtf(myss * E.rs_div + EPS) : 1.f); if (E.mode == 1) { v = fmaxf(v, 0.f); v = v * v; } E.O[(size_t)(MR0 + r) * E.ldc + n] = (bf16)f2bf(v); }
            else { bf16* p = E.xr + (size_t)(MR0 + r) * DM + n; *p = (bf16)f2bf(bf1(*p) + mine); } }
    }
}

__global__ void __launch_bounds__(NWAVES * 64, 2) hybrid_fwd(Args args) {
    extern __shared__ __attribute__((aligned(16))) unsigned char lds_raw[];
    LAS unsigned char* lds = (LAS unsigned char*)lds_raw;
    cg::grid_group grid = cg::this_grid();
    const int G = gridDim.x, NGW = G * NWAVES;
    const int wave_s = __builtin_amdgcn_readfirstlane((int)threadIdx.x >> 6);
    if (threadIdx.x < 2) ((LAS unsigned*)(lds + XB_LDS_OFF))[threadIdx.x] = 0u;
    __syncthreads();
    if (args.ph_hi - args.ph_lo > 1) (void)xcd_barrier_post((unsigned*)args.ws, (volatile LAS unsigned*)(lds + XB_LDS_OFF));
    const int lo = args.ph_lo, hi = args.ph_hi;
    for (int ph = lo; ph < hi; ++ph) {
        KArgsP ap = (KArgsP)__builtin_amdgcn_kernarg_segment_ptr(); asm volatile("" : "+s"(ap));
        unsigned char* const ws = ap->ws;
        int wave = wave_s; asm volatile("" : "+s"(wave));
        int lane = (int)__builtin_amdgcn_mbcnt_hi(~0u, __builtin_amdgcn_mbcnt_lo(~0u, 0u)); asm volatile("" : "+v"(lane));
        const int tid = wave * 64 + lane, gw = blockIdx.x * NWAVES + wave;
        const int l = ph == 0 ? 0 : (ph - 1) / NPP, k = ph == 0 ? -1 : (ph - 1) % NPP;
        if (k == -1) {
            LAS float* scr = (LAS float*)(lds + wave * 16384);
            constexpr int I_IN = 16 * 69, I_UQ = 4 * 24, I_UKV = 2 * 32, I_O = 16 * 32, I_1 = 16 * 128, I_2 = 64 * 32, I_L = I_IN + I_UQ + I_UKV + I_O + I_1 + I_2;
            for (int it = gw; it < DEPTH * I_L; it += NGW) {
                const int ll = it / I_L; int r = it - ll * I_L;
                if (r < I_IN) { p0_transpose_item(ap->in[I_WIN] + (size_t)ll * DM * DIN, ap->in[I_ANG] + ll * DM, DM, DIN, WIN + (size_t)ll * DINP * DM, scr, r, lane); continue; } r -= I_IN;
                if (r < I_UQ) { p0_transpose_item(ap->in[I_WUQ] + (size_t)ll * 256 * 768, ap->in[I_QNG] + ll * 256, 256, 768, WUQ + (size_t)ll * 768 * 256, scr, r, lane); continue; } r -= I_UQ;
                if (r < I_UKV) { p0_transpose_item(ap->in[I_WUKV] + (size_t)ll * 128 * 1024, ap->in[I_KVNG] + ll * 128, 128, 1024, WUKV + (size_t)ll * 1024 * 128, scr, r, lane); continue; } r -= I_UKV;
                if (r < I_O) { p0_transpose_item(ap->in[I_WOUT] + (size_t)ll * DM * DM, nullptr, DM, DM, WOUT + (size_t)ll * DM * DM, scr, r, lane); continue; } r -= I_O;
                if (r < I_1) { p0_transpose_item(ap->in[I_W1] + (size_t)ll * DM * DFF, ap->in[I_MLPG] + ll * DM, DM, DFF, W1 + (size_t)ll * DFF * DM, scr, r, lane); continue; } r -= I_1;
                p0_transpose_item(ap->in[I_W2] + (size_t)ll * DFF * DM, nullptr, DFF, DM, W2 + (size_t)ll * DM * DFF, scr, r, lane);
            }
            for (int it = gw; it < DEPTH * (DINP - DIN); it += NGW) {
                const int ll = it / (DINP - DIN), r = DIN + it % (DINP - DIN); u32x4* p = (u32x4*)(WIN + ((size_t)ll * DINP + r) * DM) + lane;
                u32x4 z = {0u, 0u, 0u, 0u}; asm volatile("" : "+v"(z));
                p[0] = z; p[64] = z;
            }
            for (int e = blockIdx.x * 512 + tid; e < TT * 32; e += G * 512) { const int t = e >> 5, i = e & 31; const float inv = exp2f(-13.287712379549449f * (float)(2 * i) * (1.f / 64.f)); RT[e] = cossin((float)t * inv); }
            for (int e = blockIdx.x * 512 + tid; e < TT * 16; e += G * 512) { const int t = e >> 4, i = e & 15; const float inv = exp2f(-13.287712379549449f * (float)(2 * i) * (1.f / 32.f)); MT[e] = cossin((float)t * inv); }
            for (int m = gw; m < MV; m += NGW) {
                const float* src = m >= MR0 ? ap->in[I_META] + (size_t)(m - MR0) * DM : ap->in[I_X] + (size_t)m * DM;
                row_prep(src, XR + (size_t)m * DM, SSX + (size_t)m * 16, lane); }
        } else if (k == 0 || k == 1 || k == 4 || k == 5 || k == 6) {
            const int ng = k == 1 ? 2 : 1;
            for (int gi = 0; gi < ng; ++gi) {
                pg8::Gemm g; pg8::EpiAny E; E.xr = XR; E.out = ap->out; E.O = nullptr; E.ldc = 0; E.ssx = SSX; E.rs_src = nullptr; E.rs_cnt = 16; E.rs_div = 1.f / 1024.f; E.ssq = nullptr; E.sskv = nullptr;
                EpiMeta Em; Em.need_rs = 0; Em.rs_div = 1.f / 1024.f; Em.O = nullptr; Em.ldc = 0; Em.xr = XR;
                if (k == 0)      { g = pg8::Gemm{XR, WIN + (size_t)l * DINP * DM, MREAL, DINP, DM, DM}; E.mode = 0; E.perm = 1; E.O = PROJ; E.ldc = DINP; E.rs_src = SSX; E.ssq = SSQ; E.sskv = SSKV; Em.need_rs = 1; }
                else if (k == 1 && gi == 0) { g = pg8::Gemm{PROJ + C_CQ, WUQ + (size_t)l * 768 * 256, MREAL, 768, 256, DINP}; E.mode = 0; E.perm = 1; E.O = QRAW; E.ldc = 768; E.rs_src = SSQ; E.rs_cnt = 4; E.rs_div = 1.f / 256.f; Em.need_rs = 1; Em.rs_div = 1.f / 256.f; }
                else if (k == 1) { g = pg8::Gemm{PROJ + C_CKV, WUKV + (size_t)l * 1024 * 128, MREAL, 1024, 128, DINP}; E.mode = 0; E.perm = 1; E.O = KVR; E.ldc = 1024; E.rs_src = SSKV; E.rs_cnt = 4; E.rs_div = 1.f / 128.f; Em.need_rs = 1; Em.rs_div = 1.f / 128.f; }
                else if (k == 4) { g = pg8::Gemm{MIX, WOUT + (size_t)l * DM * DM, MREAL, DM, DM, DM}; E.mode = 2; E.perm = 0; }
                else if (k == 5) { g = pg8::Gemm{XR, W1 + (size_t)l * DFF * DM, MREAL, DFF, DM, DM}; E.mode = 1; E.perm = 1; E.O = HB; E.ldc = DFF; E.rs_src = SSX; Em.need_rs = 1; }
                else             { g = pg8::Gemm{HB, W2 + (size_t)l * DM * DFF, MREAL, DM, DFF, DFF}; E.mode = (l == DEPTH - 1) ? 3 : 2; E.perm = 0; }
                Em.mode = E.mode; Em.O = E.O; Em.ldc = E.ldc;
                pg8::StaticOrder S; S.init(MREAL, g.N, G, (int)blockIdx.x);
                pg8::gemm_phase<pg8::EpiAny, pg8::StaticOrder, true, true>(lds, g, S, E, tid);
                if (E.mode != 3) meta_gemm(g.A + (size_t)MR0 * g.lda, g.lda, g.Bt, g.N, g.K, Em, gw, NGW, lane);
            }
            if (k == 1) {
                const float* cw = ap->in[I_CONVW] + l * 3 * 256;
                for (int it = blockIdx.x * 512 + tid; it < MV * 32; it += G * 512) {
                    const int m = it >> 5, c = (it & 31) * 8; const int t = m >= MR0 ? m - MR0 : (m & (SEQ - 1)) + NMETA; const bf16* pr = PROJ + (size_t)m * DINP;
                    const u32x4 cbv = *(const u32x4*)(pr + C_CB + c); float a[8];
#pragma unroll
                    for (int e = 0; e < 8; ++e) a[e] = 0.f;
#pragma unroll
                    for (int j = 0; j < 3; ++j) { const int tj = t - 2 + j; if (tj >= 0) { const int mj = (m >= MR0 || tj >= NMETA) ? m - (2 - j) : MR0 + tj;
                            const bf16* p2 = PROJ + (size_t)mj * DINP; const u32x4 ccv = *(const u32x4*)(p2 + C_CC + c), chv = *(const u32x4*)(p2 + C_CH + c);
                            const f32x4 w0 = *(const f32x4*)(cw + j * 256 + c), w1 = *(const f32x4*)(cw + j * 256 + c + 4);
#pragma unroll
                            for (int e = 0; e < 4; ++e) { const float wl = e < 2 ? w0[2 * e] : w1[2 * e - 4], wh = e < 2 ? w0[2 * e + 1] : w1[2 * e - 3];
                                a[2 * e] += wl * (bflo(ccv[e]) * bflo(chv[e])); a[2 * e + 1] += wh * (bfhi(ccv[e]) * bfhi(chv[e])); } } }
                    u32x4 o;
#pragma unroll
                    for (int e = 0; e < 4; ++e) o[e] = att::cvtpk(bflo(cbv[e]) * a[2 * e], bfhi(cbv[e]) * a[2 * e + 1]);
                    *(u32x4*)(MIX + (size_t)m * DM + c) = o;
                }
                for (int it = blockIdx.x * 512 + tid; it < MV * 32; it += G * 512) {
                    const int m = it >> 5, j = it & 31, w = j >> 4, h = (j >> 2) & 3, i0 = (j & 3) * 8; const int t = m >= MR0 ? m - MR0 : (m & (SEQ - 1)) + NMETA;
                    bf16* p = PROJ + (size_t)m * DINP + (w ? C_RK : C_RQ) + 64 * h + i0; const float sc = w ? 0.125f : 1.f;
                    const u32x4 x1 = *(const u32x4*)p, x2 = *(const u32x4*)(p + 32); const f32x4* cs = (const f32x4*)(RT + t * 32 + i0);
                    u32x4 o1, o2;
#pragma unroll
                    for (int e = 0; e < 4; ++e) { const f32x4 c4 = cs[e]; const float a0 = bflo(x1[e]), a1 = bfhi(x1[e]), b0 = bflo(x2[e]), b1 = bfhi(x2[e]);
                        o1[e] = att::cvtpk((a0 * c4.x - b0 * c4.y) * sc, (a1 * c4.z - b1 * c4.w) * sc); o2[e] = att::cvtpk((b0 * c4.x + a0 * c4.y) * sc, (b1 * c4.z + a1 * c4.w) * sc); }
                    *(u32x4*)p = o1; *(u32x4*)(p + 32) = o2;
                }
            }
        } else if (k == 2) {
            const float* kg = ap->in[I_KHG] + l * 96;
            for (int it = blockIdx.x * 512 + tid; it < MV * 8; it += G * 512) {
                const int m = it >> 3, h = it & 7; const int t = m >= MR0 ? m - MR0 : (m & (SEQ - 1)) + NMETA;
                const f32x4* mt = (const f32x4*)(MT + t * 16);
                { bf16* kn = KVR + (size_t)m * 1024 + 128 * h; bf16* pr = PROJ + (size_t)m * DINP; bf16* ko = pr + 96 * h; u32x4 w[8], r[4]; float ssn = 0.f, ssr = 0.f;
#pragma unroll
                  for (int c = 0; c < 8; ++c) w[c] = *(const u32x4*)(kn + 8 * c);
#pragma unroll
                  for (int c = 0; c < 4; ++c) r[c] = *(const u32x4*)(pr + C_KR + 8 * c);
#pragma unroll
                  for (int c = 0; c < 8; ++c)
#pragma unroll
                      for (int e = 0; e < 4; ++e) { const float a0 = bflo(w[c][e]), a1 = bfhi(w[c][e]); ssn += a0 * a0 + a1 * a1; }
#pragma unroll
                  for (int c = 0; c < 4; ++c)
#pragma unroll
                      for (int e = 0; e < 4; ++e) { const float a0 = bflo(r[c][e]), a1 = bfhi(r[c][e]); ssr += a0 * a0 + a1 * a1; }
                  const float rs = 1.0f / sqrtf((ssn + ssr) * (1.f / 96.f) + EPS), rn = rs;
#pragma unroll
                  for (int c = 0; c < 8; ++c) { u32x4 o;
#pragma unroll
                      for (int e = 0; e < 4; ++e) o[e] = att::cvtpk(bflo(w[c][e]) * rn * kg[8 * c + 2 * e], bfhi(w[c][e]) * rn * kg[8 * c + 2 * e + 1]);
                      *(u32x4*)(ko + 8 * c) = o; }
#pragma unroll
                  for (int cc = 0; cc < 2; ++cc) { u32x4 o1, o2;
#pragma unroll
                      for (int e = 0; e < 4; ++e) { const int i = 8 * cc + 2 * e; const f32x4 c4 = mt[4 * cc + e];
                          const float a0 = bflo(r[cc][e]) * rs * kg[64 + i], a1 = bfhi(r[cc][e]) * rs * kg[64 + i + 1], b0 = bflo(r[2 + cc][e]) * rs * kg[80 + i], b1 = bfhi(r[2 + cc][e]) * rs * kg[80 + i + 1];
                          o1[e] = att::cvtpk(a0 * c4.x - b0 * c4.y, a1 * c4.z - b1 * c4.w); o2[e] = att::cvtpk(b0 * c4.x + a0 * c4.y, b1 * c4.z + a1 * c4.w); }
                      *(u32x4*)(ko + 64 + 8 * cc) = o1; *(u32x4*)(ko + 80 + 8 * cc) = o2; }
                }
            }
        } else {
            for (int item = blockIdx.x; item < 524; item += G) {
                if (item < 256 || (item >= 512 && item < 520)) { const bool meta = item >= 512; const int b = meta ? 0 : item >> 3, h = item & 7;
                    const bf16* Qp = QRAW + 96 * h; const bf16* Kp = PROJ + 96 * h; const bf16* Vp = KVR + 128 * h + 64; bf16* Op = MIX + 512 + 64 * h;
                    if (meta) att::unit<96, true>(lds, Qp, 768, Kp, DINP, Vp, 1024, Op, DM, nullptr, 0, nullptr, 0.f, b, 0, 16, tid, SQA, ap->in[I_QHG] + l * 96, MT);
                    else for (int blk = 8; blk >= 1; --blk) { const int q0 = 16 + 256 * (blk - 1);
                        att::unit<96, true>(lds, Qp, 768, Kp, DINP, Vp, 1024, Op, DM, nullptr, 0, nullptr, 0.f, b, q0, q0 + 256, tid, SQA, ap->in[I_QHG] + l * 96, MT); }
                } else { const bool meta = item >= 520; const int it = item - 256, bh = it >> 1, hf = it & 1, b = meta ? 0 : bh >> 2, h = meta ? item - 520 : bh & 3;
                    const bf16* Pp = PROJ + 64 * h; bf16* Op = MIX + 256 + 64 * h; const float* gn = ap->in[I_RETG] + l * 256 + 64 * h;
                    const float lg2 = log2f(1.0f - exp2f(-5.0f - (float)h)); const unsigned bm = hf ? 0x0CCu : 0x132u;
                    if (meta) att::unit<64, false>(lds, Pp + C_RQ, DINP, Pp + C_RK, DINP, Pp + C_RV, DINP, Op, DM, Pp + C_RG, DINP, gn, lg2, b, 0, 16, tid, nullptr, nullptr, nullptr);
                    else for (int blk = 8; blk >= 1; --blk) { if (!((bm >> blk) & 1u)) continue; const int q0 = 16 + 256 * (blk - 1);
                        att::unit<64, false>(lds, Pp + C_RQ, DINP, Pp + C_RK, DINP, Pp + C_RV, DINP, Op, DM, Pp + C_RG, DINP, gn, lg2, b, q0, q0 + 256, tid, nullptr, nullptr, nullptr); }
                }
            }
        }
        if (ph + 1 < hi) {
            if (ph == lo) grid.sync();
            else { XcdBarrier xbar; xbar.bar = (unsigned*)ws; xbar.x = xb_xcc_id(); xbar.st = (volatile LAS unsigned*)(lds + XB_LDS_OFF); xcd_barrier(xbar); }
        }
    }
}

extern "C" void kernel_launch(void* const* d_in, const int* in_sizes, int n_in, void* d_out, int out_size, void* d_ws, size_t ws_size, hipStream_t stream) {
    static int grid = 0;
    if (grid == 0) {
        if (n_in != 16 || out_size != MREAL * DM || ws_size < WS_END) { fprintf(stderr, "kernel_launch: unexpected shapes (n_in %d, out %d, ws %zu)\n", n_in, out_size, ws_size); grid = -1; return; }
        int dev = 0, cus = 0, per_cu = 0;
        if (hipGetDevice(&dev) != hipSuccess || hipDeviceGetAttribute(&cus, hipDeviceAttributeMultiprocessorCount, dev) != hipSuccess) { grid = -1; return; }
        if (hipFuncSetAttribute((const void*)hybrid_fwd, hipFuncAttributeMaxDynamicSharedMemorySize, LDS_BYTES) != hipSuccess) { fprintf(stderr, "kernel_launch: hipFuncSetAttribute failed\n"); grid = -1; return; }
        if (hipOccupancyMaxActiveBlocksPerMultiprocessor(&per_cu, (const void*)hybrid_fwd, NWAVES * 64, LDS_BYTES) != hipSuccess || per_cu < 1) { fprintf(stderr, "kernel_launch: occupancy query says %d\n", per_cu); per_cu = 1; }
        (void)hipGetLastError();
        grid = cus;
    }
    if (grid < 0) return;
    if (hipMemsetAsync(d_ws, 0, 16384, stream) != hipSuccess) { fprintf(stderr, "kernel_launch: hipMemsetAsync of the barrier words failed\n"); return; }
    Args a{};
    for (int i = 0; i < 16; ++i) a.in[i] = (const float*)d_in[i];
    a.out = (float*)d_out; a.ws = (unsigned char*)d_ws;
#if MK_MULTI
    for (int ph = 0; ph < NPHASE; ++ph) { a.ph_lo = ph; a.ph_hi = ph + 1; hipLaunchKernelGGL(hybrid_fwd, dim3(grid), dim3(NWAVES * 64), LDS_BYTES, stream, a); }
#else
    a.ph_lo = 0; a.ph_hi = NPHASE;
    void* kargs[] = {&a};
    const hipError_t e = hipLaunchCooperativeKernel((const void*)hybrid_fwd, dim3(grid), dim3(NWAVES * 64), kargs, LDS_BYTES, stream);
    if (e != hipSuccess) fprintf(stderr, "kernel_launch: cooperative launch failed: %s (grid %d)\n", hipGetErrorString(e), grid);
#endif
}
```

```cpp
#include <hip/hip_runtime.h>
#include <hip/hip_cooperative_groups.h>
#include <cstdio>
#include <cstdint>
#include <cmath>
namespace cg = cooperative_groups;
#ifndef MK_MULTI
#define MK_MULTI 0
#endif
namespace pg8 {
#define PG8_LAS __attribute__((address_space(3)))
typedef unsigned short bf16_t;
typedef short bf16x8 __attribute__((ext_vector_type(8)));
typedef float f32x4 __attribute__((ext_vector_type(4)));
typedef unsigned u32x4 __attribute__((ext_vector_type(4)));
typedef unsigned u32x2 __attribute__((ext_vector_type(2)));
constexpr int BM = 256, BK = 64, HALF = 128, HTB = HALF * BK * 2  , STAGE_BYTES = 8 * HTB, NXCD = 8, WGM = 8;

__host__ __device__ __forceinline__ int lds_byte(int r, int c) { const int st = (r >> 4) * 2 + (c >> 5), rr = r & 15, cc = c & 31, ob = rr * 64 + cc * 2; return st * 1024 + (ob ^ (((ob >> 9) & 1) << 5)); }
__host__ __device__ __forceinline__ void stage_rc(int b, int& R, int& C) { const int st = b / 1024, sb = b % 1024, swz = sb ^ (((sb >> 9) & 1) << 5); R = (st >> 1) * 16 + swz / 64; C = (st & 1) * 32 + (swz % 64) / 2; }
__host__ __device__ __forceinline__ int perm32(int rho) { const int n = rho >> 4, i = rho & 15; return 8 * (i >> 2) + 4 * n + (i & 3); }

__device__ __forceinline__ int opaque_tid() { int t = threadIdx.x; asm volatile("" : "+v"(t)); return t; }
struct Unit { int pm, pn; };
struct Gemm { const bf16_t* A; const bf16_t* Bt; int M, N, K, lda; };

struct StaticOrder {
    int nM, nN, nwg, G, c;
    __host__ __device__ void init(int M, int N, int G_, int c_) { nM = M / BM; nN = N / BM; nwg = nM * nN; G = G_; c = c_; }
    __host__ __device__ bool next(int i, Unit& u) const {
        const long L = (long)i * G + c; if (L >= nwg) return false;
        int wgid = (int)L; { const int q = nwg / NXCD, r = nwg % NXCD, xcd = wgid % NXCD, off = wgid / NXCD; wgid = (xcd < r ? xcd * (q + 1) : r * (q + 1) + (xcd - r) * q) + off; }
        const int nig = WGM * nN, gid = wgid / nig, fm = gid * WGM, gsz = (nM - fm) < WGM ? (nM - fm) : WGM;
        u.pm = fm + ((wgid % nig) % gsz); u.pn = (wgid % nig) / gsz; return true;
    }
    __device__ __forceinline__ void a_ready(const Unit&) const {}
    __device__ __forceinline__ void done(const Unit&) const {}
};

__device__ __forceinline__ unsigned cvt_pk_bf16(float lo, float hi) { unsigned r; asm volatile("v_cvt_pk_bf16_f32 %0, %1, %2" : "=v"(r) : "v"(lo), "v"(hi)); return r; }
__device__ __forceinline__ float fq_sum(float v) {
    auto a = __builtin_amdgcn_permlane16_swap(__float_as_uint(v), __float_as_uint(v), false, false); v = __uint_as_float(a[0]) + __uint_as_float(a[1]);
    auto b = __builtin_amdgcn_permlane32_swap(__float_as_uint(v), __float_as_uint(v), false, false); return __uint_as_float(b[0]) + __uint_as_float(b[1]);
}
struct EpiAny {
    static constexpr bool AFTER_DRAIN = false;
    int mode, perm; bf16_t* O; int ldc; bf16_t* xr; float* out; float* ssx; const float* rs_src; int rs_cnt; float rs_div; float* ssq; float* sskv;
    __device__ __forceinline__ void operator()(const f32x4 (&acc)[2][2][4][2], const Unit& u, int wr, int wc, int fr, int fq) const {
        if (mode < 2) {
            const int row0 = u.pm * BM + wr * 64 + fr; const int col0 = u.pn * BM + wc * 32 + 8 * fq; const bool sq = mode == 1;
            const int sstile = ssq ? (u.pn == 7 ? 1 : (u.pn == 8 ? 2 : 0)) : 0;
            float rsv[2][4];
            if (rs_src) {
                f32x4 pq[2][4]; const bool split = rs_cnt == 16;
#pragma unroll
                for (int ai = 0; ai < 2; ++ai)
#pragma unroll
                    for (int m = 0; m < 4; ++m) pq[ai][m] = *(const f32x4*)(rs_src + (size_t)(row0 + ai * HALF + m * 16) * rs_cnt + (split ? 4 * fq : 0));
#pragma unroll
                for (int ai = 0; ai < 2; ++ai)
#pragma unroll
                    for (int m = 0; m < 4; ++m) { const f32x4 a = pq[ai][m]; float t = (a[0] + a[1]) + (a[2] + a[3]); if (split) t = fq_sum(t); rsv[ai][m] = 1.0f / sqrtf(t * rs_div + 1e-6f); }
            } else {
#pragma unroll
                for (int ai = 0; ai < 2; ++ai)
#pragma unroll
                    for (int m = 0; m < 4; ++m) rsv[ai][m] = 1.f;
            }
#pragma unroll
            for (int ai = 0; ai < 2; ++ai)
#pragma unroll
                for (int m = 0; m < 4; ++m) { const int row = row0 + ai * HALF + m * 16; bf16_t* rowp = O + (size_t)row * ldc + col0;
                    const float rs = rsv[ai][m]; float part = 0.f;
#pragma unroll
                    for (int bj = 0; bj < 2; ++bj) { f32x4 v0 = acc[ai][bj][m][0] * rs, v1 = acc[ai][bj][m][1] * rs;
                        if (sq) {
#pragma unroll
                            for (int e = 0; e < 4; ++e) { const float a = fmaxf(v0[e], 0.f), b = fmaxf(v1[e], 0.f); v0[e] = a * a; v1[e] = b * b; } }
                        if (sstile == 1 || (sstile == 2 && bj == 0)) part += ((v0[0] * v0[0] + v0[1] * v0[1]) + (v0[2] * v0[2] + v0[3] * v0[3])) + ((v1[0] * v1[0] + v1[1] * v1[1]) + (v1[2] * v1[2] + v1[3] * v1[3]));
                        u32x4 w; w.x = cvt_pk_bf16(v0[0], v0[1]); w.y = cvt_pk_bf16(v0[2], v0[3]); w.z = cvt_pk_bf16(v1[0], v1[1]); w.w = cvt_pk_bf16(v1[2], v1[3]);
                        *(u32x4*)(rowp + bj * HALF) = w; }
                    if (sstile) { part = fq_sum(part); if (fq == 0) (sstile == 1 ? ssq : sskv)[(size_t)row * 4 + wc] = part; }
                }
        } else {
            const int col0 = u.pn * BM + wc * 32 + 8 * fq; const bool toout = mode == 3;
#pragma unroll
            for (int ai = 0; ai < 2; ++ai) {
                u32x4 xw[4][2];
#pragma unroll
                for (int m = 0; m < 4; ++m) { const bf16_t* xp = xr + (size_t)(u.pm * BM + ai * HALF + wr * 64 + m * 16 + fr) * 1024 + col0;
#pragma unroll
                    for (int bj = 0; bj < 2; ++bj) xw[m][bj] = *(const u32x4*)(xp + bj * HALF); }
#pragma unroll
                for (int m = 0; m < 4; ++m) { const int r = u.pm * BM + ai * HALF + wr * 64 + m * 16 + fr; bf16_t* xp = xr + (size_t)r * 1024 + col0; float* op = out + (size_t)r * 1024 + col0; float part = 0.f;
#pragma unroll
                    for (int bj = 0; bj < 2; ++bj) { const u32x4 w0 = xw[m][bj]; f32x4 v0 = acc[ai][bj][m][0], v1 = acc[ai][bj][m][1];
                        v0[0] += __uint_as_float(w0.x << 16); v0[1] += __uint_as_float(w0.x & 0xffff0000u); v0[2] += __uint_as_float(w0.y << 16); v0[3] += __uint_as_float(w0.y & 0xffff0000u);
                        v1[0] += __uint_as_float(w0.z << 16); v1[1] += __uint_as_float(w0.z & 0xffff0000u); v1[2] += __uint_as_float(w0.w << 16); v1[3] += __uint_as_float(w0.w & 0xffff0000u);
                        if (toout) { *(f32x4*)(op + bj * HALF) = v0; *(f32x4*)(op + bj * HALF + 4) = v1; }
                        else { part += ((v0[0] * v0[0] + v0[1] * v0[1]) + (v0[2] * v0[2] + v0[3] * v0[3])) + ((v1[0] * v1[0] + v1[1] * v1[1]) + (v1[2] * v1[2] + v1[3] * v1[3]));
                               u32x4 w; w.x = cvt_pk_bf16(v0[0], v0[1]); w.y = cvt_pk_bf16(v0[2], v0[3]); w.z = cvt_pk_bf16(v1[0], v1[1]); w.w = cvt_pk_bf16(v1[2], v1[3]); *(u32x4*)(xp + bj * HALF) = w; } }
                    if (!toout) { part = fq_sum(part); if (fq == 0) ssx[(size_t)r * 16 + u.pn * 4 + wc] = part; }
                }
                asm volatile("" ::: "memory");
            }
        }
    }
};

template <class Epi, class Sched, bool ALIGN_EPI = false, bool SP2 = false>
__device__ __forceinline__ void gemm_phase(PG8_LAS unsigned char* lds, const Gemm g, const Sched& S, const Epi& E, const int tid_in) {
    int tid_o = tid_in; asm volatile("" : "+v"(tid_o));
    const int tid = tid_o, wid = __builtin_amdgcn_readfirstlane(tid >> 6), lane = tid & 63, wr = wid >> 2, wc = wid & 3, fr = lane & 15, fq = lane >> 4;
    const int K = g.K, nt = K / BK;
    unsigned voffA[2], voffB[2];
#pragma unroll
    for (int i = 0; i < 2; ++i) { int R, C; stage_rc(tid * 16 + i * 8192, R, C); const int Rb = E.perm ? ((R & ~31) + perm32(R & 31)) : R;
        voffA[i] = (unsigned)(R * g.lda + C) * 2u; voffB[i] = (unsigned)(Rb * K + C) * 2u; }
    const size_t kstep = (size_t)(BK * 2);
    const size_t hstepA = (size_t)HALF * g.lda * 2, hstepB = (size_t)HALF * K * 2;
    const size_t tstepA = 2 * hstepA, tstepB = 2 * hstepB;
    const unsigned ldsw = (unsigned)wid * 1024u;
    const int aoff = lds_byte(wr * 64 + fr, fq * 8), boff = lds_byte(wc * 32 + fr, fq * 8);
#define PG8_SA(b, h) (((b) * 2 + (h)) * HTB)
#define PG8_SB(b, h) ((4 + (b) * 2 + (h)) * HTB)
#define PG8_STAGE(bufoff, gbase, voff) do { _Pragma("unroll") for (int _i = 0; _i < 2; ++_i) \
        __builtin_amdgcn_global_load_lds((const unsigned*)((const char*)(gbase) + (voff)[_i]), (PG8_LAS unsigned*)(lds + (bufoff) + ldsw + _i * 8192), 16, 0, 0); } while (0)
#define PG8_LDA(dst, b, h) do { _Pragma("unroll") for (int m = 0; m < 4; ++m) _Pragma("unroll") for (int k = 0; k < 2; ++k) dst[m][k] = *(const PG8_LAS bf16x8*)(lds + PG8_SA(b, h) + aoff + m * 2048 + k * 1024); } while (0)
#define PG8_LDB(dst, b, h) do { _Pragma("unroll") for (int n = 0; n < 2; ++n) _Pragma("unroll") for (int k = 0; k < 2; ++k) dst[n][k] = *(const PG8_LAS bf16x8*)(lds + PG8_SB(b, h) + boff + n * 2048 + k * 1024); } while (0)
#define PG8_MMA(ai, bj, At, Bt) do { __builtin_amdgcn_s_setprio(1); _Pragma("unroll") for (int m = 0; m < 4; ++m) _Pragma("unroll") for (int n = 0; n < 2; ++n) _Pragma("unroll") for (int k = 0; k < 2; ++k) \
        acc[ai][bj][m][n] = __builtin_amdgcn_mfma_f32_16x16x32_bf16(Bt[n][k], At[m][k], acc[ai][bj][m][n], 0, 0, 0); __builtin_amdgcn_s_setprio(0); } while (0)
#define PG8_WAIT_V(n) asm volatile("s_waitcnt vmcnt(" #n ")" ::: "memory")
#define PG8_WAIT_L(n) asm volatile("s_waitcnt lgkmcnt(" #n ")" ::: "memory")
#define PG8_BAR __builtin_amdgcn_s_barrier()
#define PG8_SCHED __builtin_amdgcn_sched_barrier(0)
    Unit cur, nxt; int ui = 0;
    if (!S.next(0, cur)) return;
    f32x4 acc[2][2][4][2];
#pragma unroll
    for (int a = 0; a < 2; ++a)
#pragma unroll
        for (int b = 0; b < 2; ++b)
#pragma unroll
            for (int m = 0; m < 4; ++m)
#pragma unroll
                for (int n = 0; n < 2; ++n) acc[a][b][m][n] = (f32x4){0.f, 0.f, 0.f, 0.f};
    bf16x8 At[4][2], B0[2][2], B1[2][2];
    const char* cA = (const char*)g.A + (size_t)cur.pm * tstepA; const char* cB = (const char*)g.Bt + (size_t)cur.pn * tstepB;
    S.a_ready(cur);
    if constexpr (SP2) {
        PG8_STAGE(PG8_SB(0, 0), cB, voffB); PG8_STAGE(PG8_SB(0, 1), cB + hstepB, voffB); PG8_STAGE(PG8_SA(0, 0), cA, voffA); PG8_STAGE(PG8_SA(0, 1), cA + hstepA, voffA);
        if (wr == 1) PG8_BAR;
        PG8_WAIT_V(2); PG8_BAR;
        PG8_STAGE(PG8_SB(1, 0), cB + kstep, voffB); PG8_STAGE(PG8_SA(1, 0), cA + kstep, voffA); PG8_STAGE(PG8_SB(1, 1), cB + hstepB + kstep, voffB);
        PG8_WAIT_V(6); PG8_BAR;
    } else {
        PG8_STAGE(PG8_SB(0, 0), cB, voffB); PG8_STAGE(PG8_SA(0, 0), cA, voffA); PG8_STAGE(PG8_SB(0, 1), cB + hstepB, voffB); PG8_STAGE(PG8_SA(0, 1), cA + hstepA, voffA);
        if (wr == 1) PG8_BAR;
        PG8_WAIT_V(4); PG8_BAR;
        PG8_STAGE(PG8_SB(1, 0), cB + kstep, voffB); PG8_STAGE(PG8_SA(1, 0), cA + kstep, voffA); PG8_STAGE(PG8_SB(1, 1), cB + hstepB + kstep, voffB);
        PG8_WAIT_V(6); PG8_BAR;
    }
    for (;;) {
        const bool has_next = S.next(ui + 1, nxt);
        const char* nA = has_next ? (const char*)g.A + (size_t)nxt.pm * tstepA : cA; const char* nB = has_next ? (const char*)g.Bt + (size_t)nxt.pn * tstepB : cB;
        for (int t = 0; t < nt; t += 2) {
            const bool last = (t == nt - 2);
            const char* a1 = cA + (size_t)(t + 1) * kstep;
            const char* a2 = last ? nA : cA + (size_t)(t + 2) * kstep; const char* b2 = last ? nB : cB + (size_t)(t + 2) * kstep;
            const char* a3 = a2 + kstep; const char* b3 = b2 + kstep;
            if (last && has_next) S.a_ready(nxt);
            if constexpr (SP2) {
            PG8_LDB(B0, 0, 0); PG8_LDB(B1, 0, 1); PG8_SCHED; PG8_LDA(At, 0, 0); PG8_STAGE(PG8_SA(1, 1), a1 + hstepA, voffA);
            PG8_WAIT_V(8); PG8_WAIT_L(0); PG8_BAR; PG8_MMA(0, 0, At, B0); PG8_MMA(0, 1, At, B1); PG8_BAR; PG8_SCHED;
            PG8_LDA(At, 0, 1); PG8_STAGE(PG8_SB(0, 0), b2, voffB); PG8_STAGE(PG8_SB(0, 1), b2 + hstepB, voffB); PG8_STAGE(PG8_SA(0, 0), a2, voffA);
            PG8_WAIT_V(8); PG8_WAIT_L(0); PG8_BAR; PG8_MMA(1, 0, At, B0); PG8_MMA(1, 1, At, B1); PG8_BAR; PG8_SCHED;
            PG8_LDB(B0, 1, 0); PG8_LDB(B1, 1, 1); PG8_SCHED; PG8_LDA(At, 1, 0); PG8_STAGE(PG8_SA(0, 1), a2 + hstepA, voffA);
            PG8_WAIT_V(8); PG8_WAIT_L(0); PG8_BAR; PG8_MMA(0, 0, At, B0); PG8_MMA(0, 1, At, B1); PG8_BAR; PG8_SCHED;
            PG8_LDA(At, 1, 1); PG8_STAGE(PG8_SB(1, 0), b3, voffB); PG8_STAGE(PG8_SB(1, 1), b3 + hstepB, voffB); PG8_STAGE(PG8_SA(1, 0), a3, voffA);
            PG8_WAIT_V(8); PG8_WAIT_L(0); PG8_BAR; PG8_MMA(1, 0, At, B0); PG8_MMA(1, 1, At, B1); PG8_BAR; PG8_SCHED;
            } else {
            PG8_LDB(B0, 0, 0); PG8_SCHED; PG8_LDA(At, 0, 0); PG8_STAGE(PG8_SA(1, 1), a1 + hstepA, voffA);
            PG8_WAIT_L(8); PG8_BAR; PG8_WAIT_L(0); PG8_MMA(0, 0, At, B0); PG8_BAR; PG8_SCHED;
            PG8_LDB(B1, 0, 1); PG8_STAGE(PG8_SB(0, 0), b2, voffB);
            PG8_BAR; PG8_WAIT_L(0); PG8_MMA(0, 1, At, B1); PG8_BAR;
            PG8_LDA(At, 0, 1); PG8_STAGE(PG8_SA(0, 0), a2, voffA);
            PG8_BAR; PG8_WAIT_L(0); PG8_MMA(1, 0, At, B0); PG8_BAR; PG8_SCHED;
            PG8_STAGE(PG8_SB(0, 1), b2 + hstepB, voffB);
            PG8_WAIT_V(6); PG8_BAR; PG8_MMA(1, 1, At, B1); PG8_BAR;
            PG8_LDB(B0, 1, 0); PG8_SCHED; PG8_LDA(At, 1, 0); PG8_STAGE(PG8_SA(0, 1), a2 + hstepA, voffA);
            PG8_WAIT_L(8); PG8_BAR; PG8_WAIT_L(0); PG8_MMA(0, 0, At, B0); PG8_BAR; PG8_SCHED;
            PG8_LDB(B1, 1, 1); PG8_STAGE(PG8_SB(1, 0), b3, voffB);
            PG8_BAR; PG8_WAIT_L(0); PG8_MMA(0, 1, At, B1); PG8_BAR;
            PG8_LDA(At, 1, 1); PG8_STAGE(PG8_SA(1, 0), a3, voffA);
            PG8_BAR; PG8_WAIT_L(0); PG8_MMA(1, 0, At, B0); PG8_BAR; PG8_SCHED;
            PG8_STAGE(PG8_SB(1, 1), b3 + hstepB, voffB);
            PG8_WAIT_V(6); PG8_BAR; PG8_MMA(1, 1, At, B1); PG8_BAR;
            }
        }
        if constexpr (ALIGN_EPI) { if (wr == 0) PG8_BAR; }
        if constexpr (!Epi::AFTER_DRAIN) { E(acc, cur, wr, wc, fr, fq); S.done(cur); }
        if (!has_next) break;
#pragma unroll
        for (int a = 0; a < 2; ++a)
#pragma unroll
            for (int b = 0; b < 2; ++b)
#pragma unroll
                for (int m = 0; m < 4; ++m)
#pragma unroll
                    for (int n = 0; n < 2; ++n) acc[a][b][m][n] = (f32x4){0.f, 0.f, 0.f, 0.f};
        cur = nxt; cA = nA; cB = nB; ++ui;
        if constexpr (ALIGN_EPI) { if (wr == 1) PG8_BAR; }
    }
    PG8_WAIT_V(0);
    if constexpr (!ALIGN_EPI) { if (wr == 0) PG8_BAR; }
    PG8_BAR;
    if constexpr (Epi::AFTER_DRAIN) { E.fused(acc, cur, wr, wc, fr, fq, lds, wid, lane); S.done(cur); }
#undef PG8_SA
#undef PG8_SB
#undef PG8_STAGE
#undef PG8_LDA
#undef PG8_LDB
#undef PG8_MMA
#undef PG8_WAIT_V
#undef PG8_WAIT_L
#undef PG8_BAR
#undef PG8_SCHED
}
}

#define GAS __attribute__((address_space(1)))
#define LAS __attribute__((address_space(3)))
typedef unsigned short bf16;
typedef unsigned u32x4 __attribute__((ext_vector_type(4)));
typedef unsigned u32x2 __attribute__((ext_vector_type(2)));
typedef float f32x4 __attribute__((ext_vector_type(4)));
typedef float f32x2 __attribute__((ext_vector_type(2)));
typedef short bf16x8 __attribute__((ext_vector_type(8)));
typedef float f32x16 __attribute__((ext_vector_type(16)));
constexpr int DM = 1024, BATCH = 32, SEQ = 2048, NMETA = 16, TT = SEQ + NMETA, DIN = 2208, DINP = 2304, DFF = 4096, DEPTH = 2;
constexpr int MREAL = BATCH * SEQ, MR0 = MREAL, MV = MREAL + NMETA, M = MREAL + 256;
static_assert(MREAL % 256 == 0, "row tiles");
__device__ __forceinline__ int rowof(int b, int t) { return t < NMETA ? MR0 + t : b * SEQ + (t - NMETA); }
constexpr int C_CB = 0, C_CC = 256, C_CH = 512, C_RQ = 768, C_RK = 1024, C_RV = 1280, C_RG = 1536, C_CQ = 1792, C_CKV = 2048, C_KR = 2176;
constexpr float EPS = 1e-6f;
constexpr float QSCALE = 0.10206207261596575f * 1.4426950408889634f;
constexpr size_t MiB = 1u << 20;
constexpr size_t WS_RT = 1 * MiB, WS_MT = 1 * MiB + 768 * 1024;
constexpr size_t WS_WIN = 4 * MiB, WS_WUQ = 13 * MiB, WS_WUKV = 14 * MiB, WS_WOUT = 15 * MiB, WS_W1 = 19 * MiB, WS_W2 = 35 * MiB;
constexpr size_t WS_X = 52 * MiB, WS_XN = 310 * MiB, WS_PROJ = 440 * MiB, WS_QRAW = 731 * MiB, WS_KV = 828 * MiB, WS_H = 440 * MiB, WS_SSX = 958 * MiB, WS_SSQ = 964 * MiB, WS_SSKV = 966 * MiB, WS_SQA = 968 * MiB, WS_END = 969 * MiB;
static_assert(WS_X + (size_t)M * DM * 4 <= WS_XN && WS_XN + (size_t)M * DM * 2 <= WS_PROJ && WS_PROJ + (size_t)M * DINP * 2 <= WS_QRAW && WS_QRAW + (size_t)M * 768 * 2 <= WS_KV &&
              WS_KV + (size_t)M * 1024 * 2 <= WS_SSX && WS_H + (size_t)M * DFF * 2 <= WS_SSX && WS_SSX + (size_t)M * 64 <= WS_SSQ && WS_SSQ + (size_t)M * 16 <= WS_SSKV && WS_SSKV + (size_t)M * 16 <= WS_SQA && WS_SQA + (size_t)M * 4 <= WS_END, "d_ws map");
constexpr int NWAVES = 8, LDS_BYTES = 147456, XB_LDS_OFF = 131072 + 256;

__device__ __forceinline__ unsigned f2bf(float f) { unsigned u = __builtin_bit_cast(unsigned, f); return (u + 0x7fffu + ((u >> 16) & 1u)) >> 16; }
__device__ __forceinline__ unsigned pk2(float lo, float hi) { return f2bf(lo) | (f2bf(hi) << 16); }
__device__ __forceinline__ float bflo(unsigned w) { return __uint_as_float(w << 16); }
__device__ __forceinline__ float bfhi(unsigned w) { return __uint_as_float(w & 0xffff0000u); }
__device__ __forceinline__ float bf1(bf16 h) { return __uint_as_float((unsigned)h << 16); }
__device__ __forceinline__ float wave_sum(float v) {
#pragma unroll
    for (int o = 1; o < 64; o <<= 1) v += __shfl_xor(v, o);
    return v;
}
__device__ __forceinline__ float half_sum(float v) {
#pragma unroll
    for (int o = 1; o < 32; o <<= 1) v += __shfl_xor(v, o);
    return v;
}

namespace att {
typedef float f32x2_t __attribute__((ext_vector_type(2))); typedef __bf16 bf16x2_t __attribute__((ext_vector_type(2)));
__device__ __forceinline__ unsigned cvtpk(float lo, float hi) { f32x2_t v = {lo, hi}; bf16x2_t b = __builtin_convertvector(v, bf16x2_t); return __builtin_bit_cast(unsigned, b); }
constexpr int VP = 144;
__device__ __forceinline__ float xhalf_max(float v) { auto rr = __builtin_amdgcn_permlane32_swap(__float_as_uint(v), __float_as_uint(v), false, false); return fmaxf(__uint_as_float(rr[0]), __uint_as_float(rr[1])); }
__device__ __forceinline__ float xhalf_sum(float v) { auto rr = __builtin_amdgcn_permlane32_swap(__float_as_uint(v), __float_as_uint(v), false, false); return __uint_as_float(rr[0]) + __uint_as_float(rr[1]); }
template <int DQK, bool SM>
__device__ __forceinline__ void unit(LAS unsigned char* lds, const bf16* Q, int ldq, const bf16* K, int ldk, const bf16* V, int ldv, bf16* O, int ldo,
                                     const bf16* G, int ldg, const float* gain, float lg2, int b, int q0, int qend, const int tid_in, const float* sqa, const float* qgain, const f32x2* mtab) {
    constexpr int KP = DQK * 2 + 16, CH = DQK / 8, ND = DQK / 16, KB = 64 * KP, VB = 64 * VP, SB = KB + VB;
    int tid_o = tid_in; asm volatile("" : "+v"(tid_o));
    const int tid = tid_o, lane = tid & 63, wid = __builtin_amdgcn_readfirstlane(tid >> 6), r32 = lane & 31, hi = lane >> 5;
    const int q0w = q0 + 32 * wid, tq = q0w + r32;
    const bool wact = q0w < qend;
    bf16x8 qr[ND];
    const int qrow = rowof(b, tq < TT ? tq : TT - 1);
    { const bf16* qp = Q + (size_t)qrow * ldq + 8 * hi;
#pragma unroll
      for (int d0 = 0; d0 < ND; ++d0) qr[d0] = *(const bf16x8*)(qp + 16 * d0); }
    if (SM) {
        const int tpos = tq < TT ? tq : TT - 1;
        float ss = 0.f;
#pragma unroll
        for (int d0 = 0; d0 < ND; ++d0) { const u32x4 w = __builtin_bit_cast(u32x4, qr[d0]);
#pragma unroll
            for (int e = 0; e < 4; ++e) { const float a0 = bflo(w[e]), a1 = bfhi(w[e]); ss += a0 * a0 + a1 * a1; } }
        ss = xhalf_sum(ss);
        const float rs = QSCALE / sqrtf(ss * (1.f / 96.f) + EPS);
#pragma unroll
        for (int d0 = 0; d0 < 4; ++d0) { const u32x4 w = __builtin_bit_cast(u32x4, qr[d0]); const f32x4 g0 = *(const f32x4*)(qgain + 16 * d0 + 8 * hi), g1 = *(const f32x4*)(qgain + 16 * d0 + 8 * hi + 4); u32x4 o;
            o[0] = cvtpk(bflo(w[0]) * rs * g0[0], bfhi(w[0]) * rs * g0[1]); o[1] = cvtpk(bflo(w[1]) * rs * g0[2], bfhi(w[1]) * rs * g0[3]);
            o[2] = cvtpk(bflo(w[2]) * rs * g1[0], bfhi(w[2]) * rs * g1[1]); o[3] = cvtpk(bflo(w[3]) * rs * g1[2], bfhi(w[3]) * rs * g1[3]);
            qr[d0] = __builtin_bit_cast(bf16x8, o); }
        { const u32x4 w1 = __builtin_bit_cast(u32x4, qr[4]), w2 = __builtin_bit_cast(u32x4, qr[5]); const f32x4* cs = (const f32x4*)(mtab + tpos * 16 + 8 * hi);
          const float* ga = qgain + 64 + 8 * hi; const float* gb = qgain + 80 + 8 * hi; u32x4 o1, o2;
#pragma unroll
          for (int e = 0; e < 4; ++e) { const f32x4 c4 = cs[e];
              const float a0 = bflo(w1[e]) * rs * ga[2 * e], a1 = bfhi(w1[e]) * rs * ga[2 * e + 1], b0 = bflo(w2[e]) * rs * gb[2 * e], b1 = bfhi(w2[e]) * rs * gb[2 * e + 1];
              o1[e] = cvtpk(a0 * c4.x - b0 * c4.y, a1 * c4.z - b1 * c4.w); o2[e] = cvtpk(b0 * c4.x + a0 * c4.y, b1 * c4.z + a1 * c4.w); }
          qr[4] = __builtin_bit_cast(bf16x8, o1); qr[5] = __builtin_bit_cast(bf16x8, o2); }
    }
    const int ntiles = (qend - 1) / 64 + 1;
    const int nw = wact ? ((q0w + 31) / 64 + 1 < ntiles ? (q0w + 31) / 64 + 1 : ntiles) : 0;
    const int nfull = (q0w + 1) / 64;
    const int kkey0 = tid / CH, kch0 = tid % CH, kkey1 = (tid + 512) / CH, kch1 = (tid + 512) % CH;
    const bool has2 = (64 * CH > 512) && (tid + 512 < 64 * CH);
    const int vkey = tid & 63, vch = tid >> 6;
    const int pr32 = (r32 & 0x13) | ((r32 & 4) << 1) | ((r32 & 8) >> 1);
    const int koff = pr32 * KP + 16 * hi, voff = KB + r32 * VP + 16 * hi;
    u32x4 kreg0, kreg1 = {0u, 0u, 0u, 0u}, vreg;
#define ATT_LOAD(j) do { int r0_ = 64 * (j) + kkey0; r0_ = r0_ < TT ? r0_ : TT - 1; kreg0 = *(const u32x4*)(K + (size_t)rowof(b, r0_) * ldk + 8 * kch0); \
        if (has2) { int r1_ = 64 * (j) + kkey1; r1_ = r1_ < TT ? r1_ : TT - 1; kreg1 = *(const u32x4*)(K + (size_t)rowof(b, r1_) * ldk + 8 * kch1); } \
        int rv_ = 64 * (j) + vkey; rv_ = rv_ < TT ? rv_ : TT - 1; vreg = *(const u32x4*)(V + (size_t)rowof(b, rv_) * ldv + 8 * vch); } while (0)
#define ATT_STORE(so) do { *(LAS u32x4*)(lds + (so) + kkey0 * KP + 16 * kch0) = kreg0; if (has2) *(LAS u32x4*)(lds + (so) + kkey1 * KP + 16 * kch1) = kreg1; \
        LAS unsigned char* vd_ = lds + (so) + KB + (8 * vch) * VP + 2 * vkey; \
        _Pragma("unroll") for (int i_ = 0; i_ < 8; ++i_) { const unsigned w_ = vreg[i_ >> 1]; *(LAS unsigned short*)(vd_ + i_ * VP) = (unsigned short)((i_ & 1) ? (w_ >> 16) : (w_ & 0xffffu)); } } while (0)
#define ATT_KREAD(so) do { const LAS unsigned char* kb_ = lds + (so) + koff; \
        _Pragma("unroll") for (int d0 = 0; d0 < ND; ++d0) { kf0[d0] = *(const LAS bf16x8*)(kb_ + 32 * d0); kf1[d0] = *(const LAS bf16x8*)(kb_ + 32 * KP + 32 * d0); } } while (0)
#define ATT_VREAD(so) do { const LAS unsigned char* vb_ = lds + (so) + voff; \
        _Pragma("unroll") for (int ks = 0; ks < 4; ++ks) { vf0[ks] = *(const LAS bf16x8*)(vb_ + 32 * ks); vf1[ks] = *(const LAS bf16x8*)(vb_ + 32 * VP + 32 * ks); } } while (0)
#define ATT_QKM(S0, S1) do { \
        _Pragma("unroll") for (int r_ = 0; r_ < 16; ++r_) { S0[r_] = 0.f; S1[r_] = 0.f; } \
        _Pragma("unroll") for (int d0 = 0; d0 < ND; ++d0) { \
            S0 = __builtin_amdgcn_mfma_f32_32x32x16_bf16(kf0[d0], qr[d0], S0, 0, 0, 0); S1 = __builtin_amdgcn_mfma_f32_32x32x16_bf16(kf1[d0], qr[d0], S1, 0, 0, 0); } } while (0)
#define ATT_QKI(S0, S1, so) do { const LAS unsigned char* kb_ = lds + (so) + koff; \
        _Pragma("unroll") for (int r_ = 0; r_ < 16; ++r_) { S0[r_] = 0.f; S1[r_] = 0.f; } \
        _Pragma("unroll") for (int d0 = 0; d0 < ND; ++d0) { const bf16x8 k0_ = *(const LAS bf16x8*)(kb_ + 32 * d0), k1_ = *(const LAS bf16x8*)(kb_ + 32 * KP + 32 * d0); \
            S0 = __builtin_amdgcn_mfma_f32_32x32x16_bf16(k0_, qr[d0], S0, 0, 0, 0); S1 = __builtin_amdgcn_mfma_f32_32x32x16_bf16(k1_, qr[d0], S1, 0, 0, 0); } } while (0)
#define ATT_TILE(j, so, MASK, VPRE) do { const int kbase_ = 64 * (j) + 8 * hi; \
        if (SM) { \
            if (MASK) { _Pragma("unroll") for (int r = 0; r < 16; ++r) { const int kk = kbase_ + 16 * (r >> 3) + (r & 7); if (kk > tq) s0[r] = -INFINITY; if (kk + 32 > tq) s1[r] = -INFINITY; } } \
            float mx = fmaxf(s0[0], s1[0]); \
            _Pragma("unroll") for (int r = 1; r < 16; ++r) mx = fmaxf(mx, fmaxf(s0[r], s1[r])); \
            mx = xhalf_max(mx); \
            const float mn = fmaxf(m_run, mx), alpha = __builtin_amdgcn_exp2f(m_run - mn); m_run = mn; \
            float ps = 0.f; \
            _Pragma("unroll") for (int r = 0; r < 16; ++r) { s0[r] = __builtin_amdgcn_exp2f(s0[r] - mn); s1[r] = __builtin_amdgcn_exp2f(s1[r] - mn); ps += s0[r] + s1[r]; } \
            l_run = l_run * alpha + ps; \
            _Pragma("unroll") for (int r = 0; r < 16; ++r) { o0[r] *= alpha; o1[r] *= alpha; } \
        } else { \
            const float rf0 = __builtin_amdgcn_exp2f(lg2 * (float)(tq - kbase_)), rf1 = rf0 * c32; \
            _Pragma("unroll") for (int r = 0; r < 16; ++r) { s0[r] = (s0[r] * cfac[r]) * rf0; s1[r] = (s1[r] * cfac[r]) * rf1; } \
            if (MASK) { _Pragma("unroll") for (int r = 0; r < 16; ++r) { const int kk = kbase_ + 16 * (r >> 3) + (r & 7); if (kk > tq) s0[r] = 0.f; if (kk + 32 > tq) s1[r] = 0.f; } } \
        } \
        u32x4 pw[4]; \
        _Pragma("unroll") for (int ks = 0; ks < 2; ++ks) { \
            pw[ks] = (u32x4){cvtpk(s0[8 * ks], s0[8 * ks + 1]), cvtpk(s0[8 * ks + 2], s0[8 * ks + 3]), cvtpk(s0[8 * ks + 4], s0[8 * ks + 5]), cvtpk(s0[8 * ks + 6], s0[8 * ks + 7])}; \
            pw[2 + ks] = (u32x4){cvtpk(s1[8 * ks], s1[8 * ks + 1]), cvtpk(s1[8 * ks + 2], s1[8 * ks + 3]), cvtpk(s1[8 * ks + 4], s1[8 * ks + 5]), cvtpk(s1[8 * ks + 6], s1[8 * ks + 7])}; } \
        const LAS unsigned char* vb_ = lds + (so) + voff; \
        _Pragma("unroll") for (int ks = 0; ks < 4; ++ks) { const bf16x8 pf_ = __builtin_bit_cast(bf16x8, pw[ks]); \
            const bf16x8 v0_ = (VPRE) ? vf0[ks] : *(const LAS bf16x8*)(vb_ + 32 * ks), v1_ = (VPRE) ? vf1[ks] : *(const LAS bf16x8*)(vb_ + 32 * VP + 32 * ks); \
            o0 = __builtin_amdgcn_mfma_f32_32x32x16_bf16(v0_, pf_, o0, 0, 0, 0); o1 = __builtin_amdgcn_mfma_f32_32x32x16_bf16(v1_, pf_, o1, 0, 0, 0); } } while (0)
    f32x16 o0, o1, s0, s1, t0, t1; bf16x8 kf0[ND], kf1[ND], vf0[4], vf1[4];
#pragma unroll
    for (int r = 0; r < 16; ++r) { o0[r] = 0.f; o1[r] = 0.f; s0[r] = 0.f; s1[r] = 0.f; t0[r] = 0.f; t1[r] = 0.f; }
    float m_run = -INFINITY, l_run = 0.f;
    float cfac[16]; const float c32 = SM ? 0.f : __builtin_amdgcn_exp2f(-32.f * lg2);
#pragma unroll
    for (int r = 0; r < 16; ++r) cfac[r] = SM ? 0.f : __builtin_amdgcn_exp2f(-lg2 * (float)(16 * (r >> 3) + (r & 7)));
    int so_c = 0, so_n = SB, so_nn = 2 * SB;
    ATT_LOAD(0); ATT_STORE(0);
    if (ntiles > 1) { ATT_LOAD(1); ATT_STORE(SB); }
    __syncthreads();
    if (nw > 0) ATT_QKI(s0, s1, 0);
    for (int j = 0; j < ntiles; ++j) {
        if (j + 2 < ntiles) ATT_LOAD(j + 2);
        if (j + 1 < nw && j < nfull) {
            if (SM) {
                ATT_QKI(t0, t1, so_n);
                ATT_TILE(j, so_c, false, false);
            } else if (wid < 4) {
                ATT_KREAD(so_n); ATT_VREAD(so_c); __builtin_amdgcn_sched_barrier(0);
                ATT_QKM(t0, t1);
                ATT_TILE(j, so_c, false, true);
            } else {
                ATT_VREAD(so_c); __builtin_amdgcn_sched_barrier(0);
                ATT_TILE(j, so_c, false, true); __builtin_amdgcn_sched_barrier(0);
                ATT_KREAD(so_n); __builtin_amdgcn_sched_barrier(0);
                ATT_QKM(t0, t1);
            }
#pragma unroll
            for (int r = 0; r < 16; ++r) { s0[r] = t0[r]; s1[r] = t1[r]; }
        } else if (j < nw) {
            if (SM) { if (j + 1 < nw) ATT_QKI(t0, t1, so_n); ATT_TILE(j, so_c, true, false); }
            else { if (j + 1 < nw) { ATT_KREAD(so_n); ATT_VREAD(so_c); __builtin_amdgcn_sched_barrier(0); ATT_QKM(t0, t1); } else { ATT_VREAD(so_c); }
                   ATT_TILE(j, so_c, true, true); }
#pragma unroll
            for (int r = 0; r < 16; ++r) { s0[r] = t0[r]; s1[r] = t1[r]; }
        }
        if (j + 2 < ntiles) ATT_STORE(so_nn);
        __syncthreads();
        { const int t_ = so_c; so_c = so_n; so_n = so_nn; so_nn = t_; }
    }
#undef ATT_LOAD
#undef ATT_STORE
#undef ATT_KREAD
#undef ATT_VREAD
#undef ATT_QKM
#undef ATT_QKI
#undef ATT_TILE
    if (wact) {
        if (SM) {
            const float l = xhalf_sum(l_run), inv = 1.f / l;
            if (tq < qend) { bf16* op = O + (size_t)qrow * ldo + 4 * hi;
#pragma unroll
                for (int g = 0; g < 4; ++g) {
                    u32x2 a, bq; a.x = cvtpk(o0[4 * g] * inv, o0[4 * g + 1] * inv); a.y = cvtpk(o0[4 * g + 2] * inv, o0[4 * g + 3] * inv);
                    bq.x = cvtpk(o1[4 * g] * inv, o1[4 * g + 1] * inv); bq.y = cvtpk(o1[4 * g + 2] * inv, o1[4 * g + 3] * inv);
                    *(u32x2*)(op + 8 * g) = a; *(u32x2*)(op + 32 + 8 * g) = bq; } }
        } else {
            float ss = 0.f;
#pragma unroll
            for (int r = 0; r < 16; ++r) ss += o0[r] * o0[r] + o1[r] * o1[r];
            ss = xhalf_sum(ss);
            const float rs = 1.0f / sqrtf(ss * (1.f / 64.f) + EPS);
            if (tq < qend) { bf16* op = O + (size_t)qrow * ldo + 4 * hi; const bf16* gp = G + (size_t)qrow * ldg + 4 * hi; const float* gn = gain + 4 * hi;
#pragma unroll
                for (int g = 0; g < 4; ++g) {
#pragma unroll
                    for (int db = 0; db < 2; ++db) {
                        const u32x2 gw = *(const u32x2*)(gp + 32 * db + 8 * g); const f32x4 ga = *(const f32x4*)(gn + 32 * db + 8 * g);
                        float gv[4] = {bflo(gw.x), bfhi(gw.x), bflo(gw.y), bfhi(gw.y)}; float y[4];
#pragma unroll
                        for (int e = 0; e < 4; ++e) { const float ov = db ? o1[4 * g + e] : o0[4 * g + e]; const float sg = gv[e] / (1.f + __expf(-gv[e])); y[e] = ov * rs * ga[e] * sg; }
                        u32x2 w; w.x = cvtpk(y[0], y[1]); w.y = cvtpk(y[2], y[3]); *(u32x2*)(op + 32 * db + 8 * g) = w; } } }
        }
    }
}
}

struct Args { const float* in[16]; float* out; unsigned char* ws; int ph_lo, ph_hi; };
typedef const __attribute__((address_space(4))) Args* KArgsP;
#define RT   ((f32x2*)(ws + WS_RT))
#define MT   ((f32x2*)(ws + WS_MT))
#define WIN  ((bf16*)(ws + WS_WIN))
#define WUQ  ((bf16*)(ws + WS_WUQ))
#define WUKV ((bf16*)(ws + WS_WUKV))
#define WOUT ((bf16*)(ws + WS_WOUT))
#define W1   ((bf16*)(ws + WS_W1))
#define W2   ((bf16*)(ws + WS_W2))
#define XR   ((bf16*)(ws + WS_X))
#define XN   ((bf16*)(ws + WS_XN))
#define MIX  ((bf16*)(ws + WS_XN))
#define PROJ ((bf16*)(ws + WS_PROJ))
#define QRAW ((bf16*)(ws + WS_QRAW))
#define KVR  ((bf16*)(ws + WS_KV))
#define HB   ((bf16*)(ws + WS_H))
#define SSX  ((float*)(ws + WS_SSX))
#define SSQ  ((float*)(ws + WS_SSQ))
#define SSKV ((float*)(ws + WS_SSKV))
#define SQA  ((float*)(ws + WS_SQA))
enum { I_X = 0, I_META, I_ANG, I_WIN, I_CONVW, I_RETG, I_QNG, I_WUQ, I_KVNG, I_WUKV, I_QHG, I_KHG, I_WOUT, I_MLPG, I_W1, I_W2 };
constexpr int NPP = 7, NPHASE = 1 + NPP * DEPTH;

__device__ __forceinline__ void p0_transpose_item(const float* W, const float* gk, int K, int N, bf16* WT, LAS float* scr, int item, int lane) {
    const int nblk = N / 32, kb = item / nblk, nb = item % nblk, k0 = 64 * kb, n0 = 32 * nb;
#pragma unroll 8
    for (int i = 0; i < 32; ++i) { const int kk = 2 * i + (lane >> 5); const float gv = gk ? gk[k0 + kk] : 1.f; scr[kk * 33 + (lane & 31)] = W[(size_t)(k0 + kk) * N + n0 + (lane & 31)] * gv; }
    asm volatile("s_waitcnt lgkmcnt(0)" ::: "memory");
    const int c = lane & 7;
#pragma unroll
    for (int j = 0; j < 4; ++j) { const int n = (lane >> 3) + 8 * j; const LAS float* s = scr + (8 * c) * 33 + n;
        u32x4 o; o.x = pk2(s[0 * 33], s[1 * 33]); o.y = pk2(s[2 * 33], s[3 * 33]); o.z = pk2(s[4 * 33], s[5 * 33]); o.w = pk2(s[6 * 33], s[7 * 33]);
        *(u32x4*)(WT + (size_t)(n0 + n) * K + k0 + 8 * c) = o; }
    asm volatile("s_waitcnt lgkmcnt(0)" ::: "memory");
}
__device__ __forceinline__ void row_prep(const float* xrow, bf16* orow, float* ss16, int lane) {
    const f32x4* xr = (const f32x4*)xrow + lane;
    f32x4 v[4]; float s = 0.f;
#pragma unroll
    for (int j = 0; j < 4; ++j) { v[j] = xr[64 * j]; s += (v[j].x * v[j].x + v[j].y * v[j].y) + (v[j].z * v[j].z + v[j].w * v[j].w); }
    const float tot = wave_sum(s);
    if (lane < 16) ss16[lane] = lane == 0 ? tot : 0.f;
    unsigned long long* o8 = (unsigned long long*)orow + lane;
#pragma unroll
    for (int j = 0; j < 4; ++j) o8[64 * j] = (unsigned long long)att::cvtpk(v[j].x, v[j].y) | ((unsigned long long)att::cvtpk(v[j].z, v[j].w) << 32);
}
__device__ __forceinline__ f32x2 cossin(float ang) {
    const float n = rintf(ang * 0.15915494309189535f);
    float r = fmaf(-n, 6.28125f, ang); r = fmaf(-n, 0.0019353071795864769f, r);
    const float rev = r * 0.15915494309189535f;
    f32x2 o; o.x = __builtin_amdgcn_cosf(rev); o.y = __builtin_amdgcn_sinf(rev); return o;
}

#define XB_TMO      128
#define XB_XCNT(j)  (256  + 64 * (j))
#define XB_XSUB(j)  (1280 + 64 * (j))
#define XB_XGEN(j)  (2304 + 64 * (j))
#define XB_TOP      3328
#define XB_TOPGEN   3392
#define XCD_BAR_WORDS 3456
#define XB_SPIN_CAP (1u << 18)

__device__ __forceinline__ unsigned xb_ld(unsigned* p)              { return __hip_atomic_load(p, __ATOMIC_RELAXED, __HIP_MEMORY_SCOPE_AGENT); }
__device__ __forceinline__ unsigned xb_add(unsigned* p, unsigned v) { return __hip_atomic_fetch_add(p, v, __ATOMIC_RELAXED, __HIP_MEMORY_SCOPE_AGENT); }
__device__ __forceinline__ unsigned xb_xcc_id() { return (unsigned)__builtin_amdgcn_s_getreg((3 << 11) | 20) & 0xFu; }
#define XB_SPIN(cond, bar) do { unsigned _sp = 0; while (cond) { __builtin_amdgcn_s_sleep(1); \
    if ((++_sp & 255u) == 0u) { if (xb_ld(&(bar)[XB_TMO])) break; if (_sp > XB_SPIN_CAP) { atomicAdd(&(bar)[XB_TMO], 1u); break; } } } } while (0)

struct XcdBarrier {
    unsigned* bar; unsigned x;
    volatile LAS unsigned* st;
};

__device__ __forceinline__ XcdBarrier xcd_barrier_post(unsigned* bar, volatile LAS unsigned* st) {
    XcdBarrier b; b.bar = bar; b.x = xb_xcc_id(); b.st = st;
    if (threadIdx.x == 0) (void)xb_add(&bar[XB_XCNT(b.x)], 1u);
    return b;
}
__device__ __forceinline__ void xcd_barrier_complete(unsigned* bar, unsigned x, unsigned& nloc, unsigned& nx) {
    const unsigned G = gridDim.x * gridDim.y * gridDim.z;
    unsigned sum, cnt, mine, sp = 0u;
    for (;;) {
        sum = 0u; cnt = 0u; mine = 0u;
#pragma unroll
        for (unsigned j = 0; j < 16; ++j) { const unsigned c = xb_ld(&bar[XB_XCNT(j)]); sum += c; cnt += (c > 0u) ? 1u : 0u; mine = (j == x) ? c : mine; }
        if (sum == G) break;
        __builtin_amdgcn_s_sleep(1);
        if ((++sp & 255u) == 0u) { if (xb_ld(&bar[XB_TMO])) break; if (sp > XB_SPIN_CAP) { atomicAdd(&bar[XB_TMO], 1u); break; } }
    }
    nloc = mine > 0u ? mine : 1u; nx = cnt > 0u ? cnt : 1u;
}

__device__ __forceinline__ void xcd_barrier(const XcdBarrier& b) {
    asm volatile("s_waitcnt vmcnt(0)" ::: "memory");
    __syncthreads();
    if (threadIdx.x == 0) {
        unsigned* bar = b.bar;
        __builtin_amdgcn_s_waitcnt(0);
        unsigned nloc = b.st[0], nx = b.st[1];
        if (nloc == 0u) { xcd_barrier_complete(bar, b.x, nloc, nx); b.st[0] = nloc; b.st[1] = nx; }
        const unsigned old = xb_add(&bar[XB_XSUB(b.x)], 1u);
        const unsigned gen = old / nloc;
        if (old + 1u == (gen + 1u) * nloc) {
            __builtin_amdgcn_fence(__ATOMIC_RELEASE, "agent");
            asm volatile("s_waitcnt vmcnt(0)" ::: "memory");
            const unsigned og = xb_add(&bar[XB_TOP], 1u);
            const unsigned tg = og / nx;
            if (og + 1u == (tg + 1u) * nx) xb_add(&bar[XB_TOPGEN], 1u);
            else XB_SPIN(xb_ld(&bar[XB_TOPGEN]) == tg, bar);
            __builtin_amdgcn_fence(__ATOMIC_ACQUIRE, "agent");
            xb_add(&bar[XB_XGEN(b.x)], 1u);
            asm volatile("s_waitcnt vmcnt(0)" ::: "memory");
        } else {
            XB_SPIN(xb_ld(&bar[XB_XGEN(b.x)]) == gen, bar);
            __builtin_amdgcn_fence(__ATOMIC_ACQUIRE, "agent");
            asm volatile("s_waitcnt vmcnt(0)" ::: "memory");
        }
    }
    __syncthreads();
}

struct EpiMeta { int mode, need_rs; float rs_div; bf16* O; int ldc; bf16* xr; };
__device__ __forceinline__ void meta_gemm(const bf16* A, int lda, const bf16* Bt, int N, int K, const EpiMeta& E, int gw, int NGW, int lane) {
    for (int n = gw; n < N; n += NGW) {
        float acc[16], ssa[16];
#pragma unroll
        for (int r = 0; r < 16; ++r) { acc[r] = 0.f; ssa[r] = 0.f; }
        for (int c = lane; c < K / 8; c += 64) {
            const u32x4 w = *(const u32x4*)(Bt + (size_t)n * K + 8 * c);
            float wf[8];
#pragma unroll
            for (int e = 0; e < 4; ++e) { wf[2 * e] = bflo(w[e]); wf[2 * e + 1] = bfhi(w[e]); }
#pragma unroll
            for (int r = 0; r < 16; ++r) { const u32x4 a = *(const u32x4*)(A + (size_t)r * lda + 8 * c);
#pragma unroll
                for (int e = 0; e < 4; ++e) { const float a0 = bflo(a[e]), a1 = bfhi(a[e]); acc[r] += a0 * wf[2 * e] + a1 * wf[2 * e + 1]; ssa[r] += a0 * a0 + a1 * a1; } }
        }
        float mine = 0.f, myss = 0.f;
#pragma unroll
        for (int r = 0; r < 16; ++r) { const float s = wave_sum(acc[r]), q = E.need_rs ? wave_sum(ssa[r]) : 0.f; if (lane == r) { mine = s; myss = q; } }
        if (lane < 16) { const int r = lane;
            if (E.mode < 2) { float v = mine * (E.need_rs ? 1.0f / sqrtf(myss * E.rs_div + EPS) : 1.f); if (E.mode == 1) { v = fmaxf(v, 0.f); v = v * v; } E.O[(size_t)(MR0 + r) * E.ldc + n] = (bf16)f2bf(v); }
            else { bf16* p = E.xr + (size_t)(MR0 + r) * DM + n; *p = (bf16)f2bf(bf1(*p) + mine); } }
    }
}

__global__ void __launch_bounds__(NWAVES * 64, 2) hybrid_fwd(Args args) {
    extern __shared__ __attribute__((aligned(16))) unsigned char lds_raw[];
    LAS unsigned char* lds = (LAS unsigned char*)lds_raw;
    cg::grid_group grid = cg::this_grid();
    const int G = gridDim.x, NGW = G * NWAVES;
    const int wave_s = __builtin_amdgcn_readfirstlane((int)threadIdx.x >> 6);
    if (threadIdx.x < 2) ((LAS unsigned*)(lds + XB_LDS_OFF))[threadIdx.x] = 0u;
    __syncthreads();
    if (args.ph_hi - args.ph_lo > 1) (void)xcd_barrier_post((unsigned*)args.ws, (volatile LAS unsigned*)(lds + XB_LDS_OFF));
    const int lo = args.ph_lo, hi = args.ph_hi;
    for (int ph = lo; ph < hi; ++ph) {
        KArgsP ap = (KArgsP)__builtin_amdgcn_kernarg_segment_ptr(); asm volatile("" : "+s"(ap));
        unsigned char* const ws = ap->ws;
        int wave = wave_s; asm volatile("" : "+s"(wave));
        int lane = (int)__builtin_amdgcn_mbcnt_hi(~0u, __builtin_amdgcn_mbcnt_lo(~0u, 0u)); asm volatile("" : "+v"(lane));
        const int tid = wave * 64 + lane, gw = blockIdx.x * NWAVES + wave;
        const int l = ph == 0 ? 0 : (ph - 1) / NPP, k = ph == 0 ? -1 : (ph - 1) % NPP;
        if (k == -1) {
            LAS float* scr = (LAS float*)(lds + wave * 16384);
            constexpr int I_IN = 16 * 69, I_UQ = 4 * 24, I_UKV = 2 * 32, I_O = 16 * 32, I_1 = 16 * 128, I_2 = 64 * 32, I_L = I_IN + I_UQ + I_UKV + I_O + I_1 + I_2;
            for (int it = gw; it < DEPTH * I_L; it += NGW) {
                const int ll = it / I_L; int r = it - ll * I_L;
                if (r < I_IN) { p0_transpose_item(ap->in[I_WIN] + (size_t)ll * DM * DIN, ap->in[I_ANG] + ll * DM, DM, DIN, WIN + (size_t)ll * DINP * DM, scr, r, lane); continue; } r -= I_IN;
                if (r < I_UQ) { p0_transpose_item(ap->in[I_WUQ] + (size_t)ll * 256 * 768, ap->in[I_QNG] + ll * 256, 256, 768, WUQ + (size_t)ll * 768 * 256, scr, r, lane); continue; } r -= I_UQ;
                if (r < I_UKV) { p0_transpose_item(ap->in[I_WUKV] + (size_t)ll * 128 * 1024, ap->in[I_KVNG] + ll * 128, 128, 1024, WUKV + (size_t)ll * 1024 * 128, scr, r, lane); continue; } r -= I_UKV;
                if (r < I_O) { p0_transpose_item(ap->in[I_WOUT] + (size_t)ll * DM * DM, nullptr, DM, DM, WOUT + (size_t)ll * DM * DM, scr, r, lane); continue; } r -= I_O;
                if (r < I_1) { p0_transpose_item(ap->in[I_W1] + (size_t)ll * DM * DFF, ap->in[I_MLPG] + ll * DM, DM, DFF, W1 + (size_t)ll * DFF * DM, scr, r, lane); continue; } r -= I_1;
                p0_transpose_item(ap->in[I_W2] + (size_t)ll * DFF * DM, nullptr, DFF, DM, W2 + (size_t)ll * DM * DFF, scr, r, lane);
            }
            for (int it = gw; it < DEPTH * (DINP - DIN); it += NGW) {
                const int ll = it / (DINP - DIN), r = DIN + it % (DINP - DIN); u32x4* p = (u32x4*)(WIN + ((size_t)ll * DINP + r) * DM) + lane;
                u32x4 z = {0u, 0u, 0u, 0u}; asm volatile("" : "+v"(z));
                p[0] = z; p[64] = z;
            }
            for (int e = blockIdx.x * 512 + tid; e < TT * 32; e += G * 512) { const int t = e >> 5, i = e & 31; const float inv = exp2f(-13.287712379549449f * (float)(2 * i) * (1.f / 64.f)); RT[e] = cossin((float)t * inv); }
            for (int e = blockIdx.x * 512 + tid; e < TT * 16; e += G * 512) { const int t = e >> 4, i = e & 15; const float inv = exp2f(-13.287712379549449f * (float)(2 * i) * (1.f / 32.f)); MT[e] = cossin((float)t * inv); }
            for (int m = gw; m < MV; m += NGW) {
                const float* src = m >= MR0 ? ap->in[I_META] + (size_t)(m - MR0) * DM : ap->in[I_X] + (size_t)m * DM;
                row_prep(src, XR + (size_t)m * DM, SSX + (size_t)m * 16, lane); }
        } else if (k == 0 || k == 1 || k == 4 || k == 5 || k == 6) {
            const int ng = k == 1 ? 2 : 1;
            for (int gi = 0; gi < ng; ++gi) {
                pg8::Gemm g; pg8::EpiAny E; E.xr = XR; E.out = ap->out; E.O = nullptr; E.ldc = 0; E.ssx = SSX; E.rs_src = nullptr; E.rs_cnt = 16; E.rs_div = 1.f / 1024.f; E.ssq = nullptr; E.sskv = nullptr;
                EpiMeta Em; Em.need_rs = 0; Em.rs_div = 1.f / 1024.f; Em.O = nullptr; Em.ldc = 0; Em.xr = XR;
                if (k == 0)      { g = pg8::Gemm{XR, WIN + (size_t)l * DINP * DM, MREAL, DINP, DM, DM}; E.mode = 0; E.perm = 1; E.O = PROJ; E.ldc = DINP; E.rs_src = SSX; E.ssq = SSQ; E.sskv = SSKV; Em.need_rs = 1; }
                else if (k == 1 && gi == 0) { g = pg8::Gemm{PROJ + C_CQ, WUQ + (size_t)l * 768 * 256, MREAL, 768, 256, DINP}; E.mode = 0; E.perm = 1; E.O = QRAW; E.ldc = 768; E.rs_src = SSQ; E.rs_cnt = 4; E.rs_div = 1.f / 256.f; Em.need_rs = 1; Em.rs_div = 1.f / 256.f; }
                else if (k == 1) { g = pg8::Gemm{PROJ + C_CKV, WUKV + (size_t)l * 1024 * 128, MREAL, 1024, 128, DINP}; E.mode = 0; E.perm = 1; E.O = KVR; E.ldc = 1024; E.rs_src = SSKV; E.rs_cnt = 4; E.rs_div = 1.f / 128.f; Em.need_rs = 1; Em.rs_div = 1.f / 128.f; }
                else if (k == 4) { g = pg8::Gemm{MIX, WOUT + (size_t)l * DM * DM, MREAL, DM, DM, DM}; E.mode = 2; E.perm = 1; }
                else if (k == 5) { g = pg8::Gemm{XR, W1 + (size_t)l * DFF * DM, MREAL, DFF, DM, DM}; E.mode = 1; E.perm = 1; E.O = HB; E.ldc = DFF; E.rs_src = SSX; Em.need_rs = 1; }
                else             { g = pg8::Gemm{HB, W2 + (size_t)l * DM * DFF, MREAL, DM, DFF, DFF}; E.mode = (l == DEPTH - 1) ? 3 : 2; E.perm = 1; }
                Em.mode = E.mode; Em.O = E.O; Em.ldc = E.ldc;
                pg8::StaticOrder S; S.init(MREAL, g.N, G, (int)blockIdx.x);
                pg8::gemm_phase<pg8::EpiAny, pg8::StaticOrder, true, true>(lds, g, S, E, tid);
                if (E.mode != 3) meta_gemm(g.A + (size_t)MR0 * g.lda, g.lda, g.Bt, g.N, g.K, Em, gw, NGW, lane);
            }
            if (k == 1) {
                const float* cw = ap->in[I_CONVW] + l * 3 * 256;
                for (int it = blockIdx.x * 512 + tid; it < MV * 32; it += G * 512) {
                    const int m = it >> 5, c = (it & 31) * 8; const int t = m >= MR0 ? m - MR0 : (m & (SEQ - 1)) + NMETA; const bf16* pr = PROJ + (size_t)m * DINP;
                    const u32x4 cbv = *(const u32x4*)(pr + C_CB + c); float a[8];
#pragma unroll
                    for (int e = 0; e < 8; ++e) a[e] = 0.f;
#pragma unroll
                    for (int j = 0; j < 3; ++j) { const int tj = t - 2 + j; if (tj >= 0) { const int mj = (m >= MR0 || tj >= NMETA) ? m - (2 - j) : MR0 + tj;
                            const bf16* p2 = PROJ + (size_t)mj * DINP; const u32x4 ccv = *(const u32x4*)(p2 + C_CC + c), chv = *(const u32x4*)(p2 + C_CH + c);
                            const f32x4 w0 = *(const f32x4*)(cw + j * 256 + c), w1 = *(const f32x4*)(cw + j * 256 + c + 4);
#pragma unroll
                            for (int e = 0; e < 4; ++e) { const float wl = e < 2 ? w0[2 * e] : w1[2 * e - 4], wh = e < 2 ? w0[2 * e + 1] : w1[2 * e - 3];
                                a[2 * e] += wl * (bflo(ccv[e]) * bflo(chv[e])); a[2 * e + 1] += wh * (bfhi(ccv[e]) * bfhi(chv[e])); } } }
                    u32x4 o;
#pragma unroll
                    for (int e = 0; e < 4; ++e) o[e] = att::cvtpk(bflo(cbv[e]) * a[2 * e], bfhi(cbv[e]) * a[2 * e + 1]);
                    *(u32x4*)(MIX + (size_t)m * DM + c) = o;
                }
                for (int it = blockIdx.x * 512 + tid; it < MV * 32; it += G * 512) {
                    const int m = it >> 5, j = it & 31, w = j >> 4, h = (j >> 2) & 3, i0 = (j & 3) * 8; const int t = m >= MR0 ? m - MR0 : (m & (SEQ - 1)) + NMETA;
                    bf16* p = PROJ + (size_t)m * DINP + (w ? C_RK : C_RQ) + 64 * h + i0; const float sc = w ? 0.125f : 1.f;
                    const u32x4 x1 = *(const u32x4*)p, x2 = *(const u32x4*)(p + 32); const f32x4* cs = (const f32x4*)(RT + t * 32 + i0);
                    u32x4 o1, o2;
#pragma unroll
                    for (int e = 0; e < 4; ++e) { const f32x4 c4 = cs[e]; const float a0 = bflo(x1[e]), a1 = bfhi(x1[e]), b0 = bflo(x2[e]), b1 = bfhi(x2[e]);
                        o1[e] = att::cvtpk((a0 * c4.x - b0 * c4.y) * sc, (a1 * c4.z - b1 * c4.w) * sc); o2[e] = att::cvtpk((b0 * c4.x + a0 * c4.y) * sc, (b1 * c4.z + a1 * c4.w) * sc); }
                    *(u32x4*)p = o1; *(u32x4*)(p + 32) = o2;
                }
            }
        } else if (k == 2) {
            const float* kg = ap->in[I_KHG] + l * 96;
            for (int it = blockIdx.x * 512 + tid; it < MV * 8; it += G * 512) {
                const int m = it >> 3, h = it & 7; const int t = m >= MR0 ? m - MR0 : (m & (SEQ - 1)) + NMETA;
                const f32x4* mt = (const f32x4*)(MT + t * 16);
                { bf16* kn = KVR + (size_t)m * 1024 + 128 * h; bf16* pr = PROJ + (size_t)m * DINP; bf16* ko = pr + 96 * h; u32x4 w[8], r[4]; float ssn = 0.f, ssr = 0.f;
#pragma unroll
                  for (int c = 0; c < 8; ++c) w[c] = *(const u32x4*)(kn + 8 * c);
#pragma unroll
                  for (int c = 0; c < 4; ++c) r[c] = *(const u32x4*)(pr + C_KR + 8 * c);
#pragma unroll
                  for (int c = 0; c < 8; ++c)
#pragma unroll
                      for (int e = 0; e < 4; ++e) { const float a0 = bflo(w[c][e]), a1 = bfhi(w[c][e]); ssn += a0 * a0 + a1 * a1; }
#pragma unroll
                  for (int c = 0; c < 4; ++c)
#pragma unroll
                      for (int e = 0; e < 4; ++e) { const float a0 = bflo(r[c][e]), a1 = bfhi(r[c][e]); ssr += a0 * a0 + a1 * a1; }
                  const float rs = 1.0f / sqrtf((ssn + ssr) * (1.f / 96.f) + EPS), rn = rs;
#pragma unroll
                  for (int c = 0; c < 8; ++c) { u32x4 o;
#pragma unroll
                      for (int e = 0; e < 4; ++e) o[e] = att::cvtpk(bflo(w[c][e]) * rn * kg[8 * c + 2 * e], bfhi(w[c][e]) * rn * kg[8 * c + 2 * e + 1]);
                      *(u32x4*)(ko + 8 * c) = o; }
#pragma unroll
                  for (int cc = 0; cc < 2; ++cc) { u32x4 o1, o2;
#pragma unroll
                      for (int e = 0; e < 4; ++e) { const int i = 8 * cc + 2 * e; const f32x4 c4 = mt[4 * cc + e];
                          const float a0 = bflo(r[cc][e]) * rs * kg[64 + i], a1 = bfhi(r[cc][e]) * rs * kg[64 + i + 1], b0 = bflo(r[2 + cc][e]) * rs * kg[80 + i], b1 = bfhi(r[2 + cc][e]) * rs * kg[80 + i + 1];
                          o1[e] = att::cvtpk(a0 * c4.x - b0 * c4.y, a1 * c4.z - b1 * c4.w); o2[e] = att::cvtpk(b0 * c4.x + a0 * c4.y, b1 * c4.z + a1 * c4.w); }
                      *(u32x4*)(ko + 64 + 8 * cc) = o1; *(u32x4*)(ko + 80 + 8 * cc) = o2; }
                }
            }
        } else {
            for (int item = blockIdx.x; item < 524; item += G) {
                if (item < 256 || (item >= 512 && item < 520)) { const bool meta = item >= 512; const int b = meta ? 0 : item >> 3, h = item & 7;
                    const bf16* Qp = QRAW + 96 * h; const bf16* Kp = PROJ + 96 * h; const bf16* Vp = KVR + 128 * h + 64; bf16* Op = MIX + 512 + 64 * h;
                    if (meta) att::unit<96, true>(lds, Qp, 768, Kp, DINP, Vp, 1024, Op, DM, nullptr, 0, nullptr, 0.f, b, 0, 16, tid, SQA, ap->in[I_QHG] + l * 96, MT);
                    else for (int blk = 8; blk >= 1; --blk) { const int q0 = 16 + 256 * (blk - 1);
                        att::unit<96, true>(lds, Qp, 768, Kp, DINP, Vp, 1024, Op, DM, nullptr, 0, nullptr, 0.f, b, q0, q0 + 256, tid, SQA, ap->in[I_QHG] + l * 96, MT); }
                } else { const bool meta = item >= 520; const int it = item - 256, bh = it >> 1, hf = it & 1, b = meta ? 0 : bh >> 2, h = meta ? item - 520 : bh & 3;
                    const bf16* Pp = PROJ + 64 * h; bf16* Op = MIX + 256 + 64 * h; const float* gn = ap->in[I_RETG] + l * 256 + 64 * h;
                    const float lg2 = log2f(1.0f - exp2f(-5.0f - (float)h)); const unsigned bm = hf ? 0x0CCu : 0x132u;
                    if (meta) att::unit<64, false>(lds, Pp + C_RQ, DINP, Pp + C_RK, DINP, Pp + C_RV, DINP, Op, DM, Pp + C_RG, DINP, gn, lg2, b, 0, 16, tid, nullptr, nullptr, nullptr);
                    else for (int blk = 8; blk >= 1; --blk) { if (!((bm >> blk) & 1u)) continue; const int q0 = 16 + 256 * (blk - 1);
                        att::unit<64, false>(lds, Pp + C_RQ, DINP, Pp + C_RK, DINP, Pp + C_RV, DINP, Op, DM, Pp + C_RG, DINP, gn, lg2, b, q0, q0 + 256, tid, nullptr, nullptr, nullptr); }
                }
            }
        }
        if (ph + 1 < hi) {
            if (lo < 0) grid.sync();
            { XcdBarrier xbar; xbar.bar = (unsigned*)ws; xbar.x = xb_xcc_id(); xbar.st = (volatile LAS unsigned*)(lds + XB_LDS_OFF); xcd_barrier(xbar); }
        }
    }
}

extern "C" void kernel_launch(void* const* d_in, const int* in_sizes, int n_in, void* d_out, int out_size, void* d_ws, size_t ws_size, hipStream_t stream) {
    static int grid = 0;
    if (grid == 0) {
        if (n_in != 16 || out_size != MREAL * DM || ws_size < WS_END) { fprintf(stderr, "kernel_launch: unexpected shapes (n_in %d, out %d, ws %zu)\n", n_in, out_size, ws_size); grid = -1; return; }
        int dev = 0, cus = 0, per_cu = 0;
        if (hipGetDevice(&dev) != hipSuccess || hipDeviceGetAttribute(&cus, hipDeviceAttributeMultiprocessorCount, dev) != hipSuccess) { grid = -1; return; }
        if (hipFuncSetAttribute((const void*)hybrid_fwd, hipFuncAttributeMaxDynamicSharedMemorySize, LDS_BYTES) != hipSuccess) { fprintf(stderr, "kernel_launch: hipFuncSetAttribute failed\n"); grid = -1; return; }
        if (hipOccupancyMaxActiveBlocksPerMultiprocessor(&per_cu, (const void*)hybrid_fwd, NWAVES * 64, LDS_BYTES) != hipSuccess || per_cu < 1) { fprintf(stderr, "kernel_launch: occupancy query says %d\n", per_cu); per_cu = 1; }
        (void)hipGetLastError();
        grid = cus;
    }
    if (grid < 0) return;
    if (hipMemsetAsync(d_ws, 0, 16384, stream) != hipSuccess) { fprintf(stderr, "kernel_launch: hipMemsetAsync of the barrier words failed\n"); return; }
    Args a{};
    for (int i = 0; i < 16; ++i) a.in[i] = (const float*)d_in[i];
    a.out = (float*)d_out; a.ws = (unsigned char*)d_ws;
#if MK_MULTI
    for (int ph = 0; ph < NPHASE; ++ph) { a.ph_lo = ph; a.ph_hi = ph + 1; hipLaunchKernelGGL(hybrid_fwd, dim3(grid), dim3(NWAVES * 64), LDS_BYTES, stream, a); }
#else
    a.ph_lo = 0; a.ph_hi = NPHASE;
    void* kargs[] = {&a};
    const hipError_t e = hipLaunchCooperativeKernel((const void*)hybrid_fwd, dim3(grid), dim3(NWAVES * 64), kargs, LDS_BYTES, stream);
    if (e != hipSuccess) fprintf(stderr, "kernel_launch: cooperative launch failed: %s (grid %d)\n", hipGetErrorString(e), grid);
#endif
}
```

```cpp
#include <hip/hip_runtime.h>
#include <hip/hip_cooperative_groups.h>
#include <cstdio>
#include <cstdint>
#include <cmath>
namespace cg = cooperative_groups;
#ifndef MK_MULTI
#define MK_MULTI 0
#endif
namespace pg8 {
#define PG8_LAS __attribute__((address_space(3)))
typedef unsigned short bf16_t;
typedef short bf16x8 __attribute__((ext_vector_type(8)));
typedef float f32x4 __attribute__((ext_vector_type(4)));
typedef unsigned u32x4 __attribute__((ext_vector_type(4)));
typedef unsigned u32x2 __attribute__((ext_vector_type(2)));
constexpr int BM = 256, BK = 64, HALF = 128, HTB = HALF * BK * 2  , STAGE_BYTES = 8 * HTB, NXCD = 8, WGM = 8;

__host__ __device__ __forceinline__ int lds_byte(int r, int c) { const int st = (r >> 4) * 2 + (c >> 5), rr = r & 15, cc = c & 31, ob = rr * 64 + cc * 2; return st * 1024 + (ob ^ (((ob >> 9) & 1) << 5)); }
__host__ __device__ __forceinline__ void stage_rc(int b, int& R, int& C) { const int st = b / 1024, sb = b % 1024, swz = sb ^ (((sb >> 9) & 1) << 5); R = (st >> 1) * 16 + swz / 64; C = (st & 1) * 32 + (swz % 64) / 2; }
__host__ __device__ __forceinline__ int perm32(int rho) { const int n = rho >> 4, i = rho & 15; return 8 * (i >> 2) + 4 * n + (i & 3); }

__device__ __forceinline__ int lane_asm() { int l; asm volatile("v_mbcnt_lo_u32_b32 %0, -1, 0\n\tv_mbcnt_hi_u32_b32 %0, -1, %0" : "=v"(l)); return l; }
__device__ __forceinline__ int opaque_tid() { int t = threadIdx.x; asm volatile("" : "+v"(t)); return t; }
struct Unit { int pm, pn; };
struct Gemm { const bf16_t* A; const bf16_t* Bt; int M, N, K, lda; };

struct StaticOrder {
    int nM, nN, nwg, G, c;
    __host__ __device__ void init(int M, int N, int G_, int c_) { nM = M / BM; nN = N / BM; nwg = nM * nN; G = G_; c = c_; }
    __host__ __device__ bool next(int i, Unit& u) const {
        const long L = (long)i * G + c; if (L >= nwg) return false;
        int wgid = (int)L; { const int q = nwg / NXCD, r = nwg % NXCD, xcd = wgid % NXCD, off = wgid / NXCD; wgid = (xcd < r ? xcd * (q + 1) : r * (q + 1) + (xcd - r) * q) + off; }
        const int nig = WGM * nN, gid = wgid / nig, fm = gid * WGM, gsz = (nM - fm) < WGM ? (nM - fm) : WGM;
        u.pm = fm + ((wgid % nig) % gsz); u.pn = (wgid % nig) / gsz; return true;
    }
    __device__ __forceinline__ void a_ready(const Unit&) const {}
    __device__ __forceinline__ void done(const Unit&) const {}
};

__device__ __forceinline__ unsigned cvt_pk_bf16(float lo, float hi) { unsigned r; asm volatile("v_cvt_pk_bf16_f32 %0, %1, %2" : "=v"(r) : "v"(lo), "v"(hi)); return r; }
__device__ __forceinline__ float fq_sum(float v) {
    auto a = __builtin_amdgcn_permlane16_swap(__float_as_uint(v), __float_as_uint(v), false, false); v = __uint_as_float(a[0]) + __uint_as_float(a[1]);
    auto b = __builtin_amdgcn_permlane32_swap(__float_as_uint(v), __float_as_uint(v), false, false); return __uint_as_float(b[0]) + __uint_as_float(b[1]);
}
struct EpiAny {
    static constexpr bool AFTER_DRAIN = false;
    int mode, perm; bf16_t* O; int ldc; bf16_t* xr; float* out; float* ssx; const float* rs_src; int rs_cnt; float rs_div; float* ssq; float* sskv;
    __device__ __forceinline__ void operator()(const f32x4 (&acc)[2][2][4][2], const Unit& u, int wr, int wc, int fr, int fq) const {
        if (mode < 2) {
            const int row0 = u.pm * BM + wr * 64 + fr; const int col0 = u.pn * BM + wc * 32 + 8 * fq; const bool sq = mode == 1;
            const int sstile = ssq ? (u.pn == 7 ? 1 : (u.pn == 8 ? 2 : 0)) : 0;
            float rsv[2][4];
            if (rs_src) {
                f32x4 pq[2][4]; const bool split = rs_cnt == 16;
#pragma unroll
                for (int ai = 0; ai < 2; ++ai)
#pragma unroll
                    for (int m = 0; m < 4; ++m) pq[ai][m] = *(const f32x4*)(rs_src + (size_t)(row0 + ai * HALF + m * 16) * rs_cnt + (split ? 4 * fq : 0));
#pragma unroll
                for (int ai = 0; ai < 2; ++ai)
#pragma unroll
                    for (int m = 0; m < 4; ++m) { const f32x4 a = pq[ai][m]; float t = (a[0] + a[1]) + (a[2] + a[3]); if (split) t = fq_sum(t); rsv[ai][m] = 1.0f / sqrtf(t * rs_div + 1e-6f); }
            } else {
#pragma unroll
                for (int ai = 0; ai < 2; ++ai)
#pragma unroll
                    for (int m = 0; m < 4; ++m) rsv[ai][m] = 1.f;
            }
#pragma unroll
            for (int ai = 0; ai < 2; ++ai)
#pragma unroll
                for (int m = 0; m < 4; ++m) { const int row = row0 + ai * HALF + m * 16; bf16_t* rowp = O + (size_t)row * ldc + col0;
                    const float rs = rsv[ai][m]; float part = 0.f;
#pragma unroll
                    for (int bj = 0; bj < 2; ++bj) { f32x4 v0 = acc[ai][bj][m][0] * rs, v1 = acc[ai][bj][m][1] * rs;
                        if (sq) {
#pragma unroll
                            for (int e = 0; e < 4; ++e) { const float a = fmaxf(v0[e], 0.f), b = fmaxf(v1[e], 0.f); v0[e] = a * a; v1[e] = b * b; } }
                        if (sstile == 1 || (sstile == 2 && bj == 0)) part += ((v0[0] * v0[0] + v0[1] * v0[1]) + (v0[2] * v0[2] + v0[3] * v0[3])) + ((v1[0] * v1[0] + v1[1] * v1[1]) + (v1[2] * v1[2] + v1[3] * v1[3]));
                        u32x4 w; w.x = cvt_pk_bf16(v0[0], v0[1]); w.y = cvt_pk_bf16(v0[2], v0[3]); w.z = cvt_pk_bf16(v1[0], v1[1]); w.w = cvt_pk_bf16(v1[2], v1[3]);
                        *(u32x4*)(rowp + bj * HALF) = w; }
                    if (sstile) { part = fq_sum(part); if (fq == 0) (sstile == 1 ? ssq : sskv)[(size_t)row * 4 + wc] = part; }
                }
        } else {
            const int col0 = u.pn * BM + wc * 32 + 8 * fq; const bool toout = mode == 3;
#pragma unroll
            for (int ai = 0; ai < 2; ++ai) {
                u32x4 xw[4][2];
#pragma unroll
                for (int m = 0; m < 4; ++m) { const bf16_t* xp = xr + (size_t)(u.pm * BM + ai * HALF + wr * 64 + m * 16 + fr) * 1024 + col0;
#pragma unroll
                    for (int bj = 0; bj < 2; ++bj) xw[m][bj] = *(const u32x4*)(xp + bj * HALF); }
#pragma unroll
                for (int m = 0; m < 4; ++m) { const int r = u.pm * BM + ai * HALF + wr * 64 + m * 16 + fr; bf16_t* xp = xr + (size_t)r * 1024 + col0; float* op = out + (size_t)r * 1024 + col0; float part = 0.f;
#pragma unroll
                    for (int bj = 0; bj < 2; ++bj) { const u32x4 w0 = xw[m][bj]; f32x4 v0 = acc[ai][bj][m][0], v1 = acc[ai][bj][m][1];
                        v0[0] += __uint_as_float(w0.x << 16); v0[1] += __uint_as_float(w0.x & 0xffff0000u); v0[2] += __uint_as_float(w0.y << 16); v0[3] += __uint_as_float(w0.y & 0xffff0000u);
                        v1[0] += __uint_as_float(w0.z << 16); v1[1] += __uint_as_float(w0.z & 0xffff0000u); v1[2] += __uint_as_float(w0.w << 16); v1[3] += __uint_as_float(w0.w & 0xffff0000u);
                        if (toout) { *(f32x4*)(op + bj * HALF) = v0; *(f32x4*)(op + bj * HALF + 4) = v1; }
                        else { part += ((v0[0] * v0[0] + v0[1] * v0[1]) + (v0[2] * v0[2] + v0[3] * v0[3])) + ((v1[0] * v1[0] + v1[1] * v1[1]) + (v1[2] * v1[2] + v1[3] * v1[3]));
                               u32x4 w; w.x = cvt_pk_bf16(v0[0], v0[1]); w.y = cvt_pk_bf16(v0[2], v0[3]); w.z = cvt_pk_bf16(v1[0], v1[1]); w.w = cvt_pk_bf16(v1[2], v1[3]); *(u32x4*)(xp + bj * HALF) = w; } }
                    if (!toout) { part = fq_sum(part); if (fq == 0) ssx[(size_t)r * 16 + u.pn * 4 + wc] = part; }
                }
                asm volatile("" ::: "memory");
            }
        }
    }
};

template <class Epi, class Sched, bool ALIGN_EPI = false, bool SP2 = false>
__device__ __forceinline__ void gemm_phase(PG8_LAS unsigned char* lds, const Gemm g, const Sched& S, const Epi& E, const int tid_in) {
    int tid_o = tid_in + lane_asm();
    const int tid = tid_o, wid = __builtin_amdgcn_readfirstlane(tid >> 6), lane = tid & 63, wr = wid >> 2, wc = wid & 3, fr = lane & 15, fq = lane >> 4;
    const int K = g.K, nt = K / BK;
    unsigned voffA[2], voffB[2];
#pragma unroll
    for (int i = 0; i < 2; ++i) { int R, C; stage_rc(tid * 16 + i * 8192, R, C); const int Rb = E.perm ? ((R & ~31) + perm32(R & 31)) : R;
        voffA[i] = (unsigned)(R * g.lda + C) * 2u; voffB[i] = (unsigned)(Rb * K + C) * 2u; }
    const size_t kstep = (size_t)(BK * 2);
    const size_t hstepA = (size_t)HALF * g.lda * 2, hstepB = (size_t)HALF * K * 2;
    const size_t tstepA = 2 * hstepA, tstepB = 2 * hstepB;
    const unsigned ldsw = (unsigned)wid * 1024u;
    const int aoff = lds_byte(wr * 64 + fr, fq * 8), boff = lds_byte(wc * 32 + fr, fq * 8);
#define PG8_SA(b, h) (((b) * 2 + (h)) * HTB)
#define PG8_SB(b, h) ((4 + (b) * 2 + (h)) * HTB)
#define PG8_STAGE(bufoff, gbase, voff) do { _Pragma("unroll") for (int _i = 0; _i < 2; ++_i) \
        __builtin_amdgcn_global_load_lds((const unsigned*)((const char*)(gbase) + (voff)[_i]), (PG8_LAS unsigned*)(lds + (bufoff) + ldsw + _i * 8192), 16, 0, 0); } while (0)
#define PG8_LDA(dst, b, h) do { _Pragma("unroll") for (int m = 0; m < 4; ++m) _Pragma("unroll") for (int k = 0; k < 2; ++k) dst[m][k] = *(const PG8_LAS bf16x8*)(lds + PG8_SA(b, h) + aoff + m * 2048 + k * 1024); } while (0)
#define PG8_LDB(dst, b, h) do { _Pragma("unroll") for (int n = 0; n < 2; ++n) _Pragma("unroll") for (int k = 0; k < 2; ++k) dst[n][k] = *(const PG8_LAS bf16x8*)(lds + PG8_SB(b, h) + boff + n * 2048 + k * 1024); } while (0)
#define PG8_MMA(ai, bj, At, Bt) do { __builtin_amdgcn_s_setprio(1); _Pragma("unroll") for (int m = 0; m < 4; ++m) _Pragma("unroll") for (int n = 0; n < 2; ++n) _Pragma("unroll") for (int k = 0; k < 2; ++k) \
        acc[ai][bj][m][n] = __builtin_amdgcn_mfma_f32_16x16x32_bf16(Bt[n][k], At[m][k], acc[ai][bj][m][n], 0, 0, 0); __builtin_amdgcn_s_setprio(0); } while (0)
#define PG8_WAIT_V(n) asm volatile("s_waitcnt vmcnt(" #n ")" ::: "memory")
#define PG8_WAIT_L(n) asm volatile("s_waitcnt lgkmcnt(" #n ")" ::: "memory")
#define PG8_BAR __builtin_amdgcn_s_barrier()
#define PG8_SCHED __builtin_amdgcn_sched_barrier(0)
    Unit cur, nxt; int ui = 0;
    if (!S.next(0, cur)) return;
    f32x4 acc[2][2][4][2];
#pragma unroll
    for (int a = 0; a < 2; ++a)
#pragma unroll
        for (int b = 0; b < 2; ++b)
#pragma unroll
            for (int m = 0; m < 4; ++m)
#pragma unroll
                for (int n = 0; n < 2; ++n) acc[a][b][m][n] = (f32x4){0.f, 0.f, 0.f, 0.f};
    bf16x8 At[4][2], B0[2][2], B1[2][2];
    const char* cA = (const char*)g.A + (size_t)cur.pm * tstepA; const char* cB = (const char*)g.Bt + (size_t)cur.pn * tstepB;
    S.a_ready(cur);
    if constexpr (SP2) {
        PG8_STAGE(PG8_SB(0, 0), cB, voffB); PG8_STAGE(PG8_SB(0, 1), cB + hstepB, voffB); PG8_STAGE(PG8_SA(0, 0), cA, voffA); PG8_STAGE(PG8_SA(0, 1), cA + hstepA, voffA);
        if (wr == 1) PG8_BAR;
        PG8_WAIT_V(2); PG8_BAR;
        PG8_STAGE(PG8_SB(1, 0), cB + kstep, voffB); PG8_STAGE(PG8_SA(1, 0), cA + kstep, voffA); PG8_STAGE(PG8_SB(1, 1), cB + hstepB + kstep, voffB);
        PG8_WAIT_V(6); PG8_BAR;
    } else {
        PG8_STAGE(PG8_SB(0, 0), cB, voffB); PG8_STAGE(PG8_SA(0, 0), cA, voffA); PG8_STAGE(PG8_SB(0, 1), cB + hstepB, voffB); PG8_STAGE(PG8_SA(0, 1), cA + hstepA, voffA);
        if (wr == 1) PG8_BAR;
        PG8_WAIT_V(4); PG8_BAR;
        PG8_STAGE(PG8_SB(1, 0), cB + kstep, voffB); PG8_STAGE(PG8_SA(1, 0), cA + kstep, voffA); PG8_STAGE(PG8_SB(1, 1), cB + hstepB + kstep, voffB);
        PG8_WAIT_V(6); PG8_BAR;
    }
    for (;;) {
        const bool has_next = S.next(ui + 1, nxt);
        const char* nA = has_next ? (const char*)g.A + (size_t)nxt.pm * tstepA : cA; const char* nB = has_next ? (const char*)g.Bt + (size_t)nxt.pn * tstepB : cB;
        for (int t = 0; t < nt; t += 2) {
            const bool last = (t == nt - 2);
            const char* a1 = cA + (size_t)(t + 1) * kstep;
            const char* a2 = last ? nA : cA + (size_t)(t + 2) * kstep; const char* b2 = last ? nB : cB + (size_t)(t + 2) * kstep;
            const char* a3 = a2 + kstep; const char* b3 = b2 + kstep;
            if (last && has_next) S.a_ready(nxt);
            if constexpr (SP2) {
            PG8_LDB(B0, 0, 0); PG8_LDB(B1, 0, 1); PG8_SCHED; PG8_LDA(At, 0, 0); PG8_STAGE(PG8_SA(1, 1), a1 + hstepA, voffA);
            PG8_WAIT_V(8); PG8_WAIT_L(0); PG8_BAR; PG8_MMA(0, 0, At, B0); PG8_MMA(0, 1, At, B1); PG8_BAR; PG8_SCHED;
            PG8_LDA(At, 0, 1); PG8_STAGE(PG8_SB(0, 0), b2, voffB); PG8_STAGE(PG8_SB(0, 1), b2 + hstepB, voffB); PG8_STAGE(PG8_SA(0, 0), a2, voffA);
            PG8_WAIT_V(8); PG8_WAIT_L(0); PG8_BAR; PG8_MMA(1, 0, At, B0); PG8_MMA(1, 1, At, B1); PG8_BAR; PG8_SCHED;
            PG8_LDB(B0, 1, 0); PG8_LDB(B1, 1, 1); PG8_SCHED; PG8_LDA(At, 1, 0); PG8_STAGE(PG8_SA(0, 1), a2 + hstepA, voffA);
            PG8_WAIT_V(8); PG8_WAIT_L(0); PG8_BAR; PG8_MMA(0, 0, At, B0); PG8_MMA(0, 1, At, B1); PG8_BAR; PG8_SCHED;
            PG8_LDA(At, 1, 1); PG8_STAGE(PG8_SB(1, 0), b3, voffB); PG8_STAGE(PG8_SB(1, 1), b3 + hstepB, voffB); PG8_STAGE(PG8_SA(1, 0), a3, voffA);
            PG8_WAIT_V(8); PG8_WAIT_L(0); PG8_BAR; PG8_MMA(1, 0, At, B0); PG8_MMA(1, 1, At, B1); PG8_BAR; PG8_SCHED;
            } else {
            PG8_LDB(B0, 0, 0); PG8_SCHED; PG8_LDA(At, 0, 0); PG8_STAGE(PG8_SA(1, 1), a1 + hstepA, voffA);
            PG8_WAIT_L(8); PG8_BAR; PG8_WAIT_L(0); PG8_MMA(0, 0, At, B0); PG8_BAR; PG8_SCHED;
            PG8_LDB(B1, 0, 1); PG8_STAGE(PG8_SB(0, 0), b2, voffB);
            PG8_BAR; PG8_WAIT_L(0); PG8_MMA(0, 1, At, B1); PG8_BAR;
            PG8_LDA(At, 0, 1); PG8_STAGE(PG8_SA(0, 0), a2, voffA);
            PG8_BAR; PG8_WAIT_L(0); PG8_MMA(1, 0, At, B0); PG8_BAR; PG8_SCHED;
            PG8_STAGE(PG8_SB(0, 1), b2 + hstepB, voffB);
            PG8_WAIT_V(6); PG8_BAR; PG8_MMA(1, 1, At, B1); PG8_BAR;
            PG8_LDB(B0, 1, 0); PG8_SCHED; PG8_LDA(At, 1, 0); PG8_STAGE(PG8_SA(0, 1), a2 + hstepA, voffA);
            PG8_WAIT_L(8); PG8_BAR; PG8_WAIT_L(0); PG8_MMA(0, 0, At, B0); PG8_BAR; PG8_SCHED;
            PG8_LDB(B1, 1, 1); PG8_STAGE(PG8_SB(1, 0), b3, voffB);
            PG8_BAR; PG8_WAIT_L(0); PG8_MMA(0, 1, At, B1); PG8_BAR;
            PG8_LDA(At, 1, 1); PG8_STAGE(PG8_SA(1, 0), a3, voffA);
            PG8_BAR; PG8_WAIT_L(0); PG8_MMA(1, 0, At, B0); PG8_BAR; PG8_SCHED;
            PG8_STAGE(PG8_SB(1, 1), b3 + hstepB, voffB);
            PG8_WAIT_V(6); PG8_BAR; PG8_MMA(1, 1, At, B1); PG8_BAR;
            }
        }
        if constexpr (ALIGN_EPI) { if (wr == 0) PG8_BAR; }
        if constexpr (!Epi::AFTER_DRAIN) { E(acc, cur, wr, wc, fr, fq); S.done(cur); }
        if (!has_next) break;
#pragma unroll
        for (int a = 0; a < 2; ++a)
#pragma unroll
            for (int b = 0; b < 2; ++b)
#pragma unroll
                for (int m = 0; m < 4; ++m)
#pragma unroll
                    for (int n = 0; n < 2; ++n) acc[a][b][m][n] = (f32x4){0.f, 0.f, 0.f, 0.f};
        cur = nxt; cA = nA; cB = nB; ++ui;
        if constexpr (ALIGN_EPI) { if (wr == 1) PG8_BAR; }
    }
    PG8_WAIT_V(0);
    if constexpr (!ALIGN_EPI) { if (wr == 0) PG8_BAR; }
    PG8_BAR;
    if constexpr (Epi::AFTER_DRAIN) { E.fused(acc, cur, wr, wc, fr, fq, lds, wid, lane); S.done(cur); }
#undef PG8_SA
#undef PG8_SB
#undef PG8_STAGE
#undef PG8_LDA
#undef PG8_LDB
#undef PG8_MMA
#undef PG8_WAIT_V
#undef PG8_WAIT_L
#undef PG8_BAR
#undef PG8_SCHED
}
}

#define GAS __attribute__((address_space(1)))
#define LAS __attribute__((address_space(3)))
typedef unsigned short bf16;
typedef unsigned u32x4 __attribute__((ext_vector_type(4)));
typedef unsigned u32x2 __attribute__((ext_vector_type(2)));
typedef float f32x4 __attribute__((ext_vector_type(4)));
typedef float f32x2 __attribute__((ext_vector_type(2)));
typedef short bf16x8 __attribute__((ext_vector_type(8)));
typedef float f32x16 __attribute__((ext_vector_type(16)));
constexpr int DM = 1024, BATCH = 32, SEQ = 2048, NMETA = 16, TT = SEQ + NMETA, DIN = 2208, DINP = 2304, DFF = 4096, DEPTH = 2;
constexpr int MREAL = BATCH * SEQ, MR0 = MREAL, MV = MREAL + NMETA, M = MREAL + 256;
static_assert(MREAL % 256 == 0, "row tiles");
__device__ __forceinline__ int rowof(int b, int t) { return t < NMETA ? MR0 + t : b * SEQ + (t - NMETA); }
constexpr int C_CB = 0, C_CC = 256, C_CH = 512, C_RQ = 768, C_RK = 1024, C_RV = 1280, C_RG = 1536, C_CQ = 1792, C_CKV = 2048, C_KR = 2176;
constexpr float EPS = 1e-6f;
constexpr float QSCALE = 0.10206207261596575f * 1.4426950408889634f;
constexpr size_t MiB = 1u << 20;
constexpr size_t WS_RT = 1 * MiB, WS_MT = 1 * MiB + 768 * 1024;
constexpr size_t WS_WIN = 4 * MiB, WS_WUQ = 13 * MiB, WS_WUKV = 14 * MiB, WS_WOUT = 15 * MiB, WS_W1 = 19 * MiB, WS_W2 = 35 * MiB;
constexpr size_t WS_X = 52 * MiB, WS_XN = 310 * MiB, WS_PROJ = 440 * MiB, WS_QRAW = 731 * MiB, WS_KV = 828 * MiB, WS_H = 440 * MiB, WS_SSX = 958 * MiB, WS_SSQ = 964 * MiB, WS_SSKV = 966 * MiB, WS_SQA = 968 * MiB, WS_END = 969 * MiB;
static_assert(WS_X + (size_t)M * DM * 4 <= WS_XN && WS_XN + (size_t)M * DM * 2 <= WS_PROJ && WS_PROJ + (size_t)M * DINP * 2 <= WS_QRAW && WS_QRAW + (size_t)M * 768 * 2 <= WS_KV &&
              WS_KV + (size_t)M * 1024 * 2 <= WS_SSX && WS_H + (size_t)M * DFF * 2 <= WS_SSX && WS_SSX + (size_t)M * 64 <= WS_SSQ && WS_SSQ + (size_t)M * 16 <= WS_SSKV && WS_SSKV + (size_t)M * 16 <= WS_SQA && WS_SQA + (size_t)M * 4 <= WS_END, "d_ws map");
constexpr int NWAVES = 8, LDS_BYTES = 147456, XB_LDS_OFF = 131072 + 256;

__device__ __forceinline__ unsigned f2bf(float f) { unsigned u = __builtin_bit_cast(unsigned, f); return (u + 0x7fffu + ((u >> 16) & 1u)) >> 16; }
__device__ __forceinline__ unsigned pk2(float lo, float hi) { return f2bf(lo) | (f2bf(hi) << 16); }
__device__ __forceinline__ float bflo(unsigned w) { return __uint_as_float(w << 16); }
__device__ __forceinline__ float bfhi(unsigned w) { return __uint_as_float(w & 0xffff0000u); }
__device__ __forceinline__ float bf1(bf16 h) { return __uint_as_float((unsigned)h << 16); }
__device__ __forceinline__ float dpp_add(float v, int ctrl_b1, int ctrl_4e, int ctrl_hm, int ctrl_m) { return v; }
__device__ __forceinline__ float wave_sum(float v) {
    v += __int_as_float(__builtin_amdgcn_update_dpp(0, __float_as_int(v), 0xB1, 0xF, 0xF, false));
    v += __int_as_float(__builtin_amdgcn_update_dpp(0, __float_as_int(v), 0x4E, 0xF, 0xF, false));
    v += __int_as_float(__builtin_amdgcn_update_dpp(0, __float_as_int(v), 0x141, 0xF, 0xF, false));
    v += __int_as_float(__builtin_amdgcn_update_dpp(0, __float_as_int(v), 0x140, 0xF, 0xF, false));
    return pg8::fq_sum(v);
}

namespace att {
typedef float f32x2_t __attribute__((ext_vector_type(2))); typedef __bf16 bf16x2_t __attribute__((ext_vector_type(2)));
__device__ __forceinline__ unsigned cvtpk(float lo, float hi) { f32x2_t v = {lo, hi}; bf16x2_t b = __builtin_convertvector(v, bf16x2_t); return __builtin_bit_cast(unsigned, b); }
constexpr int VP = 144;
__device__ __forceinline__ float xhalf_max(float v) { auto rr = __builtin_amdgcn_permlane32_swap(__float_as_uint(v), __float_as_uint(v), false, false); return fmaxf(__uint_as_float(rr[0]), __uint_as_float(rr[1])); }
__device__ __forceinline__ float xhalf_sum(float v) { auto rr = __builtin_amdgcn_permlane32_swap(__float_as_uint(v), __float_as_uint(v), false, false); return __uint_as_float(rr[0]) + __uint_as_float(rr[1]); }
template <int DQK, bool SM>
__device__ __forceinline__ void unit(LAS unsigned char* lds, const bf16* Q, int ldq, const bf16* K, int ldk, const bf16* V, int ldv, bf16* O, int ldo,
                                     const bf16* G, int ldg, const float* gain, float lg2, int b, int q0, int qend, const int tid_in, const float* sqa, const float* qgain, const f32x2* mtab) {
    constexpr int KP = DQK * 2 + 16, CH = DQK / 8, ND = DQK / 16, KB = 64 * KP, VB = 64 * VP, SB = KB + VB;
    int tid_o = tid_in + pg8::lane_asm();
    const int tid = tid_o, lane = tid & 63, wid = __builtin_amdgcn_readfirstlane(tid >> 6), r32 = lane & 31, hi = lane >> 5;
    const int q0w = q0 + 32 * wid, tq = q0w + r32;
    const bool wact = q0w < qend;
    bf16x8 qr[ND];
    const int qrow = rowof(b, tq < TT ? tq : TT - 1);
    { const bf16* qp = Q + (size_t)qrow * ldq + 8 * hi;
#pragma unroll
      for (int d0 = 0; d0 < ND; ++d0) qr[d0] = *(const bf16x8*)(qp + 16 * d0); }
    if (SM) {
        const int tpos = tq < TT ? tq : TT - 1;
        float ss = 0.f;
#pragma unroll
        for (int d0 = 0; d0 < ND; ++d0) { const u32x4 w = __builtin_bit_cast(u32x4, qr[d0]);
#pragma unroll
            for (int e = 0; e < 4; ++e) { const float a0 = bflo(w[e]), a1 = bfhi(w[e]); ss += a0 * a0 + a1 * a1; } }
        ss = xhalf_sum(ss);
        const float rs = QSCALE / sqrtf(ss * (1.f / 96.f) + EPS);
#pragma unroll
        for (int d0 = 0; d0 < 4; ++d0) { const u32x4 w = __builtin_bit_cast(u32x4, qr[d0]); const f32x4 g0 = *(const f32x4*)(qgain + 16 * d0 + 8 * hi), g1 = *(const f32x4*)(qgain + 16 * d0 + 8 * hi + 4); u32x4 o;
            o[0] = cvtpk(bflo(w[0]) * rs * g0[0], bfhi(w[0]) * rs * g0[1]); o[1] = cvtpk(bflo(w[1]) * rs * g0[2], bfhi(w[1]) * rs * g0[3]);
            o[2] = cvtpk(bflo(w[2]) * rs * g1[0], bfhi(w[2]) * rs * g1[1]); o[3] = cvtpk(bflo(w[3]) * rs * g1[2], bfhi(w[3]) * rs * g1[3]);
            qr[d0] = __builtin_bit_cast(bf16x8, o); }
        { const u32x4 w1 = __builtin_bit_cast(u32x4, qr[4]), w2 = __builtin_bit_cast(u32x4, qr[5]); const f32x4* cs = (const f32x4*)(mtab + tpos * 16 + 8 * hi);
          const float* ga = qgain + 64 + 8 * hi; const float* gb = qgain + 80 + 8 * hi; u32x4 o1, o2;
#pragma unroll
          for (int e = 0; e < 4; ++e) { const f32x4 c4 = cs[e];
              const float a0 = bflo(w1[e]) * rs * ga[2 * e], a1 = bfhi(w1[e]) * rs * ga[2 * e + 1], b0 = bflo(w2[e]) * rs * gb[2 * e], b1 = bfhi(w2[e]) * rs * gb[2 * e + 1];
              o1[e] = cvtpk(a0 * c4.x - b0 * c4.y, a1 * c4.z - b1 * c4.w); o2[e] = cvtpk(b0 * c4.x + a0 * c4.y, b1 * c4.z + a1 * c4.w); }
          qr[4] = __builtin_bit_cast(bf16x8, o1); qr[5] = __builtin_bit_cast(bf16x8, o2); }
    }
    const int ntiles = (qend - 1) / 64 + 1;
    const int nw = wact ? ((q0w + 31) / 64 + 1 < ntiles ? (q0w + 31) / 64 + 1 : ntiles) : 0;
    const int nfull = (q0w + 1) / 64;
    const int kkey0 = tid / CH, kch0 = tid % CH; constexpr bool has2 = 64 * CH > 512;
    const int kc1 = 512 + (tid >> 1), kkey1 = kc1 / CH, kch1 = kc1 % CH, khalf = tid & 1;
    const int vkey = tid & 63, vch = tid >> 6;
    const int pr32 = (r32 & 0x13) | ((r32 & 4) << 1) | ((r32 & 8) >> 1);
    const int koff = pr32 * KP + 16 * hi, voff = KB + r32 * VP + 16 * hi;
    u32x4 kreg0A, kreg0B, vregA, vregB; u32x2 kreg1A, kreg1B;
#define ATT_LOADK(j, S) do { int r0_ = 64 * (j) + kkey0; r0_ = r0_ < TT ? r0_ : TT - 1; kreg0##S = *(const u32x4*)(K + (size_t)rowof(b, r0_) * ldk + 8 * kch0); \
        if (has2) { int r1_ = 64 * (j) + kkey1; r1_ = r1_ < TT ? r1_ : TT - 1; kreg1##S = *(const u32x2*)(K + (size_t)rowof(b, r1_) * ldk + 8 * kch1 + 4 * khalf); } } while (0)
#define ATT_LOADV(j, S) do { int rv_ = 64 * (j) + vkey; rv_ = rv_ < TT ? rv_ : TT - 1; vreg##S = *(const u32x4*)(V + (size_t)rowof(b, rv_) * ldv + 8 * vch); } while (0)
#define ATT_STOREK(so, S) do { *(LAS u32x4*)(lds + (so) + kkey0 * KP + 16 * kch0) = kreg0##S; if (has2) *(LAS u32x2*)(lds + (so) + kkey1 * KP + 16 * kch1 + 8 * khalf) = kreg1##S; } while (0)
#define ATT_STOREV(so, S) do { LAS unsigned char* vd_ = lds + (so) + KB + (8 * vch) * VP + 2 * vkey; \
        _Pragma("unroll") for (int i_ = 0; i_ < 8; ++i_) { const unsigned w_ = vreg##S[i_ >> 1]; *(LAS unsigned short*)(vd_ + i_ * VP) = (unsigned short)((i_ & 1) ? (w_ >> 16) : (w_ & 0xffffu)); } } while (0)
#define ATT_KREAD(so) do { const LAS unsigned char* kb_ = lds + (so) + koff; \
        _Pragma("unroll") for (int d0 = 0; d0 < ND; ++d0) { kf0[d0] = *(const LAS bf16x8*)(kb_ + 32 * d0); kf1[d0] = *(const LAS bf16x8*)(kb_ + 32 * KP + 32 * d0); } } while (0)
#define ATT_VREAD(so) do { const LAS unsigned char* vb_ = lds + (so) + voff; \
        _Pragma("unroll") for (int ks = 0; ks < 4; ++ks) { vf0[ks] = *(const LAS bf16x8*)(vb_ + 32 * ks); vf1[ks] = *(const LAS bf16x8*)(vb_ + 32 * VP + 32 * ks); } } while (0)
#define ATT_QKM(S0, S1) do { \
        _Pragma("unroll") for (int r_ = 0; r_ < 16; ++r_) { S0[r_] = 0.f; S1[r_] = 0.f; } \
        _Pragma("unroll") for (int d0 = 0; d0 < ND; ++d0) { \
            S0 = __builtin_amdgcn_mfma_f32_32x32x16_bf16(kf0[d0], qr[d0], S0, 0, 0, 0); S1 = __builtin_amdgcn_mfma_f32_32x32x16_bf16(kf1[d0], qr[d0], S1, 0, 0, 0); } } while (0)
#define ATT_QKI(S0, S1, so) do { const LAS unsigned char* kb_ = lds + (so) + koff; \
        _Pragma("unroll") for (int r_ = 0; r_ < 16; ++r_) { S0[r_] = 0.f; S1[r_] = 0.f; } \
        _Pragma("unroll") for (int d0 = 0; d0 < ND; ++d0) { const bf16x8 k0_ = *(const LAS bf16x8*)(kb_ + 32 * d0), k1_ = *(const LAS bf16x8*)(kb_ + 32 * KP + 32 * d0); \
            S0 = __builtin_amdgcn_mfma_f32_32x32x16_bf16(k0_, qr[d0], S0, 0, 0, 0); S1 = __builtin_amdgcn_mfma_f32_32x32x16_bf16(k1_, qr[d0], S1, 0, 0, 0); } } while (0)
#define ATT_TILE(j, so, MASK, VPRE) do { const int kbase_ = 64 * (j) + 8 * hi; \
        if (SM) { \
            if (MASK) { _Pragma("unroll") for (int r = 0; r < 16; ++r) { const int kk = kbase_ + 16 * (r >> 3) + (r & 7); if (kk > tq) s0[r] = -INFINITY; if (kk + 32 > tq) s1[r] = -INFINITY; } } \
            float mx = fmaxf(s0[0], s1[0]); \
            _Pragma("unroll") for (int r = 1; r < 16; ++r) mx = fmaxf(mx, fmaxf(s0[r], s1[r])); \
            mx = xhalf_max(mx); \
            const float mn = fmaxf(m_run, mx), alpha = __builtin_amdgcn_exp2f(m_run - mn); m_run = mn; \
            float ps = 0.f; \
            _Pragma("unroll") for (int r = 0; r < 16; ++r) { s0[r] = __builtin_amdgcn_exp2f(s0[r] - mn); s1[r] = __builtin_amdgcn_exp2f(s1[r] - mn); ps += s0[r] + s1[r]; } \
            l_run = l_run * alpha + ps; \
            _Pragma("unroll") for (int r = 0; r < 16; ++r) { o0[r] *= alpha; o1[r] *= alpha; } \
        } else { \
            const float rf0 = __builtin_amdgcn_exp2f(lg2 * (float)(tq - kbase_)), rf1 = rf0 * c32; \
            _Pragma("unroll") for (int r = 0; r < 16; ++r) { s0[r] = (s0[r] * cfac[r]) * rf0; s1[r] = (s1[r] * cfac[r]) * rf1; } \
            if (MASK) { _Pragma("unroll") for (int r = 0; r < 16; ++r) { const int kk = kbase_ + 16 * (r >> 3) + (r & 7); if (kk > tq) s0[r] = 0.f; if (kk + 32 > tq) s1[r] = 0.f; } } \
        } \
        u32x4 pw[4]; \
        _Pragma("unroll") for (int ks = 0; ks < 2; ++ks) { \
            pw[ks] = (u32x4){cvtpk(s0[8 * ks], s0[8 * ks + 1]), cvtpk(s0[8 * ks + 2], s0[8 * ks + 3]), cvtpk(s0[8 * ks + 4], s0[8 * ks + 5]), cvtpk(s0[8 * ks + 6], s0[8 * ks + 7])}; \
            pw[2 + ks] = (u32x4){cvtpk(s1[8 * ks], s1[8 * ks + 1]), cvtpk(s1[8 * ks + 2], s1[8 * ks + 3]), cvtpk(s1[8 * ks + 4], s1[8 * ks + 5]), cvtpk(s1[8 * ks + 6], s1[8 * ks + 7])}; } \
        const LAS unsigned char* vb_ = lds + (so) + voff; \
        _Pragma("unroll") for (int ks = 0; ks < 4; ++ks) { const bf16x8 pf_ = __builtin_bit_cast(bf16x8, pw[ks]); \
            const bf16x8 v0_ = (VPRE) ? vf0[ks] : *(const LAS bf16x8*)(vb_ + 32 * ks), v1_ = (VPRE) ? vf1[ks] : *(const LAS bf16x8*)(vb_ + 32 * VP + 32 * ks); \
            o0 = __builtin_amdgcn_mfma_f32_32x32x16_bf16(v0_, pf_, o0, 0, 0, 0); o1 = __builtin_amdgcn_mfma_f32_32x32x16_bf16(v1_, pf_, o1, 0, 0, 0); } } while (0)
    f32x16 o0, o1, s0, s1, t0, t1; bf16x8 kf0[ND], kf1[ND], vf0[4], vf1[4];
#pragma unroll
    for (int r = 0; r < 16; ++r) { o0[r] = 0.f; o1[r] = 0.f; s0[r] = 0.f; s1[r] = 0.f; t0[r] = 0.f; t1[r] = 0.f; }
    float m_run = -INFINITY, l_run = 0.f;
    float cfac[16]; const float c32 = SM ? 0.f : __builtin_amdgcn_exp2f(-32.f * lg2);
#pragma unroll
    for (int r = 0; r < 16; ++r) cfac[r] = SM ? 0.f : __builtin_amdgcn_exp2f(-lg2 * (float)(16 * (r >> 3) + (r & 7)));
    int so_c = 0, so_n = SB, so_nn = 2 * SB;
    ATT_LOADK(0, A); ATT_LOADV(0, A); ATT_STOREK(0, A); ATT_STOREV(0, A);
    if (ntiles > 1) { ATT_LOADK(1, A); ATT_LOADV(1, A); ATT_STOREK(SB, A); ATT_STOREV(SB, A); }
    if (ntiles > 2) { ATT_LOADK(2, B); ATT_LOADV(2, B); }
    __syncthreads();
    if (nw > 0) ATT_QKI(s0, s1, 0);
#define ATT_ITER(J, SL, SS) do { const int j = (J); \
        if (j + 3 < ntiles) { ATT_LOADK(j + 3, SL); ATT_LOADV(j + 3, SL); } \
        if (j + 1 < nw && j < nfull) { \
            if (SM) { \
                ATT_QKI(t0, t1, so_n); \
                ATT_TILE(j, so_c, false, false); \
            } else if (wid < 4) { \
                ATT_QKI(t0, t1, so_n); __builtin_amdgcn_sched_barrier(0); \
                ATT_TILE(j, so_c, false, false); \
            } else { \
                ATT_TILE(j, so_c, false, false); __builtin_amdgcn_sched_barrier(0); \
                ATT_QKI(t0, t1, so_n); \
            } \
_Pragma("unroll") \
            for (int r = 0; r < 16; ++r) { s0[r] = t0[r]; s1[r] = t1[r]; } \
        } else if (j < nw) { \
            if (SM) { if (j + 1 < nw) ATT_QKI(t0, t1, so_n); ATT_TILE(j, so_c, true, false); } \
            else { if (j + 1 < nw) ATT_QKI(t0, t1, so_n); ATT_TILE(j, so_c, true, false); } \
_Pragma("unroll") \
            for (int r = 0; r < 16; ++r) { s0[r] = t0[r]; s1[r] = t1[r]; } \
        } \
        if (j + 2 < ntiles) { ATT_STOREK(so_nn, SS); ATT_STOREV(so_nn, SS); } \
        __syncthreads(); \
        { const int t_ = so_c; so_c = so_n; so_n = so_nn; so_nn = t_; } } while (0)
    for (int jj = 0; jj < ntiles; jj += 2) { ATT_ITER(jj, A, B); if (jj + 1 < ntiles) ATT_ITER(jj + 1, B, A); }
#undef ATT_ITER
#undef ATT_LOADK
#undef ATT_LOADV
#undef ATT_STOREK
#undef ATT_STOREV
#undef ATT_KREAD
#undef ATT_VREAD
#undef ATT_QKM
#undef ATT_QKI
#undef ATT_TILE
    if (wact) {
        if (SM) {
            const float l = xhalf_sum(l_run), inv = 1.f / l;
            if (tq < qend) { bf16* op = O + (size_t)qrow * ldo + 4 * hi;
#pragma unroll
                for (int g = 0; g < 4; ++g) {
                    u32x2 a, bq; a.x = cvtpk(o0[4 * g] * inv, o0[4 * g + 1] * inv); a.y = cvtpk(o0[4 * g + 2] * inv, o0[4 * g + 3] * inv);
                    bq.x = cvtpk(o1[4 * g] * inv, o1[4 * g + 1] * inv); bq.y = cvtpk(o1[4 * g + 2] * inv, o1[4 * g + 3] * inv);
                    *(u32x2*)(op + 8 * g) = a; *(u32x2*)(op + 32 + 8 * g) = bq; } }
        } else {
            float ss = 0.f;
#pragma unroll
            for (int r = 0; r < 16; ++r) ss += o0[r] * o0[r] + o1[r] * o1[r];
            ss = xhalf_sum(ss);
            const float rs = 1.0f / sqrtf(ss * (1.f / 64.f) + EPS);
            if (tq < qend) { bf16* op = O + (size_t)qrow * ldo + 4 * hi; const bf16* gp = G + (size_t)qrow * ldg + 4 * hi; const float* gn = gain + 4 * hi;
#pragma unroll
                for (int g = 0; g < 4; ++g) {
#pragma unroll
                    for (int db = 0; db < 2; ++db) {
                        const u32x2 gw = *(const u32x2*)(gp + 32 * db + 8 * g); const f32x4 ga = *(const f32x4*)(gn + 32 * db + 8 * g);
                        float gv[4] = {bflo(gw.x), bfhi(gw.x), bflo(gw.y), bfhi(gw.y)}; float y[4];
#pragma unroll
                        for (int e = 0; e < 4; ++e) { const float ov = db ? o1[4 * g + e] : o0[4 * g + e]; const float sg = gv[e] / (1.f + __expf(-gv[e])); y[e] = ov * rs * ga[e] * sg; }
                        u32x2 w; w.x = cvtpk(y[0], y[1]); w.y = cvtpk(y[2], y[3]); *(u32x2*)(op + 32 * db + 8 * g) = w; } } }
        }
    }
}
}

struct Args { const float* in[16]; float* out; unsigned char* ws; int ph_lo, ph_hi; };
typedef const __attribute__((address_space(4))) Args* KArgsP;
#define RT   ((f32x2*)(ws + WS_RT))
#define MT   ((f32x2*)(ws + WS_MT))
#define WIN  ((bf16*)(ws + WS_WIN))
#define WUQ  ((bf16*)(ws + WS_WUQ))
#define WUKV ((bf16*)(ws + WS_WUKV))
#define WOUT ((bf16*)(ws + WS_WOUT))
#define W1   ((bf16*)(ws + WS_W1))
#define W2   ((bf16*)(ws + WS_W2))
#define XR   ((bf16*)(ws + WS_X))
#define XN   ((bf16*)(ws + WS_XN))
#define MIX  ((bf16*)(ws + WS_XN))
#define PROJ ((bf16*)(ws + WS_PROJ))
#define QRAW ((bf16*)(ws + WS_QRAW))
#define KVR  ((bf16*)(ws + WS_KV))
#define HB   ((bf16*)(ws + WS_H))
#define SSX  ((float*)(ws + WS_SSX))
#define SSQ  ((float*)(ws + WS_SSQ))
#define SSKV ((float*)(ws + WS_SSKV))
#define SQA  ((float*)(ws + WS_SQA))
enum { I_X = 0, I_META, I_ANG, I_WIN, I_CONVW, I_RETG, I_QNG, I_WUQ, I_KVNG, I_WUKV, I_QHG, I_KHG, I_WOUT, I_MLPG, I_W1, I_W2 };
constexpr int NPP = 7, NPHASE = 1 + NPP * DEPTH;

__device__ __forceinline__ void p0_transpose_item(const float* W, const float* gk, int K, int N, bf16* WT, LAS float* scr, int item, int lane) {
    const int nblk = N / 32, kb = item / nblk, nb = item % nblk, k0 = 64 * kb, n0 = 32 * nb;
#pragma unroll 8
    for (int i = 0; i < 32; ++i) { const int kk = 2 * i + (lane >> 5); const float gv = gk ? gk[k0 + kk] : 1.f; scr[kk * 33 + (lane & 31)] = W[(size_t)(k0 + kk) * N + n0 + (lane & 31)] * gv; }
    asm volatile("s_waitcnt lgkmcnt(0)" ::: "memory");
    const int c = lane & 7;
#pragma unroll
    for (int j = 0; j < 4; ++j) { const int n = (lane >> 3) + 8 * j; const LAS float* s = scr + (8 * c) * 33 + n;
        u32x4 o; o.x = pk2(s[0 * 33], s[1 * 33]); o.y = pk2(s[2 * 33], s[3 * 33]); o.z = pk2(s[4 * 33], s[5 * 33]); o.w = pk2(s[6 * 33], s[7 * 33]);
        *(u32x4*)(WT + (size_t)(n0 + n) * K + k0 + 8 * c) = o; }
    asm volatile("s_waitcnt lgkmcnt(0)" ::: "memory");
}
__device__ __forceinline__ void row_prep(const float* xrow, bf16* orow, float* ss16, int lane) {
    const f32x4* xr = (const f32x4*)xrow + lane;
    f32x4 v[4]; float s = 0.f;
#pragma unroll
    for (int j = 0; j < 4; ++j) { v[j] = xr[64 * j]; s += (v[j].x * v[j].x + v[j].y * v[j].y) + (v[j].z * v[j].z + v[j].w * v[j].w); }
    const float tot = wave_sum(s);
    if (lane < 16) ss16[lane] = lane == 0 ? tot : 0.f;
    unsigned long long* o8 = (unsigned long long*)orow + lane;
#pragma unroll
    for (int j = 0; j < 4; ++j) o8[64 * j] = (unsigned long long)att::cvtpk(v[j].x, v[j].y) | ((unsigned long long)att::cvtpk(v[j].z, v[j].w) << 32);
}
__device__ __forceinline__ f32x2 cossin(float ang) {
    const float n = rintf(ang * 0.15915494309189535f);
    float r = fmaf(-n, 6.28125f, ang); r = fmaf(-n, 0.0019353071795864769f, r);
    const float rev = r * 0.15915494309189535f;
    f32x2 o; o.x = __builtin_amdgcn_cosf(rev); o.y = __builtin_amdgcn_sinf(rev); return o;
}

#define XB_TMO      128
#define XB_XCNT(j)  (256  + 64 * (j))
#define XB_XSUB(j)  (1280 + 64 * (j))
#define XB_XGEN(j)  (2304 + 64 * (j))
#define XB_TOP      3328
#define XB_TOPGEN   3392
#define XCD_BAR_WORDS 3456
#define XB_SPIN_CAP (1u << 18)

__device__ __forceinline__ unsigned xb_ld(unsigned* p)              { return __hip_atomic_load(p, __ATOMIC_RELAXED, __HIP_MEMORY_SCOPE_AGENT); }
__device__ __forceinline__ unsigned xb_add(unsigned* p, unsigned v) { return __hip_atomic_fetch_add(p, v, __ATOMIC_RELAXED, __HIP_MEMORY_SCOPE_AGENT); }
__device__ __forceinline__ unsigned xb_xcc_id() { return (unsigned)__builtin_amdgcn_s_getreg((3 << 11) | 20) & 0xFu; }
#define XB_SPIN(cond, bar) do { unsigned _sp = 0; while (cond) { __builtin_amdgcn_s_sleep(1); \
    if ((++_sp & 255u) == 0u) { if (xb_ld(&(bar)[XB_TMO])) break; if (_sp > XB_SPIN_CAP) { atomicAdd(&(bar)[XB_TMO], 1u); break; } } } } while (0)

struct XcdBarrier {
    unsigned* bar; unsigned x;
    volatile LAS unsigned* st;
};

__device__ __forceinline__ XcdBarrier xcd_barrier_post(unsigned* bar, volatile LAS unsigned* st) {
    XcdBarrier b; b.bar = bar; b.x = xb_xcc_id(); b.st = st;
    if (threadIdx.x == 0) (void)xb_add(&bar[XB_XCNT(b.x)], 1u);
    return b;
}
__device__ __forceinline__ void xcd_barrier_complete(unsigned* bar, unsigned x, unsigned& nloc, unsigned& nx) {
    const unsigned G = gridDim.x * gridDim.y * gridDim.z;
    unsigned sum, cnt, mine, sp = 0u;
    for (;;) {
        sum = 0u; cnt = 0u; mine = 0u;
#pragma unroll
        for (unsigned j = 0; j < 16; ++j) { const unsigned c = xb_ld(&bar[XB_XCNT(j)]); sum += c; cnt += (c > 0u) ? 1u : 0u; mine = (j == x) ? c : mine; }
        if (sum == G) break;
        __builtin_amdgcn_s_sleep(1);
        if ((++sp & 255u) == 0u) { if (xb_ld(&bar[XB_TMO])) break; if (sp > XB_SPIN_CAP) { atomicAdd(&bar[XB_TMO], 1u); break; } }
    }
    nloc = mine > 0u ? mine : 1u; nx = cnt > 0u ? cnt : 1u;
}

__device__ __forceinline__ void xcd_barrier(const XcdBarrier& b) {
    asm volatile("s_waitcnt vmcnt(0)" ::: "memory");
    __syncthreads();
    if (threadIdx.x == 0) {
        unsigned* bar = b.bar;
        __builtin_amdgcn_s_waitcnt(0);
        unsigned nloc = b.st[0], nx = b.st[1];
        if (nloc == 0u) { xcd_barrier_complete(bar, b.x, nloc, nx); b.st[0] = nloc; b.st[1] = nx; }
        const unsigned old = xb_add(&bar[XB_XSUB(b.x)], 1u);
        const unsigned gen = old / nloc;
        if (old + 1u == (gen + 1u) * nloc) {
            __builtin_amdgcn_fence(__ATOMIC_RELEASE, "agent");
            asm volatile("s_waitcnt vmcnt(0)" ::: "memory");
            const unsigned og = xb_add(&bar[XB_TOP], 1u);
            const unsigned tg = og / nx;
            if (og + 1u == (tg + 1u) * nx) xb_add(&bar[XB_TOPGEN], 1u);
            else XB_SPIN(xb_ld(&bar[XB_TOPGEN]) == tg, bar);
            __builtin_amdgcn_fence(__ATOMIC_ACQUIRE, "agent");
            xb_add(&bar[XB_XGEN(b.x)], 1u);
            asm volatile("s_waitcnt vmcnt(0)" ::: "memory");
        } else {
            XB_SPIN(xb_ld(&bar[XB_XGEN(b.x)]) == gen, bar);
            __builtin_amdgcn_fence(__ATOMIC_ACQUIRE, "agent");
            asm volatile("s_waitcnt vmcnt(0)" ::: "memory");
        }
    }
    __syncthreads();
}

struct EpiMeta { int mode, need_rs; float rs_div; bf16* O; int ldc; bf16* xr; };
__device__ __forceinline__ void meta_gemm(const bf16* A, int lda, const bf16* Bt, int N, int K, const EpiMeta& E, int gw, int NGW, int lane) {
    for (int n = gw; n < N; n += NGW) {
        float acc[16], ssa[16];
#pragma unroll
        for (int r = 0; r < 16; ++r) { acc[r] = 0.f; ssa[r] = 0.f; }
        for (int c = lane; c < K / 8; c += 64) {
            const u32x4 w = *(const u32x4*)(Bt + (size_t)n * K + 8 * c);
            float wf[8];
#pragma unroll
            for (int e = 0; e < 4; ++e) { wf[2 * e] = bflo(w[e]); wf[2 * e + 1] = bfhi(w[e]); }
#pragma unroll
            for (int r = 0; r < 16; ++r) { const u32x4 a = *(const u32x4*)(A + (size_t)r * lda + 8 * c);
#pragma unroll
                for (int e = 0; e < 4; ++e) { const float a0 = bflo(a[e]), a1 = bfhi(a[e]); acc[r] += a0 * wf[2 * e] + a1 * wf[2 * e + 1]; ssa[r] += a0 * a0 + a1 * a1; } }
        }
        float mine = 0.f, myss = 0.f;
#pragma unroll
        for (int r = 0; r < 16; ++r) { const float s = wave_sum(acc[r]), q = E.need_rs ? wave_sum(ssa[r]) : 0.f; if (lane == r) { mine = s; myss = q; } }
        if (lane < 16) { const int r = lane;
            if (E.mode < 2) { float v = mine * (E.need_rs ? 1.0f / sqrtf(myss * E.rs_div + EPS) : 1.f); if (E.mode == 1) { v = fmaxf(v, 0.f); v = v * v; } E.O[(size_t)(MR0 + r) * E.ldc + n] = (bf16)f2bf(v); }
            else { bf16* p = E.xr + (size_t)(MR0 + r) * DM + n; *p = (bf16)f2bf(bf1(*p) + mine); } }
    }
}

__global__ void __launch_bounds__(NWAVES * 64, 2) hybrid_fwd(Args args) {
#define LANE pg8::lane_asm()
#define TID (wave * 64 + pg8::lane_asm())
    extern __shared__ __attribute__((aligned(16))) unsigned char lds_raw[];
    LAS unsigned char* lds = (LAS unsigned char*)lds_raw;
    cg::grid_group grid = cg::this_grid();
    const int G = gridDim.x, NGW = G * NWAVES;
    const int wave_s = __builtin_amdgcn_readfirstlane((int)threadIdx.x >> 6);
    if (threadIdx.x < 2) ((LAS unsigned*)(lds + XB_LDS_OFF))[threadIdx.x] = 0u;
    __syncthreads();
    if (args.ph_hi - args.ph_lo > 1) (void)xcd_barrier_post((unsigned*)args.ws, (volatile LAS unsigned*)(lds + XB_LDS_OFF));
    const int lo = args.ph_lo, hi = args.ph_hi;
    for (int ph = lo; ph < hi; ++ph) {
        KArgsP ap = (KArgsP)__builtin_amdgcn_kernarg_segment_ptr(); asm volatile("" : "+s"(ap));
        unsigned char* const ws = ap->ws;
        int wave = wave_s; asm volatile("" : "+s"(wave));
        const int gw = blockIdx.x * NWAVES + wave;
        const int l = ph == 0 ? 0 : (ph - 1) / NPP, k = ph == 0 ? -1 : (ph - 1) % NPP;
        if (k == -1) {
            LAS float* scr = (LAS float*)(lds + wave * 16384);
            constexpr int I_IN = 16 * 69, I_UQ = 4 * 24, I_UKV = 2 * 32, I_O = 16 * 32, I_1 = 16 * 128, I_2 = 64 * 32, I_L = I_IN + I_UQ + I_UKV + I_O + I_1 + I_2;
            for (int it = gw; it < DEPTH * I_L; it += NGW) {
                const int ll = it / I_L; int r = it - ll * I_L;
                if (r < I_IN) { p0_transpose_item(ap->in[I_WIN] + (size_t)ll * DM * DIN, ap->in[I_ANG] + ll * DM, DM, DIN, WIN + (size_t)ll * DINP * DM, scr, r, LANE); continue; } r -= I_IN;
                if (r < I_UQ) { p0_transpose_item(ap->in[I_WUQ] + (size_t)ll * 256 * 768, ap->in[I_QNG] + ll * 256, 256, 768, WUQ + (size_t)ll * 768 * 256, scr, r, LANE); continue; } r -= I_UQ;
                if (r < I_UKV) { p0_transpose_item(ap->in[I_WUKV] + (size_t)ll * 128 * 1024, ap->in[I_KVNG] + ll * 128, 128, 1024, WUKV + (size_t)ll * 1024 * 128, scr, r, LANE); continue; } r -= I_UKV;
                if (r < I_O) { p0_transpose_item(ap->in[I_WOUT] + (size_t)ll * DM * DM, nullptr, DM, DM, WOUT + (size_t)ll * DM * DM, scr, r, LANE); continue; } r -= I_O;
                if (r < I_1) { p0_transpose_item(ap->in[I_W1] + (size_t)ll * DM * DFF, ap->in[I_MLPG] + ll * DM, DM, DFF, W1 + (size_t)ll * DFF * DM, scr, r, LANE); continue; } r -= I_1;
                p0_transpose_item(ap->in[I_W2] + (size_t)ll * DFF * DM, nullptr, DFF, DM, W2 + (size_t)ll * DM * DFF, scr, r, LANE);
            }
            for (int it = gw; it < DEPTH * (DINP - DIN); it += NGW) {
                const int ll = it / (DINP - DIN), r = DIN + it % (DINP - DIN); u32x4* p = (u32x4*)(WIN + ((size_t)ll * DINP + r) * DM) + LANE;
                u32x4 z = {0u, 0u, 0u, 0u}; asm volatile("" : "+v"(z));
                p[0] = z; p[64] = z;
            }
            for (int e = blockIdx.x * 512 + TID; e < TT * 32; e += G * 512) { const int t = e >> 5, i = e & 31; const float inv = exp2f(-13.287712379549449f * (float)(2 * i) * (1.f / 64.f)); RT[e] = cossin((float)t * inv); }
            for (int e = blockIdx.x * 512 + TID; e < TT * 16; e += G * 512) { const int t = e >> 4, i = e & 15; const float inv = exp2f(-13.287712379549449f * (float)(2 * i) * (1.f / 32.f)); MT[e] = cossin((float)t * inv); }
            for (int m = gw; m < MV; m += NGW) {
                const float* src = m >= MR0 ? ap->in[I_META] + (size_t)(m - MR0) * DM : ap->in[I_X] + (size_t)m * DM;
                row_prep(src, XR + (size_t)m * DM, SSX + (size_t)m * 16, LANE); }
        } else if (k == 0 || k == 1 || k == 4 || k == 5 || k == 6) {
            const int ng = k == 1 ? 2 : 1;
            for (int gi = 0; gi < ng; ++gi) {
                pg8::Gemm g; pg8::EpiAny E; E.xr = XR; E.out = ap->out; E.O = nullptr; E.ldc = 0; E.ssx = SSX; E.rs_src = nullptr; E.rs_cnt = 16; E.rs_div = 1.f / 1024.f; E.ssq = nullptr; E.sskv = nullptr;
                EpiMeta Em; Em.need_rs = 0; Em.rs_div = 1.f / 1024.f; Em.O = nullptr; Em.ldc = 0; Em.xr = XR;
                if (k == 0)      { g = pg8::Gemm{XR, WIN + (size_t)l * DINP * DM, MREAL, DINP, DM, DM}; E.mode = 0; E.perm = 1; E.O = PROJ; E.ldc = DINP; E.rs_src = SSX; E.ssq = SSQ; E.sskv = SSKV; Em.need_rs = 1; }
                else if (k == 1 && gi == 0) { g = pg8::Gemm{PROJ + C_CQ, WUQ + (size_t)l * 768 * 256, MREAL, 768, 256, DINP}; E.mode = 0; E.perm = 1; E.O = QRAW; E.ldc = 768; E.rs_src = SSQ; E.rs_cnt = 4; E.rs_div = 1.f / 256.f; Em.need_rs = 1; Em.rs_div = 1.f / 256.f; }
                else if (k == 1) { g = pg8::Gemm{PROJ + C_CKV, WUKV + (size_t)l * 1024 * 128, MREAL, 1024, 128, DINP}; E.mode = 0; E.perm = 1; E.O = KVR; E.ldc = 1024; E.rs_src = SSKV; E.rs_cnt = 4; E.rs_div = 1.f / 128.f; Em.need_rs = 1; Em.rs_div = 1.f / 128.f; }
                else if (k == 4) { g = pg8::Gemm{MIX, WOUT + (size_t)l * DM * DM, MREAL, DM, DM, DM}; E.mode = 2; E.perm = 1; }
                else if (k == 5) { g = pg8::Gemm{XR, W1 + (size_t)l * DFF * DM, MREAL, DFF, DM, DM}; E.mode = 1; E.perm = 1; E.O = HB; E.ldc = DFF; E.rs_src = SSX; Em.need_rs = 1; }
                else             { g = pg8::Gemm{HB, W2 + (size_t)l * DM * DFF, MREAL, DM, DFF, DFF}; E.mode = (l == DEPTH - 1) ? 3 : 2; E.perm = 1; }
                Em.mode = E.mode; Em.O = E.O; Em.ldc = E.ldc;
                pg8::StaticOrder S; S.init(MREAL, g.N, G, (int)blockIdx.x);
                pg8::gemm_phase<pg8::EpiAny, pg8::StaticOrder, true, true>(lds, g, S, E, wave * 64);
                if (E.mode != 3) meta_gemm(g.A + (size_t)MR0 * g.lda, g.lda, g.Bt, g.N, g.K, Em, gw, NGW, LANE);
            }
            if (k == 1) {
                const float* cw = ap->in[I_CONVW] + l * 3 * 256;
                for (int it = blockIdx.x * 512 + TID; it < MV * 32; it += G * 512) {
                    const int m = it >> 5, c = (it & 31) * 8; const int t = m >= MR0 ? m - MR0 : (m & (SEQ - 1)) + NMETA; const bf16* pr = PROJ + (size_t)m * DINP;
                    const u32x4 cbv = *(const u32x4*)(pr + C_CB + c); float a[8];
#pragma unroll
                    for (int e = 0; e < 8; ++e) a[e] = 0.f;
#pragma unroll
                    for (int j = 0; j < 3; ++j) { const int tj = t - 2 + j; if (tj >= 0) { const int mj = (m >= MR0 || tj >= NMETA) ? m - (2 - j) : MR0 + tj;
                            const bf16* p2 = PROJ + (size_t)mj * DINP; const u32x4 ccv = *(const u32x4*)(p2 + C_CC + c), chv = *(const u32x4*)(p2 + C_CH + c);
                            const f32x4 w0 = *(const f32x4*)(cw + j * 256 + c), w1 = *(const f32x4*)(cw + j * 256 + c + 4);
#pragma unroll
                            for (int e = 0; e < 4; ++e) { const float wl = e < 2 ? w0[2 * e] : w1[2 * e - 4], wh = e < 2 ? w0[2 * e + 1] : w1[2 * e - 3];
                                a[2 * e] += wl * (bflo(ccv[e]) * bflo(chv[e])); a[2 * e + 1] += wh * (bfhi(ccv[e]) * bfhi(chv[e])); } } }
                    u32x4 o;
#pragma unroll
                    for (int e = 0; e < 4; ++e) o[e] = att::cvtpk(bflo(cbv[e]) * a[2 * e], bfhi(cbv[e]) * a[2 * e + 1]);
                    *(u32x4*)(MIX + (size_t)m * DM + c) = o;
                }
                for (int it = blockIdx.x * 512 + TID; it < MV * 32; it += G * 512) {
                    const int m = it >> 5, j = it & 31, w = j >> 4, h = (j >> 2) & 3, i0 = (j & 3) * 8; const int t = m >= MR0 ? m - MR0 : (m & (SEQ - 1)) + NMETA;
                    bf16* p = PROJ + (size_t)m * DINP + (w ? C_RK : C_RQ) + 64 * h + i0; const float sc = w ? 0.125f : 1.f;
                    const u32x4 x1 = *(const u32x4*)p, x2 = *(const u32x4*)(p + 32); const f32x4* cs = (const f32x4*)(RT + t * 32 + i0);
                    u32x4 o1, o2;
#pragma unroll
                    for (int e = 0; e < 4; ++e) { const f32x4 c4 = cs[e]; const float a0 = bflo(x1[e]), a1 = bfhi(x1[e]), b0 = bflo(x2[e]), b1 = bfhi(x2[e]);
                        o1[e] = att::cvtpk((a0 * c4.x - b0 * c4.y) * sc, (a1 * c4.z - b1 * c4.w) * sc); o2[e] = att::cvtpk((b0 * c4.x + a0 * c4.y) * sc, (b1 * c4.z + a1 * c4.w) * sc); }
                    *(u32x4*)p = o1; *(u32x4*)(p + 32) = o2;
                }
            }
        } else if (k == 2) {
            const float* kg = ap->in[I_KHG] + l * 96;
            for (int it = blockIdx.x * 512 + TID; it < MV * 8; it += G * 512) {
                const int m = it >> 3, h = it & 7; const int t = m >= MR0 ? m - MR0 : (m & (SEQ - 1)) + NMETA;
                const f32x4* mt = (const f32x4*)(MT + t * 16);
                { bf16* kn = KVR + (size_t)m * 1024 + 128 * h; bf16* pr = PROJ + (size_t)m * DINP; bf16* ko = pr + 96 * h; u32x4 w[8], r[4]; float ssn = 0.f, ssr = 0.f;
#pragma unroll
                  for (int c = 0; c < 8; ++c) w[c] = *(const u32x4*)(kn + 8 * c);
#pragma unroll
                  for (int c = 0; c < 4; ++c) r[c] = *(const u32x4*)(pr + C_KR + 8 * c);
#pragma unroll
                  for (int c = 0; c < 8; ++c)
#pragma unroll
                      for (int e = 0; e < 4; ++e) { const float a0 = bflo(w[c][e]), a1 = bfhi(w[c][e]); ssn += a0 * a0 + a1 * a1; }
#pragma unroll
                  for (int c = 0; c < 4; ++c)
#pragma unroll
                      for (int e = 0; e < 4; ++e) { const float a0 = bflo(r[c][e]), a1 = bfhi(r[c][e]); ssr += a0 * a0 + a1 * a1; }
                  const float rs = 1.0f / sqrtf((ssn + ssr) * (1.f / 96.f) + EPS), rn = rs;
#pragma unroll
                  for (int c = 0; c < 8; ++c) { u32x4 o;
#pragma unroll
                      for (int e = 0; e < 4; ++e) o[e] = att::cvtpk(bflo(w[c][e]) * rn * kg[8 * c + 2 * e], bfhi(w[c][e]) * rn * kg[8 * c + 2 * e + 1]);
                      *(u32x4*)(ko + 8 * c) = o; }
#pragma unroll
                  for (int cc = 0; cc < 2; ++cc) { u32x4 o1, o2;
#pragma unroll
                      for (int e = 0; e < 4; ++e) { const int i = 8 * cc + 2 * e; const f32x4 c4 = mt[4 * cc + e];
                          const float a0 = bflo(r[cc][e]) * rs * kg[64 + i], a1 = bfhi(r[cc][e]) * rs * kg[64 + i + 1], b0 = bflo(r[2 + cc][e]) * rs * kg[80 + i], b1 = bfhi(r[2 + cc][e]) * rs * kg[80 + i + 1];
                          o1[e] = att::cvtpk(a0 * c4.x - b0 * c4.y, a1 * c4.z - b1 * c4.w); o2[e] = att::cvtpk(b0 * c4.x + a0 * c4.y, b1 * c4.z + a1 * c4.w); }
                      *(u32x4*)(ko + 64 + 8 * cc) = o1; *(u32x4*)(ko + 80 + 8 * cc) = o2; }
                }
            }
        } else {
            for (int item = blockIdx.x; item < 524; item += G) {
                if (item < 256 || (item >= 512 && item < 520)) { const bool meta = item >= 512; const int b = meta ? 0 : item >> 3, h = item & 7;
                    const bf16* Qp = QRAW + 96 * h; const bf16* Kp = PROJ + 96 * h; const bf16* Vp = KVR + 128 * h + 64; bf16* Op = MIX + 512 + 64 * h;
                    if (meta) att::unit<96, true>(lds, Qp, 768, Kp, DINP, Vp, 1024, Op, DM, nullptr, 0, nullptr, 0.f, b, 0, 16, wave * 64, SQA, ap->in[I_QHG] + l * 96, MT);
                    else for (int blk = 8; blk >= 1; --blk) { const int q0 = 16 + 256 * (blk - 1);
                        att::unit<96, true>(lds, Qp, 768, Kp, DINP, Vp, 1024, Op, DM, nullptr, 0, nullptr, 0.f, b, q0, q0 + 256, wave * 64, SQA, ap->in[I_QHG] + l * 96, MT); }
                } else { const bool meta = item >= 520; const int it = item - 256, bh = it >> 1, hf = it & 1, b = meta ? 0 : bh >> 2, h = meta ? item - 520 : bh & 3;
                    const bf16* Pp = PROJ + 64 * h; bf16* Op = MIX + 256 + 64 * h; const float* gn = ap->in[I_RETG] + l * 256 + 64 * h;
                    const float lg2 = log2f(1.0f - exp2f(-5.0f - (float)h)); const unsigned bm = hf ? 0x0CCu : 0x132u;
                    if (meta) att::unit<64, false>(lds, Pp + C_RQ, DINP, Pp + C_RK, DINP, Pp + C_RV, DINP, Op, DM, Pp + C_RG, DINP, gn, lg2, b, 0, 16, wave * 64, nullptr, nullptr, nullptr);
                    else for (int blk = 8; blk >= 1; --blk) { if (!((bm >> blk) & 1u)) continue; const int q0 = 16 + 256 * (blk - 1);
                        att::unit<64, false>(lds, Pp + C_RQ, DINP, Pp + C_RK, DINP, Pp + C_RV, DINP, Op, DM, Pp + C_RG, DINP, gn, lg2, b, q0, q0 + 256, wave * 64, nullptr, nullptr, nullptr); }
                }
            }
        }
        if (ph + 1 < hi) {
            if (lo < 0) grid.sync();
            { XcdBarrier xbar; xbar.bar = (unsigned*)ws; xbar.x = xb_xcc_id(); xbar.st = (volatile LAS unsigned*)(lds + XB_LDS_OFF); xcd_barrier(xbar); }
        }
    }
}
#undef LANE
#undef TID

extern "C" void kernel_launch(void* const* d_in, const int* in_sizes, int n_in, void* d_out, int out_size, void* d_ws, size_t ws_size, hipStream_t stream) {
    static int grid = 0;
    if (grid == 0) {
        if (n_in != 16 || out_size != MREAL * DM || ws_size < WS_END) { fprintf(stderr, "kernel_launch: unexpected shapes (n_in %d, out %d, ws %zu)\n", n_in, out_size, ws_size); grid = -1; return; }
        int dev = 0, cus = 0, per_cu = 0;
        if (hipGetDevice(&dev) != hipSuccess || hipDeviceGetAttribute(&cus, hipDeviceAttributeMultiprocessorCount, dev) != hipSuccess) { grid = -1; return; }
        if (hipFuncSetAttribute((const void*)hybrid_fwd, hipFuncAttributeMaxDynamicSharedMemorySize, LDS_BYTES) != hipSuccess) { fprintf(stderr, "kernel_launch: hipFuncSetAttribute failed\n"); grid = -1; return; }
        if (hipOccupancyMaxActiveBlocksPerMultiprocessor(&per_cu, (const void*)hybrid_fwd, NWAVES * 64, LDS_BYTES) != hipSuccess || per_cu < 1) { fprintf(stderr, "kernel_launch: occupancy query says %d\n", per_cu); per_cu = 1; }
        (void)hipGetLastError();
        grid = cus;
    }
    if (grid < 0) return;
    if (hipMemsetAsync(d_ws, 0, 16384, stream) != hipSuccess) { fprintf(stderr, "kernel_launch: hipMemsetAsync of the barrier words failed\n"); return; }
    Args a{};
    for (int i = 0; i < 16; ++i) a.in[i] = (const float*)d_in[i];
    a.out = (float*)d_out; a.ws = (unsigned char*)d_ws;
#if MK_MULTI
    for (int ph = 0; ph < NPHASE; ++ph) { a.ph_lo = ph; a.ph_hi = ph + 1; hipLaunchKernelGGL(hybrid_fwd, dim3(grid), dim3(NWAVES * 64), LDS_BYTES, stream, a); }
#else
    a.ph_lo = 0; a.ph_hi = NPHASE;
    void* kargs[] = {&a};
    const hipError_t e = hipLaunchCooperativeKernel((const void*)hybrid_fwd, dim3(grid), dim3(NWAVES * 64), kargs, LDS_BYTES, stream);
    if (e != hipSuccess) fprintf(stderr, "kernel_launch: cooperative launch failed: %s (grid %d)\n", hipGetErrorString(e), grid);
#endif
}
```

```cpp
#include <hip/hip_runtime.h>
#include <hip/hip_cooperative_groups.h>
#include <cstdio>
#include <cstdint>
#include <cmath>
namespace cg = cooperative_groups;
#ifndef MK_MULTI
#define MK_MULTI 0
#endif
namespace pg8 {
#define PG8_LAS __attribute__((address_space(3)))
typedef unsigned short bf16_t;
typedef short bf16x8 __attribute__((ext_vector_type(8)));
typedef float f32x4 __attribute__((ext_vector_type(4)));
typedef unsigned u32x4 __attribute__((ext_vector_type(4)));
typedef unsigned u32x2 __attribute__((ext_vector_type(2)));
constexpr int BM = 256, BK = 64, HALF = 128, HTB = HALF * BK * 2  , STAGE_BYTES = 8 * HTB, NXCD = 8, WGM = 8;

__host__ __device__ __forceinline__ int lds_byte(int r, int c) { const int st = (r >> 4) * 2 + (c >> 5), rr = r & 15, cc = c & 31, ob = rr * 64 + cc * 2; return st * 1024 + (ob ^ (((ob >> 9) & 1) << 5)); }
__host__ __device__ __forceinline__ void stage_rc(int b, int& R, int& C) { const int st = b / 1024, sb = b % 1024, swz = sb ^ (((sb >> 9) & 1) << 5); R = (st >> 1) * 16 + swz / 64; C = (st & 1) * 32 + (swz % 64) / 2; }
__host__ __device__ __forceinline__ int perm32(int rho) { const int n = rho >> 4, i = rho & 15; return 8 * (i >> 2) + 4 * n + (i & 3); }

__device__ __forceinline__ int lane_asm() { int l; asm volatile("v_mbcnt_lo_u32_b32 %0, -1, 0\n\tv_mbcnt_hi_u32_b32 %0, -1, %0" : "=v"(l)); return l; }
__device__ __forceinline__ int opaque_tid() { int t = threadIdx.x; asm volatile("" : "+v"(t)); return t; }
struct Unit { int pm, pn; };
struct Gemm { const bf16_t* A; const bf16_t* Bt; int M, N, K, lda; };

struct StaticOrder {
    int nM, nN, nwg, G, c;
    __host__ __device__ void init(int M, int N, int G_, int c_) { nM = M / BM; nN = N / BM; nwg = nM * nN; G = G_; c = c_; }
    __host__ __device__ bool next(int i, Unit& u) const {
        const long L = (long)i * G + c; if (L >= nwg) return false;
        int wgid = (int)L; { const int q = nwg / NXCD, r = nwg % NXCD, xcd = wgid % NXCD, off = wgid / NXCD; wgid = (xcd < r ? xcd * (q + 1) : r * (q + 1) + (xcd - r) * q) + off; }
        const int nig = WGM * nN, gid = wgid / nig, fm = gid * WGM, gsz = (nM - fm) < WGM ? (nM - fm) : WGM;
        u.pm = fm + ((wgid % nig) % gsz); u.pn = (wgid % nig) / gsz; return true;
    }
    __device__ __forceinline__ void a_ready(const Unit&) const {}
    __device__ __forceinline__ void done(const Unit&) const {}
};

__device__ __forceinline__ unsigned cvt_pk_bf16(float lo, float hi) { unsigned r; asm volatile("v_cvt_pk_bf16_f32 %0, %1, %2" : "=v"(r) : "v"(lo), "v"(hi)); return r; }
__device__ __forceinline__ float fq_sum(float v) {
    auto a = __builtin_amdgcn_permlane16_swap(__float_as_uint(v), __float_as_uint(v), false, false); v = __uint_as_float(a[0]) + __uint_as_float(a[1]);
    auto b = __builtin_amdgcn_permlane32_swap(__float_as_uint(v), __float_as_uint(v), false, false); return __uint_as_float(b[0]) + __uint_as_float(b[1]);
}
struct EpiAny {
    static constexpr bool AFTER_DRAIN = false;
    int mode, perm; bf16_t* O; int ldc; bf16_t* xr; float* out; float* ssx; const float* rs_src; int rs_cnt; float rs_div; float* ssq; float* sskv;
    __device__ __forceinline__ void operator()(const f32x4 (&acc)[2][2][4][2], const Unit& u, int wr, int wc, int fr, int fq) const {
        if (mode < 2) {
            const int row0 = u.pm * BM + wr * 64 + fr; const int col0 = u.pn * BM + wc * 32 + 8 * fq; const bool sq = mode == 1;
            const int sstile = ssq ? (u.pn == 7 ? 1 : (u.pn == 8 ? 2 : 0)) : 0;
            float rsv[2][4];
            if (rs_src) {
                f32x4 pq[2][4]; const bool split = rs_cnt == 16;
#pragma unroll
                for (int ai = 0; ai < 2; ++ai)
#pragma unroll
                    for (int m = 0; m < 4; ++m) pq[ai][m] = *(const f32x4*)(rs_src + (size_t)(row0 + ai * HALF + m * 16) * rs_cnt + (split ? 4 * fq : 0));
#pragma unroll
                for (int ai = 0; ai < 2; ++ai)
#pragma unroll
                    for (int m = 0; m < 4; ++m) { const f32x4 a = pq[ai][m]; float t = (a[0] + a[1]) + (a[2] + a[3]); if (split) t = fq_sum(t); rsv[ai][m] = 1.0f / sqrtf(t * rs_div + 1e-6f); }
            } else {
#pragma unroll
                for (int ai = 0; ai < 2; ++ai)
#pragma unroll
                    for (int m = 0; m < 4; ++m) rsv[ai][m] = 1.f;
            }
#pragma unroll
            for (int ai = 0; ai < 2; ++ai)
#pragma unroll
                for (int m = 0; m < 4; ++m) { const int row = row0 + ai * HALF + m * 16; bf16_t* rowp = O + (size_t)row * ldc + col0;
                    const float rs = rsv[ai][m]; float part = 0.f;
#pragma unroll
                    for (int bj = 0; bj < 2; ++bj) { f32x4 v0 = acc[ai][bj][m][0] * rs, v1 = acc[ai][bj][m][1] * rs;
                        if (sq) {
#pragma unroll
                            for (int e = 0; e < 4; ++e) { const float a = fmaxf(v0[e], 0.f), b = fmaxf(v1[e], 0.f); v0[e] = a * a; v1[e] = b * b; } }
                        if (sstile == 1 || (sstile == 2 && bj == 0)) part += ((v0[0] * v0[0] + v0[1] * v0[1]) + (v0[2] * v0[2] + v0[3] * v0[3])) + ((v1[0] * v1[0] + v1[1] * v1[1]) + (v1[2] * v1[2] + v1[3] * v1[3]));
                        u32x4 w; w.x = cvt_pk_bf16(v0[0], v0[1]); w.y = cvt_pk_bf16(v0[2], v0[3]); w.z = cvt_pk_bf16(v1[0], v1[1]); w.w = cvt_pk_bf16(v1[2], v1[3]);
                        *(u32x4*)(rowp + bj * HALF) = w; }
                    if (sstile) { part = fq_sum(part); if (fq == 0) (sstile == 1 ? ssq : sskv)[(size_t)row * 4 + wc] = part; }
                }
        } else {
            const int col0 = u.pn * BM + wc * 32 + 8 * fq; const bool toout = mode == 3;
#pragma unroll
            for (int ai = 0; ai < 2; ++ai) {
                u32x4 xw[4][2];
#pragma unroll
                for (int m = 0; m < 4; ++m) { const bf16_t* xp = xr + (size_t)(u.pm * BM + ai * HALF + wr * 64 + m * 16 + fr) * 1024 + col0;
#pragma unroll
                    for (int bj = 0; bj < 2; ++bj) xw[m][bj] = *(const u32x4*)(xp + bj * HALF); }
#pragma unroll
                for (int m = 0; m < 4; ++m) { const int r = u.pm * BM + ai * HALF + wr * 64 + m * 16 + fr; bf16_t* xp = xr + (size_t)r * 1024 + col0; float* op = out + (size_t)r * 1024 + col0; float part = 0.f;
#pragma unroll
                    for (int bj = 0; bj < 2; ++bj) { const u32x4 w0 = xw[m][bj]; f32x4 v0 = acc[ai][bj][m][0], v1 = acc[ai][bj][m][1];
                        v0[0] += __uint_as_float(w0.x << 16); v0[1] += __uint_as_float(w0.x & 0xffff0000u); v0[2] += __uint_as_float(w0.y << 16); v0[3] += __uint_as_float(w0.y & 0xffff0000u);
                        v1[0] += __uint_as_float(w0.z << 16); v1[1] += __uint_as_float(w0.z & 0xffff0000u); v1[2] += __uint_as_float(w0.w << 16); v1[3] += __uint_as_float(w0.w & 0xffff0000u);
                        if (toout) { *(f32x4*)(op + bj * HALF) = v0; *(f32x4*)(op + bj * HALF + 4) = v1; }
                        else { part += ((v0[0] * v0[0] + v0[1] * v0[1]) + (v0[2] * v0[2] + v0[3] * v0[3])) + ((v1[0] * v1[0] + v1[1] * v1[1]) + (v1[2] * v1[2] + v1[3] * v1[3]));
                               u32x4 w; w.x = cvt_pk_bf16(v0[0], v0[1]); w.y = cvt_pk_bf16(v0[2], v0[3]); w.z = cvt_pk_bf16(v1[0], v1[1]); w.w = cvt_pk_bf16(v1[2], v1[3]); *(u32x4*)(xp + bj * HALF) = w; } }
                    if (!toout) { part = fq_sum(part); if (fq == 0) ssx[(size_t)r * 16 + u.pn * 4 + wc] = part; }
                }
                asm volatile("" ::: "memory");
            }
        }
    }
};

template <class Epi, class Sched, bool ALIGN_EPI = false, bool SP2 = false>
__device__ __forceinline__ void gemm_phase(PG8_LAS unsigned char* lds, const Gemm g, const Sched& S, const Epi& E, const int tid_in) {
    int tid_o = tid_in + lane_asm();
    const int tid = tid_o, wid = __builtin_amdgcn_readfirstlane(tid >> 6), lane = tid & 63, wr = wid >> 2, wc = wid & 3, fr = lane & 15, fq = lane >> 4;
    const int K = g.K, nt = K / BK;
    unsigned voffA[2], voffB[2];
#pragma unroll
    for (int i = 0; i < 2; ++i) { int R, C; stage_rc(tid * 16 + i * 8192, R, C); const int Rb = E.perm ? ((R & ~31) + perm32(R & 31)) : R;
        voffA[i] = (unsigned)(R * g.lda + C) * 2u; voffB[i] = (unsigned)(Rb * K + C) * 2u; }
    const size_t kstep = (size_t)(BK * 2);
    const size_t hstepA = (size_t)HALF * g.lda * 2, hstepB = (size_t)HALF * K * 2;
    const size_t tstepA = 2 * hstepA, tstepB = 2 * hstepB;
    const unsigned ldsw = (unsigned)wid * 1024u;
    const int aoff = lds_byte(wr * 64 + fr, fq * 8), boff = lds_byte(wc * 32 + fr, fq * 8);
#define PG8_SA(b, h) (((b) * 2 + (h)) * HTB)
#define PG8_SB(b, h) ((4 + (b) * 2 + (h)) * HTB)
#define PG8_STAGE(bufoff, gbase, voff) do { _Pragma("unroll") for (int _i = 0; _i < 2; ++_i) \
        __builtin_amdgcn_global_load_lds((const unsigned*)((const char*)(gbase) + (voff)[_i]), (PG8_LAS unsigned*)(lds + (bufoff) + ldsw + _i * 8192), 16, 0, 0); } while (0)
#define PG8_LDA(dst, b, h) do { _Pragma("unroll") for (int m = 0; m < 4; ++m) _Pragma("unroll") for (int k = 0; k < 2; ++k) dst[m][k] = *(const PG8_LAS bf16x8*)(lds + PG8_SA(b, h) + aoff + m * 2048 + k * 1024); } while (0)
#define PG8_LDB(dst, b, h) do { _Pragma("unroll") for (int n = 0; n < 2; ++n) _Pragma("unroll") for (int k = 0; k < 2; ++k) dst[n][k] = *(const PG8_LAS bf16x8*)(lds + PG8_SB(b, h) + boff + n * 2048 + k * 1024); } while (0)
#define PG8_MMA(ai, bj, At, Bt) do { __builtin_amdgcn_s_setprio(1); _Pragma("unroll") for (int m = 0; m < 4; ++m) _Pragma("unroll") for (int n = 0; n < 2; ++n) _Pragma("unroll") for (int k = 0; k < 2; ++k) \
        acc[ai][bj][m][n] = __builtin_amdgcn_mfma_f32_16x16x32_bf16(Bt[n][k], At[m][k], acc[ai][bj][m][n], 0, 0, 0); __builtin_amdgcn_s_setprio(0); } while (0)
#define PG8_WAIT_V(n) asm volatile("s_waitcnt vmcnt(" #n ")" ::: "memory")
#define PG8_WAIT_L(n) asm volatile("s_waitcnt lgkmcnt(" #n ")" ::: "memory")
#define PG8_BAR __builtin_amdgcn_s_barrier()
#define PG8_SCHED __builtin_amdgcn_sched_barrier(0)
    Unit cur, nxt; int ui = 0;
    if (!S.next(0, cur)) return;
    f32x4 acc[2][2][4][2];
#pragma unroll
    for (int a = 0; a < 2; ++a)
#pragma unroll
        for (int b = 0; b < 2; ++b)
#pragma unroll
            for (int m = 0; m < 4; ++m)
#pragma unroll
                for (int n = 0; n < 2; ++n) acc[a][b][m][n] = (f32x4){0.f, 0.f, 0.f, 0.f};
    bf16x8 At[4][2], B0[2][2], B1[2][2];
    const char* cA = (const char*)g.A + (size_t)cur.pm * tstepA; const char* cB = (const char*)g.Bt + (size_t)cur.pn * tstepB;
    S.a_ready(cur);
    if constexpr (SP2) {
        PG8_STAGE(PG8_SB(0, 0), cB, voffB); PG8_STAGE(PG8_SB(0, 1), cB + hstepB, voffB); PG8_STAGE(PG8_SA(0, 0), cA, voffA); PG8_STAGE(PG8_SA(0, 1), cA + hstepA, voffA);
        if (wr == 1) PG8_BAR;
        PG8_WAIT_V(2); PG8_BAR;
        PG8_STAGE(PG8_SB(1, 0), cB + kstep, voffB); PG8_STAGE(PG8_SA(1, 0), cA + kstep, voffA); PG8_STAGE(PG8_SB(1, 1), cB + hstepB + kstep, voffB);
        PG8_WAIT_V(6); PG8_BAR;
    } else {
        PG8_STAGE(PG8_SB(0, 0), cB, voffB); PG8_STAGE(PG8_SA(0, 0), cA, voffA); PG8_STAGE(PG8_SB(0, 1), cB + hstepB, voffB); PG8_STAGE(PG8_SA(0, 1), cA + hstepA, voffA);
        if (wr == 1) PG8_BAR;
        PG8_WAIT_V(4); PG8_BAR;
        PG8_STAGE(PG8_SB(1, 0), cB + kstep, voffB); PG8_STAGE(PG8_SA(1, 0), cA + kstep, voffA); PG8_STAGE(PG8_SB(1, 1), cB + hstepB + kstep, voffB);
        PG8_WAIT_V(6); PG8_BAR;
    }
    for (;;) {
        const bool has_next = S.next(ui + 1, nxt);
        const char* nA = has_next ? (const char*)g.A + (size_t)nxt.pm * tstepA : cA; const char* nB = has_next ? (const char*)g.Bt + (size_t)nxt.pn * tstepB : cB;
        for (int t = 0; t < nt; t += 2) {
            const bool last = (t == nt - 2);
            const char* a1 = cA + (size_t)(t + 1) * kstep;
            const char* a2 = last ? nA : cA + (size_t)(t + 2) * kstep; const char* b2 = last ? nB : cB + (size_t)(t + 2) * kstep;
            const char* a3 = a2 + kstep; const char* b3 = b2 + kstep;
            if (last && has_next) S.a_ready(nxt);
            if constexpr (SP2) {
            PG8_LDB(B0, 0, 0); PG8_LDB(B1, 0, 1); PG8_SCHED; PG8_LDA(At, 0, 0); PG8_STAGE(PG8_SA(1, 1), a1 + hstepA, voffA);
            PG8_WAIT_V(8); PG8_WAIT_L(0); PG8_BAR; PG8_MMA(0, 0, At, B0); PG8_MMA(0, 1, At, B1); PG8_BAR; PG8_SCHED;
            PG8_LDA(At, 0, 1); PG8_STAGE(PG8_SB(0, 0), b2, voffB); PG8_STAGE(PG8_SB(0, 1), b2 + hstepB, voffB); PG8_STAGE(PG8_SA(0, 0), a2, voffA);
            PG8_WAIT_V(8); PG8_WAIT_L(0); PG8_BAR; PG8_MMA(1, 0, At, B0); PG8_MMA(1, 1, At, B1); PG8_BAR; PG8_SCHED;
            PG8_LDB(B0, 1, 0); PG8_LDB(B1, 1, 1); PG8_SCHED; PG8_LDA(At, 1, 0); PG8_STAGE(PG8_SA(0, 1), a2 + hstepA, voffA);
            PG8_WAIT_V(8); PG8_WAIT_L(0); PG8_BAR; PG8_MMA(0, 0, At, B0); PG8_MMA(0, 1, At, B1); PG8_BAR; PG8_SCHED;
            PG8_LDA(At, 1, 1); PG8_STAGE(PG8_SB(1, 0), b3, voffB); PG8_STAGE(PG8_SB(1, 1), b3 + hstepB, voffB); PG8_STAGE(PG8_SA(1, 0), a3, voffA);
            PG8_WAIT_V(8); PG8_WAIT_L(0); PG8_BAR; PG8_MMA(1, 0, At, B0); PG8_MMA(1, 1, At, B1); PG8_BAR; PG8_SCHED;
            } else {
            PG8_LDB(B0, 0, 0); PG8_SCHED; PG8_LDA(At, 0, 0); PG8_STAGE(PG8_SA(1, 1), a1 + hstepA, voffA);
            PG8_WAIT_L(8); PG8_BAR; PG8_WAIT_L(0); PG8_MMA(0, 0, At, B0); PG8_BAR; PG8_SCHED;
            PG8_LDB(B1, 0, 1); PG8_STAGE(PG8_SB(0, 0), b2, voffB);
            PG8_BAR; PG8_WAIT_L(0); PG8_MMA(0, 1, At, B1); PG8_BAR;
            PG8_LDA(At, 0, 1); PG8_STAGE(PG8_SA(0, 0), a2, voffA);
            PG8_BAR; PG8_WAIT_L(0); PG8_MMA(1, 0, At, B0); PG8_BAR; PG8_SCHED;
            PG8_STAGE(PG8_SB(0, 1), b2 + hstepB, voffB);
            PG8_WAIT_V(6); PG8_BAR; PG8_MMA(1, 1, At, B1); PG8_BAR;
            PG8_LDB(B0, 1, 0); PG8_SCHED; PG8_LDA(At, 1, 0); PG8_STAGE(PG8_SA(0, 1), a2 + hstepA, voffA);
            PG8_WAIT_L(8); PG8_BAR; PG8_WAIT_L(0); PG8_MMA(0, 0, At, B0); PG8_BAR; PG8_SCHED;
            PG8_LDB(B1, 1, 1); PG8_STAGE(PG8_SB(1, 0), b3, voffB);
            PG8_BAR; PG8_WAIT_L(0); PG8_MMA(0, 1, At, B1); PG8_BAR;
            PG8_LDA(At, 1, 1); PG8_STAGE(PG8_SA(1, 0), a3, voffA);
            PG8_BAR; PG8_WAIT_L(0); PG8_MMA(1, 0, At, B0); PG8_BAR; PG8_SCHED;
            PG8_STAGE(PG8_SB(1, 1), b3 + hstepB, voffB);
            PG8_WAIT_V(6); PG8_BAR; PG8_MMA(1, 1, At, B1); PG8_BAR;
            }
        }
        if constexpr (ALIGN_EPI) { if (wr == 0) PG8_BAR; }
        if constexpr (!Epi::AFTER_DRAIN) { E(acc, cur, wr, wc, fr, fq); S.done(cur); }
        if (!has_next) break;
#pragma unroll
        for (int a = 0; a < 2; ++a)
#pragma unroll
            for (int b = 0; b < 2; ++b)
#pragma unroll
                for (int m = 0; m < 4; ++m)
#pragma unroll
                    for (int n = 0; n < 2; ++n) acc[a][b][m][n] = (f32x4){0.f, 0.f, 0.f, 0.f};
        cur = nxt; cA = nA; cB = nB; ++ui;
        if constexpr (ALIGN_EPI) { if (wr == 1) PG8_BAR; }
    }
    PG8_WAIT_V(0);
    if constexpr (!ALIGN_EPI) { if (wr == 0) PG8_BAR; }
    PG8_BAR;
    if constexpr (Epi::AFTER_DRAIN) { E.fused(acc, cur, wr, wc, fr, fq, lds, wid, lane); S.done(cur); }
#undef PG8_SA
#undef PG8_SB
#undef PG8_STAGE
#undef PG8_LDA
#undef PG8_LDB
#undef PG8_MMA
#undef PG8_WAIT_V
#undef PG8_WAIT_L
#undef PG8_BAR
#undef PG8_SCHED
}
}

#define GAS __attribute__((address_space(1)))
#define LAS __attribute__((address_space(3)))
typedef unsigned short bf16;
typedef unsigned u32x4 __attribute__((ext_vector_type(4)));
typedef unsigned u32x2 __attribute__((ext_vector_type(2)));
typedef float f32x4 __attribute__((ext_vector_type(4)));
typedef float f32x2 __attribute__((ext_vector_type(2)));
typedef short bf16x8 __attribute__((ext_vector_type(8)));
typedef float f32x16 __attribute__((ext_vector_type(16)));
constexpr int DM = 1024, BATCH = 32, SEQ = 2048, NMETA = 16, TT = SEQ + NMETA, DIN = 2208, DINP = 2304, DFF = 4096, DEPTH = 2;
constexpr int MREAL = BATCH * SEQ, MR0 = MREAL, MV = MREAL + NMETA, M = MREAL + 256;
static_assert(MREAL % 256 == 0, "row tiles");
__device__ __forceinline__ int rowof(int b, int t) { return t < NMETA ? MR0 + t : b * SEQ + (t - NMETA); }
constexpr int C_CB = 0, C_CC = 256, C_CH = 512, C_RQ = 768, C_RK = 1024, C_RV = 1280, C_RG = 1536, C_CQ = 1792, C_CKV = 2048, C_KR = 2176;
constexpr float EPS = 1e-6f;
constexpr float QSCALE = 0.10206207261596575f * 1.4426950408889634f;
constexpr size_t MiB = 1u << 20;
constexpr size_t WS_RT = 1 * MiB, WS_MT = 1 * MiB + 768 * 1024;
constexpr size_t WS_WIN = 4 * MiB, WS_WUQ = 13 * MiB, WS_WUKV = 14 * MiB, WS_WOUT = 15 * MiB, WS_W1 = 19 * MiB, WS_W2 = 35 * MiB;
constexpr size_t WS_X = 52 * MiB, WS_XN = 310 * MiB, WS_PROJ = 440 * MiB, WS_QRAW = 731 * MiB, WS_KV = 828 * MiB, WS_H = 440 * MiB, WS_SSX = 958 * MiB, WS_SSQ = 964 * MiB, WS_SSKV = 966 * MiB, WS_SQA = 968 * MiB, WS_END = 969 * MiB;
static_assert(WS_X + (size_t)M * DM * 4 <= WS_XN && WS_XN + (size_t)M * DM * 2 <= WS_PROJ && WS_PROJ + (size_t)M * DINP * 2 <= WS_QRAW && WS_QRAW + (size_t)M * 768 * 2 <= WS_KV &&
              WS_KV + (size_t)M * 1024 * 2 <= WS_SSX && WS_H + (size_t)M * DFF * 2 <= WS_SSX && WS_SSX + (size_t)M * 64 <= WS_SSQ && WS_SSQ + (size_t)M * 16 <= WS_SSKV && WS_SSKV + (size_t)M * 16 <= WS_SQA && WS_SQA + (size_t)M * 4 <= WS_END, "d_ws map");
constexpr int NWAVES = 8, LDS_BYTES = 147456, XB_LDS_OFF = 131072 + 256;

__device__ __forceinline__ unsigned f2bf(float f) { unsigned u = __builtin_bit_cast(unsigned, f); return (u + 0x7fffu + ((u >> 16) & 1u)) >> 16; }
__device__ __forceinline__ unsigned pk2(float lo, float hi) { return f2bf(lo) | (f2bf(hi) << 16); }
__device__ __forceinline__ float bflo(unsigned w) { return __uint_as_float(w << 16); }
__device__ __forceinline__ float bfhi(unsigned w) { return __uint_as_float(w & 0xffff0000u); }
__device__ __forceinline__ float bf1(bf16 h) { return __uint_as_float((unsigned)h << 16); }
__device__ __forceinline__ float dpp_add(float v, int ctrl_b1, int ctrl_4e, int ctrl_hm, int ctrl_m) { return v; }
__device__ __forceinline__ float wave_sum(float v) {
    v += __int_as_float(__builtin_amdgcn_update_dpp(0, __float_as_int(v), 0xB1, 0xF, 0xF, false));
    v += __int_as_float(__builtin_amdgcn_update_dpp(0, __float_as_int(v), 0x4E, 0xF, 0xF, false));
    v += __int_as_float(__builtin_amdgcn_update_dpp(0, __float_as_int(v), 0x141, 0xF, 0xF, false));
    v += __int_as_float(__builtin_amdgcn_update_dpp(0, __float_as_int(v), 0x140, 0xF, 0xF, false));
    return pg8::fq_sum(v);
}

namespace att {
typedef float f32x2_t __attribute__((ext_vector_type(2))); typedef __bf16 bf16x2_t __attribute__((ext_vector_type(2)));
__device__ __forceinline__ unsigned cvtpk(float lo, float hi) { f32x2_t v = {lo, hi}; bf16x2_t b = __builtin_convertvector(v, bf16x2_t); return __builtin_bit_cast(unsigned, b); }
constexpr int VP = 144;
__device__ __forceinline__ float xhalf_max(float v) { auto rr = __builtin_amdgcn_permlane32_swap(__float_as_uint(v), __float_as_uint(v), false, false); return fmaxf(__uint_as_float(rr[0]), __uint_as_float(rr[1])); }
__device__ __forceinline__ float xhalf_sum(float v) { auto rr = __builtin_amdgcn_permlane32_swap(__float_as_uint(v), __float_as_uint(v), false, false); return __uint_as_float(rr[0]) + __uint_as_float(rr[1]); }
template <int DQK, bool SM>
__device__ __forceinline__ void unit(LAS unsigned char* lds, const bf16* Q, int ldq, const bf16* K, int ldk, const bf16* V, int ldv, bf16* O, int ldo,
                                     const bf16* G, int ldg, const float* gain, float lg2, int b, int q0, int qend, const int tid_in, const float* sqa, const float* qgain, const f32x2* mtab) {
    constexpr int KP = DQK * 2 + 16, CH = DQK / 8, ND = DQK / 16, KB = 64 * KP, VB = 64 * VP, SB = KB + VB;
    int tid_o = tid_in + pg8::lane_asm();
    const int tid = tid_o, lane = tid & 63, wid = __builtin_amdgcn_readfirstlane(tid >> 6), r32 = lane & 31, hi = lane >> 5;
    const int q0w = q0 + 32 * wid, tq = q0w + r32;
    const bool wact = q0w < qend;
    bf16x8 qr[ND];
    const int qrow = rowof(b, tq < TT ? tq : TT - 1);
    { const bf16* qp = Q + (size_t)qrow * ldq + 8 * hi;
#pragma unroll
      for (int d0 = 0; d0 < ND; ++d0) qr[d0] = *(const bf16x8*)(qp + 16 * d0); }
    const int ntiles = (qend - 1) / 64 + 1;
    const int nw = wact ? ((q0w + 31) / 64 + 1 < ntiles ? (q0w + 31) / 64 + 1 : ntiles) : 0;
    const int nfull = (q0w + 1) / 64;
    const int kkey0 = tid / CH, kch0 = tid % CH; constexpr bool has2 = 64 * CH > 512;
    const int kc1 = 512 + (tid >> 1), kkey1 = kc1 / CH, kch1 = kc1 % CH, khalf = tid & 1;
    const int vkey = tid & 63, vch = tid >> 6;
    const int pr32 = (r32 & 0x13) | ((r32 & 4) << 1) | ((r32 & 8) >> 1);
    const int koff = pr32 * KP + 16 * hi, voff = KB + r32 * VP + 16 * hi;
    u32x4 kreg0A, kreg0B, vregA, vregB; u32x2 kreg1A, kreg1B;
#define ATT_LOADK(j, S) do { int r0_ = 64 * (j) + kkey0; r0_ = r0_ < TT ? r0_ : TT - 1; kreg0##S = *(const u32x4*)(K + (size_t)rowof(b, r0_) * ldk + 8 * kch0); \
        if (has2) { int r1_ = 64 * (j) + kkey1; r1_ = r1_ < TT ? r1_ : TT - 1; kreg1##S = *(const u32x2*)(K + (size_t)rowof(b, r1_) * ldk + 8 * kch1 + 4 * khalf); } } while (0)
#define ATT_LOADV(j, S) do { int rv_ = 64 * (j) + vkey; rv_ = rv_ < TT ? rv_ : TT - 1; vreg##S = *(const u32x4*)(V + (size_t)rowof(b, rv_) * ldv + 8 * vch); } while (0)
#define ATT_STOREK(so, S) do { *(LAS u32x4*)(lds + (so) + kkey0 * KP + 16 * kch0) = kreg0##S; if (has2) *(LAS u32x2*)(lds + (so) + kkey1 * KP + 16 * kch1 + 8 * khalf) = kreg1##S; } while (0)
#define ATT_STOREV(so, S) do { LAS unsigned char* vd_ = lds + (so) + KB + (8 * vch) * VP + 2 * vkey; \
        _Pragma("unroll") for (int i_ = 0; i_ < 8; ++i_) { const unsigned w_ = vreg##S[i_ >> 1]; *(LAS unsigned short*)(vd_ + i_ * VP) = (unsigned short)((i_ & 1) ? (w_ >> 16) : (w_ & 0xffffu)); } } while (0)
#define ATT_KREAD(so) do { const LAS unsigned char* kb_ = lds + (so) + koff; \
        _Pragma("unroll") for (int d0 = 0; d0 < ND; ++d0) { kf0[d0] = *(const LAS bf16x8*)(kb_ + 32 * d0); kf1[d0] = *(const LAS bf16x8*)(kb_ + 32 * KP + 32 * d0); } } while (0)
#define ATT_VREAD(so) do { const LAS unsigned char* vb_ = lds + (so) + voff; \
        _Pragma("unroll") for (int ks = 0; ks < 4; ++ks) { vf0[ks] = *(const LAS bf16x8*)(vb_ + 32 * ks); vf1[ks] = *(const LAS bf16x8*)(vb_ + 32 * VP + 32 * ks); } } while (0)
#define ATT_QKM(S0, S1) do { \
        _Pragma("unroll") for (int r_ = 0; r_ < 16; ++r_) { S0[r_] = 0.f; S1[r_] = 0.f; } \
        _Pragma("unroll") for (int d0 = 0; d0 < ND; ++d0) { \
            S0 = __builtin_amdgcn_mfma_f32_32x32x16_bf16(kf0[d0], qr[d0], S0, 0, 0, 0); S1 = __builtin_amdgcn_mfma_f32_32x32x16_bf16(kf1[d0], qr[d0], S1, 0, 0, 0); } } while (0)
#define ATT_QKI(S0, S1, so) do { const LAS unsigned char* kb_ = lds + (so) + koff; \
        _Pragma("unroll") for (int r_ = 0; r_ < 16; ++r_) { S0[r_] = 0.f; S1[r_] = 0.f; } \
        _Pragma("unroll") for (int d0 = 0; d0 < ND; ++d0) { const bf16x8 k0_ = *(const LAS bf16x8*)(kb_ + 32 * d0), k1_ = *(const LAS bf16x8*)(kb_ + 32 * KP + 32 * d0); \
            S0 = __builtin_amdgcn_mfma_f32_32x32x16_bf16(k0_, qr[d0], S0, 0, 0, 0); S1 = __builtin_amdgcn_mfma_f32_32x32x16_bf16(k1_, qr[d0], S1, 0, 0, 0); } } while (0)
#define ATT_TILE(j, so, MASK, VPRE) do { const int kbase_ = 64 * (j) + 8 * hi; \
        if (SM) { \
            if (MASK) { _Pragma("unroll") for (int r = 0; r < 16; ++r) { const int kk = kbase_ + 16 * (r >> 3) + (r & 7); if (kk > tq) s0[r] = -INFINITY; if (kk + 32 > tq) s1[r] = -INFINITY; } } \
            float mx = fmaxf(s0[0], s1[0]); \
            _Pragma("unroll") for (int r = 1; r < 16; ++r) mx = fmaxf(mx, fmaxf(s0[r], s1[r])); \
            mx = xhalf_max(mx); \
            const float mn = fmaxf(m_run, mx), alpha = __builtin_amdgcn_exp2f(m_run - mn); m_run = mn; \
            float ps = 0.f; \
            _Pragma("unroll") for (int r = 0; r < 16; ++r) { s0[r] = __builtin_amdgcn_exp2f(s0[r] - mn); s1[r] = __builtin_amdgcn_exp2f(s1[r] - mn); ps += s0[r] + s1[r]; } \
            l_run = l_run * alpha + ps; \
            _Pragma("unroll") for (int r = 0; r < 16; ++r) { o0[r] *= alpha; o1[r] *= alpha; } \
        } else { \
            const float rf0 = __builtin_amdgcn_exp2f(lg2 * (float)(tq - kbase_)), rf1 = rf0 * c32; \
            _Pragma("unroll") for (int r = 0; r < 16; ++r) { s0[r] = (s0[r] * cfac[r]) * rf0; s1[r] = (s1[r] * cfac[r]) * rf1; } \
            if (MASK) { _Pragma("unroll") for (int r = 0; r < 16; ++r) { const int kk = kbase_ + 16 * (r >> 3) + (r & 7); if (kk > tq) s0[r] = 0.f; if (kk + 32 > tq) s1[r] = 0.f; } } \
        } \
        u32x4 pw[4]; \
        _Pragma("unroll") for (int ks = 0; ks < 2; ++ks) { \
            pw[ks] = (u32x4){cvtpk(s0[8 * ks], s0[8 * ks + 1]), cvtpk(s0[8 * ks + 2], s0[8 * ks + 3]), cvtpk(s0[8 * ks + 4], s0[8 * ks + 5]), cvtpk(s0[8 * ks + 6], s0[8 * ks + 7])}; \
            pw[2 + ks] = (u32x4){cvtpk(s1[8 * ks], s1[8 * ks + 1]), cvtpk(s1[8 * ks + 2], s1[8 * ks + 3]), cvtpk(s1[8 * ks + 4], s1[8 * ks + 5]), cvtpk(s1[8 * ks + 6], s1[8 * ks + 7])}; } \
        const LAS unsigned char* vb_ = lds + (so) + voff; \
        _Pragma("unroll") for (int ks = 0; ks < 4; ++ks) { const bf16x8 pf_ = __builtin_bit_cast(bf16x8, pw[ks]); \
            const bf16x8 v0_ = (VPRE) ? vf0[ks] : *(const LAS bf16x8*)(vb_ + 32 * ks), v1_ = (VPRE) ? vf1[ks] : *(const LAS bf16x8*)(vb_ + 32 * VP + 32 * ks); \
            o0 = __builtin_amdgcn_mfma_f32_32x32x16_bf16(v0_, pf_, o0, 0, 0, 0); o1 = __builtin_amdgcn_mfma_f32_32x32x16_bf16(v1_, pf_, o1, 0, 0, 0); } } while (0)
    f32x16 o0, o1, s0, s1, t0, t1; bf16x8 kf0[ND], kf1[ND], vf0[4], vf1[4];
#pragma unroll
    for (int r = 0; r < 16; ++r) { o0[r] = 0.f; o1[r] = 0.f; s0[r] = 0.f; s1[r] = 0.f; t0[r] = 0.f; t1[r] = 0.f; }
    float m_run = -INFINITY, l_run = 0.f;
    float cfac[16]; const float c32 = SM ? 0.f : __builtin_amdgcn_exp2f(-32.f * lg2);
#pragma unroll
    for (int r = 0; r < 16; ++r) cfac[r] = SM ? 0.f : __builtin_amdgcn_exp2f(-lg2 * (float)(16 * (r >> 3) + (r & 7)));
    int so_c = 0, so_n = SB, so_nn = 2 * SB;
    ATT_LOADK(0, A); ATT_LOADV(0, A);
    if (ntiles > 1) { ATT_LOADK(1, B); ATT_LOADV(1, B); }
    if (SM) {
        const int tpos = tq < TT ? tq : TT - 1;
        float ss = 0.f;
#pragma unroll
        for (int d0 = 0; d0 < ND; ++d0) { const u32x4 w = __builtin_bit_cast(u32x4, qr[d0]);
#pragma unroll
            for (int e = 0; e < 4; ++e) { const float a0 = bflo(w[e]), a1 = bfhi(w[e]); ss += a0 * a0 + a1 * a1; } }
        ss = xhalf_sum(ss);
        const float rs = QSCALE / sqrtf(ss * (1.f / 96.f) + EPS);
#pragma unroll
        for (int d0 = 0; d0 < 4; ++d0) { const u32x4 w = __builtin_bit_cast(u32x4, qr[d0]); const f32x4 g0 = *(const f32x4*)(qgain + 16 * d0 + 8 * hi), g1 = *(const f32x4*)(qgain + 16 * d0 + 8 * hi + 4); u32x4 o;
            o[0] = cvtpk(bflo(w[0]) * rs * g0[0], bfhi(w[0]) * rs * g0[1]); o[1] = cvtpk(bflo(w[1]) * rs * g0[2], bfhi(w[1]) * rs * g0[3]);
            o[2] = cvtpk(bflo(w[2]) * rs * g1[0], bfhi(w[2]) * rs * g1[1]); o[3] = cvtpk(bflo(w[3]) * rs * g1[2], bfhi(w[3]) * rs * g1[3]);
            qr[d0] = __builtin_bit_cast(bf16x8, o); }
        { const u32x4 w1 = __builtin_bit_cast(u32x4, qr[4]), w2 = __builtin_bit_cast(u32x4, qr[5]); const f32x4* cs = (const f32x4*)(mtab + tpos * 16 + 8 * hi);
          const float* ga = qgain + 64 + 8 * hi; const float* gb = qgain + 80 + 8 * hi; u32x4 o1, o2;
#pragma unroll
          for (int e = 0; e < 4; ++e) { const f32x4 c4 = cs[e];
              const float a0 = bflo(w1[e]) * rs * ga[2 * e], a1 = bfhi(w1[e]) * rs * ga[2 * e + 1], b0 = bflo(w2[e]) * rs * gb[2 * e], b1 = bfhi(w2[e]) * rs * gb[2 * e + 1];
              o1[e] = cvtpk(a0 * c4.x - b0 * c4.y, a1 * c4.z - b1 * c4.w); o2[e] = cvtpk(b0 * c4.x + a0 * c4.y, b1 * c4.z + a1 * c4.w); }
          qr[4] = __builtin_bit_cast(bf16x8, o1); qr[5] = __builtin_bit_cast(bf16x8, o2); }
    }
    ATT_STOREK(0, A); ATT_STOREV(0, A);
    if (ntiles > 1) { ATT_STOREK(SB, B); ATT_STOREV(SB, B); }
    if (ntiles > 2) { ATT_LOADK(2, B); ATT_LOADV(2, B); }
    __syncthreads();
    if (nw > 0) ATT_QKI(s0, s1, 0);
#define ATT_ITER(J, SL, SS) do { const int j = (J); \
        if (j + 3 < ntiles) { ATT_LOADK(j + 3, SL); ATT_LOADV(j + 3, SL); } \
        if (j + 1 < nw && j < nfull) { \
            if (SM) { \
                ATT_QKI(t0, t1, so_n); \
                ATT_TILE(j, so_c, false, false); \
            } else if (wid < 4) { \
                ATT_QKI(t0, t1, so_n); __builtin_amdgcn_sched_barrier(0); \
                ATT_TILE(j, so_c, false, false); \
            } else { \
                ATT_TILE(j, so_c, false, false); __builtin_amdgcn_sched_barrier(0); \
                ATT_QKI(t0, t1, so_n); \
            } \
_Pragma("unroll") \
            for (int r = 0; r < 16; ++r) { s0[r] = t0[r]; s1[r] = t1[r]; } \
        } else if (j < nw) { \
            if (SM) { if (j + 1 < nw) ATT_QKI(t0, t1, so_n); ATT_TILE(j, so_c, true, false); } \
            else { if (j + 1 < nw) ATT_QKI(t0, t1, so_n); ATT_TILE(j, so_c, true, false); } \
_Pragma("unroll") \
            for (int r = 0; r < 16; ++r) { s0[r] = t0[r]; s1[r] = t1[r]; } \
        } \
        if (j + 2 < ntiles) { ATT_STOREK(so_nn, SS); ATT_STOREV(so_nn, SS); } \
        __syncthreads(); \
        { const int t_ = so_c; so_c = so_n; so_n = so_nn; so_nn = t_; } } while (0)
    for (int jj = 0; jj < ntiles; jj += 2) { ATT_ITER(jj, A, B); if (jj + 1 < ntiles) ATT_ITER(jj + 1, B, A); }
#undef ATT_ITER
#undef ATT_LOADK
#undef ATT_LOADV
#undef ATT_STOREK
#undef ATT_STOREV
#undef ATT_KREAD
#undef ATT_VREAD
#undef ATT_QKM
#undef ATT_QKI
#undef ATT_TILE
    if (wact) {
        if (SM) {
            const float l = xhalf_sum(l_run), inv = 1.f / l;
            u32x2 pa[2][4];
#pragma unroll
            for (int g = 0; g < 4; ++g) { pa[0][g].x = cvtpk(o0[4 * g] * inv, o0[4 * g + 1] * inv); pa[0][g].y = cvtpk(o0[4 * g + 2] * inv, o0[4 * g + 3] * inv);
                                          pa[1][g].x = cvtpk(o1[4 * g] * inv, o1[4 * g + 1] * inv); pa[1][g].y = cvtpk(o1[4 * g + 2] * inv, o1[4 * g + 3] * inv); }
            bf16* op = O + (size_t)qrow * ldo + 8 * hi;
#pragma unroll
            for (int db = 0; db < 2; ++db)
#pragma unroll
                for (int p = 0; p < 2; ++p) { auto rx = __builtin_amdgcn_permlane32_swap(pa[db][2 * p].x, pa[db][2 * p + 1].x, false, false); auto ry = __builtin_amdgcn_permlane32_swap(pa[db][2 * p].y, pa[db][2 * p + 1].y, false, false);
                    const u32x4 w = {rx[0], ry[0], rx[1], ry[1]}; if (tq < qend) *(u32x4*)(op + 32 * db + 16 * p) = w; }
        } else {
            float ss = 0.f;
#pragma unroll
            for (int r = 0; r < 16; ++r) ss += o0[r] * o0[r] + o1[r] * o1[r];
            ss = xhalf_sum(ss);
            const float rs = 1.0f / sqrtf(ss * (1.f / 64.f) + EPS);
            u32x2 pa[2][4];
            { const bf16* gp = G + (size_t)qrow * ldg + 4 * hi; const float* gn = gain + 4 * hi;
#pragma unroll
              for (int g = 0; g < 4; ++g) {
#pragma unroll
                  for (int db = 0; db < 2; ++db) {
                      const u32x2 gw = *(const u32x2*)(gp + 32 * db + 8 * g); const f32x4 ga = *(const f32x4*)(gn + 32 * db + 8 * g);
                      float gv[4] = {bflo(gw.x), bfhi(gw.x), bflo(gw.y), bfhi(gw.y)}; float y[4];
#pragma unroll
                      for (int e = 0; e < 4; ++e) { const float ov = db ? o1[4 * g + e] : o0[4 * g + e]; const float sg = gv[e] / (1.f + __expf(-gv[e])); y[e] = ov * rs * ga[e] * sg; }
                      pa[db][g].x = cvtpk(y[0], y[1]); pa[db][g].y = cvtpk(y[2], y[3]); } } }
            bf16* op = O + (size_t)qrow * ldo + 8 * hi;
#pragma unroll
            for (int db = 0; db < 2; ++db)
#pragma unroll
                for (int p = 0; p < 2; ++p) { auto rx = __builtin_amdgcn_permlane32_swap(pa[db][2 * p].x, pa[db][2 * p + 1].x, false, false); auto ry = __builtin_amdgcn_permlane32_swap(pa[db][2 * p].y, pa[db][2 * p + 1].y, false, false);
                    const u32x4 w = {rx[0], ry[0], rx[1], ry[1]}; if (tq < qend) *(u32x4*)(op + 32 * db + 16 * p) = w; }
        }
    }
}
}

struct Args { const float* in[16]; float* out; unsigned char* ws; int ph_lo, ph_hi; };
typedef const __attribute__((address_space(4))) Args* KArgsP;
#define RT   ((f32x2*)(ws + WS_RT))
#define MT   ((f32x2*)(ws + WS_MT))
#define WIN  ((bf16*)(ws + WS_WIN))
#define WUQ  ((bf16*)(ws + WS_WUQ))
#define WUKV ((bf16*)(ws + WS_WUKV))
#define WOUT ((bf16*)(ws + WS_WOUT))
#define W1   ((bf16*)(ws + WS_W1))
#define W2   ((bf16*)(ws + WS_W2))
#define XR   ((bf16*)(ws + WS_X))
#define XN   ((bf16*)(ws + WS_XN))
#define MIX  ((bf16*)(ws + WS_XN))
#define PROJ ((bf16*)(ws + WS_PROJ))
#define QRAW ((bf16*)(ws + WS_QRAW))
#define KVR  ((bf16*)(ws + WS_KV))
#define HB   ((bf16*)(ws + WS_H))
#define SSX  ((float*)(ws + WS_SSX))
#define SSQ  ((float*)(ws + WS_SSQ))
#define SSKV ((float*)(ws + WS_SSKV))
#define SQA  ((float*)(ws + WS_SQA))
enum { I_X = 0, I_META, I_ANG, I_WIN, I_CONVW, I_RETG, I_QNG, I_WUQ, I_KVNG, I_WUKV, I_QHG, I_KHG, I_WOUT, I_MLPG, I_W1, I_W2 };
constexpr int NPP = 7, NPHASE = 1 + NPP * DEPTH;

__device__ __forceinline__ void p0_transpose_item(const float* W, const float* gk, int K, int N, bf16* WT, LAS float* scr, int item, int lane) {
    const int nblk = N / 32, kb = item / nblk, nb = item % nblk, k0 = 64 * kb, n0 = 32 * nb;
#pragma unroll
    for (int i = 0; i < 8; ++i) { const int kk = 8 * i + (lane >> 3), q = lane & 7; const float gv = gk ? gk[k0 + kk] : 1.f;
        const f32x4 v = *(const f32x4*)(W + (size_t)(k0 + kk) * N + n0 + 4 * q); LAS float* d = scr + kk * 33 + 4 * q; d[0] = v.x * gv; d[1] = v.y * gv; d[2] = v.z * gv; d[3] = v.w * gv; }
    asm volatile("s_waitcnt lgkmcnt(0)" ::: "memory");
    const int c = lane & 7;
#pragma unroll
    for (int j = 0; j < 4; ++j) { const int n = (lane >> 3) + 8 * j; const LAS float* s = scr + (8 * c) * 33 + n;
        u32x4 o; o.x = pk2(s[0 * 33], s[1 * 33]); o.y = pk2(s[2 * 33], s[3 * 33]); o.z = pk2(s[4 * 33], s[5 * 33]); o.w = pk2(s[6 * 33], s[7 * 33]);
        *(u32x4*)(WT + (size_t)(n0 + n) * K + k0 + 8 * c) = o; }
    asm volatile("s_waitcnt lgkmcnt(0)" ::: "memory");
}
__device__ __forceinline__ void row_prep(const float* xrow, bf16* orow, float* ss16, int lane) {
    const f32x4* xr = (const f32x4*)xrow + lane;
    f32x4 v[4]; float s = 0.f;
#pragma unroll
    for (int j = 0; j < 4; ++j) { v[j] = xr[64 * j]; s += (v[j].x * v[j].x + v[j].y * v[j].y) + (v[j].z * v[j].z + v[j].w * v[j].w); }
    const float tot = wave_sum(s);
    if (lane < 16) ss16[lane] = lane == 0 ? tot : 0.f;
    unsigned long long* o8 = (unsigned long long*)orow + lane;
#pragma unroll
    for (int j = 0; j < 4; ++j) o8[64 * j] = (unsigned long long)att::cvtpk(v[j].x, v[j].y) | ((unsigned long long)att::cvtpk(v[j].z, v[j].w) << 32);
}
__device__ __forceinline__ f32x2 cossin(float ang) {
    const float n = rintf(ang * 0.15915494309189535f);
    float r = fmaf(-n, 6.28125f, ang); r = fmaf(-n, 0.0019353071795864769f, r);
    const float rev = r * 0.15915494309189535f;
    f32x2 o; o.x = __builtin_amdgcn_cosf(rev); o.y = __builtin_amdgcn_sinf(rev); return o;
}

#define XB_TMO      128
#define XB_XCNT(j)  (256  + 64 * (j))
#define XB_XSUB(j)  (1280 + 64 * (j))
#define XB_XGEN(j)  (2304 + 64 * (j))
#define XB_TOP      3328
#define XB_TOPGEN   3392
#define XCD_BAR_WORDS 3456
#define XB_SPIN_CAP (1u << 18)

__device__ __forceinline__ unsigned xb_ld(unsigned* p)              { return __hip_atomic_load(p, __ATOMIC_RELAXED, __HIP_MEMORY_SCOPE_AGENT); }
__device__ __forceinline__ unsigned xb_add(unsigned* p, unsigned v) { return __hip_atomic_fetch_add(p, v, __ATOMIC_RELAXED, __HIP_MEMORY_SCOPE_AGENT); }
__device__ __forceinline__ unsigned xb_xcc_id() { return (unsigned)__builtin_amdgcn_s_getreg((3 << 11) | 20) & 0xFu; }
#define XB_SPIN(cond, bar) do { unsigned _sp = 0; while (cond) { __builtin_amdgcn_s_sleep(1); \
    if ((++_sp & 255u) == 0u) { if (xb_ld(&(bar)[XB_TMO])) break; if (_sp > XB_SPIN_CAP) { atomicAdd(&(bar)[XB_TMO], 1u); break; } } } } while (0)

struct XcdBarrier {
    unsigned* bar; unsigned x;
    volatile LAS unsigned* st;
};

__device__ __forceinline__ XcdBarrier xcd_barrier_post(unsigned* bar, volatile LAS unsigned* st) {
    XcdBarrier b; b.bar = bar; b.x = xb_xcc_id(); b.st = st;
    if (threadIdx.x == 0) (void)xb_add(&bar[XB_XCNT(b.x)], 1u);
    return b;
}
__device__ __forceinline__ void xcd_barrier_complete(unsigned* bar, unsigned x, unsigned& nloc, unsigned& nx) {
    const unsigned G = gridDim.x * gridDim.y * gridDim.z;
    unsigned sum, cnt, mine, sp = 0u;
    for (;;) {
        sum = 0u; cnt = 0u; mine = 0u;
#pragma unroll
        for (unsigned j = 0; j < 16; ++j) { const unsigned c = xb_ld(&bar[XB_XCNT(j)]); sum += c; cnt += (c > 0u) ? 1u : 0u; mine = (j == x) ? c : mine; }
        if (sum == G) break;
        __builtin_amdgcn_s_sleep(1);
        if ((++sp & 255u) == 0u) { if (xb_ld(&bar[XB_TMO])) break; if (sp > XB_SPIN_CAP) { atomicAdd(&bar[XB_TMO], 1u); break; } }
    }
    nloc = mine > 0u ? mine : 1u; nx = cnt > 0u ? cnt : 1u;
}

__device__ __forceinline__ void xcd_barrier(const XcdBarrier& b) {
    asm volatile("s_waitcnt vmcnt(0)" ::: "memory");
    __syncthreads();
    if (threadIdx.x == 0) {
        unsigned* bar = b.bar;
        __builtin_amdgcn_s_waitcnt(0);
        unsigned nloc = b.st[0], nx = b.st[1];
        if (nloc == 0u) { xcd_barrier_complete(bar, b.x, nloc, nx); b.st[0] = nloc; b.st[1] = nx; }
        const unsigned old = xb_add(&bar[XB_XSUB(b.x)], 1u);
        const unsigned gen = old / nloc;
        if (old + 1u == (gen + 1u) * nloc) {
            __builtin_amdgcn_fence(__ATOMIC_RELEASE, "agent");
            asm volatile("s_waitcnt vmcnt(0)" ::: "memory");
            const unsigned og = xb_add(&bar[XB_TOP], 1u);
            const unsigned tg = og / nx;
            if (og + 1u == (tg + 1u) * nx) xb_add(&bar[XB_TOPGEN], 1u);
            else XB_SPIN(xb_ld(&bar[XB_TOPGEN]) == tg, bar);
            __builtin_amdgcn_fence(__ATOMIC_ACQUIRE, "agent");
            xb_add(&bar[XB_XGEN(b.x)], 1u);
            asm volatile("s_waitcnt vmcnt(0)" ::: "memory");
        } else {
            XB_SPIN(xb_ld(&bar[XB_XGEN(b.x)]) == gen, bar);
            __builtin_amdgcn_fence(__ATOMIC_ACQUIRE, "agent");
            asm volatile("s_waitcnt vmcnt(0)" ::: "memory");
        }
    }
    __syncthreads();
}

struct EpiMeta { int mode, need_rs; float rs_div; bf16* O; int ldc; bf16* xr; };
__device__ __forceinline__ void meta_gemm(const bf16* A, int lda, const bf16* Bt, int N, int K, const EpiMeta& E, int gw, int NGW, int lane) {
    for (int n = gw; n < N; n += NGW) {
        float acc[16], ssa[16];
#pragma unroll
        for (int r = 0; r < 16; ++r) { acc[r] = 0.f; ssa[r] = 0.f; }
        for (int c = lane; c < K / 8; c += 64) {
            const u32x4 w = *(const u32x4*)(Bt + (size_t)n * K + 8 * c);
            u32x4 a[16];
#pragma unroll
            for (int r = 0; r < 16; ++r) a[r] = *(const u32x4*)(A + (size_t)r * lda + 8 * c);
#pragma unroll
            for (int r = 0; r < 16; ++r) {
#pragma unroll
                for (int e = 0; e < 4; ++e) asm volatile("v_dot2c_f32_bf16 %0, %1, %2" : "+v"(acc[r]) : "v"(a[r][e]), "v"(w[e]));
                if (E.need_rs) {
#pragma unroll
                    for (int e = 0; e < 4; ++e) asm volatile("v_dot2c_f32_bf16 %0, %1, %2" : "+v"(ssa[r]) : "v"(a[r][e]), "v"(a[r][e])); }
            }
        }
        asm volatile("s_nop 3" ::: "memory");
        float mine = 0.f, myss = 0.f;
#pragma unroll
        for (int r = 0; r < 16; ++r) { const float s = wave_sum(acc[r]), q = E.need_rs ? wave_sum(ssa[r]) : 0.f; if (lane == r) { mine = s; myss = q; } }
        if (lane < 16) { const int r = lane;
            if (E.mode < 2) { float v = mine * (E.need_rs ? 1.0f / sqrtf(myss * E.rs_div + EPS) : 1.f); if (E.mode == 1) { v = fmaxf(v, 0.f); v = v * v; } E.O[(size_t)(MR0 + r) * E.ldc + n] = (bf16)f2bf(v); }
            else { bf16* p = E.xr + (size_t)(MR0 + r) * DM + n; *p = (bf16)f2bf(bf1(*p) + mine); } }
    }
}

__global__ void __launch_bounds__(NWAVES * 64, 2) hybrid_fwd(Args args) {
#define LANE pg8::lane_asm()
#define TID (wave * 64 + pg8::lane_asm())
    extern __shared__ __attribute__((aligned(16))) unsigned char lds_raw[];
    LAS unsigned char* lds = (LAS unsigned char*)lds_raw;
    cg::grid_group grid = cg::this_grid();
    const int G = gridDim.x, NGW = G * NWAVES;
    const int wave_s = __builtin_amdgcn_readfirstlane((int)threadIdx.x >> 6);
    if (threadIdx.x < 2) ((LAS unsigned*)(lds + XB_LDS_OFF))[threadIdx.x] = 0u;
    __syncthreads();
    if (args.ph_hi - args.ph_lo > 1) (void)xcd_barrier_post((unsigned*)args.ws, (volatile LAS unsigned*)(lds + XB_LDS_OFF));
    const int lo = args.ph_lo, hi = args.ph_hi;
    for (int ph = lo; ph < hi; ++ph) {
        KArgsP ap = (KArgsP)__builtin_amdgcn_kernarg_segment_ptr(); asm volatile("" : "+s"(ap));
        unsigned char* const ws = ap->ws;
        int wave = wave_s; asm volatile("" : "+s"(wave));
        const int gw = blockIdx.x * NWAVES + wave;
        const int l = ph == 0 ? 0 : (ph - 1) / NPP, k = ph == 0 ? -1 : (ph - 1) % NPP;
        if (k == -1) {
            LAS float* scr = (LAS float*)(lds + wave * 16384);
            constexpr int I_IN = 16 * 69, I_UQ = 4 * 24, I_UKV = 2 * 32, I_O = 16 * 32, I_1 = 16 * 128, I_2 = 64 * 32, I_L = I_IN + I_UQ + I_UKV + I_O + I_1 + I_2;
            for (int it = gw; it < DEPTH * I_L; it += NGW) {
                const int ll = it / I_L; int r = it - ll * I_L;
                if (r < I_IN) { p0_transpose_item(ap->in[I_WIN] + (size_t)ll * DM * DIN, ap->in[I_ANG] + ll * DM, DM, DIN, WIN + (size_t)ll * DINP * DM, scr, r, LANE); continue; } r -= I_IN;
                if (r < I_UQ) { p0_transpose_item(ap->in[I_WUQ] + (size_t)ll * 256 * 768, ap->in[I_QNG] + ll * 256, 256, 768, WUQ + (size_t)ll * 768 * 256, scr, r, LANE); continue; } r -= I_UQ;
                if (r < I_UKV) { p0_transpose_item(ap->in[I_WUKV] + (size_t)ll * 128 * 1024, ap->in[I_KVNG] + ll * 128, 128, 1024, WUKV + (size_t)ll * 1024 * 128, scr, r, LANE); continue; } r -= I_UKV;
                if (r < I_O) { p0_transpose_item(ap->in[I_WOUT] + (size_t)ll * DM * DM, nullptr, DM, DM, WOUT + (size_t)ll * DM * DM, scr, r, LANE); continue; } r -= I_O;
                if (r < I_1) { p0_transpose_item(ap->in[I_W1] + (size_t)ll * DM * DFF, ap->in[I_MLPG] + ll * DM, DM, DFF, W1 + (size_t)ll * DFF * DM, scr, r, LANE); continue; } r -= I_1;
                p0_transpose_item(ap->in[I_W2] + (size_t)ll * DFF * DM, nullptr, DFF, DM, W2 + (size_t)ll * DM * DFF, scr, r, LANE);
            }
            for (int it = gw; it < DEPTH * (DINP - DIN); it += NGW) {
                const int ll = it / (DINP - DIN), r = DIN + it % (DINP - DIN); u32x4* p = (u32x4*)(WIN + ((size_t)ll * DINP + r) * DM) + LANE;
                u32x4 z = {0u, 0u, 0u, 0u}; asm volatile("" : "+v"(z));
                p[0] = z; p[64] = z;
            }
            for (int e = blockIdx.x * 512 + TID; e < TT * 32; e += G * 512) { const int t = e >> 5, i = e & 31; const float inv = exp2f(-13.287712379549449f * (float)(2 * i) * (1.f / 64.f)); RT[e] = cossin((float)t * inv); }
            for (int e = blockIdx.x * 512 + TID; e < TT * 16; e += G * 512) { const int t = e >> 4, i = e & 15; const float inv = exp2f(-13.287712379549449f * (float)(2 * i) * (1.f / 32.f)); MT[e] = cossin((float)t * inv); }
            for (int m = gw; m < MV; m += NGW) {
                const float* src = m >= MR0 ? ap->in[I_META] + (size_t)(m - MR0) * DM : ap->in[I_X] + (size_t)m * DM;
                row_prep(src, XR + (size_t)m * DM, SSX + (size_t)m * 16, LANE); }
        } else if (k == 0 || k == 1 || k == 4 || k == 5 || k == 6) {
            const int ng = k == 1 ? 2 : 1;
            for (int gi = 0; gi < ng; ++gi) {
                pg8::Gemm g; pg8::EpiAny E; E.xr = XR; E.out = ap->out; E.O = nullptr; E.ldc = 0; E.ssx = SSX; E.rs_src = nullptr; E.rs_cnt = 16; E.rs_div = 1.f / 1024.f; E.ssq = nullptr; E.sskv = nullptr;
                EpiMeta Em; Em.need_rs = 0; Em.rs_div = 1.f / 1024.f; Em.O = nullptr; Em.ldc = 0; Em.xr = XR;
                if (k == 0)      { g = pg8::Gemm{XR, WIN + (size_t)l * DINP * DM, MREAL, DINP, DM, DM}; E.mode = 0; E.perm = 1; E.O = PROJ; E.ldc = DINP; E.rs_src = SSX; E.ssq = SSQ; E.sskv = SSKV; Em.need_rs = 1; }
                else if (k == 1 && gi == 0) { g = pg8::Gemm{PROJ + C_CQ, WUQ + (size_t)l * 768 * 256, MREAL, 768, 256, DINP}; E.mode = 0; E.perm = 1; E.O = QRAW; E.ldc = 768; E.rs_src = SSQ; E.rs_cnt = 4; E.rs_div = 1.f / 256.f; Em.need_rs = 1; Em.rs_div = 1.f / 256.f; }
                else if (k == 1) { g = pg8::Gemm{PROJ + C_CKV, WUKV + (size_t)l * 1024 * 128, MREAL, 1024, 128, DINP}; E.mode = 0; E.perm = 1; E.O = KVR; E.ldc = 1024; E.rs_src = SSKV; E.rs_cnt = 4; E.rs_div = 1.f / 128.f; Em.need_rs = 1; Em.rs_div = 1.f / 128.f; }
                else if (k == 4) { g = pg8::Gemm{MIX, WOUT + (size_t)l * DM * DM, MREAL, DM, DM, DM}; E.mode = 2; E.perm = 1; }
                else if (k == 5) { g = pg8::Gemm{XR, W1 + (size_t)l * DFF * DM, MREAL, DFF, DM, DM}; E.mode = 1; E.perm = 1; E.O = HB; E.ldc = DFF; E.rs_src = SSX; Em.need_rs = 1; }
                else             { g = pg8::Gemm{HB, W2 + (size_t)l * DM * DFF, MREAL, DM, DFF, DFF}; E.mode = (l == DEPTH - 1) ? 3 : 2; E.perm = 1; }
                Em.mode = E.mode; Em.O = E.O; Em.ldc = E.ldc;
                pg8::StaticOrder S; S.init(MREAL, g.N, G, (int)blockIdx.x);
                pg8::gemm_phase<pg8::EpiAny, pg8::StaticOrder, true, true>(lds, g, S, E, wave * 64);
                if (E.mode != 3) meta_gemm(g.A + (size_t)MR0 * g.lda, g.lda, g.Bt, g.N, g.K, Em, gw, NGW, LANE);
            }
            if (k == 1) {
                const float* cw = ap->in[I_CONVW] + l * 3 * 256;
                for (int it = blockIdx.x * 512 + TID; it < MV * 32; it += G * 512) {
                    const int m = it >> 5, c = (it & 31) * 8; const int t = m >= MR0 ? m - MR0 : (m & (SEQ - 1)) + NMETA; const bf16* pr = PROJ + (size_t)m * DINP;
                    const u32x4 cbv = *(const u32x4*)(pr + C_CB + c); float a[8];
#pragma unroll
                    for (int e = 0; e < 8; ++e) a[e] = 0.f;
#pragma unroll
                    for (int j = 0; j < 3; ++j) { const int tj = t - 2 + j; if (tj >= 0) { const int mj = (m >= MR0 || tj >= NMETA) ? m - (2 - j) : MR0 + tj;
                            const bf16* p2 = PROJ + (size_t)mj * DINP; const u32x4 ccv = *(const u32x4*)(p2 + C_CC + c), chv = *(const u32x4*)(p2 + C_CH + c);
                            const f32x4 w0 = *(const f32x4*)(cw + j * 256 + c), w1 = *(const f32x4*)(cw + j * 256 + c + 4);
#pragma unroll
                            for (int e = 0; e < 4; ++e) { const float wl = e < 2 ? w0[2 * e] : w1[2 * e - 4], wh = e < 2 ? w0[2 * e + 1] : w1[2 * e - 3];
                                a[2 * e] += wl * (bflo(ccv[e]) * bflo(chv[e])); a[2 * e + 1] += wh * (bfhi(ccv[e]) * bfhi(chv[e])); } } }
                    u32x4 o;
#pragma unroll
                    for (int e = 0; e < 4; ++e) o[e] = att::cvtpk(bflo(cbv[e]) * a[2 * e], bfhi(cbv[e]) * a[2 * e + 1]);
                    *(u32x4*)(MIX + (size_t)m * DM + c) = o;
                }
                for (int it = blockIdx.x * 512 + TID; it < MV * 32; it += G * 512) {
                    const int m = it >> 5, j = it & 31, w = j >> 4, h = (j >> 2) & 3, i0 = (j & 3) * 8; const int t = m >= MR0 ? m - MR0 : (m & (SEQ - 1)) + NMETA;
                    bf16* p = PROJ + (size_t)m * DINP + (w ? C_RK : C_RQ) + 64 * h + i0; const float sc = w ? 0.125f : 1.f;
                    const u32x4 x1 = *(const u32x4*)p, x2 = *(const u32x4*)(p + 32); const f32x4* cs = (const f32x4*)(RT + t * 32 + i0);
                    u32x4 o1, o2;
#pragma unroll
                    for (int e = 0; e < 4; ++e) { const f32x4 c4 = cs[e]; const float a0 = bflo(x1[e]), a1 = bfhi(x1[e]), b0 = bflo(x2[e]), b1 = bfhi(x2[e]);
                        o1[e] = att::cvtpk((a0 * c4.x - b0 * c4.y) * sc, (a1 * c4.z - b1 * c4.w) * sc); o2[e] = att::cvtpk((b0 * c4.x + a0 * c4.y) * sc, (b1 * c4.z + a1 * c4.w) * sc); }
                    *(u32x4*)p = o1; *(u32x4*)(p + 32) = o2;
                }
            }
        } else if (k == 2) {
            const float* kg = ap->in[I_KHG] + l * 96;
            for (int it = blockIdx.x * 512 + TID; it < MV * 8; it += G * 512) {
                const int m = it >> 3, h = it & 7; const int t = m >= MR0 ? m - MR0 : (m & (SEQ - 1)) + NMETA;
                const f32x4* mt = (const f32x4*)(MT + t * 16);
                { bf16* kn = KVR + (size_t)m * 1024 + 128 * h; bf16* pr = PROJ + (size_t)m * DINP; bf16* ko = pr + 96 * h; u32x4 w[8], r[4]; float ssn = 0.f, ssr = 0.f;
#pragma unroll
                  for (int c = 0; c < 8; ++c) w[c] = *(const u32x4*)(kn + 8 * c);
#pragma unroll
                  for (int c = 0; c < 4; ++c) r[c] = *(const u32x4*)(pr + C_KR + 8 * c);
#pragma unroll
                  for (int c = 0; c < 8; ++c)
#pragma unroll
                      for (int e = 0; e < 4; ++e) { const float a0 = bflo(w[c][e]), a1 = bfhi(w[c][e]); ssn += a0 * a0 + a1 * a1; }
#pragma unroll
                  for (int c = 0; c < 4; ++c)
#pragma unroll
                      for (int e = 0; e < 4; ++e) { const float a0 = bflo(r[c][e]), a1 = bfhi(r[c][e]); ssr += a0 * a0 + a1 * a1; }
                  const float rs = 1.0f / sqrtf((ssn + ssr) * (1.f / 96.f) + EPS), rn = rs;
#pragma unroll
                  for (int c = 0; c < 8; ++c) { u32x4 o;
#pragma unroll
                      for (int e = 0; e < 4; ++e) o[e] = att::cvtpk(bflo(w[c][e]) * rn * kg[8 * c + 2 * e], bfhi(w[c][e]) * rn * kg[8 * c + 2 * e + 1]);
                      *(u32x4*)(ko + 8 * c) = o; }
#pragma unroll
                  for (int cc = 0; cc < 2; ++cc) { u32x4 o1, o2;
#pragma unroll
                      for (int e = 0; e < 4; ++e) { const int i = 8 * cc + 2 * e; const f32x4 c4 = mt[4 * cc + e];
                          const float a0 = bflo(r[cc][e]) * rs * kg[64 + i], a1 = bfhi(r[cc][e]) * rs * kg[64 + i + 1], b0 = bflo(r[2 + cc][e]) * rs * kg[80 + i], b1 = bfhi(r[2 + cc][e]) * rs * kg[80 + i + 1];
                          o1[e] = att::cvtpk(a0 * c4.x - b0 * c4.y, a1 * c4.z - b1 * c4.w); o2[e] = att::cvtpk(b0 * c4.x + a0 * c4.y, b1 * c4.z + a1 * c4.w); }
                      *(u32x4*)(ko + 64 + 8 * cc) = o1; *(u32x4*)(ko + 80 + 8 * cc) = o2; }
                }
            }
        } else {
            for (int item = blockIdx.x; item < 524; item += G) {
                if (item < 256 || (item >= 512 && item < 520)) { const bool meta = item >= 512; const int b = meta ? 0 : item >> 3, h = item & 7;
                    const bf16* Qp = QRAW + 96 * h; const bf16* Kp = PROJ + 96 * h; const bf16* Vp = KVR + 128 * h + 64; bf16* Op = MIX + 512 + 64 * h;
                    if (meta) att::unit<96, true>(lds, Qp, 768, Kp, DINP, Vp, 1024, Op, DM, nullptr, 0, nullptr, 0.f, b, 0, 16, wave * 64, SQA, ap->in[I_QHG] + l * 96, MT);
                    else for (int blk = 8; blk >= 1; --blk) { const int q0 = 16 + 256 * (blk - 1);
                        att::unit<96, true>(lds, Qp, 768, Kp, DINP, Vp, 1024, Op, DM, nullptr, 0, nullptr, 0.f, b, q0, q0 + 256, wave * 64, SQA, ap->in[I_QHG] + l * 96, MT); }
                } else { const bool meta = item >= 520; const int it = item - 256, bh = ((it >> 4) << 3) | (it & 7), hf = (it >> 3) & 1  , b = meta ? 0 : bh >> 2, h = meta ? item - 520 : bh & 3;
                    const bf16* Pp = PROJ + 64 * h; bf16* Op = MIX + 256 + 64 * h; const float* gn = ap->in[I_RETG] + l * 256 + 64 * h;
                    const float lg2 = log2f(1.0f - exp2f(-5.0f - (float)h)); const unsigned bm = hf ? 0x0CCu : 0x132u;
                    if (meta) att::unit<64, false>(lds, Pp + C_RQ, DINP, Pp + C_RK, DINP, Pp + C_RV, DINP, Op, DM, Pp + C_RG, DINP, gn, lg2, b, 0, 16, wave * 64, nullptr, nullptr, nullptr);
                    else for (int blk = 8; blk >= 1; --blk) { if (!((bm >> blk) & 1u)) continue; const int q0 = 16 + 256 * (blk - 1);
                        att::unit<64, false>(lds, Pp + C_RQ, DINP, Pp + C_RK, DINP, Pp + C_RV, DINP, Op, DM, Pp + C_RG, DINP, gn, lg2, b, q0, q0 + 256, wave * 64, nullptr, nullptr, nullptr); }
                }
            }
        }
        if (ph + 1 < hi) {
            if (lo < 0) grid.sync();
            { XcdBarrier xbar; xbar.bar = (unsigned*)ws; xbar.x = xb_xcc_id(); xbar.st = (volatile LAS unsigned*)(lds + XB_LDS_OFF); xcd_barrier(xbar); }
        }
    }
}
#undef LANE
#undef TID

extern "C" void kernel_launch(void* const* d_in, const int* in_sizes, int n_in, void* d_out, int out_size, void* d_ws, size_t ws_size, hipStream_t stream) {
    static int grid = 0;
    if (grid == 0) {
        if (n_in != 16 || out_size != MREAL * DM || ws_size < WS_END) { fprintf(stderr, "kernel_launch: unexpected shapes (n_in %d, out %d, ws %zu)\n", n_in, out_size, ws_size); grid = -1; return; }
        int dev = 0, cus = 0, per_cu = 0;
        if (hipGetDevice(&dev) != hipSuccess || hipDeviceGetAttribute(&cus, hipDeviceAttributeMultiprocessorCount, dev) != hipSuccess) { grid = -1; return; }
        if (hipFuncSetAttribute((const void*)hybrid_fwd, hipFuncAttributeMaxDynamicSharedMemorySize, LDS_BYTES) != hipSuccess) { fprintf(stderr, "kernel_launch: hipFuncSetAttribute failed\n"); grid = -1; return; }
        if (hipOccupancyMaxActiveBlocksPerMultiprocessor(&per_cu, (const void*)hybrid_fwd, NWAVES * 64, LDS_BYTES) != hipSuccess || per_cu < 1) { fprintf(stderr, "kernel_launch: occupancy query says %d\n", per_cu); per_cu = 1; }
        (void)hipGetLastError();
        grid = cus;
    }
    if (grid < 0) return;
    if (hipMemsetAsync(d_ws, 0, 16384, stream) != hipSuccess) { fprintf(stderr, "kernel_launch: hipMemsetAsync of the barrier words failed\n"); return; }
    Args a{};
    for (int i = 0; i < 16; ++i) a.in[i] = (const float*)d_in[i];
    a.out = (float*)d_out; a.ws = (unsigned char*)d_ws;
#if MK_MULTI
    for (int ph = 0; ph < NPHASE; ++ph) { a.ph_lo = ph; a.ph_hi = ph + 1; hipLaunchKernelGGL(hybrid_fwd, dim3(grid), dim3(NWAVES * 64), LDS_BYTES, stream, a); }
#else
    a.ph_lo = 0; a.ph_hi = NPHASE;
    void* kargs[] = {&a};
    const hipError_t e = hipLaunchCooperativeKernel((const void*)hybrid_fwd, dim3(grid), dim3(NWAVES * 64), kargs, LDS_BYTES, stream);
    if (e != hipSuccess) fprintf(stderr, "kernel_launch: cooperative launch failed: %s (grid %d)\n", hipGetErrorString(e), grid);
#endif
}
```

```cpp
#include <hip/hip_runtime.h>
#include <hip/hip_cooperative_groups.h>
#include <cstdio>
#include <cstdint>
#include <cmath>
namespace cg = cooperative_groups;
#ifndef MK_MULTI
#define MK_MULTI 0
#endif
namespace pg8 {
#define PG8_LAS __attribute__((address_space(3)))
typedef unsigned short bf16_t;
typedef short bf16x8 __attribute__((ext_vector_type(8)));
typedef float f32x4 __attribute__((ext_vector_type(4)));
typedef unsigned u32x4 __attribute__((ext_vector_type(4)));
typedef unsigned u32x2 __attribute__((ext_vector_type(2)));
constexpr int BM = 256, BK = 64, HALF = 128, HTB = HALF * BK * 2  , STAGE_BYTES = 8 * HTB, NXCD = 8, WGM = 8;

__host__ __device__ __forceinline__ int lds_byte(int r, int c) { const int st = (r >> 4) * 2 + (c >> 5), rr = r & 15, cc = c & 31, ob = rr * 64 + cc * 2; return st * 1024 + (ob ^ (((ob >> 9) & 1) << 5)); }
__host__ __device__ __forceinline__ void stage_rc(int b, int& R, int& C) { const int st = b / 1024, sb = b % 1024, swz = sb ^ (((sb >> 9) & 1) << 5); R = (st >> 1) * 16 + swz / 64; C = (st & 1) * 32 + (swz % 64) / 2; }
__host__ __device__ __forceinline__ int perm32(int rho) { const int n = rho >> 4, i = rho & 15; return 8 * (i >> 2) + 4 * n + (i & 3); }

__device__ __forceinline__ int lane_asm() { int l; asm volatile("v_mbcnt_lo_u32_b32 %0, -1, 0\n\tv_mbcnt_hi_u32_b32 %0, -1, %0" : "=v"(l)); return l; }
__device__ __forceinline__ int opaque_tid() { int t = threadIdx.x; asm volatile("" : "+v"(t)); return t; }
struct Unit { int pm, pn; };
struct Gemm { const bf16_t* A; const bf16_t* Bt; int M, N, K, lda; };

struct StaticOrder {
    int nM, nN, nwg, G, c;
    __host__ __device__ void init(int M, int N, int G_, int c_) { nM = M / BM; nN = N / BM; nwg = nM * nN; G = G_; c = c_; }
    __host__ __device__ bool next(int i, Unit& u) const {
        const long L = (long)i * G + c; if (L >= nwg) return false;
        int wgid = (int)L; { const int q = nwg / NXCD, r = nwg % NXCD, xcd = wgid % NXCD, off = wgid / NXCD; wgid = (xcd < r ? xcd * (q + 1) : r * (q + 1) + (xcd - r) * q) + off; }
        const int nig = WGM * nN, gid = wgid / nig, fm = gid * WGM, gsz = (nM - fm) < WGM ? (nM - fm) : WGM;
        u.pm = fm + ((wgid % nig) % gsz); u.pn = (wgid % nig) / gsz; return true;
    }
    __device__ __forceinline__ void a_ready(const Unit&) const {}
    __device__ __forceinline__ void done(const Unit&) const {}
};

__device__ __forceinline__ unsigned cvt_pk_bf16(float lo, float hi) { unsigned r; asm volatile("v_cvt_pk_bf16_f32 %0, %1, %2" : "=v"(r) : "v"(lo), "v"(hi)); return r; }
__device__ __forceinline__ float fq_sum(float v) {
    auto a = __builtin_amdgcn_permlane16_swap(__float_as_uint(v), __float_as_uint(v), false, false); v = __uint_as_float(a[0]) + __uint_as_float(a[1]);
    auto b = __builtin_amdgcn_permlane32_swap(__float_as_uint(v), __float_as_uint(v), false, false); return __uint_as_float(b[0]) + __uint_as_float(b[1]);
}
struct EpiAny {
    static constexpr bool AFTER_DRAIN = false;
    int mode, perm; bf16_t* O; int ldc; bf16_t* xr; float* out; float* ssx; const float* rs_src; int rs_cnt; float rs_div; float* ssq; float* sskv;
    __device__ __forceinline__ void operator()(const f32x4 (&acc)[2][2][4][2], const Unit& u, int wr, int wc, int fr, int fq) const {
        if (mode < 2) {
            const int row0 = u.pm * BM + wr * 64 + fr; const int col0 = u.pn * BM + wc * 32 + 8 * fq; const bool sq = mode == 1;
            const int sstile = ssq ? (u.pn == 7 ? 1 : (u.pn == 8 ? 2 : 0)) : 0;
            float rsv[2][4];
            if (rs_src) {
                f32x4 pq[2][4]; const bool split = rs_cnt == 16;
#pragma unroll
                for (int ai = 0; ai < 2; ++ai)
#pragma unroll
                    for (int m = 0; m < 4; ++m) pq[ai][m] = *(const f32x4*)(rs_src + (size_t)(row0 + ai * HALF + m * 16) * rs_cnt + (split ? 4 * fq : 0));
#pragma unroll
                for (int ai = 0; ai < 2; ++ai)
#pragma unroll
                    for (int m = 0; m < 4; ++m) { const f32x4 a = pq[ai][m]; float t = (a[0] + a[1]) + (a[2] + a[3]); if (split) t = fq_sum(t); rsv[ai][m] = 1.0f / sqrtf(t * rs_div + 1e-6f); }
            } else {
#pragma unroll
                for (int ai = 0; ai < 2; ++ai)
#pragma unroll
                    for (int m = 0; m < 4; ++m) rsv[ai][m] = 1.f;
            }
#pragma unroll
            for (int ai = 0; ai < 2; ++ai)
#pragma unroll
                for (int m = 0; m < 4; ++m) { const int row = row0 + ai * HALF + m * 16; bf16_t* rowp = O + (size_t)row * ldc + col0;
                    const float rs = rsv[ai][m]; float part = 0.f;
#pragma unroll
                    for (int bj = 0; bj < 2; ++bj) { f32x4 v0 = acc[ai][bj][m][0] * rs, v1 = acc[ai][bj][m][1] * rs;
                        if (sq) {
#pragma unroll
                            for (int e = 0; e < 4; ++e) { const float a = fmaxf(v0[e], 0.f), b = fmaxf(v1[e], 0.f); v0[e] = a * a; v1[e] = b * b; } }
                        if (sstile == 1 || (sstile == 2 && bj == 0)) part += ((v0[0] * v0[0] + v0[1] * v0[1]) + (v0[2] * v0[2] + v0[3] * v0[3])) + ((v1[0] * v1[0] + v1[1] * v1[1]) + (v1[2] * v1[2] + v1[3] * v1[3]));
                        u32x4 w; w.x = cvt_pk_bf16(v0[0], v0[1]); w.y = cvt_pk_bf16(v0[2], v0[3]); w.z = cvt_pk_bf16(v1[0], v1[1]); w.w = cvt_pk_bf16(v1[2], v1[3]);
                        *(u32x4*)(rowp + bj * HALF) = w; }
                    if (sstile) { part = fq_sum(part); if (fq == 0) (sstile == 1 ? ssq : sskv)[(size_t)row * 4 + wc] = part; }
                }
        } else {
            const int col0 = u.pn * BM + wc * 32 + 8 * fq; const bool toout = mode == 3;
#pragma unroll
            for (int ai = 0; ai < 2; ++ai) {
                u32x4 xw[4][2];
#pragma unroll
                for (int m = 0; m < 4; ++m) { const bf16_t* xp = xr + (size_t)(u.pm * BM + ai * HALF + wr * 64 + m * 16 + fr) * 1024 + col0;
#pragma unroll
                    for (int bj = 0; bj < 2; ++bj) xw[m][bj] = *(const u32x4*)(xp + bj * HALF); }
#pragma unroll
                for (int m = 0; m < 4; ++m) { const int r = u.pm * BM + ai * HALF + wr * 64 + m * 16 + fr; bf16_t* xp = xr + (size_t)r * 1024 + col0; float* op = out + (size_t)r * 1024 + col0; float part = 0.f;
#pragma unroll
                    for (int bj = 0; bj < 2; ++bj) { const u32x4 w0 = xw[m][bj]; f32x4 v0 = acc[ai][bj][m][0], v1 = acc[ai][bj][m][1];
                        v0[0] += __uint_as_float(w0.x << 16); v0[1] += __uint_as_float(w0.x & 0xffff0000u); v0[2] += __uint_as_float(w0.y << 16); v0[3] += __uint_as_float(w0.y & 0xffff0000u);
                        v1[0] += __uint_as_float(w0.z << 16); v1[1] += __uint_as_float(w0.z & 0xffff0000u); v1[2] += __uint_as_float(w0.w << 16); v1[3] += __uint_as_float(w0.w & 0xffff0000u);
                        if (toout) { *(f32x4*)(op + bj * HALF) = v0; *(f32x4*)(op + bj * HALF + 4) = v1; }
                        else { part += ((v0[0] * v0[0] + v0[1] * v0[1]) + (v0[2] * v0[2] + v0[3] * v0[3])) + ((v1[0] * v1[0] + v1[1] * v1[1]) + (v1[2] * v1[2] + v1[3] * v1[3]));
                               u32x4 w; w.x = cvt_pk_bf16(v0[0], v0[1]); w.y = cvt_pk_bf16(v0[2], v0[3]); w.z = cvt_pk_bf16(v1[0], v1[1]); w.w = cvt_pk_bf16(v1[2], v1[3]); *(u32x4*)(xp + bj * HALF) = w; } }
                    if (!toout) { part = fq_sum(part); if (fq == 0) ssx[(size_t)r * 16 + u.pn * 4 + wc] = part; }
                }
                asm volatile("" ::: "memory");
            }
        }
    }
};

template <class Epi, class Sched, bool ALIGN_EPI = false, bool SP2 = false>
__device__ __forceinline__ void gemm_phase(PG8_LAS unsigned char* lds, const Gemm g, const Sched& S, const Epi& E, const int tid_in) {
    int tid_o = tid_in + lane_asm();
    const int tid = tid_o, wid = __builtin_amdgcn_readfirstlane(tid >> 6), lane = tid & 63, wr = wid >> 2, wc = wid & 3, fr = lane & 15, fq = lane >> 4;
    const int K = g.K, nt = K / BK;
    unsigned voffA[2], voffB[2];
#pragma unroll
    for (int i = 0; i < 2; ++i) { int R, C; stage_rc(tid * 16 + i * 8192, R, C); const int Rb = E.perm ? ((R & ~31) + perm32(R & 31)) : R;
        voffA[i] = (unsigned)(R * g.lda + C) * 2u; voffB[i] = (unsigned)(Rb * K + C) * 2u; }
    const size_t kstep = (size_t)(BK * 2);
    const size_t hstepA = (size_t)HALF * g.lda * 2, hstepB = (size_t)HALF * K * 2;
    const size_t tstepA = 2 * hstepA, tstepB = 2 * hstepB;
    const unsigned ldsw = (unsigned)wid * 1024u;
    const int aoff = lds_byte(wr * 64 + fr, fq * 8), boff = lds_byte(wc * 32 + fr, fq * 8);
#define PG8_SA(b, h) (((b) * 2 + (h)) * HTB)
#define PG8_SB(b, h) ((4 + (b) * 2 + (h)) * HTB)
#define PG8_STAGE(bufoff, gbase, voff) do { _Pragma("unroll") for (int _i = 0; _i < 2; ++_i) \
        __builtin_amdgcn_global_load_lds((const unsigned*)((const char*)(gbase) + (voff)[_i]), (PG8_LAS unsigned*)(lds + (bufoff) + ldsw + _i * 8192), 16, 0, 0); } while (0)
#define PG8_LDA(dst, b, h) do { _Pragma("unroll") for (int m = 0; m < 4; ++m) _Pragma("unroll") for (int k = 0; k < 2; ++k) dst[m][k] = *(const PG8_LAS bf16x8*)(lds + PG8_SA(b, h) + aoff + m * 2048 + k * 1024); } while (0)
#define PG8_LDB(dst, b, h) do { _Pragma("unroll") for (int n = 0; n < 2; ++n) _Pragma("unroll") for (int k = 0; k < 2; ++k) dst[n][k] = *(const PG8_LAS bf16x8*)(lds + PG8_SB(b, h) + boff + n * 2048 + k * 1024); } while (0)
#define PG8_MMA(ai, bj, At, Bt) do { __builtin_amdgcn_s_setprio(1); _Pragma("unroll") for (int m = 0; m < 4; ++m) _Pragma("unroll") for (int n = 0; n < 2; ++n) _Pragma("unroll") for (int k = 0; k < 2; ++k) \
        acc[ai][bj][m][n] = __builtin_amdgcn_mfma_f32_16x16x32_bf16(Bt[n][k], At[m][k], acc[ai][bj][m][n], 0, 0, 0); __builtin_amdgcn_s_setprio(0); } while (0)
#define PG8_WAIT_V(n) asm volatile("s_waitcnt vmcnt(" #n ")" ::: "memory")
#define PG8_WAIT_L(n) asm volatile("s_waitcnt lgkmcnt(" #n ")" ::: "memory")
#define PG8_BAR __builtin_amdgcn_s_barrier()
#define PG8_SCHED __builtin_amdgcn_sched_barrier(0)
    Unit cur, nxt; int ui = 0;
    if (!S.next(0, cur)) return;
    f32x4 acc[2][2][4][2];
#pragma unroll
    for (int a = 0; a < 2; ++a)
#pragma unroll
        for (int b = 0; b < 2; ++b)
#pragma unroll
            for (int m = 0; m < 4; ++m)
#pragma unroll
                for (int n = 0; n < 2; ++n) acc[a][b][m][n] = (f32x4){0.f, 0.f, 0.f, 0.f};
    bf16x8 At[4][2], B0[2][2], B1[2][2];
    const char* cA = (const char*)g.A + (size_t)cur.pm * tstepA; const char* cB = (const char*)g.Bt + (size_t)cur.pn * tstepB;
    S.a_ready(cur);
    if constexpr (SP2) {
        PG8_STAGE(PG8_SB(0, 0), cB, voffB); PG8_STAGE(PG8_SB(0, 1), cB + hstepB, voffB); PG8_STAGE(PG8_SA(0, 0), cA, voffA); PG8_STAGE(PG8_SA(0, 1), cA + hstepA, voffA);
        if (wr == 1) PG8_BAR;
        PG8_WAIT_V(2); PG8_BAR;
        PG8_STAGE(PG8_SB(1, 0), cB + kstep, voffB); PG8_STAGE(PG8_SA(1, 0), cA + kstep, voffA); PG8_STAGE(PG8_SB(1, 1), cB + hstepB + kstep, voffB);
        PG8_WAIT_V(6); PG8_BAR;
    } else {
        PG8_STAGE(PG8_SB(0, 0), cB, voffB); PG8_STAGE(PG8_SA(0, 0), cA, voffA); PG8_STAGE(PG8_SB(0, 1), cB + hstepB, voffB); PG8_STAGE(PG8_SA(0, 1), cA + hstepA, voffA);
        if (wr == 1) PG8_BAR;
        PG8_WAIT_V(4); PG8_BAR;
        PG8_STAGE(PG8_SB(1, 0), cB + kstep, voffB); PG8_STAGE(PG8_SA(1, 0), cA + kstep, voffA); PG8_STAGE(PG8_SB(1, 1), cB + hstepB + kstep, voffB);
        PG8_WAIT_V(6); PG8_BAR;
    }
    for (;;) {
        const bool has_next = S.next(ui + 1, nxt);
        const char* nA = has_next ? (const char*)g.A + (size_t)nxt.pm * tstepA : cA; const char* nB = has_next ? (const char*)g.Bt + (size_t)nxt.pn * tstepB : cB;
        for (int t = 0; t < nt; t += 2) {
            const bool last = (t == nt - 2);
            const char* a1 = cA + (size_t)(t + 1) * kstep;
            const char* a2 = last ? nA : cA + (size_t)(t + 2) * kstep; const char* b2 = last ? nB : cB + (size_t)(t + 2) * kstep;
            const char* a3 = a2 + kstep; const char* b3 = b2 + kstep;
            if (last && has_next) S.a_ready(nxt);
            if constexpr (SP2) {
            PG8_LDB(B0, 0, 0); PG8_LDB(B1, 0, 1); PG8_SCHED; PG8_LDA(At, 0, 0); PG8_STAGE(PG8_SA(1, 1), a1 + hstepA, voffA);
            PG8_WAIT_V(8); PG8_WAIT_L(0); PG8_BAR; PG8_MMA(0, 0, At, B0); PG8_MMA(0, 1, At, B1); PG8_BAR; PG8_SCHED;
            PG8_LDA(At, 0, 1); PG8_STAGE(PG8_SB(0, 0), b2, voffB); PG8_STAGE(PG8_SB(0, 1), b2 + hstepB, voffB); PG8_STAGE(PG8_SA(0, 0), a2, voffA);
            PG8_WAIT_V(8); PG8_WAIT_L(0); PG8_BAR; PG8_MMA(1, 0, At, B0); PG8_MMA(1, 1, At, B1); PG8_BAR; PG8_SCHED;
            PG8_LDB(B0, 1, 0); PG8_LDB(B1, 1, 1); PG8_SCHED; PG8_LDA(At, 1, 0); PG8_STAGE(PG8_SA(0, 1), a2 + hstepA, voffA);
            PG8_WAIT_V(8); PG8_WAIT_L(0); PG8_BAR; PG8_MMA(0, 0, At, B0); PG8_MMA(0, 1, At, B1); PG8_BAR; PG8_SCHED;
            PG8_LDA(At, 1, 1); PG8_STAGE(PG8_SB(1, 0), b3, voffB); PG8_STAGE(PG8_SB(1, 1), b3 + hstepB, voffB); PG8_STAGE(PG8_SA(1, 0), a3, voffA);
            PG8_WAIT_V(8); PG8_WAIT_L(0); PG8_BAR; PG8_MMA(1, 0, At, B0); PG8_MMA(1, 1, At, B1); PG8_BAR; PG8_SCHED;
            } else {
            PG8_LDB(B0, 0, 0); PG8_SCHED; PG8_LDA(At, 0, 0); PG8_STAGE(PG8_SA(1, 1), a1 + hstepA, voffA);
            PG8_WAIT_L(8); PG8_BAR; PG8_WAIT_L(0); PG8_MMA(0, 0, At, B0); PG8_BAR; PG8_SCHED;
            PG8_LDB(B1, 0, 1); PG8_STAGE(PG8_SB(0, 0), b2, voffB);
            PG8_BAR; PG8_WAIT_L(0); PG8_MMA(0, 1, At, B1); PG8_BAR;
            PG8_LDA(At, 0, 1); PG8_STAGE(PG8_SA(0, 0), a2, voffA);
            PG8_BAR; PG8_WAIT_L(0); PG8_MMA(1, 0, At, B0); PG8_BAR; PG8_SCHED;
            PG8_STAGE(PG8_SB(0, 1), b2 + hstepB, voffB);
            PG8_WAIT_V(6); PG8_BAR; PG8_MMA(1, 1, At, B1); PG8_BAR;
            PG8_LDB(B0, 1, 0); PG8_SCHED; PG8_LDA(At, 1, 0); PG8_STAGE(PG8_SA(0, 1), a2 + hstepA, voffA);
            PG8_WAIT_L(8); PG8_BAR; PG8_WAIT_L(0); PG8_MMA(0, 0, At, B0); PG8_BAR; PG8_SCHED;
            PG8_LDB(B1, 1, 1); PG8_STAGE(PG8_SB(1, 0), b3, voffB);
            PG8_BAR; PG8_WAIT_L(0); PG8_MMA(0, 1, At, B1); PG8_BAR;
            PG8_LDA(At, 1, 1); PG8_STAGE(PG8_SA(1, 0), a3, voffA);
            PG8_BAR; PG8_WAIT_L(0); PG8_MMA(1, 0, At, B0); PG8_BAR; PG8_SCHED;
            PG8_STAGE(PG8_SB(1, 1), b3 + hstepB, voffB);
            PG8_WAIT_V(6); PG8_BAR; PG8_MMA(1, 1, At, B1); PG8_BAR;
            }
        }
        if constexpr (ALIGN_EPI) { if (wr == 0) PG8_BAR; }
        if constexpr (!Epi::AFTER_DRAIN) { E(acc, cur, wr, wc, fr, fq); S.done(cur); }
        if (!has_next) break;
#pragma unroll
        for (int a = 0; a < 2; ++a)
#pragma unroll
            for (int b = 0; b < 2; ++b)
#pragma unroll
                for (int m = 0; m < 4; ++m)
#pragma unroll
                    for (int n = 0; n < 2; ++n) acc[a][b][m][n] = (f32x4){0.f, 0.f, 0.f, 0.f};
        cur = nxt; cA = nA; cB = nB; ++ui;
        if constexpr (ALIGN_EPI) { if (wr == 1) PG8_BAR; }
    }
    PG8_WAIT_V(0);
    if constexpr (!ALIGN_EPI) { if (wr == 0) PG8_BAR; }
    PG8_BAR;
    if constexpr (Epi::AFTER_DRAIN) { E.fused(acc, cur, wr, wc, fr, fq, lds, wid, lane); S.done(cur); }
#undef PG8_SA
#undef PG8_SB
#undef PG8_STAGE
#undef PG8_LDA
#undef PG8_LDB
#undef PG8_MMA
#undef PG8_WAIT_V
#undef PG8_WAIT_L
#undef PG8_BAR
#undef PG8_SCHED
}
}

#define GAS __attribute__((address_space(1)))
#define LAS __attribute__((address_space(3)))
typedef unsigned short bf16;
typedef unsigned u32x4 __attribute__((ext_vector_type(4)));
typedef unsigned u32x2 __attribute__((ext_vector_type(2)));
typedef float f32x4 __attribute__((ext_vector_type(4)));
typedef float f32x2 __attribute__((ext_vector_type(2)));
typedef short bf16x8 __attribute__((ext_vector_type(8)));
typedef float f32x16 __attribute__((ext_vector_type(16)));
constexpr int DM = 1024, BATCH = 32, SEQ = 2048, NMETA = 16, TT = SEQ + NMETA, DIN = 2208, DINP = 2304, DFF = 4096, DEPTH = 2;
constexpr int MREAL = BATCH * SEQ, MR0 = MREAL, MV = MREAL + NMETA, M = MREAL + 256;
static_assert(MREAL % 256 == 0, "row tiles");
__device__ __forceinline__ int rowof(int b, int t) { return t < NMETA ? MR0 + t : b * SEQ + (t - NMETA); }
constexpr int C_CB = 0, C_CC = 256, C_CH = 512, C_RQ = 768, C_RK = 1024, C_RV = 1280, C_RG = 1536, C_CQ = 1792, C_CKV = 2048, C_KR = 2176;
constexpr float EPS = 1e-6f;
constexpr float QSCALE = 0.10206207261596575f * 1.4426950408889634f;
constexpr size_t MiB = 1u << 20;
constexpr size_t WS_RT = 1 * MiB, WS_MT = 1 * MiB + 768 * 1024;
constexpr size_t WS_WIN = 4 * MiB, WS_WUQ = 13 * MiB, WS_WUKV = 14 * MiB, WS_WOUT = 15 * MiB, WS_W1 = 19 * MiB, WS_W2 = 35 * MiB;
constexpr size_t WS_KM = 184 * MiB;
constexpr size_t WS_X = 52 * MiB, WS_XN = 310 * MiB, WS_PROJ = 440 * MiB, WS_QRAW = 731 * MiB, WS_KV = 828 * MiB, WS_H = 440 * MiB, WS_SSX = 958 * MiB, WS_SSQ = 964 * MiB, WS_SSKV = 966 * MiB, WS_SQA = 968 * MiB, WS_END = 969 * MiB;
static_assert(WS_X + (size_t)M * DM * 4 <= WS_XN && WS_XN + (size_t)M * DM * 2 <= WS_PROJ && WS_PROJ + (size_t)M * DINP * 2 <= WS_QRAW && WS_QRAW + (size_t)M * 768 * 2 <= WS_KV &&
              WS_KV + (size_t)M * 1024 * 2 <= WS_SSX && WS_H + (size_t)M * DFF * 2 <= WS_SSX && WS_SSX + (size_t)M * 64 <= WS_SSQ && WS_SSQ + (size_t)M * 16 <= WS_SSKV && WS_SSKV + (size_t)M * 16 <= WS_SQA && WS_SQA + (size_t)M * 4 <= WS_END, "d_ws map");
constexpr int NWAVES = 8, LDS_BYTES = 147456, XB_LDS_OFF = 131072 + 256;

__device__ __forceinline__ unsigned f2bf(float f) { unsigned u = __builtin_bit_cast(unsigned, f); return (u + 0x7fffu + ((u >> 16) & 1u)) >> 16; }
__device__ __forceinline__ unsigned pk2(float lo, float hi) { return f2bf(lo) | (f2bf(hi) << 16); }
__device__ __forceinline__ float bflo(unsigned w) { return __uint_as_float(w << 16); }
__device__ __forceinline__ float bfhi(unsigned w) { return __uint_as_float(w & 0xffff0000u); }
__device__ __forceinline__ float bf1(bf16 h) { return __uint_as_float((unsigned)h << 16); }
__device__ __forceinline__ float dpp_add(float v, int ctrl_b1, int ctrl_4e, int ctrl_hm, int ctrl_m) { return v; }
__device__ __forceinline__ float wave_sum(float v) {
    v += __int_as_float(__builtin_amdgcn_update_dpp(0, __float_as_int(v), 0xB1, 0xF, 0xF, false));
    v += __int_as_float(__builtin_amdgcn_update_dpp(0, __float_as_int(v), 0x4E, 0xF, 0xF, false));
    v += __int_as_float(__builtin_amdgcn_update_dpp(0, __float_as_int(v), 0x141, 0xF, 0xF, false));
    v += __int_as_float(__builtin_amdgcn_update_dpp(0, __float_as_int(v), 0x140, 0xF, 0xF, false));
    return pg8::fq_sum(v);
}

namespace att {
typedef float f32x2_t __attribute__((ext_vector_type(2))); typedef __bf16 bf16x2_t __attribute__((ext_vector_type(2)));
__device__ __forceinline__ unsigned cvtpk(float lo, float hi) { f32x2_t v = {lo, hi}; bf16x2_t b = __builtin_convertvector(v, bf16x2_t); return __builtin_bit_cast(unsigned, b); }
constexpr int VP = 144;
__device__ __forceinline__ float xhalf_max(float v) { auto rr = __builtin_amdgcn_permlane32_swap(__float_as_uint(v), __float_as_uint(v), false, false); return fmaxf(__uint_as_float(rr[0]), __uint_as_float(rr[1])); }
__device__ __forceinline__ float xhalf_sum(float v) { auto rr = __builtin_amdgcn_permlane32_swap(__float_as_uint(v), __float_as_uint(v), false, false); return __uint_as_float(rr[0]) + __uint_as_float(rr[1]); }
template <int DQK, bool SM>
__device__ __forceinline__ void unit(LAS unsigned char* lds, const bf16* Q, int ldq, const bf16* K, int ldk, const bf16* V, int ldv, bf16* O, int ldo,
                                     const bf16* G, int ldg, const float* gain, float lg2, int b, int q0, int qend, const int tid_in, const float* sqa, const float* qgain, const f32x2* mtab, const int kdirect) {
    constexpr int KP = DQK * 2 + 16, CH = DQK / 8, ND = DQK / 16, KB = 64 * KP, VB = 64 * VP, SB = KB + VB;
    int tid_o = tid_in + pg8::lane_asm();
    const int tid = tid_o, lane = tid & 63, wid = __builtin_amdgcn_readfirstlane(tid >> 6), r32 = lane & 31, hi = lane >> 5;
    const int q0w = q0 + 32 * wid, tq = q0w + r32;
    const bool wact = q0w < qend;
    bf16x8 qr[ND];
    const int qrow = rowof(b, tq < TT ? tq : TT - 1);
    { const bf16* qp = Q + (size_t)qrow * ldq + 8 * hi;
#pragma unroll
      for (int d0 = 0; d0 < ND; ++d0) qr[d0] = *(const bf16x8*)(qp + 16 * d0); }
    const int ntiles = (qend - 1) / 64 + 1;
    const int nw = wact ? ((q0w + 31) / 64 + 1 < ntiles ? (q0w + 31) / 64 + 1 : ntiles) : 0;
    const int nfull = (q0w + 1) / 64;
    const int kkey0 = tid / CH, kch0 = tid % CH; constexpr bool has2 = 64 * CH > 512;
    const int kc1 = 512 + (tid >> 1), kkey1 = kc1 / CH, kch1 = kc1 % CH, khalf = tid & 1;
    const int vkey = tid & 63, vch = tid >> 6;
    const int pr32 = (r32 & 0x13) | ((r32 & 4) << 1) | ((r32 & 8) >> 1);
    const int koff = pr32 * KP + 16 * hi, voff = KB + r32 * VP + 16 * hi;
    u32x4 kreg0A, kreg0B, vregA, vregB; u32x2 kreg1A, kreg1B;
#define ATT_LOADK(j, S) do { int r0_ = 64 * (j) + kkey0; r0_ = r0_ < TT ? r0_ : TT - 1; kreg0##S = *(const u32x4*)(K + (size_t)(kdirect ? r0_ : rowof(b, r0_)) * ldk + 8 * kch0); \
        if (has2) { int r1_ = 64 * (j) + kkey1; r1_ = r1_ < TT ? r1_ : TT - 1; kreg1##S = *(const u32x2*)(K + (size_t)(kdirect ? r1_ : rowof(b, r1_)) * ldk + 8 * kch1 + 4 * khalf); } } while (0)
#define ATT_LOADV(j, S) do { int rv_ = 64 * (j) + vkey; rv_ = rv_ < TT ? rv_ : TT - 1; vreg##S = *(const u32x4*)(V + (size_t)rowof(b, rv_) * ldv + 8 * vch); } while (0)
#define ATT_STOREK(so, S) do { *(LAS u32x4*)(lds + (so) + kkey0 * KP + 16 * kch0) = kreg0##S; if (has2) *(LAS u32x2*)(lds + (so) + kkey1 * KP + 16 * kch1 + 8 * khalf) = kreg1##S; } while (0)
#define ATT_STOREV(so, S) do { LAS unsigned char* vd_ = lds + (so) + KB + (8 * vch) * VP + 2 * vkey; \
        _Pragma("unroll") for (int i_ = 0; i_ < 8; ++i_) { const unsigned w_ = vreg##S[i_ >> 1]; *(LAS unsigned short*)(vd_ + i_ * VP) = (unsigned short)((i_ & 1) ? (w_ >> 16) : (w_ & 0xffffu)); } } while (0)
#define ATT_KREAD(so) do { const LAS unsigned char* kb_ = lds + (so) + koff; \
        _Pragma("unroll") for (int d0 = 0; d0 < ND; ++d0) { kf0[d0] = *(const LAS bf16x8*)(kb_ + 32 * d0); kf1[d0] = *(const LAS bf16x8*)(kb_ + 32 * KP + 32 * d0); } } while (0)
#define ATT_VREAD(so) do { const LAS unsigned char* vb_ = lds + (so) + voff; \
        _Pragma("unroll") for (int ks = 0; ks < 4; ++ks) { vf0[ks] = *(const LAS bf16x8*)(vb_ + 32 * ks); vf1[ks] = *(const LAS bf16x8*)(vb_ + 32 * VP + 32 * ks); } } while (0)
#define ATT_QKM(S0, S1) do { \
        _Pragma("unroll") for (int r_ = 0; r_ < 16; ++r_) { S0[r_] = 0.f; S1[r_] = 0.f; } \
        _Pragma("unroll") for (int d0 = 0; d0 < ND; ++d0) { \
            S0 = __builtin_amdgcn_mfma_f32_32x32x16_bf16(kf0[d0], qr[d0], S0, 0, 0, 0); S1 = __builtin_amdgcn_mfma_f32_32x32x16_bf16(kf1[d0], qr[d0], S1, 0, 0, 0); } } while (0)
#define ATT_QKI(S0, S1, so) do { const LAS unsigned char* kb_ = lds + (so) + koff; \
        _Pragma("unroll") for (int r_ = 0; r_ < 16; ++r_) { S0[r_] = 0.f; S1[r_] = 0.f; } \
        _Pragma("unroll") for (int d0 = 0; d0 < ND; ++d0) { const bf16x8 k0_ = *(const LAS bf16x8*)(kb_ + 32 * d0), k1_ = *(const LAS bf16x8*)(kb_ + 32 * KP + 32 * d0); \
            S0 = __builtin_amdgcn_mfma_f32_32x32x16_bf16(k0_, qr[d0], S0, 0, 0, 0); S1 = __builtin_amdgcn_mfma_f32_32x32x16_bf16(k1_, qr[d0], S1, 0, 0, 0); } } while (0)
#define ATT_TILE(j, so, MASK, VPRE) do { const int kbase_ = 64 * (j) + 8 * hi; \
        if (SM) { \
            if (MASK) { _Pragma("unroll") for (int r = 0; r < 16; ++r) { const int kk = kbase_ + 16 * (r >> 3) + (r & 7); if (kk > tq) s0[r] = -INFINITY; if (kk + 32 > tq) s1[r] = -INFINITY; } } \
            float mx = fmaxf(s0[0], s1[0]); \
            _Pragma("unroll") for (int r = 1; r < 16; ++r) mx = fmaxf(mx, fmaxf(s0[r], s1[r])); \
            mx = xhalf_max(mx); \
              \
              \
            if (!__all(mx - m_run <= 8.0f)) { const float mn = fmaxf(m_run, mx), alpha = __builtin_amdgcn_exp2f(m_run - mn); m_run = mn; l_run *= alpha; \
                _Pragma("unroll") for (int r = 0; r < 16; ++r) { o0[r] *= alpha; o1[r] *= alpha; } } \
            float ps = 0.f; \
            _Pragma("unroll") for (int r = 0; r < 16; ++r) { s0[r] = __builtin_amdgcn_exp2f(s0[r] - m_run); s1[r] = __builtin_amdgcn_exp2f(s1[r] - m_run); ps += s0[r] + s1[r]; } \
            l_run += ps; \
        } else { \
            const float rf0 = __builtin_amdgcn_exp2f(lg2 * (float)(tq - kbase_)), rf1 = rf0 * c32; \
            _Pragma("unroll") for (int r = 0; r < 16; ++r) { s0[r] = (s0[r] * cfac[r]) * rf0; s1[r] = (s1[r] * cfac[r]) * rf1; } \
            if (MASK) { _Pragma("unroll") for (int r = 0; r < 16; ++r) { const int kk = kbase_ + 16 * (r >> 3) + (r & 7); if (kk > tq) s0[r] = 0.f; if (kk + 32 > tq) s1[r] = 0.f; } } \
        } \
        u32x4 pw[4]; \
        _Pragma("unroll") for (int ks = 0; ks < 2; ++ks) { \
            pw[ks] = (u32x4){cvtpk(s0[8 * ks], s0[8 * ks + 1]), cvtpk(s0[8 * ks + 2], s0[8 * ks + 3]), cvtpk(s0[8 * ks + 4], s0[8 * ks + 5]), cvtpk(s0[8 * ks + 6], s0[8 * ks + 7])}; \
            pw[2 + ks] = (u32x4){cvtpk(s1[8 * ks], s1[8 * ks + 1]), cvtpk(s1[8 * ks + 2], s1[8 * ks + 3]), cvtpk(s1[8 * ks + 4], s1[8 * ks + 5]), cvtpk(s1[8 * ks + 6], s1[8 * ks + 7])}; } \
        const LAS unsigned char* vb_ = lds + (so) + voff; \
        _Pragma("unroll") for (int ks = 0; ks < 4; ++ks) { const bf16x8 pf_ = __builtin_bit_cast(bf16x8, pw[ks]); \
            const bf16x8 v0_ = (VPRE) ? vf0[ks] : *(const LAS bf16x8*)(vb_ + 32 * ks), v1_ = (VPRE) ? vf1[ks] : *(const LAS bf16x8*)(vb_ + 32 * VP + 32 * ks); \
            o0 = __builtin_amdgcn_mfma_f32_32x32x16_bf16(v0_, pf_, o0, 0, 0, 0); o1 = __builtin_amdgcn_mfma_f32_32x32x16_bf16(v1_, pf_, o1, 0, 0, 0); } } while (0)
    f32x16 o0, o1, s0, s1, t0, t1; bf16x8 kf0[ND], kf1[ND], vf0[4], vf1[4];
#pragma unroll
    for (int r = 0; r < 16; ++r) { o0[r] = 0.f; o1[r] = 0.f; s0[r] = 0.f; s1[r] = 0.f; t0[r] = 0.f; t1[r] = 0.f; }
    float m_run = -INFINITY, l_run = 0.f;
    float cfac[16]; const float c32 = SM ? 0.f : __builtin_amdgcn_exp2f(-32.f * lg2);
#pragma unroll
    for (int r = 0; r < 16; ++r) cfac[r] = SM ? 0.f : __builtin_amdgcn_exp2f(-lg2 * (float)(16 * (r >> 3) + (r & 7)));
    int so_c = 0, so_n = SB, so_nn = 2 * SB;
    ATT_LOADK(0, A); ATT_LOADV(0, A);
    if (ntiles > 1) { ATT_LOADK(1, B); ATT_LOADV(1, B); }
    if (SM) {
        const int tpos = tq < TT ? tq : TT - 1;
        float ss = 0.f;
#pragma unroll
        for (int d0 = 0; d0 < ND; ++d0) { const u32x4 w = __builtin_bit_cast(u32x4, qr[d0]);
#pragma unroll
            for (int e = 0; e < 4; ++e) { const float a0 = bflo(w[e]), a1 = bfhi(w[e]); ss += a0 * a0 + a1 * a1; } }
        ss = xhalf_sum(ss);
        const float rs = QSCALE / sqrtf(ss * (1.f / 96.f) + EPS);
#pragma unroll
        for (int d0 = 0; d0 < 4; ++d0) { const u32x4 w = __builtin_bit_cast(u32x4, qr[d0]); const f32x4 g0 = *(const f32x4*)(qgain + 16 * d0 + 8 * hi), g1 = *(const f32x4*)(qgain + 16 * d0 + 8 * hi + 4); u32x4 o;
            o[0] = cvtpk(bflo(w[0]) * rs * g0[0], bfhi(w[0]) * rs * g0[1]); o[1] = cvtpk(bflo(w[1]) * rs * g0[2], bfhi(w[1]) * rs * g0[3]);
            o[2] = cvtpk(bflo(w[2]) * rs * g1[0], bfhi(w[2]) * rs * g1[1]); o[3] = cvtpk(bflo(w[3]) * rs * g1[2], bfhi(w[3]) * rs * g1[3]);
            qr[d0] = __builtin_bit_cast(bf16x8, o); }
        { const u32x4 w1 = __builtin_bit_cast(u32x4, qr[4]), w2 = __builtin_bit_cast(u32x4, qr[5]); const f32x4* cs = (const f32x4*)(mtab + tpos * 16 + 8 * hi);
          const float* ga = qgain + 64 + 8 * hi; const float* gb = qgain + 80 + 8 * hi; u32x4 o1, o2;
#pragma unroll
          for (int e = 0; e < 4; ++e) { const f32x4 c4 = cs[e];
              const float a0 = bflo(w1[e]) * rs * ga[2 * e], a1 = bfhi(w1[e]) * rs * ga[2 * e + 1], b0 = bflo(w2[e]) * rs * gb[2 * e], b1 = bfhi(w2[e]) * rs * gb[2 * e + 1];
              o1[e] = cvtpk(a0 * c4.x - b0 * c4.y, a1 * c4.z - b1 * c4.w); o2[e] = cvtpk(b0 * c4.x + a0 * c4.y, b1 * c4.z + a1 * c4.w); }
          qr[4] = __builtin_bit_cast(bf16x8, o1); qr[5] = __builtin_bit_cast(bf16x8, o2); }
    }
    ATT_STOREK(0, A); ATT_STOREV(0, A);
    if (ntiles > 1) { ATT_STOREK(SB, B); ATT_STOREV(SB, B); }
    if (ntiles > 2) { ATT_LOADK(2, B); ATT_LOADV(2, B); }
    __syncthreads();
    if (nw > 0) ATT_QKI(s0, s1, 0);
#define ATT_ITER(J, SL, SS) do { const int j = (J); \
        if (j + 3 < ntiles) { ATT_LOADK(j + 3, SL); ATT_LOADV(j + 3, SL); } \
        if (j + 1 < nw && j < nfull) { \
            if (SM) { \
                ATT_QKI(t0, t1, so_n); \
                ATT_TILE(j, so_c, false, false); \
            } else if (wid < 4) { \
                ATT_QKI(t0, t1, so_n); __builtin_amdgcn_sched_barrier(0); \
                ATT_TILE(j, so_c, false, false); \
            } else { \
                ATT_TILE(j, so_c, false, false); __builtin_amdgcn_sched_barrier(0); \
                ATT_QKI(t0, t1, so_n); \
            } \
_Pragma("unroll") \
            for (int r = 0; r < 16; ++r) { s0[r] = t0[r]; s1[r] = t1[r]; } \
        } else if (j < nw) { \
            if (SM) { if (j + 1 < nw) ATT_QKI(t0, t1, so_n); ATT_TILE(j, so_c, true, false); } \
            else { if (j + 1 < nw) ATT_QKI(t0, t1, so_n); ATT_TILE(j, so_c, true, false); } \
_Pragma("unroll") \
            for (int r = 0; r < 16; ++r) { s0[r] = t0[r]; s1[r] = t1[r]; } \
        } \
        if (j + 2 < ntiles) { ATT_STOREK(so_nn, SS); ATT_STOREV(so_nn, SS); } \
        __syncthreads(); \
        { const int t_ = so_c; so_c = so_n; so_n = so_nn; so_nn = t_; } } while (0)
    for (int jj = 0; jj < ntiles; jj += 2) { ATT_ITER(jj, A, B); if (jj + 1 < ntiles) ATT_ITER(jj + 1, B, A); }
#undef ATT_ITER
#undef ATT_LOADK
#undef ATT_LOADV
#undef ATT_STOREK
#undef ATT_STOREV
#undef ATT_KREAD
#undef ATT_VREAD
#undef ATT_QKM
#undef ATT_QKI
#undef ATT_TILE
    if (wact) {
        if (SM) {
            const float l = xhalf_sum(l_run), inv = 1.f / l;
            u32x2 pa[2][4];
#pragma unroll
            for (int g = 0; g < 4; ++g) { pa[0][g].x = cvtpk(o0[4 * g] * inv, o0[4 * g + 1] * inv); pa[0][g].y = cvtpk(o0[4 * g + 2] * inv, o0[4 * g + 3] * inv);
                                          pa[1][g].x = cvtpk(o1[4 * g] * inv, o1[4 * g + 1] * inv); pa[1][g].y = cvtpk(o1[4 * g + 2] * inv, o1[4 * g + 3] * inv); }
            bf16* op = O + (size_t)qrow * ldo + 8 * hi;
#pragma unroll
            for (int db = 0; db < 2; ++db)
#pragma unroll
                for (int p = 0; p < 2; ++p) { auto rx = __builtin_amdgcn_permlane32_swap(pa[db][2 * p].x, pa[db][2 * p + 1].x, false, false); auto ry = __builtin_amdgcn_permlane32_swap(pa[db][2 * p].y, pa[db][2 * p + 1].y, false, false);
                    const u32x4 w = {rx[0], ry[0], rx[1], ry[1]}; if (tq < qend) *(u32x4*)(op + 32 * db + 16 * p) = w; }
        } else {
            float ss = 0.f;
#pragma unroll
            for (int r = 0; r < 16; ++r) ss += o0[r] * o0[r] + o1[r] * o1[r];
            ss = xhalf_sum(ss);
            const float rs = 1.0f / sqrtf(ss * (1.f / 64.f) + EPS);
            u32x2 pa[2][4];
            { const bf16* gp = G + (size_t)qrow * ldg + 4 * hi; const float* gn = gain + 4 * hi;
#pragma unroll
              for (int g = 0; g < 4; ++g) {
#pragma unroll
                  for (int db = 0; db < 2; ++db) {
                      const u32x2 gw = *(const u32x2*)(gp + 32 * db + 8 * g); const f32x4 ga = *(const f32x4*)(gn + 32 * db + 8 * g);
                      float gv[4] = {bflo(gw.x), bfhi(gw.x), bflo(gw.y), bfhi(gw.y)}; float y[4];
#pragma unroll
                      for (int e = 0; e < 4; ++e) { const float ov = db ? o1[4 * g + e] : o0[4 * g + e]; const float sg = gv[e] / (1.f + __expf(-gv[e])); y[e] = ov * rs * ga[e] * sg; }
                      pa[db][g].x = cvtpk(y[0], y[1]); pa[db][g].y = cvtpk(y[2], y[3]); } } }
            bf16* op = O + (size_t)qrow * ldo + 8 * hi;
#pragma unroll
            for (int db = 0; db < 2; ++db)
#pragma unroll
                for (int p = 0; p < 2; ++p) { auto rx = __builtin_amdgcn_permlane32_swap(pa[db][2 * p].x, pa[db][2 * p + 1].x, false, false); auto ry = __builtin_amdgcn_permlane32_swap(pa[db][2 * p].y, pa[db][2 * p + 1].y, false, false);
                    const u32x4 w = {rx[0], ry[0], rx[1], ry[1]}; if (tq < qend) *(u32x4*)(op + 32 * db + 16 * p) = w; }
        }
    }
}
}

struct Args { const float* in[16]; float* out; unsigned char* ws; int ph_lo, ph_hi; };
typedef const __attribute__((address_space(4))) Args* KArgsP;
#define RT   ((f32x2*)(ws + WS_RT))
#define MT   ((f32x2*)(ws + WS_MT))
#define WIN  ((bf16*)(ws + WS_WIN))
#define WUQ  ((bf16*)(ws + WS_WUQ))
#define WUKV ((bf16*)(ws + WS_WUKV))
#define WOUT ((bf16*)(ws + WS_WOUT))
#define W1   ((bf16*)(ws + WS_W1))
#define W2   ((bf16*)(ws + WS_W2))
#define XR   ((bf16*)(ws + WS_X))
#define XN   ((bf16*)(ws + WS_XN))
#define MIX  ((bf16*)(ws + WS_XN))
#define PROJ ((bf16*)(ws + WS_PROJ))
#define QRAW ((bf16*)(ws + WS_QRAW))
#define KVR  ((bf16*)(ws + WS_KV))
#define HB   ((bf16*)(ws + WS_H))
#define SSX  ((float*)(ws + WS_SSX))
#define SSQ  ((float*)(ws + WS_SSQ))
#define SSKV ((float*)(ws + WS_SSKV))
#define SQA  ((float*)(ws + WS_SQA))
#define KM   ((bf16*)(ws + WS_KM))
enum { I_X = 0, I_META, I_ANG, I_WIN, I_CONVW, I_RETG, I_QNG, I_WUQ, I_KVNG, I_WUKV, I_QHG, I_KHG, I_WOUT, I_MLPG, I_W1, I_W2 };
constexpr int NPP = 7, NPHASE = 1 + NPP * DEPTH;

__device__ __forceinline__ void p0_transpose_item(const float* W, const float* gk, int K, int N, bf16* WT, LAS float* scr, int item, int lane) {
    const int nblk = N / 32, kb = item / nblk, nb = item % nblk, k0 = 64 * kb, n0 = 32 * nb;
#pragma unroll
    for (int i = 0; i < 8; ++i) { const int kk = 8 * i + (lane >> 3), q = lane & 7; const float gv = gk ? gk[k0 + kk] : 1.f;
        const f32x4 v = *(const f32x4*)(W + (size_t)(k0 + kk) * N + n0 + 4 * q); LAS float* d = scr + kk * 33 + 4 * q; d[0] = v.x * gv; d[1] = v.y * gv; d[2] = v.z * gv; d[3] = v.w * gv; }
    asm volatile("s_waitcnt lgkmcnt(0)" ::: "memory");
    const int c = lane & 7;
#pragma unroll
    for (int j = 0; j < 4; ++j) { const int n = (lane >> 3) + 8 * j; const LAS float* s = scr + (8 * c) * 33 + n;
        u32x4 o; o.x = pk2(s[0 * 33], s[1 * 33]); o.y = pk2(s[2 * 33], s[3 * 33]); o.z = pk2(s[4 * 33], s[5 * 33]); o.w = pk2(s[6 * 33], s[7 * 33]);
        *(u32x4*)(WT + (size_t)(n0 + n) * K + k0 + 8 * c) = o; }
    asm volatile("s_waitcnt lgkmcnt(0)" ::: "memory");
}
__device__ __forceinline__ void row_prep(const float* xrow, bf16* orow, float* ss16, int lane) {
    const f32x4* xr = (const f32x4*)xrow + lane;
    f32x4 v[4]; float s = 0.f;
#pragma unroll
    for (int j = 0; j < 4; ++j) { v[j] = xr[64 * j]; s += (v[j].x * v[j].x + v[j].y * v[j].y) + (v[j].z * v[j].z + v[j].w * v[j].w); }
    const float tot = wave_sum(s);
    if (lane < 16) ss16[lane] = lane == 0 ? tot : 0.f;
    unsigned long long* o8 = (unsigned long long*)orow + lane;
#pragma unroll
    for (int j = 0; j < 4; ++j) o8[64 * j] = (unsigned long long)att::cvtpk(v[j].x, v[j].y) | ((unsigned long long)att::cvtpk(v[j].z, v[j].w) << 32);
}
__device__ __forceinline__ f32x2 cossin(float ang) {
    const float n = rintf(ang * 0.15915494309189535f);
    float r = fmaf(-n, 6.28125f, ang); r = fmaf(-n, 0.0019353071795864769f, r);
    const float rev = r * 0.15915494309189535f;
    f32x2 o; o.x = __builtin_amdgcn_cosf(rev); o.y = __builtin_amdgcn_sinf(rev); return o;
}

#define XB_TMO      128
#define XB_XCNT(j)  (256  + 64 * (j))
#define XB_XSUB(j)  (1280 + 64 * (j))
#define XB_XGEN(j)  (2304 + 64 * (j))
#define XB_TOP      3328
#define XB_TOPGEN   3392
#define XCD_BAR_WORDS 3456
#define XB_SPIN_CAP (1u << 18)

__device__ __forceinline__ unsigned xb_ld(unsigned* p)              { return __hip_atomic_load(p, __ATOMIC_RELAXED, __HIP_MEMORY_SCOPE_AGENT); }
__device__ __forceinline__ unsigned xb_add(unsigned* p, unsigned v) { return __hip_atomic_fetch_add(p, v, __ATOMIC_RELAXED, __HIP_MEMORY_SCOPE_AGENT); }
__device__ __forceinline__ unsigned xb_xcc_id() { return (unsigned)__builtin_amdgcn_s_getreg((3 << 11) | 20) & 0xFu; }
#define XB_SPIN(cond, bar) do { unsigned _sp = 0; while (cond) { __builtin_amdgcn_s_sleep(1); \
    if ((++_sp & 255u) == 0u) { if (xb_ld(&(bar)[XB_TMO])) break; if (_sp > XB_SPIN_CAP) { atomicAdd(&(bar)[XB_TMO], 1u); break; } } } } while (0)

struct XcdBarrier {
    unsigned* bar; unsigned x;
    volatile LAS unsigned* st;
};

__device__ __forceinline__ XcdBarrier xcd_barrier_post(unsigned* bar, volatile LAS unsigned* st) {
    XcdBarrier b; b.bar = bar; b.x = xb_xcc_id(); b.st = st;
    if (threadIdx.x == 0) (void)xb_add(&bar[XB_XCNT(b.x)], 1u);
    return b;
}
__device__ __forceinline__ void xcd_barrier_complete(unsigned* bar, unsigned x, unsigned& nloc, unsigned& nx) {
    const unsigned G = gridDim.x * gridDim.y * gridDim.z;
    unsigned sum, cnt, mine, sp = 0u;
    for (;;) {
        sum = 0u; cnt = 0u; mine = 0u;
#pragma unroll
        for (unsigned j = 0; j < 16; ++j) { const unsigned c = xb_ld(&bar[XB_XCNT(j)]); sum += c; cnt += (c > 0u) ? 1u : 0u; mine = (j == x) ? c : mine; }
        if (sum == G) break;
        __builtin_amdgcn_s_sleep(1);
        if ((++sp & 255u) == 0u) { if (xb_ld(&bar[XB_TMO])) break; if (sp > XB_SPIN_CAP) { atomicAdd(&bar[XB_TMO], 1u); break; } }
    }
    nloc = mine > 0u ? mine : 1u; nx = cnt > 0u ? cnt : 1u;
}

__device__ __forceinline__ void xcd_barrier(const XcdBarrier& b) {
    asm volatile("s_waitcnt vmcnt(0)" ::: "memory");
    __syncthreads();
    if (threadIdx.x == 0) {
        unsigned* bar = b.bar;
        __builtin_amdgcn_s_waitcnt(0);
        unsigned nloc = b.st[0], nx = b.st[1];
        if (nloc == 0u) { xcd_barrier_complete(bar, b.x, nloc, nx); b.st[0] = nloc; b.st[1] = nx; }
        const unsigned old = xb_add(&bar[XB_XSUB(b.x)], 1u);
        const unsigned gen = old / nloc;
        if (old + 1u == (gen + 1u) * nloc) {
            __builtin_amdgcn_fence(__ATOMIC_RELEASE, "agent");
            asm volatile("s_waitcnt vmcnt(0)" ::: "memory");
            const unsigned og = xb_add(&bar[XB_TOP], 1u);
            const unsigned tg = og / nx;
            if (og + 1u == (tg + 1u) * nx) xb_add(&bar[XB_TOPGEN], 1u);
            else XB_SPIN(xb_ld(&bar[XB_TOPGEN]) == tg, bar);
            __builtin_amdgcn_fence(__ATOMIC_ACQUIRE, "agent");
            xb_add(&bar[XB_XGEN(b.x)], 1u);
            asm volatile("s_waitcnt vmcnt(0)" ::: "memory");
        } else {
            XB_SPIN(xb_ld(&bar[XB_XGEN(b.x)]) == gen, bar);
            __builtin_amdgcn_fence(__ATOMIC_ACQUIRE, "agent");
            asm volatile("s_waitcnt vmcnt(0)" ::: "memory");
        }
    }
    __syncthreads();
}

struct EpiMeta { int mode, need_rs; float rs_div; bf16* O; int ldc; bf16* xr; };
__device__ __forceinline__ void meta_gemm(const bf16* A, int lda, const bf16* Bt, int N, int K, const EpiMeta& E, int gw, int NGW, int lane) {
    for (int n = gw; n < N; n += NGW) {
        float acc[16], ssa[16];
#pragma unroll
        for (int r = 0; r < 16; ++r) { acc[r] = 0.f; ssa[r] = 0.f; }
        for (int c = lane; c < K / 8; c += 64) {
            const u32x4 w = *(const u32x4*)(Bt + (size_t)n * K + 8 * c);
            u32x4 a[16];
#pragma unroll
            for (int r = 0; r < 16; ++r) a[r] = *(const u32x4*)(A + (size_t)r * lda + 8 * c);
#pragma unroll
            for (int r = 0; r < 16; ++r) {
#pragma unroll
                for (int e = 0; e < 4; ++e) asm volatile("v_dot2c_f32_bf16 %0, %1, %2" : "+v"(acc[r]) : "v"(a[r][e]), "v"(w[e]));
                if (E.need_rs) {
#pragma unroll
                    for (int e = 0; e < 4; ++e) asm volatile("v_dot2c_f32_bf16 %0, %1, %2" : "+v"(ssa[r]) : "v"(a[r][e]), "v"(a[r][e])); }
            }
        }
        asm volatile("s_nop 3" ::: "memory");
        float mine = 0.f, myss = 0.f;
#pragma unroll
        for (int r = 0; r < 16; ++r) { const float s = wave_sum(acc[r]), q = E.need_rs ? wave_sum(ssa[r]) : 0.f; if (lane == r) { mine = s; myss = q; } }
        if (lane < 16) { const int r = lane;
            if (E.mode < 2) { float v = mine * (E.need_rs ? 1.0f / sqrtf(myss * E.rs_div + EPS) : 1.f); if (E.mode == 1) { v = fmaxf(v, 0.f); v = v * v; } E.O[(size_t)(MR0 + r) * E.ldc + n] = (bf16)f2bf(v); }
            else { bf16* p = E.xr + (size_t)(MR0 + r) * DM + n; *p = (bf16)f2bf(bf1(*p) + mine); } }
    }
}

__global__ void __launch_bounds__(NWAVES * 64, 2) hybrid_fwd(Args args) {
#define LANE pg8::lane_asm()
#define TID (wave * 64 + pg8::lane_asm())
    extern __shared__ __attribute__((aligned(16))) unsigned char lds_raw[];
    LAS unsigned char* lds = (LAS unsigned char*)lds_raw;
    cg::grid_group grid = cg::this_grid();
    const int G = gridDim.x, NGW = G * NWAVES;
    const int wave_s = __builtin_amdgcn_readfirstlane((int)threadIdx.x >> 6);
    if (threadIdx.x < 2) ((LAS unsigned*)(lds + XB_LDS_OFF))[threadIdx.x] = 0u;
    __syncthreads();
    if (args.ph_hi - args.ph_lo > 1) (void)xcd_barrier_post((unsigned*)args.ws, (volatile LAS unsigned*)(lds + XB_LDS_OFF));
    const int lo = args.ph_lo, hi = args.ph_hi;
    for (int ph = lo; ph < hi; ++ph) {
        KArgsP ap = (KArgsP)__builtin_amdgcn_kernarg_segment_ptr(); asm volatile("" : "+s"(ap));
        unsigned char* const ws = ap->ws;
        int wave = wave_s; asm volatile("" : "+s"(wave));
        const int gw = blockIdx.x * NWAVES + wave;
        const int l = ph == 0 ? 0 : (ph - 1) / NPP, k = ph == 0 ? -1 : (ph - 1) % NPP;
        if (k == -1) {
            LAS float* scr = (LAS float*)(lds + wave * 16384);
            constexpr int I_IN = 16 * 69, I_UQ = 4 * 24, I_UKV = 2 * 32, I_O = 16 * 32, I_1 = 16 * 128, I_2 = 64 * 32, I_L = I_IN + I_UQ + I_UKV + I_O + I_1 + I_2;
            for (int it = gw; it < DEPTH * I_L; it += NGW) {
                const int ll = it / I_L; int r = it - ll * I_L;
                if (r < I_IN) { p0_transpose_item(ap->in[I_WIN] + (size_t)ll * DM * DIN, ap->in[I_ANG] + ll * DM, DM, DIN, WIN + (size_t)ll * DINP * DM, scr, r, LANE); continue; } r -= I_IN;
                if (r < I_UQ) { p0_transpose_item(ap->in[I_WUQ] + (size_t)ll * 256 * 768, ap->in[I_QNG] + ll * 256, 256, 768, WUQ + (size_t)ll * 768 * 256, scr, r, LANE); continue; } r -= I_UQ;
                if (r < I_UKV) { p0_transpose_item(ap->in[I_WUKV] + (size_t)ll * 128 * 1024, ap->in[I_KVNG] + ll * 128, 128, 1024, WUKV + (size_t)ll * 1024 * 128, scr, r, LANE); continue; } r -= I_UKV;
                if (r < I_O) { p0_transpose_item(ap->in[I_WOUT] + (size_t)ll * DM * DM, nullptr, DM, DM, WOUT + (size_t)ll * DM * DM, scr, r, LANE); continue; } r -= I_O;
                if (r < I_1) { p0_transpose_item(ap->in[I_W1] + (size_t)ll * DM * DFF, ap->in[I_MLPG] + ll * DM, DM, DFF, W1 + (size_t)ll * DFF * DM, scr, r, LANE); continue; } r -= I_1;
                p0_transpose_item(ap->in[I_W2] + (size_t)ll * DFF * DM, nullptr, DFF, DM, W2 + (size_t)ll * DM * DFF, scr, r, LANE);
            }
            for (int it = gw; it < DEPTH * (DINP - DIN); it += NGW) {
                const int ll = it / (DINP - DIN), r = DIN + it % (DINP - DIN); u32x4* p = (u32x4*)(WIN + ((size_t)ll * DINP + r) * DM) + LANE;
                u32x4 z = {0u, 0u, 0u, 0u}; asm volatile("" : "+v"(z));
                p[0] = z; p[64] = z;
            }
            for (int e = blockIdx.x * 512 + TID; e < TT * 32; e += G * 512) { const int t = e >> 5, i = e & 31; const float inv = exp2f(-13.287712379549449f * (float)(2 * i) * (1.f / 64.f)); RT[e] = cossin((float)t * inv); }
            for (int e = blockIdx.x * 512 + TID; e < TT * 16; e += G * 512) { const int t = e >> 4, i = e & 15; const float inv = exp2f(-13.287712379549449f * (float)(2 * i) * (1.f / 32.f)); MT[e] = cossin((float)t * inv); }
            for (int m = gw; m < MV; m += NGW) {
                const float* src = m >= MR0 ? ap->in[I_META] + (size_t)(m - MR0) * DM : ap->in[I_X] + (size_t)m * DM;
                row_prep(src, XR + (size_t)m * DM, SSX + (size_t)m * 16, LANE); }
        } else if (k == 0 || k == 1 || k == 4 || k == 5 || k == 6) {
            const int ng = k == 1 ? 2 : 1;
            for (int gi = 0; gi < ng; ++gi) {
                pg8::Gemm g; pg8::EpiAny E; E.xr = XR; E.out = ap->out; E.O = nullptr; E.ldc = 0; E.ssx = SSX; E.rs_src = nullptr; E.rs_cnt = 16; E.rs_div = 1.f / 1024.f; E.ssq = nullptr; E.sskv = nullptr;
                EpiMeta Em; Em.need_rs = 0; Em.rs_div = 1.f / 1024.f; Em.O = nullptr; Em.ldc = 0; Em.xr = XR;
                if (k == 0)      { g = pg8::Gemm{XR, WIN + (size_t)l * DINP * DM, MREAL, DINP, DM, DM}; E.mode = 0; E.perm = 1; E.O = PROJ; E.ldc = DINP; E.rs_src = SSX; E.ssq = SSQ; E.sskv = SSKV; Em.need_rs = 1; }
                else if (k == 1 && gi == 0) { g = pg8::Gemm{PROJ + C_CQ, WUQ + (size_t)l * 768 * 256, MREAL, 768, 256, DINP}; E.mode = 0; E.perm = 1; E.O = QRAW; E.ldc = 768; E.rs_src = SSQ; E.rs_cnt = 4; E.rs_div = 1.f / 256.f; Em.need_rs = 1; Em.rs_div = 1.f / 256.f; }
                else if (k == 1) { g = pg8::Gemm{PROJ + C_CKV, WUKV + (size_t)l * 1024 * 128, MREAL, 1024, 128, DINP}; E.mode = 0; E.perm = 1; E.O = KVR; E.ldc = 1024; E.rs_src = SSKV; E.rs_cnt = 4; E.rs_div = 1.f / 128.f; Em.need_rs = 1; Em.rs_div = 1.f / 128.f; }
                else if (k == 4) { g = pg8::Gemm{MIX, WOUT + (size_t)l * DM * DM, MREAL, DM, DM, DM}; E.mode = 2; E.perm = 1; }
                else if (k == 5) { g = pg8::Gemm{XR, W1 + (size_t)l * DFF * DM, MREAL, DFF, DM, DM}; E.mode = 1; E.perm = 1; E.O = HB; E.ldc = DFF; E.rs_src = SSX; Em.need_rs = 1; }
                else             { g = pg8::Gemm{HB, W2 + (size_t)l * DM * DFF, MREAL, DM, DFF, DFF}; E.mode = (l == DEPTH - 1) ? 3 : 2; E.perm = 1; }
                Em.mode = E.mode; Em.O = E.O; Em.ldc = E.ldc;
                pg8::StaticOrder S; S.init(MREAL, g.N, G, (int)blockIdx.x);
                pg8::gemm_phase<pg8::EpiAny, pg8::StaticOrder, true, true>(lds, g, S, E, wave * 64);
                if (E.mode != 3) meta_gemm(g.A + (size_t)MR0 * g.lda, g.lda, g.Bt, g.N, g.K, Em, gw, NGW, LANE);
            }
            if (k == 1) {
                const float* cw = ap->in[I_CONVW] + l * 3 * 256;
                for (int it = blockIdx.x * 512 + TID; it < MV * 32; it += G * 512) {
                    const int m = it >> 5, c = (it & 31) * 8; const int t = m >= MR0 ? m - MR0 : (m & (SEQ - 1)) + NMETA; const bf16* pr = PROJ + (size_t)m * DINP;
                    const u32x4 cbv = *(const u32x4*)(pr + C_CB + c); float a[8];
#pragma unroll
                    for (int e = 0; e < 8; ++e) a[e] = 0.f;
#pragma unroll
                    for (int j = 0; j < 3; ++j) { const int tj = t - 2 + j; if (tj >= 0) { const int mj = (m >= MR0 || tj >= NMETA) ? m - (2 - j) : MR0 + tj;
                            const bf16* p2 = PROJ + (size_t)mj * DINP; const u32x4 ccv = *(const u32x4*)(p2 + C_CC + c), chv = *(const u32x4*)(p2 + C_CH + c);
                            const f32x4 w0 = *(const f32x4*)(cw + j * 256 + c), w1 = *(const f32x4*)(cw + j * 256 + c + 4);
#pragma unroll
                            for (int e = 0; e < 4; ++e) { const float wl = e < 2 ? w0[2 * e] : w1[2 * e - 4], wh = e < 2 ? w0[2 * e + 1] : w1[2 * e - 3];
                                a[2 * e] += wl * (bflo(ccv[e]) * bflo(chv[e])); a[2 * e + 1] += wh * (bfhi(ccv[e]) * bfhi(chv[e])); } } }
                    u32x4 o;
#pragma unroll
                    for (int e = 0; e < 4; ++e) o[e] = att::cvtpk(bflo(cbv[e]) * a[2 * e], bfhi(cbv[e]) * a[2 * e + 1]);
                    *(u32x4*)(MIX + (size_t)m * DM + c) = o;
                }
                for (int it = blockIdx.x * 512 + TID; it < MV * 32; it += G * 512) {
                    const int m = it >> 5, j = it & 31, w = j >> 4, h = (j >> 2) & 3, i0 = (j & 3) * 8; const int t = m >= MR0 ? m - MR0 : (m & (SEQ - 1)) + NMETA;
                    bf16* p = PROJ + (size_t)m * DINP + (w ? C_RK : C_RQ) + 64 * h + i0; const float sc = w ? 0.125f : 1.f;
                    const u32x4 x1 = *(const u32x4*)p, x2 = *(const u32x4*)(p + 32); const f32x4* cs = (const f32x4*)(RT + t * 32 + i0);
                    u32x4 o1, o2;
#pragma unroll
                    for (int e = 0; e < 4; ++e) { const f32x4 c4 = cs[e]; const float a0 = bflo(x1[e]), a1 = bfhi(x1[e]), b0 = bflo(x2[e]), b1 = bfhi(x2[e]);
                        o1[e] = att::cvtpk((a0 * c4.x - b0 * c4.y) * sc, (a1 * c4.z - b1 * c4.w) * sc); o2[e] = att::cvtpk((b0 * c4.x + a0 * c4.y) * sc, (b1 * c4.z + a1 * c4.w) * sc); }
                    *(u32x4*)p = o1; *(u32x4*)(p + 32) = o2;
                }
            }
        } else if (k == 2) {
            const float* kg = ap->in[I_KHG] + l * 96;
            for (int it = blockIdx.x * 512 + TID; it < MREAL * 8 + BATCH * NMETA * 8; it += G * 512) {
                const bool ismeta = it >= MREAL * 8; const int mi = it - MREAL * 8;
                const int h = it & 7, bb = ismeta ? mi >> 7 : it >> 14, t = ismeta ? (mi >> 3) & 15 : ((it >> 3) & (SEQ - 1)) + NMETA, m = ismeta ? MR0 + t : it >> 3;
                const f32x4* mt = (const f32x4*)(MT + t * 16);
                { bf16* kn = KVR + (size_t)m * 1024 + 128 * h; bf16* pr = PROJ + (size_t)m * DINP; bf16* ko = KM + ((size_t)(bb * 8 + h) * TT + t) * 96; u32x4 w[8], r[4]; float ssn = 0.f, ssr = 0.f;
#pragma unroll
                  for (int c = 0; c < 8; ++c) w[c] = *(const u32x4*)(kn + 8 * c);
#pragma unroll
                  for (int c = 0; c < 4; ++c) r[c] = *(const u32x4*)(pr + C_KR + 8 * c);
#pragma unroll
                  for (int c = 0; c < 8; ++c)
#pragma unroll
                      for (int e = 0; e < 4; ++e) { const float a0 = bflo(w[c][e]), a1 = bfhi(w[c][e]); ssn += a0 * a0 + a1 * a1; }
#pragma unroll
                  for (int c = 0; c < 4; ++c)
#pragma unroll
                      for (int e = 0; e < 4; ++e) { const float a0 = bflo(r[c][e]), a1 = bfhi(r[c][e]); ssr += a0 * a0 + a1 * a1; }
                  const float rs = 1.0f / sqrtf((ssn + ssr) * (1.f / 96.f) + EPS), rn = rs;
#pragma unroll
                  for (int c = 0; c < 8; ++c) { u32x4 o;
#pragma unroll
                      for (int e = 0; e < 4; ++e) o[e] = att::cvtpk(bflo(w[c][e]) * rn * kg[8 * c + 2 * e], bfhi(w[c][e]) * rn * kg[8 * c + 2 * e + 1]);
                      *(u32x4*)(ko + 8 * c) = o; }
#pragma unroll
                  for (int cc = 0; cc < 2; ++cc) { u32x4 o1, o2;
#pragma unroll
                      for (int e = 0; e < 4; ++e) { const int i = 8 * cc + 2 * e; const f32x4 c4 = mt[4 * cc + e];
                          const float a0 = bflo(r[cc][e]) * rs * kg[64 + i], a1 = bfhi(r[cc][e]) * rs * kg[64 + i + 1], b0 = bflo(r[2 + cc][e]) * rs * kg[80 + i], b1 = bfhi(r[2 + cc][e]) * rs * kg[80 + i + 1];
                          o1[e] = att::cvtpk(a0 * c4.x - b0 * c4.y, a1 * c4.z - b1 * c4.w); o2[e] = att::cvtpk(b0 * c4.x + a0 * c4.y, b1 * c4.z + a1 * c4.w); }
                      *(u32x4*)(ko + 64 + 8 * cc) = o1; *(u32x4*)(ko + 80 + 8 * cc) = o2; }
                }
            }
        } else {
            for (int item = blockIdx.x; item < 524; item += G) {
                if (item < 256 || (item >= 512 && item < 520)) { const bool meta = item >= 512; const int b = meta ? 0 : item >> 3, h = item & 7;
                    const bf16* Qp = QRAW + 96 * h; const bf16* Kp = KM + (size_t)(b * 8 + h) * TT * 96; const bf16* Vp = KVR + 128 * h + 64; bf16* Op = MIX + 512 + 64 * h;
                    if (meta) att::unit<96, true>(lds, Qp, 768, Kp, 96, Vp, 1024, Op, DM, nullptr, 0, nullptr, 0.f, b, 0, 16, wave * 64, SQA, ap->in[I_QHG] + l * 96, MT, 1);
                    else for (int blk = 8; blk >= 1; --blk) { const int q0 = 16 + 256 * (blk - 1);
                        att::unit<96, true>(lds, Qp, 768, Kp, 96, Vp, 1024, Op, DM, nullptr, 0, nullptr, 0.f, b, q0, q0 + 256, wave * 64, SQA, ap->in[I_QHG] + l * 96, MT, 1); }
                } else { const bool meta = item >= 520; const int it = item - 256, bh = ((it >> 4) << 3) | (it & 7), hf = (it >> 3) & 1  , b = meta ? 0 : bh >> 2, h = meta ? item - 520 : bh & 3;
                    const bf16* Pp = PROJ + 64 * h; bf16* Op = MIX + 256 + 64 * h; const float* gn = ap->in[I_RETG] + l * 256 + 64 * h;
                    const float lg2 = log2f(1.0f - exp2f(-5.0f - (float)h)); const unsigned bm = hf ? 0x0CCu : 0x132u;
                    if (meta) att::unit<64, false>(lds, Pp + C_RQ, DINP, Pp + C_RK, DINP, Pp + C_RV, DINP, Op, DM, Pp + C_RG, DINP, gn, lg2, b, 0, 16, wave * 64, nullptr, nullptr, nullptr, 0);
                    else for (int blk = 8; blk >= 1; --blk) { if (!((bm >> blk) & 1u)) continue; const int q0 = 16 + 256 * (blk - 1);
                        att::unit<64, false>(lds, Pp + C_RQ, DINP, Pp + C_RK, DINP, Pp + C_RV, DINP, Op, DM, Pp + C_RG, DINP, gn, lg2, b, q0, q0 + 256, wave * 64, nullptr, nullptr, nullptr, 0); }
                }
            }
        }
        if (ph + 1 < hi) {
            if (lo < 0) grid.sync();
            { XcdBarrier xbar; xbar.bar = (unsigned*)ws; xbar.x = xb_xcc_id(); xbar.st = (volatile LAS unsigned*)(lds + XB_LDS_OFF); xcd_barrier(xbar); }
        }
    }
}
#undef LANE
#undef TID

extern "C" void kernel_launch(void* const* d_in, const int* in_sizes, int n_in, void* d_out, int out_size, void* d_ws, size_t ws_size, hipStream_t stream) {
    static int grid = 0;
    if (grid == 0) {
        if (n_in != 16 || out_size != MREAL * DM || ws_size < WS_END) { fprintf(stderr, "kernel_launch: unexpected shapes (n_in %d, out %d, ws %zu)\n", n_in, out_size, ws_size); grid = -1; return; }
        int dev = 0, cus = 0, per_cu = 0;
        if (hipGetDevice(&dev) != hipSuccess || hipDeviceGetAttribute(&cus, hipDeviceAttributeMultiprocessorCount, dev) != hipSuccess) { grid = -1; return; }
        if (hipFuncSetAttribute((const void*)hybrid_fwd, hipFuncAttributeMaxDynamicSharedMemorySize, LDS_BYTES) != hipSuccess) { fprintf(stderr, "kernel_launch: hipFuncSetAttribute failed\n"); grid = -1; return; }
        if (hipOccupancyMaxActiveBlocksPerMultiprocessor(&per_cu, (const void*)hybrid_fwd, NWAVES * 64, LDS_BYTES) != hipSuccess || per_cu < 1) { fprintf(stderr, "kernel_launch: occupancy query says %d\n", per_cu); per_cu = 1; }
        (void)hipGetLastError();
        grid = cus;
    }
    if (grid < 0) return;
    if (hipMemsetAsync(d_ws, 0, 16384, stream) != hipSuccess) { fprintf(stderr, "kernel_launch: hipMemsetAsync of the barrier words failed\n"); return; }
    Args a{};
    for (int i = 0; i < 16; ++i) a.in[i] = (const float*)d_in[i];
    a.out = (float*)d_out; a.ws = (unsigned char*)d_ws;
#if MK_MULTI
    for (int ph = 0; ph < NPHASE; ++ph) { a.ph_lo = ph; a.ph_hi = ph + 1; hipLaunchKernelGGL(hybrid_fwd, dim3(grid), dim3(NWAVES * 64), LDS_BYTES, stream, a); }
#else
    a.ph_lo = 0; a.ph_hi = NPHASE;
    void* kargs[] = {&a};
    const hipError_t e = hipLaunchCooperativeKernel((const void*)hybrid_fwd, dim3(grid), dim3(NWAVES * 64), kargs, LDS_BYTES, stream);
    if (e != hipSuccess) fprintf(stderr, "kernel_launch: cooperative launch failed: %s (grid %d)\n", hipGetErrorString(e), grid);
#endif
}
```
